# Optimizing an MI355X kernel written in HIP

```python
import jax, jax.numpy as jnp
from jax import lax
import numpy as np

D_MODEL = 2048
BATCH = 2
SEQ = 4096
DEPTH = 1

HEAD_DIM = 128
MIX_WIDTH = D_MODEL
A_WIDTH = MIX_WIDTH // 2
B_WIDTH = MIX_WIDTH - A_WIDTH
A_HEADS = A_WIDTH // HEAD_DIM
B_SUB_DIM = HEAD_DIM // 2
B_HEADS = B_WIDTH // (2 * B_SUB_DIM)
B_VDIM = 2 * B_SUB_DIM
IN_WIDTH = 3 * A_WIDTH + 3 * B_WIDTH
D_FF = 5632
ROPE_THETA = 500000.0
ROPE_FRACTION = 4
DILATED_PATTERNS = ((128, 1), (512, 4), (2048, 16))
Q_BLOCK = 128
EPS = 1e-6

kernel_name = "hybrid_dilated_diff_macaron_block"


def rms_norm(x, g):
    x32 = x.astype(jnp.float32)
    y = x32 * lax.rsqrt(jnp.mean(x32 * x32, axis=-1, keepdims=True) + EPS)
    return (y * g.astype(jnp.float32)).astype(x.dtype)


def swiglu_ffn(x, g, w_in, w_out):
    h = rms_norm(x, g)
    gate, up = jnp.split(h @ w_in, 2, axis=-1)
    return (jax.nn.silu(gate) * up) @ w_out


def partial_rope(x):
    S, hd = x.shape[1], x.shape[-1]
    rd = hd // ROPE_FRACTION
    half = rd // 2
    inv = ROPE_THETA ** (-jnp.arange(0, rd, 2, dtype=jnp.float32) / rd)
    ang = jnp.arange(S, dtype=jnp.float32)[:, None] * inv[None, :]
    bshape = (S,) + (1,) * (x.ndim - 3) + (half,)
    cos = jnp.cos(ang).reshape(bshape).astype(x.dtype)
    sin = jnp.sin(ang).reshape(bshape).astype(x.dtype)
    x1, x2, xp = x[..., :half], x[..., half:rd], x[..., rd:]
    return jnp.concatenate([x1 * cos - x2 * sin, x2 * cos + x1 * sin, xp], axis=-1)


def dilated_offsets():
    offs = []
    for window, dil in DILATED_PATTERNS:
        half = window // (2 * dil)
        offs.append(dil * jnp.arange(-half, half + 1, dtype=jnp.int32))
    return offs


def dilated_mixture_attention(q, k, v):
    B, H, S, hd = q.shape
    scale = hd ** -0.5
    offsets = dilated_offsets()

    def block(i):
        start = i * Q_BLOCK
        qb = lax.dynamic_slice_in_dim(q, start, Q_BLOCK, axis=2)
        pos = start + jnp.arange(Q_BLOCK, dtype=jnp.int32)
        outs, lses = [], []
        for offs in offsets:
            kpos = pos[:, None] + offs[None, :]
            valid = (kpos >= 0) & (kpos < S)
            idx = jnp.clip(kpos, 0, S - 1)
            kg = k[:, :, idx]
            vg = v[:, :, idx]
            s = jnp.einsum('bhqd,bhqkd->bhqk', qb, kg).astype(jnp.float32) * scale
            s = jnp.where(valid[None, None], s, -jnp.inf)
            lse = jax.nn.logsumexp(s, axis=-1)
            p = jnp.exp(s - lse[..., None])
            outs.append(jnp.einsum('bhqk,bhqkd->bhqd', p.astype(v.dtype), vg))
            lses.append(lse)
        o = jnp.stack(outs, axis=3)
        w = jax.nn.softmax(jnp.stack(lses, axis=-1), axis=-1)
        return jnp.einsum('bhqg,bhqgd->bhqd', w.astype(v.dtype), o)

    out = lax.map(block, jnp.arange(S // Q_BLOCK))
    return out.transpose(1, 2, 0, 3, 4).reshape(B, H, S, hd)


def differential_attention(q, k, v, lam):
    B, H, S = q.shape[:3]
    scale = q.shape[-1] ** -0.5

    def block(i):
        qb = lax.dynamic_slice_in_dim(q, i * Q_BLOCK, Q_BLOCK, axis=2)
        s = jnp.einsum('bhqcd,bhkcd->bhcqk', qb, k).astype(jnp.float32) * scale
        p = jax.nn.softmax(s, axis=-1)
        a = p[:, :, 0] - lam * p[:, :, 1]
        return jnp.einsum('bhqk,bhkd->bhqd', a.astype(v.dtype), v)

    out = lax.map(block, jnp.arange(S // Q_BLOCK))
    return out.transpose(1, 2, 0, 3, 4).reshape(B, H, S, v.shape[-1])


def hybrid_layer(x, layer_idx, ffn1_norm, ffn1_w_in, ffn1_w_out, mix_norm, w_in,
                 a_q_norm, a_k_norm, b_q_norm, b_k_norm,
                 lambda_q1, lambda_k1, lambda_q2, lambda_k2,
                 a_out_norm, b_out_norm, w_out, ffn2_norm, ffn2_w_in, ffn2_w_out):
    B, S, _ = x.shape
    x = x + 0.5 * swiglu_ffn(x, ffn1_norm, ffn1_w_in, ffn1_w_out)

    h = rms_norm(x, mix_norm)
    proj = h @ w_in
    a_q, a_k, a_v, b_q, b_k, b_v = jnp.split(
        proj, np.cumsum([A_WIDTH] * 3 + [B_WIDTH] * 2).tolist(), axis=-1)

    a_q = partial_rope(rms_norm(a_q.reshape(B, S, A_HEADS, HEAD_DIM), a_q_norm))
    a_k = partial_rope(rms_norm(a_k.reshape(B, S, A_HEADS, HEAD_DIM), a_k_norm))
    a_v = a_v.reshape(B, S, A_HEADS, HEAD_DIM)
    a_o = dilated_mixture_attention(a_q.transpose(0, 2, 1, 3), a_k.transpose(0, 2, 1, 3),
                                    a_v.transpose(0, 2, 1, 3))
    a_o = rms_norm(a_o, a_out_norm)

    b_q = partial_rope(rms_norm(b_q.reshape(B, S, B_HEADS, 2, B_SUB_DIM), b_q_norm))
    b_k = partial_rope(rms_norm(b_k.reshape(B, S, B_HEADS, 2, B_SUB_DIM), b_k_norm))
    b_v = b_v.reshape(B, S, B_HEADS, B_VDIM)
    lambda_init = 0.8 - 0.6 * float(np.exp(-0.3 * layer_idx))
    lam = (jnp.exp(jnp.sum(lambda_q1.astype(jnp.float32) * lambda_k1.astype(jnp.float32)))
           - jnp.exp(jnp.sum(lambda_q2.astype(jnp.float32) * lambda_k2.astype(jnp.float32)))
           + lambda_init)
    b_o = differential_attention(b_q.transpose(0, 2, 1, 3, 4), b_k.transpose(0, 2, 1, 3, 4),
                                 b_v.transpose(0, 2, 1, 3), lam)
    b_o = rms_norm(b_o, b_out_norm) * (1.0 - lambda_init)

    mixed = jnp.concatenate([a_o.transpose(0, 2, 1, 3).reshape(B, S, A_WIDTH),
                             b_o.transpose(0, 2, 1, 3).reshape(B, S, B_WIDTH)], axis=-1)
    x = x + mixed @ w_out

    x = x + 0.5 * swiglu_ffn(x, ffn2_norm, ffn2_w_in, ffn2_w_out)
    return x


def setup_inputs(seed: int = 0) -> dict:
    key = jax.random.key(seed)
    ks = jax.random.split(key, 20)
    f32 = jnp.float32

    def nrm(k, shape, scale):
        return jax.random.normal(k, shape, f32) * scale

    def gain(k, shape):
        return 1.0 + 0.02 * jax.random.normal(k, shape, f32)

    return {
        "x": jax.random.normal(ks[0], (BATCH, SEQ, D_MODEL), f32),
        "ffn1_norm": gain(ks[1], (DEPTH, D_MODEL)),
        "ffn1_w_in": nrm(ks[2], (DEPTH, D_MODEL, 2 * D_FF), D_MODEL ** -0.5),
        "ffn1_w_out": nrm(ks[3], (DEPTH, D_FF, D_MODEL), D_FF ** -0.5),
        "mix_norm": gain(ks[4], (DEPTH, D_MODEL)),
        "w_in": nrm(ks[5], (DEPTH, D_MODEL, IN_WIDTH), D_MODEL ** -0.5),
        "a_q_norm": gain(ks[6], (DEPTH, HEAD_DIM)),
        "a_k_norm": gain(ks[7], (DEPTH, HEAD_DIM)),
        "b_q_norm": gain(ks[8], (DEPTH, B_SUB_DIM)),
        "b_k_norm": gain(ks[9], (DEPTH, B_SUB_DIM)),
        "lambda_q1": nrm(ks[10], (DEPTH, B_SUB_DIM), 0.1),
        "lambda_k1": nrm(ks[11], (DEPTH, B_SUB_DIM), 0.1),
        "lambda_q2": nrm(ks[12], (DEPTH, B_SUB_DIM), 0.1),
        "lambda_k2": nrm(ks[13], (DEPTH, B_SUB_DIM), 0.1),
        "a_out_norm": gain(ks[14], (DEPTH, HEAD_DIM)),
        "b_out_norm": gain(ks[15], (DEPTH, B_VDIM)),
        "w_out": nrm(ks[16], (DEPTH, MIX_WIDTH, D_MODEL), MIX_WIDTH ** -0.5),
        "ffn2_norm": gain(ks[17], (DEPTH, D_MODEL)),
        "ffn2_w_in": nrm(ks[18], (DEPTH, D_MODEL, 2 * D_FF), D_MODEL ** -0.5),
        "ffn2_w_out": nrm(ks[19], (DEPTH, D_FF, D_MODEL), D_FF ** -0.5),
    }


def reference(x, ffn1_norm, ffn1_w_in, ffn1_w_out, mix_norm, w_in,
              a_q_norm, a_k_norm, b_q_norm, b_k_norm,
              lambda_q1, lambda_k1, lambda_q2, lambda_k2,
              a_out_norm, b_out_norm, w_out, ffn2_norm, ffn2_w_in, ffn2_w_out):
    for l in range(DEPTH):
        x = hybrid_layer(x, l, ffn1_norm[l], ffn1_w_in[l], ffn1_w_out[l], mix_norm[l], w_in[l],
                         a_q_norm[l], a_k_norm[l], b_q_norm[l], b_k_norm[l],
                         lambda_q1[l], lambda_k1[l], lambda_q2[l], lambda_k2[l],
                         a_out_norm[l], b_out_norm[l], w_out[l],
                         ffn2_norm[l], ffn2_w_in[l], ffn2_w_out[l])
    return x
```

```cpp
#include <hip/hip_runtime.h>
#include <hip/hip_cooperative_groups.h>
#include <cstdio>
#include <cstdint>
#include <cmath>
namespace cg = cooperative_groups;
namespace pg8 {
#define PG8_LAS __attribute__((address_space(3)))
typedef unsigned short bf16_t;
typedef short bf16x8 __attribute__((ext_vector_type(8)));
typedef float f32x4 __attribute__((ext_vector_type(4)));
typedef unsigned u32x4 __attribute__((ext_vector_type(4)));
constexpr int BM = 256, BK = 64, HALF = 128, HTB = HALF * BK * 2  , STAGE_BYTES = 8 * HTB, NXCD = 8, WGM = 8;

__host__ __device__ __forceinline__ int lds_byte(int r, int c) { const int st = (r >> 4) * 2 + (c >> 5), rr = r & 15, cc = c & 31, ob = rr * 64 + cc * 2; return st * 1024 + (ob ^ (((ob >> 9) & 1) << 5)); }
__host__ __device__ __forceinline__ void stage_rc(int b, int& R, int& C) { const int st = b / 1024, sb = b % 1024, swz = sb ^ (((sb >> 9) & 1) << 5); R = (st >> 1) * 16 + swz / 64; C = (st & 1) * 32 + (swz % 64) / 2; }
__host__ __device__ __forceinline__ int perm32(int rho) { const int n = rho >> 4, i = rho & 15; return 8 * (i >> 2) + 4 * n + (i & 3); }

struct Unit { int pm, pn; };
struct Gemm { const bf16_t* A; const bf16_t* Bt; int M, N, K; };

struct StaticOrder {
    int nM, nN, nwg, G, c;
    __host__ __device__ void init(int M, int N, int G_, int c_) { nM = M / BM; nN = N / BM; nwg = nM * nN; G = G_; c = c_; }
    __host__ __device__ bool next(int i, Unit& u) const {
        const long L = (long)i * G + c; if (L >= nwg) return false;
        int wgid = (int)L; { const int q = nwg / NXCD, r = nwg % NXCD, xcd = wgid % NXCD, off = wgid / NXCD; wgid = (xcd < r ? xcd * (q + 1) : r * (q + 1) + (xcd - r) * q) + off; }
        const int nig = WGM * nN, gid = wgid / nig, fm = gid * WGM, gsz = (nM - fm) < WGM ? (nM - fm) : WGM;
        u.pm = fm + ((wgid % nig) % gsz); u.pn = (wgid % nig) / gsz; return true;
    }
    __device__ __forceinline__ void a_ready(const Unit&) const {}
    __device__ __forceinline__ void done(const Unit&) const {}
};

__device__ __forceinline__ unsigned cvt_pk_bf16(float lo, float hi) { unsigned r; asm volatile("v_cvt_pk_bf16_f32 %0, %1, %2" : "=v"(r) : "v"(lo), "v"(hi)); return r; }
typedef float f32x2 __attribute__((ext_vector_type(2)));

typedef unsigned u32x2 __attribute__((ext_vector_type(2)));
__device__ __forceinline__ float fast_silu(float g) { return g * __builtin_amdgcn_rcpf(1.0f + __expf(-g)); }

struct EpiSwiGLU {
    static constexpr bool PERM = true, AFTER_DRAIN = false;
    bf16_t* O; int ldc; const float* rowss;
    __device__ __forceinline__ void operator()(f32x4 (&acc)[2][2][4][2], const Unit& u, int wr, int wc, int fr, int fq) const {
        const int row0 = u.pm * BM + wr * 64 + fr; const int col0 = u.pn * HALF + wc * 32 + 8 * fq;
#pragma unroll
        for (int ai = 0; ai < 2; ++ai)
#pragma unroll
            for (int m = 0; m < 4; ++m) {
                const int row = row0 + ai * HALF + m * 16;
                float rs = 1.0f; if (rowss) rs = __builtin_amdgcn_rsqf(rowss[row] * (1.0f / 2048.0f) + 1e-6f);
                f32x4 g0 = acc[ai][0][m][0] * rs, g1 = acc[ai][0][m][1] * rs, u0 = acc[ai][1][m][0] * rs, u1 = acc[ai][1][m][1] * rs;
                u32x4 w;
                w.x = cvt_pk_bf16(fast_silu(g0[0]) * u0[0], fast_silu(g0[1]) * u0[1]); w.y = cvt_pk_bf16(fast_silu(g0[2]) * u0[2], fast_silu(g0[3]) * u0[3]);
                w.z = cvt_pk_bf16(fast_silu(g1[0]) * u1[0], fast_silu(g1[1]) * u1[1]); w.w = cvt_pk_bf16(fast_silu(g1[2]) * u1[2], fast_silu(g1[3]) * u1[3]);
                *(u32x4*)(O + (size_t)row * ldc + col0) = w;
            }
    }
};

template <bool NORMOUT> struct EpiResid {
    static constexpr bool PERM = false, AFTER_DRAIN = false;
    const float* base; float* out; float alpha; bf16_t* xn; const float* gain; float* rowss;
    __device__ __forceinline__ void operator()(f32x4 (&acc)[2][2][4][2], const Unit& u, int wr, int wc, int fr, int fq) const {
        const int row0 = u.pm * BM + wr * 64 + fr; const int col0 = u.pn * BM + wc * 32 + 4 * fq;
        f32x4 gv[2][2];
        if (NORMOUT) {
#pragma unroll
            for (int bj = 0; bj < 2; ++bj)
#pragma unroll
                for (int n = 0; n < 2; ++n) gv[bj][n] = *(const f32x4*)(gain + col0 + bj * HALF + n * 16);
        }
#pragma unroll
        for (int ai = 0; ai < 2; ++ai)
#pragma unroll
            for (int m = 0; m < 4; ++m) {
                const int row = row0 + ai * HALF + m * 16; const size_t off = (size_t)row * 2048 + col0; float ss = 0.f;
#pragma unroll
                for (int bj = 0; bj < 2; ++bj)
#pragma unroll
                    for (int n = 0; n < 2; ++n) {
                        const f32x4 b = *(const f32x4*)(base + off + bj * HALF + n * 16);
                        const f32x4 o = b + acc[ai][bj][m][n] * alpha;
                        *(f32x4*)(out + off + bj * HALF + n * 16) = o;
                        if (NORMOUT) {
                            ss += (o[0] * o[0] + o[1] * o[1]) + (o[2] * o[2] + o[3] * o[3]);
                            const f32x4 t = o * gv[bj][n]; u32x2 w; w.x = cvt_pk_bf16(t[0], t[1]); w.y = cvt_pk_bf16(t[2], t[3]);
                            *(u32x2*)(xn + off + bj * HALF + n * 16) = w;
                        }
                    }
                if (NORMOUT) { ss += __shfl_xor(ss, 16); ss += __shfl_xor(ss, 32); if (fq == 0) atomicAdd(rowss + row, ss); }
                asm volatile("" ::: "memory");
            }
    }
};

struct EpiQKV {
    static constexpr bool PERM = false, AFTER_DRAIN = false;
    bf16_t* O; const float* rowss; const float* gtab;
    const float* ropeA; const float* ropeB;
    PG8_LAS float* xch;
    __device__ __forceinline__ void operator()(f32x4 (&acc)[2][2][4][2], const Unit& u, int wr, int wc, int fr, int fq) const {
        asm volatile("" : "+v"(fr), "+v"(fq));
        const int region = u.pn >> 2;
        const int row0 = u.pm * BM + wr * 64 + fr;
#pragma unroll
        for (int ai = 0; ai < 2; ++ai)
#pragma unroll
            for (int m = 0; m < 4; ++m) {
                const float rs = __builtin_amdgcn_rsqf(rowss[row0 + ai * HALF + m * 16] * (1.0f / 2048.0f) + 1e-6f);
#pragma unroll
                for (int bj = 0; bj < 2; ++bj)
#pragma unroll
                    for (int n = 0; n < 2; ++n) acc[ai][bj][m][n] = acc[ai][bj][m][n] * rs;
            }
        const bool isv = (region == 2) || (region == 5);
        if (!isv) {
            const bool isA = region < 2;
#pragma unroll
            for (int ai = 0; ai < 2; ++ai)
#pragma unroll
                for (int m = 0; m < 4; ++m)
#pragma unroll
                    for (int bj = 0; bj < 2; ++bj) {
                        const f32x4 a = acc[ai][bj][m][0], b = acc[ai][bj][m][1];
                        float s = ((a[0] * a[0] + a[1] * a[1]) + (a[2] * a[2] + a[3] * a[3])) + ((b[0] * b[0] + b[1] * b[1]) + (b[2] * b[2] + b[3] * b[3]));
                        s += __shfl_xor(s, 16); s += __shfl_xor(s, 32);
                        if (fq == 0) xch[((ai * HALF + wr * 64 + m * 16 + fr) * 2 + bj) * 4 + wc] = s;
                    }
            asm volatile("s_waitcnt lgkmcnt(0)" ::: "memory"); __builtin_amdgcn_s_barrier(); asm volatile("" ::: "memory");
            const float* gptr = gtab + (region < 2 ? region : region - 1) * 128;
            const int dbase = isA ? wc * 32 : (wc & 1) * 32;
            f32x4 gv[2]; gv[0] = *(const f32x4*)(gptr + dbase + 4 * fq); gv[1] = *(const f32x4*)(gptr + dbase + 16 + 4 * fq);
            const float qs = region == 0 ? (0.08838834764831845f * 1.4426950408889634f) : (region == 3 ? (0.125f * 1.4426950408889634f) : 1.0f);
#pragma unroll
            for (int ai = 0; ai < 2; ++ai)
#pragma unroll
                for (int m = 0; m < 4; ++m) {
                    const int rl = ai * HALF + wr * 64 + m * 16 + fr; const int spos = (u.pm * BM + rl) & 4095;
#pragma unroll
                    for (int bj = 0; bj < 2; ++bj) {
                        const f32x4 p = *(const PG8_LAS f32x4*)(xch + (rl * 2 + bj) * 4);
                        float rn;
                        if (isA) rn = __builtin_amdgcn_rsqf(((p[0] + p[1]) + (p[2] + p[3])) * (1.0f / 128.0f) + 1e-6f);
                        else rn = __builtin_amdgcn_rsqf(((wc < 2) ? (p[0] + p[1]) : (p[2] + p[3])) * (1.0f / 64.0f) + 1e-6f);
                        f32x4 v0 = acc[ai][bj][m][0] * rn * gv[0], v1 = acc[ai][bj][m][1] * rn * gv[1];
                        if (isA) {
                            if (wc == 0) {
                                const f32x4 cs = *(const f32x4*)(ropeA + spos * 16 + 4 * fq), sn = *(const f32x4*)(ropeA + 4096 * 16 + spos * 16 + 4 * fq);
                                const f32x4 x1 = v0, x2 = v1; v0 = x1 * cs - x2 * sn; v1 = x2 * cs + x1 * sn;
                            }
                        } else {
                            if ((wc & 1) == 0) {
                                const f32x4 cs = *(const f32x4*)(ropeB + spos * 8 + 4 * (fq & 1)), sn = *(const f32x4*)(ropeB + 4096 * 8 + spos * 8 + 4 * (fq & 1));
                                f32x4 pt; pt[0] = __shfl_xor(v0[0], 32); pt[1] = __shfl_xor(v0[1], 32); pt[2] = __shfl_xor(v0[2], 32); pt[3] = __shfl_xor(v0[3], 32);
                                v0 = (fq < 2) ? (v0 * cs - pt * sn) : (v0 * cs + pt * sn);
                            }
                        }
                        acc[ai][bj][m][0] = v0 * qs; acc[ai][bj][m][1] = v1 * qs;
                    }
                }
        }
        const int col0 = u.pn * BM + wc * 32 + 4 * fq;
#pragma unroll
        for (int ai = 0; ai < 2; ++ai)
#pragma unroll
            for (int m = 0; m < 4; ++m) { bf16_t* rowp = O + (size_t)(row0 + ai * HALF + m * 16) * 6144 + col0;
#pragma unroll
                for (int bj = 0; bj < 2; ++bj)
#pragma unroll
                    for (int n = 0; n < 2; ++n) { const f32x4 v = acc[ai][bj][m][n]; u32x2 w; w.x = cvt_pk_bf16(v[0], v[1]); w.y = cvt_pk_bf16(v[2], v[3]); *(u32x2*)(rowp + bj * HALF + n * 16) = w; } }
    }
};
template <class Epi, class Sched, bool ALIGN_EPI = false, bool SP2 = false>
__device__ __forceinline__ void gemm_phase(PG8_LAS unsigned char* lds, const Gemm g, const Sched& S, const Epi& E) {
    const int tid = threadIdx.x, wid = __builtin_amdgcn_readfirstlane(tid >> 6), lane = tid & 63, wr = wid >> 2, wc = wid & 3, fr = lane & 15, fq = lane >> 4;
    const int K = g.K, nt = K / BK;
    unsigned voffA[2], voffB[2];
#pragma unroll
    for (int i = 0; i < 2; ++i) { int R, C; stage_rc(tid * 16 + i * 8192, R, C); const int Rb = Epi::PERM ? ((R & ~31) + perm32(R & 31)) : R;
        voffA[i] = (unsigned)(R * K + C) * 2u; voffB[i] = (unsigned)(Rb * K + C) * 2u; }
    const size_t kstep = (size_t)(BK * 2);
    const size_t hstep = (size_t)HALF * K * 2;
    const size_t tstep = 2 * hstep;
    const unsigned ldsw = (unsigned)wid * 1024u;
    const int aoff = lds_byte(wr * 64 + fr, fq * 8), boff = lds_byte(wc * 32 + fr, fq * 8);
#define PG8_SA(b, h) (((b) * 2 + (h)) * HTB)
#define PG8_SB(b, h) ((4 + (b) * 2 + (h)) * HTB)
#define PG8_STAGE(bufoff, gbase, voff) do { _Pragma("unroll") for (int _i = 0; _i < 2; ++_i) \
        __builtin_amdgcn_global_load_lds((const unsigned*)((const char*)(gbase) + (voff)[_i]), (PG8_LAS unsigned*)(lds + (bufoff) + ldsw + _i * 8192), 16, 0, 0); } while (0)
#define PG8_LDA(dst, b, h) do { _Pragma("unroll") for (int m = 0; m < 4; ++m) _Pragma("unroll") for (int k = 0; k < 2; ++k) dst[m][k] = *(const PG8_LAS bf16x8*)(lds + PG8_SA(b, h) + aoff + m * 2048 + k * 1024); } while (0)
#define PG8_LDB(dst, b, h) do { _Pragma("unroll") for (int n = 0; n < 2; ++n) _Pragma("unroll") for (int k = 0; k < 2; ++k) dst[n][k] = *(const PG8_LAS bf16x8*)(lds + PG8_SB(b, h) + boff + n * 2048 + k * 1024); } while (0)
#define PG8_MMA(ai, bj, At, Bt) do { __builtin_amdgcn_s_setprio(1); _Pragma("unroll") for (int m = 0; m < 4; ++m) _Pragma("unroll") for (int n = 0; n < 2; ++n) _Pragma("unroll") for (int k = 0; k < 2; ++k) \
        acc[ai][bj][m][n] = __builtin_amdgcn_mfma_f32_16x16x32_bf16(Bt[n][k], At[m][k], acc[ai][bj][m][n], 0, 0, 0); __builtin_amdgcn_s_setprio(0); } while (0)
#define PG8_WAIT_V(n) asm volatile("s_waitcnt vmcnt(" #n ")" ::: "memory")
#define PG8_WAIT_L(n) asm volatile("s_waitcnt lgkmcnt(" #n ")" ::: "memory")
#define PG8_BAR __builtin_amdgcn_s_barrier()
#define PG8_SCHED __builtin_amdgcn_sched_barrier(0)
    Unit cur, nxt; int ui = 0;
    if (!S.next(0, cur)) return;
    f32x4 acc[2][2][4][2];
#pragma unroll
    for (int a = 0; a < 2; ++a)
#pragma unroll
        for (int b = 0; b < 2; ++b)
#pragma unroll
            for (int m = 0; m < 4; ++m)
#pragma unroll
                for (int n = 0; n < 2; ++n) acc[a][b][m][n] = (f32x4){0.f, 0.f, 0.f, 0.f};
    bf16x8 At[4][2], B0[2][2], B1[2][2];
    const char* cA = (const char*)g.A + (size_t)cur.pm * tstep; const char* cB = (const char*)g.Bt + (size_t)cur.pn * tstep;
    S.a_ready(cur);
    if constexpr (SP2) {
        PG8_STAGE(PG8_SB(0, 0), cB, voffB); PG8_STAGE(PG8_SB(0, 1), cB + hstep, voffB); PG8_STAGE(PG8_SA(0, 0), cA, voffA); PG8_STAGE(PG8_SA(0, 1), cA + hstep, voffA);
        if (wr == 1) PG8_BAR;
        PG8_WAIT_V(2); PG8_BAR;
        PG8_STAGE(PG8_SB(1, 0), cB + kstep, voffB); PG8_STAGE(PG8_SA(1, 0), cA + kstep, voffA); PG8_STAGE(PG8_SB(1, 1), cB + hstep + kstep, voffB);
        PG8_WAIT_V(6); PG8_BAR;
    } else {
        PG8_STAGE(PG8_SB(0, 0), cB, voffB); PG8_STAGE(PG8_SA(0, 0), cA, voffA); PG8_STAGE(PG8_SB(0, 1), cB + hstep, voffB); PG8_STAGE(PG8_SA(0, 1), cA + hstep, voffA);
        if (wr == 1) PG8_BAR;
        PG8_WAIT_V(4); PG8_BAR;
        PG8_STAGE(PG8_SB(1, 0), cB + kstep, voffB); PG8_STAGE(PG8_SA(1, 0), cA + kstep, voffA); PG8_STAGE(PG8_SB(1, 1), cB + hstep + kstep, voffB);
        PG8_WAIT_V(6); PG8_BAR;
    }
    for (;;) {
        const bool has_next = S.next(ui + 1, nxt);
        const char* nA = has_next ? (const char*)g.A + (size_t)nxt.pm * tstep : cA; const char* nB = has_next ? (const char*)g.Bt + (size_t)nxt.pn * tstep : cB;
        for (int t = 0; t < nt; t += 2) {
            const bool last = (t == nt - 2);
            const char* a1 = cA + (size_t)(t + 1) * kstep;
            const char* a2 = last ? nA : cA + (size_t)(t + 2) * kstep; const char* b2 = last ? nB : cB + (size_t)(t + 2) * kstep;
            const char* a3 = a2 + kstep; const char* b3 = b2 + kstep;
            if (last && has_next) S.a_ready(nxt);
            if constexpr (SP2) {
            PG8_LDB(B0, 0, 0); PG8_LDB(B1, 0, 1); PG8_SCHED; PG8_LDA(At, 0, 0); PG8_STAGE(PG8_SA(1, 1), a1 + hstep, voffA);
            PG8_WAIT_V(8); PG8_WAIT_L(0); PG8_BAR; PG8_MMA(0, 0, At, B0); PG8_MMA(0, 1, At, B1); PG8_BAR; PG8_SCHED;
            PG8_LDA(At, 0, 1); PG8_STAGE(PG8_SB(0, 0), b2, voffB); PG8_STAGE(PG8_SB(0, 1), b2 + hstep, voffB); PG8_STAGE(PG8_SA(0, 0), a2, voffA);
            PG8_WAIT_V(8); PG8_WAIT_L(0); PG8_BAR; PG8_MMA(1, 0, At, B0); PG8_MMA(1, 1, At, B1); PG8_BAR; PG8_SCHED;
            PG8_LDB(B0, 1, 0); PG8_LDB(B1, 1, 1); PG8_SCHED; PG8_LDA(At, 1, 0); PG8_STAGE(PG8_SA(0, 1), a2 + hstep, voffA);
            PG8_WAIT_V(8); PG8_WAIT_L(0); PG8_BAR; PG8_MMA(0, 0, At, B0); PG8_MMA(0, 1, At, B1); PG8_BAR; PG8_SCHED;
            PG8_LDA(At, 1, 1); PG8_STAGE(PG8_SB(1, 0), b3, voffB); PG8_STAGE(PG8_SB(1, 1), b3 + hstep, voffB); PG8_STAGE(PG8_SA(1, 0), a3, voffA);
            PG8_WAIT_V(8); PG8_WAIT_L(0); PG8_BAR; PG8_MMA(1, 0, At, B0); PG8_MMA(1, 1, At, B1); PG8_BAR; PG8_SCHED;
            } else {
            PG8_LDB(B0, 0, 0); PG8_SCHED; PG8_LDA(At, 0, 0); PG8_STAGE(PG8_SA(1, 1), a1 + hstep, voffA);
            PG8_WAIT_L(8); PG8_BAR; PG8_WAIT_L(0); PG8_MMA(0, 0, At, B0); PG8_BAR; PG8_SCHED;
            PG8_LDB(B1, 0, 1); PG8_STAGE(PG8_SB(0, 0), b2, voffB);
            PG8_BAR; PG8_WAIT_L(0); PG8_MMA(0, 1, At, B1); PG8_BAR;
            PG8_LDA(At, 0, 1); PG8_STAGE(PG8_SA(0, 0), a2, voffA);
            PG8_BAR; PG8_WAIT_L(0); PG8_MMA(1, 0, At, B0); PG8_BAR; PG8_SCHED;
            PG8_STAGE(PG8_SB(0, 1), b2 + hstep, voffB);
            PG8_WAIT_V(6); PG8_BAR; PG8_MMA(1, 1, At, B1); PG8_BAR;
            PG8_LDB(B0, 1, 0); PG8_SCHED; PG8_LDA(At, 1, 0); PG8_STAGE(PG8_SA(0, 1), a2 + hstep, voffA);
            PG8_WAIT_L(8); PG8_BAR; PG8_WAIT_L(0); PG8_MMA(0, 0, At, B0); PG8_BAR; PG8_SCHED;
            PG8_LDB(B1, 1, 1); PG8_STAGE(PG8_SB(1, 0), b3, voffB);
            PG8_BAR; PG8_WAIT_L(0); PG8_MMA(0, 1, At, B1); PG8_BAR;
            PG8_LDA(At, 1, 1); PG8_STAGE(PG8_SA(1, 0), a3, voffA);
            PG8_BAR; PG8_WAIT_L(0); PG8_MMA(1, 0, At, B0); PG8_BAR; PG8_SCHED;
            PG8_STAGE(PG8_SB(1, 1), b3 + hstep, voffB);
            PG8_WAIT_V(6); PG8_BAR; PG8_MMA(1, 1, At, B1); PG8_BAR;
            }
        }
        if constexpr (ALIGN_EPI) { if (wr == 0) PG8_BAR; }
        if constexpr (!Epi::AFTER_DRAIN) { E(acc, cur, wr, wc, fr, fq); S.done(cur); }
        if (!has_next) break;
#pragma unroll
        for (int a = 0; a < 2; ++a)
#pragma unroll
            for (int b = 0; b < 2; ++b)
#pragma unroll
                for (int m = 0; m < 4; ++m)
#pragma unroll
                    for (int n = 0; n < 2; ++n) acc[a][b][m][n] = (f32x4){0.f, 0.f, 0.f, 0.f};
        cur = nxt; cA = nA; cB = nB; ++ui;
        if constexpr (ALIGN_EPI) { if (wr == 1) PG8_BAR; }
    }
    PG8_WAIT_V(0);
    if constexpr (!ALIGN_EPI) { if (wr == 0) PG8_BAR; }
    PG8_BAR;
    if constexpr (Epi::AFTER_DRAIN) { E.fused(acc, cur, wr, wc, fr, fq, lds, wid, lane); S.done(cur); }
#undef PG8_SA
#undef PG8_SB
#undef PG8_STAGE
#undef PG8_LDA
#undef PG8_LDB
#undef PG8_MMA
#undef PG8_WAIT_V
#undef PG8_WAIT_L
#undef PG8_BAR
#undef PG8_SCHED
}
}

namespace att {
#define LAS __attribute__((address_space(3)))
typedef unsigned short bf16_t;
typedef short bf16x8 __attribute__((ext_vector_type(8)));
typedef short s16x4 __attribute__((ext_vector_type(4)));
typedef short v4i16_t __attribute__((ext_vector_type(4)));
typedef float f32x16 __attribute__((ext_vector_type(16)));
typedef float f32x4 __attribute__((ext_vector_type(4)));
typedef unsigned u32x4 __attribute__((ext_vector_type(4)));
typedef unsigned u32x2 __attribute__((ext_vector_type(2)));
typedef float f32x2_t __attribute__((ext_vector_type(2))); typedef __bf16 bf16x2_t __attribute__((ext_vector_type(2)));
constexpr int SEQ = 4096, INW = 6144, DMODEL = 2048;
constexpr int KP = 272, VP = 320;
constexpr int DIFF_TILE = 64 * KP + 64 * VP;
constexpr int DIL_WAVE = 32 * KP + 32 * VP;
__device__ __forceinline__ unsigned cvtpk(float lo, float hi) { f32x2_t v = {lo, hi}; bf16x2_t b = __builtin_convertvector(v, bf16x2_t); return __builtin_bit_cast(unsigned, b); }
__device__ __forceinline__ int crow(int r, int hi) { return (r & 3) + 8 * (r >> 2) + 4 * hi; }
__device__ __forceinline__ s16x4 vtr(const LAS char* p) { return __builtin_bit_cast(s16x4, __builtin_amdgcn_ds_read_tr16_b64_v4i16((LAS v4i16_t*)p)); }
__device__ __forceinline__ bf16x8 packp(const f32x16& p, int s) {
    u32x4 w; w.x = cvtpk(p[8 * s], p[8 * s + 1]); w.y = cvtpk(p[8 * s + 2], p[8 * s + 3]); w.z = cvtpk(p[8 * s + 4], p[8 * s + 5]); w.w = cvtpk(p[8 * s + 6], p[8 * s + 7]);
    return __builtin_bit_cast(bf16x8, w);
}
#define MFMA32(a, b, c) __builtin_amdgcn_mfma_f32_32x32x16_bf16((a), (b), (c), 0, 0, 0)

__device__ __forceinline__ void diff_unit(LAS char* lds, const bf16_t* QKV, bf16_t* MIX, int b, int h, int qblk, float lam, float negM, const float* g_bout, int tid, int wid, int lane) {
    const int c = wid >> 2, r32 = lane & 31, hh = lane >> 5, cb = (lane >> 4) & 1, q_ = (lane & 15) >> 2, p_ = lane & 3;
    const size_t rowbase = (size_t)b * SEQ; const int q0 = qblk * 128 + (wid & 3) * 32;
    bf16x8 qf[4];
    { const bf16_t* qp = QKV + (rowbase + q0 + r32) * INW + 3072 + h * 128 + c * 64 + 8 * hh;
#pragma unroll
      for (int ks = 0; ks < 4; ++ks) qf[ks] = *(const bf16x8*)(qp + 16 * ks); }
    const int srow = tid >> 4, sch = tid & 15;
    const bf16_t* kg = QKV + (rowbase + srow) * INW + 4096 + h * 128 + sch * 8;
    const bf16_t* vg = kg + 1024;
    LAS char* kst = lds + srow * KP + sch * 16; LAS char* vst = lds + 64 * KP + srow * VP + sch * 16;
    f32x16 o[4];
#pragma unroll
    for (int i = 0; i < 4; ++i)
#pragma unroll
        for (int r = 0; r < 16; ++r) o[i][r] = 0.f;
    float lsum = 0.f;
    f32x16 negm;
#pragma unroll
    for (int r = 0; r < 16; ++r) negm[r] = negM;
    u32x4 kr0, kr1, vr0, vr1;
    kr0 = *(const u32x4*)(kg); kr1 = *(const u32x4*)(kg + (size_t)32 * INW); vr0 = *(const u32x4*)(vg); vr1 = *(const u32x4*)(vg + (size_t)32 * INW);
    *(LAS u32x4*)(kst) = kr0; *(LAS u32x4*)(kst + 32 * KP) = kr1; *(LAS u32x4*)(vst) = vr0; *(LAS u32x4*)(vst + 32 * VP) = vr1;
    __syncthreads();
    const int NT = SEQ / 64;
    const LAS char* kread = lds + r32 * KP + (c * 64 + 8 * hh) * 2;
    const LAS char* vread = lds + 64 * KP + (4 * hh + q_) * VP + (16 * cb + 4 * p_) * 2;
    for (int t = 0; t < NT; ++t) {
        const int cur = (t & 1) * DIFF_TILE, nxt = DIFF_TILE - cur;
        if (t + 1 < NT) { const size_t go = (size_t)(t + 1) * 64 * INW;
            kr0 = *(const u32x4*)(kg + go); kr1 = *(const u32x4*)(kg + go + (size_t)32 * INW); vr0 = *(const u32x4*)(vg + go); vr1 = *(const u32x4*)(vg + go + (size_t)32 * INW); }
        f32x16 p0 = negm, p1 = negm;
#pragma unroll
        for (int ks = 0; ks < 4; ++ks) {
            const bf16x8 k0 = *(const LAS bf16x8*)(kread + cur + ks * 32), k1 = *(const LAS bf16x8*)(kread + cur + 32 * KP + ks * 32);
            p0 = MFMA32(k0, qf[ks], p0); p1 = MFMA32(k1, qf[ks], p1);
        }
        float sa = 0.f, sb = 0.f;
#pragma unroll
        for (int r = 0; r < 16; ++r) { p0[r] = __builtin_amdgcn_exp2f(p0[r]); p1[r] = __builtin_amdgcn_exp2f(p1[r]); sa += p0[r]; sb += p1[r]; }
        lsum += sa + sb;
        bf16x8 pf[4]; pf[0] = packp(p0, 0); pf[1] = packp(p0, 1); pf[2] = packp(p1, 0); pf[3] = packp(p1, 1);
#pragma unroll
        for (int kst4 = 0; kst4 < 4; ++kst4)
#pragma unroll
            for (int db = 0; db < 4; ++db) {
                const LAS char* a = vread + cur + kst4 * 16 * VP + db * 64;
                const s16x4 lo = vtr(a), hi = vtr(a + 8 * VP);
                const bf16x8 vf = __builtin_shufflevector(lo, hi, 0, 1, 2, 3, 4, 5, 6, 7);
                o[db] = MFMA32(vf, pf[kst4], o[db]);
            }
        if (t + 1 < NT) { *(LAS u32x4*)(kst + nxt) = kr0; *(LAS u32x4*)(kst + nxt + 32 * KP) = kr1; *(LAS u32x4*)(vst + nxt) = vr0; *(LAS u32x4*)(vst + nxt + 32 * VP) = vr1; }
        __syncthreads();
    }
    lsum += __shfl_xor(lsum, 32);
    float inv = 1.0f / lsum; if (c == 1) inv *= lam;
    LAS float* X = (LAS float*)lds + (wid & 3) * 4096;
    if (c == 1) {
#pragma unroll
        for (int db = 0; db < 4; ++db)
#pragma unroll
            for (int r = 0; r < 16; ++r) X[(db * 32 + crow(r, hh)) * 32 + r32] = o[db][r] * inv;
    }
    __syncthreads();
    if (c == 0) {
        float ss = 0.f;
#pragma unroll
        for (int db = 0; db < 4; ++db)
#pragma unroll
            for (int r = 0; r < 16; ++r) { const float v = o[db][r] * inv - X[(db * 32 + crow(r, hh)) * 32 + r32]; o[db][r] = v; ss += v * v; }
        ss += __shfl_xor(ss, 32);
        const float rn = __builtin_amdgcn_rsqf(ss * (1.0f / 128.0f) + 1e-6f) * 0.8f;
        bf16_t* op = MIX + (rowbase + q0 + r32) * DMODEL + 1024 + h * 128;
#pragma unroll
        for (int db = 0; db < 4; ++db)
#pragma unroll
            for (int g4 = 0; g4 < 4; ++g4) { const int d0 = db * 32 + 8 * g4 + 4 * hh; const f32x4 gg = *(const f32x4*)(g_bout + d0);
                u32x2 w; w.x = cvtpk(o[db][4 * g4] * rn * gg[0], o[db][4 * g4 + 1] * rn * gg[1]); w.y = cvtpk(o[db][4 * g4 + 2] * rn * gg[2], o[db][4 * g4 + 3] * rn * gg[3]);
                *(u32x2*)(op + d0) = w; }
    }
    __syncthreads();
}

__device__ __forceinline__ void dil_unit(LAS char* wl, const bf16_t* QKV, bf16_t* MIX, int b, int h, int r16, int ib, float negM, const float* g_aout, int lane) {
    const int r32 = lane & 31, hh = lane >> 5, cb = (lane >> 4) & 1, q_ = (lane & 15) >> 2, p_ = lane & 3;
    const size_t rowbase = (size_t)b * SEQ;
    const int tq = r16 + 16 * (32 * ib + r32);
    bf16x8 qf[8];
    { const bf16_t* qp = QKV + (rowbase + tq) * INW + h * 128 + 8 * hh;
#pragma unroll
      for (int ks = 0; ks < 8; ++ks) qf[ks] = *(const bf16x8*)(qp + 16 * ks); }
    f32x16 o[4];
#pragma unroll
    for (int i = 0; i < 4; ++i)
#pragma unroll
        for (int r = 0; r < 16; ++r) o[i][r] = 0.f;
    float lsum = 0.f;
    f32x16 negm;
#pragma unroll
    for (int r = 0; r < 16; ++r) negm[r] = negM;
    const int lrow = lane >> 4, lch = lane & 15;
    const bf16_t* kvg = QKV + rowbase * INW + 1024 + h * 128 + lch * 8;
    LAS char* kst = wl + lrow * KP + lch * 16; LAS char* vst = wl + 32 * KP + lrow * VP + lch * 16;
    const LAS char* kread = wl + r32 * KP + 8 * hh * 2;
    const LAS char* vread = wl + 32 * KP + (4 * hh + q_) * VP + (16 * cb + 4 * p_) * 2;
    for (int pat = 0; pat < 3; ++pat) {
        const int sh = 4 - 2 * pat, dil = 1 << sh, sq = 16 >> sh;
        const int rc = r16 & (dil - 1), base_q = (r16 >> sh) + sq * 32 * ib, nkb = (SEQ >> sh) >> 5;
        const int qi = base_q + sq * r32;
        int lo_i = base_q - 64; if (lo_i < 0) lo_i = 0; const int kb_lo = lo_i >> 5;
        int kb_hi = (base_q + 31 * sq + 64) >> 5; if (kb_hi > nkb - 1) kb_hi = nkb - 1;
        for (int kb = kb_lo; kb <= kb_hi; ++kb) {
            u32x4 kr[8], vr[8];
#pragma unroll
            for (int i = 0; i < 8; ++i) { const int tok = rc + ((32 * kb + lrow + 4 * i) << sh); const bf16_t* gp = kvg + (size_t)tok * INW; kr[i] = *(const u32x4*)gp; vr[i] = *(const u32x4*)(gp + 1024); }
#pragma unroll
            for (int i = 0; i < 8; ++i) { *(LAS u32x4*)(kst + 4 * i * KP) = kr[i]; *(LAS u32x4*)(vst + 4 * i * VP) = vr[i]; }
            __builtin_amdgcn_fence(__ATOMIC_RELEASE, "wavefront"); __builtin_amdgcn_wave_barrier(); __builtin_amdgcn_fence(__ATOMIC_ACQUIRE, "wavefront");
            f32x16 p = negm;
#pragma unroll
            for (int ks = 0; ks < 8; ++ks) { const bf16x8 kf = *(const LAS bf16x8*)(kread + ks * 32); p = MFMA32(kf, qf[ks], p); }
            float sa = 0.f;
#pragma unroll
            for (int r = 0; r < 16; ++r) { const int dl = 32 * kb + crow(r, hh) - qi; const float e = __builtin_amdgcn_exp2f(p[r]); const float pv = (dl <= 64 && dl >= -64) ? e : 0.f; p[r] = pv; sa += pv; }
            lsum += sa;
            bf16x8 pf[2]; pf[0] = packp(p, 0); pf[1] = packp(p, 1);
#pragma unroll
            for (int s = 0; s < 2; ++s)
#pragma unroll
                for (int db = 0; db < 4; ++db) {
                    const LAS char* a = vread + s * 16 * VP + db * 64;
                    const s16x4 lo = vtr(a), hi = vtr(a + 8 * VP);
                    const bf16x8 vf = __builtin_shufflevector(lo, hi, 0, 1, 2, 3, 4, 5, 6, 7);
                    o[db] = MFMA32(vf, pf[s], o[db]);
                }
            __builtin_amdgcn_fence(__ATOMIC_RELEASE, "wavefront"); __builtin_amdgcn_wave_barrier(); __builtin_amdgcn_fence(__ATOMIC_ACQUIRE, "wavefront");
        }
    }
    lsum += __shfl_xor(lsum, 32);
    const float inv = 1.0f / lsum; float ss = 0.f;
#pragma unroll
    for (int db = 0; db < 4; ++db)
#pragma unroll
        for (int r = 0; r < 16; ++r) { const float v = o[db][r] * inv; o[db][r] = v; ss += v * v; }
    ss += __shfl_xor(ss, 32);
    const float rn = __builtin_amdgcn_rsqf(ss * (1.0f / 128.0f) + 1e-6f);
    bf16_t* op = MIX + (rowbase + tq) * DMODEL + h * 128;
#pragma unroll
    for (int db = 0; db < 4; ++db)
#pragma unroll
        for (int g4 = 0; g4 < 4; ++g4) { const int d0 = db * 32 + 8 * g4 + 4 * hh; const f32x4 gg = *(const f32x4*)(g_aout + d0);
            u32x2 w; w.x = cvtpk(o[db][4 * g4] * rn * gg[0], o[db][4 * g4 + 1] * rn * gg[1]); w.y = cvtpk(o[db][4 * g4 + 2] * rn * gg[2], o[db][4 * g4 + 3] * rn * gg[3]);
            *(u32x2*)(op + d0) = w; }
}
}

constexpr int NWAVES = 8;
constexpr int DM = 2048, NBATCH = 2, SEQ = 4096, MROWS = NBATCH * SEQ, DFF = 5632, INW = 6144;
constexpr size_t MiB = 1u << 20;
constexpr size_t WS_CTL = 0;
constexpr size_t OFF_GTAB = 1 * MiB - 4096;
constexpr size_t OFF_RS1 = 0, OFF_RS2 = 32768, OFF_ROPEA = 65536, OFF_ROPEB = OFF_ROPEA + 2 * 4096 * 16 * 4;
constexpr size_t WS_W1A = 1 * MiB, WS_W1B = WS_W1A + 44 * MiB, WS_WIN = WS_W1B + 22 * MiB, WS_WOUT = WS_WIN + 24 * MiB, WS_W2A = WS_WOUT + 8 * MiB, WS_W2B = WS_W2A + 44 * MiB;
constexpr size_t WS_XN = WS_W2B + 22 * MiB;
constexpr size_t WS_ACT = WS_XN + 32 * MiB;
constexpr size_t WS_MIX = WS_ACT + 96 * MiB;
constexpr size_t WS_END = WS_MIX + 32 * MiB;
constexpr int LDS_BYTES = 155648;
constexpr int XCH_OFF = 131072;
static_assert(att::DIL_WAVE * 8 <= LDS_BYTES && 2 * att::DIFF_TILE <= LDS_BYTES && XCH_OFF + 8192 <= LDS_BYTES, "LDS map");

#define LAS __attribute__((address_space(3)))
typedef unsigned short bf16;
typedef unsigned v4u __attribute__((ext_vector_type(4)));
typedef unsigned v2u __attribute__((ext_vector_type(2)));
typedef float f32x4 __attribute__((ext_vector_type(4)));
__device__ __forceinline__ unsigned f2bf(float f) { unsigned u = __builtin_bit_cast(unsigned, f); return (u + 0x7fffu + ((u >> 16) & 1u)) >> 16; }
__device__ __forceinline__ unsigned pk2(float lo, float hi) { return f2bf(lo) | (f2bf(hi) << 16); }
__device__ __forceinline__ float wave_sum(float v) {
#pragma unroll
    for (int o = 1; o < 64; o <<= 1) v += __shfl_xor(v, o);
    return v;
}
__device__ __forceinline__ float wave_max(float v) {
#pragma unroll
    for (int o = 1; o < 64; o <<= 1) v = fmaxf(v, __shfl_xor(v, o));
    return v;
}
template <bool GLU> __device__ __forceinline__ void p0_transpose_item(const float* W, int K, int N, bf16* WT, LAS float* scr, int item, int lane) {
    const int nblk = N / 32, kb = item / nblk, nb = item % nblk, k0 = 64 * kb, n0 = 32 * nb;
    int r0 = n0;
    if (GLU) { const int half = N / 2; r0 = n0 < half ? (n0 >> 7) * 256 + (n0 & 127) : ((n0 - half) >> 7) * 256 + 128 + ((n0 - half) & 127); }
#pragma unroll 8
    for (int i = 0; i < 32; ++i) { const int kk = 2 * i + (lane >> 5); scr[kk * 33 + (lane & 31)] = W[(size_t)(k0 + kk) * N + n0 + (lane & 31)]; }
    asm volatile("s_waitcnt lgkmcnt(0)" ::: "memory");
    const int c = lane & 7;
#pragma unroll
    for (int j = 0; j < 4; ++j) { const int n = (lane >> 3) + 8 * j; const LAS float* s = scr + (8 * c) * 33 + n;
        v4u o; o.x = pk2(s[0 * 33], s[1 * 33]); o.y = pk2(s[2 * 33], s[3 * 33]); o.z = pk2(s[4 * 33], s[5 * 33]); o.w = pk2(s[6 * 33], s[7 * 33]);
        *(v4u*)(WT + (size_t)(r0 + n) * K + k0 + 8 * c) = o; }
    asm volatile("s_waitcnt lgkmcnt(0)" ::: "memory");
}

struct Args {
    const float* in[20]; float* out; unsigned char* ws;
    float invA[16]; float invB[8];
};

__global__ void __launch_bounds__(NWAVES * 64) hybrid_fwd(Args args) {
    extern __shared__ __attribute__((aligned(16))) unsigned char lds_raw[];
    cg::grid_group grid = cg::this_grid();
    LAS unsigned char* lds = (LAS unsigned char*)lds_raw;
    const int tid = threadIdx.x, lane = tid & 63, wid = __builtin_amdgcn_readfirstlane(tid >> 6);
    const int G = gridDim.x, bx = blockIdx.x;
    unsigned char* ws = args.ws;
    const float* x = args.in[0];
    float* out = args.out;
    float* rowss1 = (float*)(ws + OFF_RS1); float* rowss2 = (float*)(ws + OFF_RS2);
    float* gtab = (float*)(ws + OFF_GTAB); float* ropeA = (float*)(ws + OFF_ROPEA); float* ropeB = (float*)(ws + OFF_ROPEB);
    bf16* W1A = (bf16*)(ws + WS_W1A); bf16* W1B = (bf16*)(ws + WS_W1B); bf16* WIN = (bf16*)(ws + WS_WIN); bf16* WOUT = (bf16*)(ws + WS_WOUT);
    bf16* W2A = (bf16*)(ws + WS_W2A); bf16* W2B = (bf16*)(ws + WS_W2B);
    bf16* XN = (bf16*)(ws + WS_XN); bf16* ACT = (bf16*)(ws + WS_ACT); bf16* QKV = (bf16*)(ws + WS_ACT); bf16* MIX = (bf16*)(ws + WS_MIX);

    {
        LAS float* scr = (LAS float*)(lds + wid * 16384);
        const int gw = bx * NWAVES + wid, NGW = G * NWAVES;
        constexpr int I_FA = (DM / 64) * (2 * DFF / 32), I_FB = (DFF / 64) * (DM / 32), I_IN = (DM / 64) * (INW / 32), I_OUT = (DM / 64) * (DM / 32);
        constexpr int NITEMS = 2 * I_FA + 2 * I_FB + I_IN + I_OUT;
        for (int it = gw; it < NITEMS; it += NGW) {
            int r = it;
            if (r < I_FA) { p0_transpose_item<true>(args.in[2], DM, 2 * DFF, W1A, scr, r, lane); continue; } r -= I_FA;
            if (r < I_FA) { p0_transpose_item<true>(args.in[18], DM, 2 * DFF, W2A, scr, r, lane); continue; } r -= I_FA;
            if (r < I_FB) { p0_transpose_item<false>(args.in[3], DFF, DM, W1B, scr, r, lane); continue; } r -= I_FB;
            if (r < I_FB) { p0_transpose_item<false>(args.in[19], DFF, DM, W2B, scr, r, lane); continue; } r -= I_FB;
            if (r < I_IN) { p0_transpose_item<false>(args.in[5], DM, INW, WIN, scr, r, lane); continue; } r -= I_IN;
            p0_transpose_item<false>(args.in[16], DM, DM, WOUT, scr, r, lane);
        }
        const float* g1 = args.in[1];
        for (int m = gw; m < MROWS; m += NGW) {
            const f32x4* xr = (const f32x4*)(x + (size_t)m * DM) + lane; f32x4 v[8]; float s = 0.f;
#pragma unroll
            for (int j = 0; j < 8; ++j) { v[j] = xr[64 * j]; s += (v[j][0] * v[j][0] + v[j][1] * v[j][1]) + (v[j][2] * v[j][2] + v[j][3] * v[j][3]); }
            const float rstd = 1.0f / sqrtf(wave_sum(s) * (1.0f / DM) + 1e-6f);
            v2u* o8 = (v2u*)(XN + (size_t)m * DM) + lane;
#pragma unroll
            for (int j = 0; j < 8; ++j) { const f32x4 g = *((const f32x4*)g1 + lane + 64 * j); v2u w; w.x = pk2(v[j][0] * rstd * g[0], v[j][1] * rstd * g[1]); w.y = pk2(v[j][2] * rstd * g[2], v[j][3] * rstd * g[3]); o8[64 * j] = w; }
        }
        const int gt = bx * (NWAVES * 64) + tid, NGT = G * NWAVES * 64;
        for (int i = gt; i < 2 * MROWS; i += NGT) rowss1[i] = 0.f;
        if (gt < 512) { const int t = gt >> 7, d = gt & 127; gtab[gt] = t == 0 ? args.in[6][d] : (t == 1 ? args.in[7][d] : (t == 2 ? args.in[8][d & 63] : args.in[9][d & 63])); }
        for (int i = gt; i < 4096 * 24; i += NGT) {
            const int s = i / 24, k = i % 24; const float inv = k < 16 ? args.invA[k] : args.invB[k - 16];
            const float ang = (float)s * inv; double rev = (double)ang * 0.15915494309189535; rev -= floor(rev);
            const float cs = __builtin_amdgcn_cosf((float)rev), sn = __builtin_amdgcn_sinf((float)rev);
            if (k < 16) { ropeA[s * 16 + k] = cs; ropeA[4096 * 16 + s * 16 + k] = sn; } else { ropeB[s * 8 + k - 16] = cs; ropeB[4096 * 8 + s * 8 + k - 16] = sn; }
        }
    }
    grid.sync();

    { pg8::Gemm g{XN, W1A, MROWS, 2 * DFF, DM}; pg8::StaticOrder S; S.init(MROWS, 2 * DFF, G, bx);
      pg8::EpiSwiGLU E{ACT, DFF, nullptr};
      pg8::gemm_phase<pg8::EpiSwiGLU, pg8::StaticOrder, true, true>(lds, g, S, E); }
    grid.sync();
    { pg8::Gemm g{ACT, W1B, MROWS, DM, DFF}; pg8::StaticOrder S; S.init(MROWS, DM, G, bx);
      pg8::EpiResid<true> E{x, out, 0.5f, XN, args.in[4], rowss1};
      pg8::gemm_phase<pg8::EpiResid<true>, pg8::StaticOrder, true, true>(lds, g, S, E); }
    grid.sync();
    { pg8::Gemm g{XN, WIN, MROWS, INW, DM}; pg8::StaticOrder S; S.init(MROWS, INW, G, bx);
      pg8::EpiQKV E{QKV, rowss1, gtab, ropeA, ropeB, (LAS float*)(lds + XCH_OFF)};
      pg8::gemm_phase<pg8::EpiQKV, pg8::StaticOrder, true, true>(lds, g, S, E); }
    grid.sync();
    {
        const float L2E = 1.4426950408889634f;
        float gq = fmaxf(fabsf(args.in[6][lane]), fabsf(args.in[6][lane + 64])), gk = fmaxf(fabsf(args.in[7][lane]), fabsf(args.in[7][lane + 64]));
        const float negMA = -1.02f * 11.313708498984761f * wave_max(gq) * wave_max(gk) * L2E;
        const float negMB = -1.02f * 8.0f * wave_max(fabsf(args.in[8][lane])) * wave_max(fabsf(args.in[9][lane])) * L2E;
        const float lam = __expf(wave_sum(args.in[10][lane] * args.in[11][lane])) - __expf(wave_sum(args.in[12][lane] * args.in[13][lane])) + 0.2f;
        for (int u = bx; u < 512; u += G) {
            const int bh = u >> 5, qblk = u & 31;
            att::diff_unit((LAS char*)lds, QKV, MIX, bh >> 3, bh & 7, qblk, lam, negMB, args.in[15], tid, wid, lane);
        }
        for (int wu = bx * NWAVES + wid; wu < 2048; wu += G * NWAVES) {
            const int ib = wu & 7, r16 = (wu >> 3) & 15, h = (wu >> 7) & 7, b = wu >> 10;
            att::dil_unit((LAS char*)lds + wid * att::DIL_WAVE, QKV, MIX, b, h, r16, ib, negMA, args.in[14], lane);
        }
    }
    grid.sync();
    { pg8::Gemm g{MIX, WOUT, MROWS, DM, DM}; pg8::StaticOrder S; S.init(MROWS, DM, G, bx);
      pg8::EpiResid<true> E{out, out, 1.0f, XN, args.in[17], rowss2};
      pg8::gemm_phase<pg8::EpiResid<true>, pg8::StaticOrder, true, true>(lds, g, S, E); }
    grid.sync();
    { pg8::Gemm g{XN, W2A, MROWS, 2 * DFF, DM}; pg8::StaticOrder S; S.init(MROWS, 2 * DFF, G, bx);
      pg8::EpiSwiGLU E{ACT, DFF, rowss2};
      pg8::gemm_phase<pg8::EpiSwiGLU, pg8::StaticOrder, true, true>(lds, g, S, E); }
    grid.sync();
    { pg8::Gemm g{ACT, W2B, MROWS, DM, DFF}; pg8::StaticOrder S; S.init(MROWS, DM, G, bx);
      pg8::EpiResid<false> E{out, out, 0.5f, nullptr, nullptr, nullptr};
      pg8::gemm_phase<pg8::EpiResid<false>, pg8::StaticOrder, true, true>(lds, g, S, E); }
}

extern "C" void kernel_launch(void* const* d_in, const int* in_sizes, int n_in, void* d_out, int out_size, void* d_ws, size_t ws_size, hipStream_t stream) {
    static int grid = 0;
    if (grid == 0) {
        if (n_in != 20 || in_sizes[0] != MROWS * DM || out_size != MROWS * DM || ws_size < WS_END) {
            fprintf(stderr, "kernel_launch: unexpected shapes (n_in %d, in0 %d, out %d, ws %zu < %zu)\n", n_in, n_in > 0 ? in_sizes[0] : -1, out_size, ws_size, (size_t)WS_END); grid = -1; return; }
        int dev = 0, cus = 0, per_cu = 0;
        (void)hipGetDevice(&dev); (void)hipDeviceGetAttribute(&cus, hipDeviceAttributeMultiprocessorCount, dev);
        if (hipFuncSetAttribute((const void*)hybrid_fwd, hipFuncAttributeMaxDynamicSharedMemorySize, LDS_BYTES) != hipSuccess) { fprintf(stderr, "kernel_launch: hipFuncSetAttribute failed\n"); grid = -1; return; }
        if (hipOccupancyMaxActiveBlocksPerMultiprocessor(&per_cu, (const void*)hybrid_fwd, NWAVES * 64, LDS_BYTES) != hipSuccess || per_cu < 1) { fprintf(stderr, "kernel_launch: occupancy query says %d\n", per_cu); per_cu = 1; }
        (void)hipGetLastError();
        grid = cus * per_cu;
    }
    if (grid < 0) return;
    Args a{};
    for (int i = 0; i < 20; ++i) a.in[i] = (const float*)d_in[i];
    a.out = (float*)d_out; a.ws = (unsigned char*)d_ws;
    for (int i = 0; i < 16; ++i) a.invA[i] = (float)pow(500000.0, -(double)i / 16.0);
    for (int i = 0; i < 8; ++i) a.invB[i] = (float)pow(500000.0, -(double)i / 8.0);
    void* kargs[] = {&a};
    hipError_t e = hipLaunchCooperativeKernel((const void*)hybrid_fwd, dim3(grid), dim3(NWAVES * 64), kargs, LDS_BYTES, stream);
    if (e != hipSuccess) fprintf(stderr, "kernel_launch: cooperative launch failed: %s (grid %d)\n", hipGetErrorString(e), grid);
}
```

```cpp
#include <hip/hip_runtime.h>
#include <hip/hip_cooperative_groups.h>
#include <cstdio>
#include <cstdint>
#include <cmath>
namespace cg = cooperative_groups;
namespace pg8 {
#define PG8_LAS __attribute__((address_space(3)))
typedef unsigned short bf16_t;
typedef short bf16x8 __attribute__((ext_vector_type(8)));
typedef float f32x4 __attribute__((ext_vector_type(4)));
typedef unsigned u32x4 __attribute__((ext_vector_type(4)));
constexpr int BM = 256, BK = 64, HALF = 128, HTB = HALF * BK * 2  , STAGE_BYTES = 8 * HTB, NXCD = 8, WGM = 8;

__host__ __device__ __forceinline__ int lds_byte(int r, int c) { const int st = (r >> 4) * 2 + (c >> 5), rr = r & 15, cc = c & 31, ob = rr * 64 + cc * 2; return st * 1024 + (ob ^ (((ob >> 9) & 1) << 5)); }
__host__ __device__ __forceinline__ void stage_rc(int b, int& R, int& C) { const int st = b / 1024, sb = b % 1024, swz = sb ^ (((sb >> 9) & 1) << 5); R = (st >> 1) * 16 + swz / 64; C = (st & 1) * 32 + (swz % 64) / 2; }
__host__ __device__ __forceinline__ int perm32(int rho) { const int n = rho >> 4, i = rho & 15; return 8 * (i >> 2) + 4 * n + (i & 3); }

struct Unit { int pm, pn; };
struct Gemm { const bf16_t* A; const bf16_t* Bt; int M, N, K; };

struct StaticOrder {
    int nM, nN, nwg, G, c;
    __host__ __device__ void init(int M, int N, int G_, int c_) { nM = M / BM; nN = N / BM; nwg = nM * nN; G = G_; c = c_; }
    __host__ __device__ bool next(int i, Unit& u) const {
        const long L = (long)i * G + c; if (L >= nwg) return false;
        int wgid = (int)L; { const int q = nwg / NXCD, r = nwg % NXCD, xcd = wgid % NXCD, off = wgid / NXCD; wgid = (xcd < r ? xcd * (q + 1) : r * (q + 1) + (xcd - r) * q) + off; }
        const int nig = WGM * nN, gid = wgid / nig, fm = gid * WGM, gsz = (nM - fm) < WGM ? (nM - fm) : WGM;
        u.pm = fm + ((wgid % nig) % gsz); u.pn = (wgid % nig) / gsz; return true;
    }
    __device__ __forceinline__ void a_ready(const Unit&) const {}
    __device__ __forceinline__ void done(const Unit&) const {}
};

__device__ __forceinline__ unsigned cvt_pk_bf16(float lo, float hi) { unsigned r; asm volatile("v_cvt_pk_bf16_f32 %0, %1, %2" : "=v"(r) : "v"(lo), "v"(hi)); return r; }
typedef float f32x2 __attribute__((ext_vector_type(2)));

typedef unsigned u32x2 __attribute__((ext_vector_type(2)));
__device__ __forceinline__ float fast_silu(float g) { return g * __builtin_amdgcn_rcpf(1.0f + __expf(-g)); }

struct EpiSwiGLU {
    static constexpr bool PERM = true, AFTER_DRAIN = false;
    bf16_t* O; int ldc; const float* rowss;
    __device__ __forceinline__ void operator()(f32x4 (&acc)[2][2][4][2], const Unit& u, int wr, int wc, int fr, int fq) const {
        const int row0 = u.pm * BM + wr * 64 + fr; const int col0 = u.pn * HALF + wc * 32 + 8 * fq;
#pragma unroll
        for (int ai = 0; ai < 2; ++ai)
#pragma unroll
            for (int m = 0; m < 4; ++m) {
                const int row = row0 + ai * HALF + m * 16;
                float rs = 1.0f; if (rowss) rs = __builtin_amdgcn_rsqf(rowss[row] * (1.0f / 2048.0f) + 1e-6f);
                f32x4 g0 = acc[ai][0][m][0] * rs, g1 = acc[ai][0][m][1] * rs, u0 = acc[ai][1][m][0] * rs, u1 = acc[ai][1][m][1] * rs;
                u32x4 w;
                w.x = cvt_pk_bf16(fast_silu(g0[0]) * u0[0], fast_silu(g0[1]) * u0[1]); w.y = cvt_pk_bf16(fast_silu(g0[2]) * u0[2], fast_silu(g0[3]) * u0[3]);
                w.z = cvt_pk_bf16(fast_silu(g1[0]) * u1[0], fast_silu(g1[1]) * u1[1]); w.w = cvt_pk_bf16(fast_silu(g1[2]) * u1[2], fast_silu(g1[3]) * u1[3]);
                *(u32x4*)(O + (size_t)row * ldc + col0) = w;
            }
    }
};

template <bool NORMOUT> struct EpiResid {
    static constexpr bool PERM = false, AFTER_DRAIN = false;
    const float* base; float* out; float alpha; bf16_t* xn; const float* gain; float* rowss;
    __device__ __forceinline__ void operator()(f32x4 (&acc)[2][2][4][2], const Unit& u, int wr, int wc, int fr, int fq) const {
        const int row0 = u.pm * BM + wr * 64 + fr; const int col0 = u.pn * BM + wc * 32 + 4 * fq;
        f32x4 gv[2][2];
        if (NORMOUT) {
#pragma unroll
            for (int bj = 0; bj < 2; ++bj)
#pragma unroll
                for (int n = 0; n < 2; ++n) gv[bj][n] = *(const f32x4*)(gain + col0 + bj * HALF + n * 16);
        }
#pragma unroll
        for (int ai = 0; ai < 2; ++ai)
#pragma unroll
            for (int m = 0; m < 4; ++m) {
                const int row = row0 + ai * HALF + m * 16; const size_t off = (size_t)row * 2048 + col0; float ss = 0.f;
#pragma unroll
                for (int bj = 0; bj < 2; ++bj)
#pragma unroll
                    for (int n = 0; n < 2; ++n) {
                        const f32x4 b = *(const f32x4*)(base + off + bj * HALF + n * 16);
                        const f32x4 o = b + acc[ai][bj][m][n] * alpha;
                        *(f32x4*)(out + off + bj * HALF + n * 16) = o;
                        if (NORMOUT) {
                            ss += (o[0] * o[0] + o[1] * o[1]) + (o[2] * o[2] + o[3] * o[3]);
                            const f32x4 t = o * gv[bj][n]; u32x2 w; w.x = cvt_pk_bf16(t[0], t[1]); w.y = cvt_pk_bf16(t[2], t[3]);
                            *(u32x2*)(xn + off + bj * HALF + n * 16) = w;
                        }
                    }
                if (NORMOUT) { ss += __shfl_xor(ss, 16); ss += __shfl_xor(ss, 32); if (fq == 0) atomicAdd(rowss + row, ss); }
                asm volatile("" ::: "memory");
            }
    }
};

struct EpiQKV {
    static constexpr bool PERM = false, AFTER_DRAIN = false;
    bf16_t* O; const float* rowss; const float* gtab;
    const float* ropeA; const float* ropeB;
    PG8_LAS float* xch;
    __device__ __forceinline__ void operator()(f32x4 (&acc)[2][2][4][2], const Unit& u, int wr, int wc, int fr, int fq) const {
        asm volatile("" : "+v"(fr), "+v"(fq));
        const int region = u.pn >> 2;
        const int row0 = u.pm * BM + wr * 64 + fr;
#pragma unroll
        for (int ai = 0; ai < 2; ++ai)
#pragma unroll
            for (int m = 0; m < 4; ++m) {
                const float rs = __builtin_amdgcn_rsqf(rowss[row0 + ai * HALF + m * 16] * (1.0f / 2048.0f) + 1e-6f);
#pragma unroll
                for (int bj = 0; bj < 2; ++bj)
#pragma unroll
                    for (int n = 0; n < 2; ++n) acc[ai][bj][m][n] = acc[ai][bj][m][n] * rs;
            }
        const bool isv = (region == 2) || (region == 5);
        if (!isv) {
            const bool isA = region < 2;
#pragma unroll
            for (int ai = 0; ai < 2; ++ai)
#pragma unroll
                for (int m = 0; m < 4; ++m)
#pragma unroll
                    for (int bj = 0; bj < 2; ++bj) {
                        const f32x4 a = acc[ai][bj][m][0], b = acc[ai][bj][m][1];
                        float s = ((a[0] * a[0] + a[1] * a[1]) + (a[2] * a[2] + a[3] * a[3])) + ((b[0] * b[0] + b[1] * b[1]) + (b[2] * b[2] + b[3] * b[3]));
                        s += __shfl_xor(s, 16); s += __shfl_xor(s, 32);
                        if (fq == 0) xch[((ai * HALF + wr * 64 + m * 16 + fr) * 2 + bj) * 4 + wc] = s;
                    }
            asm volatile("s_waitcnt lgkmcnt(0)" ::: "memory"); __builtin_amdgcn_s_barrier(); asm volatile("" ::: "memory");
            const float* gptr = gtab + (region < 2 ? region : region - 1) * 128;
            const int dbase = isA ? wc * 32 : (wc & 1) * 32;
            f32x4 gv[2]; gv[0] = *(const f32x4*)(gptr + dbase + 4 * fq); gv[1] = *(const f32x4*)(gptr + dbase + 16 + 4 * fq);
            const float qs = region == 0 ? (0.08838834764831845f * 1.4426950408889634f) : (region == 3 ? (0.125f * 1.4426950408889634f) : 1.0f);
#pragma unroll
            for (int ai = 0; ai < 2; ++ai)
#pragma unroll
                for (int m = 0; m < 4; ++m) {
                    const int rl = ai * HALF + wr * 64 + m * 16 + fr; const int spos = (u.pm * BM + rl) & 4095;
#pragma unroll
                    for (int bj = 0; bj < 2; ++bj) {
                        const f32x4 p = *(const PG8_LAS f32x4*)(xch + (rl * 2 + bj) * 4);
                        float rn;
                        if (isA) rn = __builtin_amdgcn_rsqf(((p[0] + p[1]) + (p[2] + p[3])) * (1.0f / 128.0f) + 1e-6f);
                        else rn = __builtin_amdgcn_rsqf(((wc < 2) ? (p[0] + p[1]) : (p[2] + p[3])) * (1.0f / 64.0f) + 1e-6f);
                        f32x4 v0 = acc[ai][bj][m][0] * rn * gv[0], v1 = acc[ai][bj][m][1] * rn * gv[1];
                        if (isA) {
                            if (wc == 0) {
                                const f32x4 cs = *(const f32x4*)(ropeA + spos * 16 + 4 * fq), sn = *(const f32x4*)(ropeA + 4096 * 16 + spos * 16 + 4 * fq);
                                const f32x4 x1 = v0, x2 = v1; v0 = x1 * cs - x2 * sn; v1 = x2 * cs + x1 * sn;
                            }
                        } else {
                            if ((wc & 1) == 0) {
                                const f32x4 cs = *(const f32x4*)(ropeB + spos * 8 + 4 * (fq & 1)), sn = *(const f32x4*)(ropeB + 4096 * 8 + spos * 8 + 4 * (fq & 1));
                                f32x4 pt; pt[0] = __shfl_xor(v0[0], 32); pt[1] = __shfl_xor(v0[1], 32); pt[2] = __shfl_xor(v0[2], 32); pt[3] = __shfl_xor(v0[3], 32);
                                v0 = (fq < 2) ? (v0 * cs - pt * sn) : (v0 * cs + pt * sn);
                            }
                        }
                        acc[ai][bj][m][0] = v0 * qs; acc[ai][bj][m][1] = v1 * qs;
                    }
                }
        }
        const int col0 = u.pn * BM + wc * 32 + 4 * fq;
#pragma unroll
        for (int ai = 0; ai < 2; ++ai)
#pragma unroll
            for (int m = 0; m < 4; ++m) { bf16_t* rowp = O + (size_t)(row0 + ai * HALF + m * 16) * 6144 + col0;
#pragma unroll
                for (int bj = 0; bj < 2; ++bj)
#pragma unroll
                    for (int n = 0; n < 2; ++n) { const f32x4 v = acc[ai][bj][m][n]; u32x2 w; w.x = cvt_pk_bf16(v[0], v[1]); w.y = cvt_pk_bf16(v[2], v[3]); *(u32x2*)(rowp + bj * HALF + n * 16) = w; } }
    }
};
template <class Epi, class Sched, bool ALIGN_EPI = false, bool SP2 = false>
__device__ __forceinline__ void gemm_phase(PG8_LAS unsigned char* lds, const Gemm g, const Sched& S, const Epi& E) {
    const int tid = threadIdx.x, wid = __builtin_amdgcn_readfirstlane(tid >> 6), lane = tid & 63, wr = wid >> 2, wc = wid & 3, fr = lane & 15, fq = lane >> 4;
    const int K = g.K, nt = K / BK;
    unsigned voffA[2], voffB[2];
#pragma unroll
    for (int i = 0; i < 2; ++i) { int R, C; stage_rc(tid * 16 + i * 8192, R, C); const int Rb = Epi::PERM ? ((R & ~31) + perm32(R & 31)) : R;
        voffA[i] = (unsigned)(R * K + C) * 2u; voffB[i] = (unsigned)(Rb * K + C) * 2u; }
    const size_t kstep = (size_t)(BK * 2);
    const size_t hstep = (size_t)HALF * K * 2;
    const size_t tstep = 2 * hstep;
    const unsigned ldsw = (unsigned)wid * 1024u;
    const int aoff = lds_byte(wr * 64 + fr, fq * 8), boff = lds_byte(wc * 32 + fr, fq * 8);
#define PG8_SA(b, h) (((b) * 2 + (h)) * HTB)
#define PG8_SB(b, h) ((4 + (b) * 2 + (h)) * HTB)
#define PG8_STAGE(bufoff, gbase, voff) do { _Pragma("unroll") for (int _i = 0; _i < 2; ++_i) \
        __builtin_amdgcn_global_load_lds((const unsigned*)((const char*)(gbase) + (voff)[_i]), (PG8_LAS unsigned*)(lds + (bufoff) + ldsw + _i * 8192), 16, 0, 0); } while (0)
#define PG8_LDA(dst, b, h) do { _Pragma("unroll") for (int m = 0; m < 4; ++m) _Pragma("unroll") for (int k = 0; k < 2; ++k) dst[m][k] = *(const PG8_LAS bf16x8*)(lds + PG8_SA(b, h) + aoff + m * 2048 + k * 1024); } while (0)
#define PG8_LDB(dst, b, h) do { _Pragma("unroll") for (int n = 0; n < 2; ++n) _Pragma("unroll") for (int k = 0; k < 2; ++k) dst[n][k] = *(const PG8_LAS bf16x8*)(lds + PG8_SB(b, h) + boff + n * 2048 + k * 1024); } while (0)
#define PG8_MMA(ai, bj, At, Bt) do { __builtin_amdgcn_s_setprio(1); _Pragma("unroll") for (int m = 0; m < 4; ++m) _Pragma("unroll") for (int n = 0; n < 2; ++n) _Pragma("unroll") for (int k = 0; k < 2; ++k) \
        acc[ai][bj][m][n] = __builtin_amdgcn_mfma_f32_16x16x32_bf16(Bt[n][k], At[m][k], acc[ai][bj][m][n], 0, 0, 0); __builtin_amdgcn_s_setprio(0); } while (0)
#define PG8_WAIT_V(n) asm volatile("s_waitcnt vmcnt(" #n ")" ::: "memory")
#define PG8_WAIT_L(n) asm volatile("s_waitcnt lgkmcnt(" #n ")" ::: "memory")
#define PG8_BAR __builtin_amdgcn_s_barrier()
#define PG8_SCHED __builtin_amdgcn_sched_barrier(0)
    Unit cur, nxt; int ui = 0;
    if (!S.next(0, cur)) return;
    f32x4 acc[2][2][4][2];
#pragma unroll
    for (int a = 0; a < 2; ++a)
#pragma unroll
        for (int b = 0; b < 2; ++b)
#pragma unroll
            for (int m = 0; m < 4; ++m)
#pragma unroll
                for (int n = 0; n < 2; ++n) acc[a][b][m][n] = (f32x4){0.f, 0.f, 0.f, 0.f};
    bf16x8 At[4][2], B0[2][2], B1[2][2];
    const char* cA = (const char*)g.A + (size_t)cur.pm * tstep; const char* cB = (const char*)g.Bt + (size_t)cur.pn * tstep;
    S.a_ready(cur);
    if constexpr (SP2) {
        PG8_STAGE(PG8_SB(0, 0), cB, voffB); PG8_STAGE(PG8_SB(0, 1), cB + hstep, voffB); PG8_STAGE(PG8_SA(0, 0), cA, voffA); PG8_STAGE(PG8_SA(0, 1), cA + hstep, voffA);
        if (wr == 1) PG8_BAR;
        PG8_WAIT_V(2); PG8_BAR;
        PG8_STAGE(PG8_SB(1, 0), cB + kstep, voffB); PG8_STAGE(PG8_SA(1, 0), cA + kstep, voffA); PG8_STAGE(PG8_SB(1, 1), cB + hstep + kstep, voffB);
        PG8_WAIT_V(6); PG8_BAR;
    } else {
        PG8_STAGE(PG8_SB(0, 0), cB, voffB); PG8_STAGE(PG8_SA(0, 0), cA, voffA); PG8_STAGE(PG8_SB(0, 1), cB + hstep, voffB); PG8_STAGE(PG8_SA(0, 1), cA + hstep, voffA);
        if (wr == 1) PG8_BAR;
        PG8_WAIT_V(4); PG8_BAR;
        PG8_STAGE(PG8_SB(1, 0), cB + kstep, voffB); PG8_STAGE(PG8_SA(1, 0), cA + kstep, voffA); PG8_STAGE(PG8_SB(1, 1), cB + hstep + kstep, voffB);
        PG8_WAIT_V(6); PG8_BAR;
    }
    for (;;) {
        const bool has_next = S.next(ui + 1, nxt);
        const char* nA = has_next ? (const char*)g.A + (size_t)nxt.pm * tstep : cA; const char* nB = has_next ? (const char*)g.Bt + (size_t)nxt.pn * tstep : cB;
        for (int t = 0; t < nt; t += 2) {
            const bool last = (t == nt - 2);
            const char* a1 = cA + (size_t)(t + 1) * kstep;
            const char* a2 = last ? nA : cA + (size_t)(t + 2) * kstep; const char* b2 = last ? nB : cB + (size_t)(t + 2) * kstep;
            const char* a3 = a2 + kstep; const char* b3 = b2 + kstep;
            if (last && has_next) S.a_ready(nxt);
            if constexpr (SP2) {
            PG8_LDB(B0, 0, 0); PG8_LDB(B1, 0, 1); PG8_SCHED; PG8_LDA(At, 0, 0); PG8_STAGE(PG8_SA(1, 1), a1 + hstep, voffA);
            PG8_WAIT_V(8); PG8_WAIT_L(0); PG8_BAR; PG8_MMA(0, 0, At, B0); PG8_MMA(0, 1, At, B1); PG8_BAR; PG8_SCHED;
            PG8_LDA(At, 0, 1); PG8_STAGE(PG8_SB(0, 0), b2, voffB); PG8_STAGE(PG8_SB(0, 1), b2 + hstep, voffB); PG8_STAGE(PG8_SA(0, 0), a2, voffA);
            PG8_WAIT_V(8); PG8_WAIT_L(0); PG8_BAR; PG8_MMA(1, 0, At, B0); PG8_MMA(1, 1, At, B1); PG8_BAR; PG8_SCHED;
            PG8_LDB(B0, 1, 0); PG8_LDB(B1, 1, 1); PG8_SCHED; PG8_LDA(At, 1, 0); PG8_STAGE(PG8_SA(0, 1), a2 + hstep, voffA);
            PG8_WAIT_V(8); PG8_WAIT_L(0); PG8_BAR; PG8_MMA(0, 0, At, B0); PG8_MMA(0, 1, At, B1); PG8_BAR; PG8_SCHED;
            PG8_LDA(At, 1, 1); PG8_STAGE(PG8_SB(1, 0), b3, voffB); PG8_STAGE(PG8_SB(1, 1), b3 + hstep, voffB); PG8_STAGE(PG8_SA(1, 0), a3, voffA);
            PG8_WAIT_V(8); PG8_WAIT_L(0); PG8_BAR; PG8_MMA(1, 0, At, B0); PG8_MMA(1, 1, At, B1); PG8_BAR; PG8_SCHED;
            } else {
            PG8_LDB(B0, 0, 0); PG8_SCHED; PG8_LDA(At, 0, 0); PG8_STAGE(PG8_SA(1, 1), a1 + hstep, voffA);
            PG8_WAIT_L(8); PG8_BAR; PG8_WAIT_L(0); PG8_MMA(0, 0, At, B0); PG8_BAR; PG8_SCHED;
            PG8_LDB(B1, 0, 1); PG8_STAGE(PG8_SB(0, 0), b2, voffB);
            PG8_BAR; PG8_WAIT_L(0); PG8_MMA(0, 1, At, B1); PG8_BAR;
            PG8_LDA(At, 0, 1); PG8_STAGE(PG8_SA(0, 0), a2, voffA);
            PG8_BAR; PG8_WAIT_L(0); PG8_MMA(1, 0, At, B0); PG8_BAR; PG8_SCHED;
            PG8_STAGE(PG8_SB(0, 1), b2 + hstep, voffB);
            PG8_WAIT_V(6); PG8_BAR; PG8_MMA(1, 1, At, B1); PG8_BAR;
            PG8_LDB(B0, 1, 0); PG8_SCHED; PG8_LDA(At, 1, 0); PG8_STAGE(PG8_SA(0, 1), a2 + hstep, voffA);
            PG8_WAIT_L(8); PG8_BAR; PG8_WAIT_L(0); PG8_MMA(0, 0, At, B0); PG8_BAR; PG8_SCHED;
            PG8_LDB(B1, 1, 1); PG8_STAGE(PG8_SB(1, 0), b3, voffB);
            PG8_BAR; PG8_WAIT_L(0); PG8_MMA(0, 1, At, B1); PG8_BAR;
            PG8_LDA(At, 1, 1); PG8_STAGE(PG8_SA(1, 0), a3, voffA);
            PG8_BAR; PG8_WAIT_L(0); PG8_MMA(1, 0, At, B0); PG8_BAR; PG8_SCHED;
            PG8_STAGE(PG8_SB(1, 1), b3 + hstep, voffB);
            PG8_WAIT_V(6); PG8_BAR; PG8_MMA(1, 1, At, B1); PG8_BAR;
            }
        }
        if constexpr (ALIGN_EPI) { if (wr == 0) PG8_BAR; }
        if constexpr (!Epi::AFTER_DRAIN) { E(acc, cur, wr, wc, fr, fq); S.done(cur); }
        if (!has_next) break;
#pragma unroll
        for (int a = 0; a < 2; ++a)
#pragma unroll
            for (int b = 0; b < 2; ++b)
#pragma unroll
                for (int m = 0; m < 4; ++m)
#pragma unroll
                    for (int n = 0; n < 2; ++n) acc[a][b][m][n] = (f32x4){0.f, 0.f, 0.f, 0.f};
        cur = nxt; cA = nA; cB = nB; ++ui;
        if constexpr (ALIGN_EPI) { if (wr == 1) PG8_BAR; }
    }
    PG8_WAIT_V(0);
    if constexpr (!ALIGN_EPI) { if (wr == 0) PG8_BAR; }
    PG8_BAR;
    if constexpr (Epi::AFTER_DRAIN) { E.fused(acc, cur, wr, wc, fr, fq, lds, wid, lane); S.done(cur); }
#undef PG8_SA
#undef PG8_SB
#undef PG8_STAGE
#undef PG8_LDA
#undef PG8_LDB
#undef PG8_MMA
#undef PG8_WAIT_V
#undef PG8_WAIT_L
#undef PG8_BAR
#undef PG8_SCHED
}
}

namespace att {
#define LAS __attribute__((address_space(3)))
typedef unsigned short bf16_t;
typedef short bf16x8 __attribute__((ext_vector_type(8)));
typedef short s16x4 __attribute__((ext_vector_type(4)));
typedef short v4i16_t __attribute__((ext_vector_type(4)));
typedef float f32x16 __attribute__((ext_vector_type(16)));
typedef float f32x4 __attribute__((ext_vector_type(4)));
typedef unsigned u32x4 __attribute__((ext_vector_type(4)));
typedef unsigned u32x2 __attribute__((ext_vector_type(2)));
typedef float f32x2_t __attribute__((ext_vector_type(2))); typedef __bf16 bf16x2_t __attribute__((ext_vector_type(2)));
constexpr int SEQ = 4096, INW = 6144, DMODEL = 2048;
constexpr int KP = 272, VP = 320;
constexpr int DIFF_TILE = 64 * KP + 64 * VP;
constexpr int DIL_WAVE = 32 * KP + 32 * VP;
__device__ __forceinline__ unsigned cvtpk(float lo, float hi) { f32x2_t v = {lo, hi}; bf16x2_t b = __builtin_convertvector(v, bf16x2_t); return __builtin_bit_cast(unsigned, b); }
__device__ __forceinline__ int crow(int r, int hi) { return (r & 3) + 8 * (r >> 2) + 4 * hi; }
__device__ __forceinline__ s16x4 vtr(const LAS char* p) { return __builtin_bit_cast(s16x4, __builtin_amdgcn_ds_read_tr16_b64_v4i16((LAS v4i16_t*)p)); }
__device__ __forceinline__ bf16x8 packp(const f32x16& p, int s) {
    u32x4 w; w.x = cvtpk(p[8 * s], p[8 * s + 1]); w.y = cvtpk(p[8 * s + 2], p[8 * s + 3]); w.z = cvtpk(p[8 * s + 4], p[8 * s + 5]); w.w = cvtpk(p[8 * s + 6], p[8 * s + 7]);
    return __builtin_bit_cast(bf16x8, w);
}
#define MFMA32(a, b, c) __builtin_amdgcn_mfma_f32_32x32x16_bf16((a), (b), (c), 0, 0, 0)

__device__ __forceinline__ void diff_unit(LAS char* lds, const bf16_t* QKV, bf16_t* MIX, int b, int h, int qblk, float lam, float negM, const float* g_bout, int tid, int wid, int lane) {
    const int c = wid >> 2, r32 = lane & 31, hh = lane >> 5, cb = (lane >> 4) & 1, q_ = (lane & 15) >> 2, p_ = lane & 3;
    const size_t rowbase = (size_t)b * SEQ; const int q0 = qblk * 128 + (wid & 3) * 32;
    bf16x8 qf[4];
    { const bf16_t* qp = QKV + (rowbase + q0 + r32) * INW + 3072 + h * 128 + c * 64 + 8 * hh;
#pragma unroll
      for (int ks = 0; ks < 4; ++ks) qf[ks] = *(const bf16x8*)(qp + 16 * ks); }
    const int srow = tid >> 4, sch = tid & 15;
    const bf16_t* kg = QKV + (rowbase + srow) * INW + 4096 + h * 128 + sch * 8;
    const bf16_t* vg = kg + 1024;
    LAS char* kst = lds + srow * KP + sch * 16; LAS char* vst = lds + 64 * KP + srow * VP + sch * 16;
    f32x16 o[4];
#pragma unroll
    for (int i = 0; i < 4; ++i)
#pragma unroll
        for (int r = 0; r < 16; ++r) o[i][r] = 0.f;
    float lsum = 0.f;
    f32x16 negm;
#pragma unroll
    for (int r = 0; r < 16; ++r) negm[r] = negM;
    u32x4 kr0, kr1, vr0, vr1;
    kr0 = *(const u32x4*)(kg); kr1 = *(const u32x4*)(kg + (size_t)32 * INW); vr0 = *(const u32x4*)(vg); vr1 = *(const u32x4*)(vg + (size_t)32 * INW);
    *(LAS u32x4*)(kst) = kr0; *(LAS u32x4*)(kst + 32 * KP) = kr1; *(LAS u32x4*)(vst) = vr0; *(LAS u32x4*)(vst + 32 * VP) = vr1;
    __syncthreads();
    const int NT = SEQ / 64;
    const LAS char* kread = lds + r32 * KP + (c * 64 + 8 * hh) * 2;
    const LAS char* vread = lds + 64 * KP + (4 * hh + q_) * VP + (16 * cb + 4 * p_) * 2;
    for (int t = 0; t < NT; ++t) {
        const int cur = (t & 1) * DIFF_TILE, nxt = DIFF_TILE - cur;
        if (t + 1 < NT) { const size_t go = (size_t)(t + 1) * 64 * INW;
            kr0 = *(const u32x4*)(kg + go); kr1 = *(const u32x4*)(kg + go + (size_t)32 * INW); vr0 = *(const u32x4*)(vg + go); vr1 = *(const u32x4*)(vg + go + (size_t)32 * INW); }
        f32x16 p0 = negm, p1 = negm;
#pragma unroll
        for (int ks = 0; ks < 4; ++ks) {
            const bf16x8 k0 = *(const LAS bf16x8*)(kread + cur + ks * 32), k1 = *(const LAS bf16x8*)(kread + cur + 32 * KP + ks * 32);
            p0 = MFMA32(k0, qf[ks], p0); p1 = MFMA32(k1, qf[ks], p1);
        }
        float sa = 0.f, sb = 0.f;
#pragma unroll
        for (int r = 0; r < 16; ++r) { p0[r] = __builtin_amdgcn_exp2f(p0[r]); p1[r] = __builtin_amdgcn_exp2f(p1[r]); sa += p0[r]; sb += p1[r]; }
        lsum += sa + sb;
        bf16x8 pf[4]; pf[0] = packp(p0, 0); pf[1] = packp(p0, 1); pf[2] = packp(p1, 0); pf[3] = packp(p1, 1);
#pragma unroll
        for (int kst4 = 0; kst4 < 4; ++kst4)
#pragma unroll
            for (int db = 0; db < 4; ++db) {
                const LAS char* a = vread + cur + kst4 * 16 * VP + db * 64;
                const s16x4 lo = vtr(a), hi = vtr(a + 8 * VP);
                const bf16x8 vf = __builtin_shufflevector(lo, hi, 0, 1, 2, 3, 4, 5, 6, 7);
                o[db] = MFMA32(vf, pf[kst4], o[db]);
            }
        if (t + 1 < NT) { *(LAS u32x4*)(kst + nxt) = kr0; *(LAS u32x4*)(kst + nxt + 32 * KP) = kr1; *(LAS u32x4*)(vst + nxt) = vr0; *(LAS u32x4*)(vst + nxt + 32 * VP) = vr1; }
        __syncthreads();
    }
    lsum += __shfl_xor(lsum, 32);
    float inv = 1.0f / lsum; if (c == 1) inv *= lam;
    LAS float* X = (LAS float*)lds + (wid & 3) * 4096;
    if (c == 1) {
#pragma unroll
        for (int db = 0; db < 4; ++db)
#pragma unroll
            for (int r = 0; r < 16; ++r) X[(db * 32 + crow(r, hh)) * 32 + r32] = o[db][r] * inv;
    }
    __syncthreads();
    if (c == 0) {
        float ss = 0.f;
#pragma unroll
        for (int db = 0; db < 4; ++db)
#pragma unroll
            for (int r = 0; r < 16; ++r) { const float v = o[db][r] * inv - X[(db * 32 + crow(r, hh)) * 32 + r32]; o[db][r] = v; ss += v * v; }
        ss += __shfl_xor(ss, 32);
        const float rn = __builtin_amdgcn_rsqf(ss * (1.0f / 128.0f) + 1e-6f) * 0.8f;
        bf16_t* op = MIX + (rowbase + q0 + r32) * DMODEL + 1024 + h * 128;
#pragma unroll
        for (int db = 0; db < 4; ++db)
#pragma unroll
            for (int g4 = 0; g4 < 4; ++g4) { const int d0 = db * 32 + 8 * g4 + 4 * hh; const f32x4 gg = *(const f32x4*)(g_bout + d0);
                u32x2 w; w.x = cvtpk(o[db][4 * g4] * rn * gg[0], o[db][4 * g4 + 1] * rn * gg[1]); w.y = cvtpk(o[db][4 * g4 + 2] * rn * gg[2], o[db][4 * g4 + 3] * rn * gg[3]);
                *(u32x2*)(op + d0) = w; }
    }
    __syncthreads();
}

__device__ __forceinline__ void dil_unit(LAS char* wl, const bf16_t* QKV, bf16_t* MIX, int b, int h, int r16, int ib, float negM, const float* g_aout, int lane) {
    const int r32 = lane & 31, hh = lane >> 5, cb = (lane >> 4) & 1, q_ = (lane & 15) >> 2, p_ = lane & 3;
    const size_t rowbase = (size_t)b * SEQ;
    const int tq = r16 + 16 * (32 * ib + r32);
    bf16x8 qf[8];
    { const bf16_t* qp = QKV + (rowbase + tq) * INW + h * 128 + 8 * hh;
#pragma unroll
      for (int ks = 0; ks < 8; ++ks) qf[ks] = *(const bf16x8*)(qp + 16 * ks); }
    f32x16 o[4];
#pragma unroll
    for (int i = 0; i < 4; ++i)
#pragma unroll
        for (int r = 0; r < 16; ++r) o[i][r] = 0.f;
    float lsum = 0.f;
    f32x16 negm;
#pragma unroll
    for (int r = 0; r < 16; ++r) negm[r] = negM;
    const int lrow = lane >> 4, lch = lane & 15;
    const bf16_t* kvg = QKV + rowbase * INW + 1024 + h * 128 + lch * 8;
    LAS char* kst = wl + lrow * KP + lch * 16; LAS char* vst = wl + 32 * KP + lrow * VP + lch * 16;
    const LAS char* kread = wl + r32 * KP + 8 * hh * 2;
    const LAS char* vread = wl + 32 * KP + (4 * hh + q_) * VP + (16 * cb + 4 * p_) * 2;
    int klo0, khi0, klo1, khi1, klo2, khi2;
    { const int bq = 32 * ib;               int lo_i = bq - 64; if (lo_i < 0) lo_i = 0; klo0 = lo_i >> 5; khi0 = (bq + 31 + 64) >> 5;      if (khi0 > 7) khi0 = 7; }
    { const int bq = (r16 >> 2) + 128 * ib; int lo_i = bq - 64; if (lo_i < 0) lo_i = 0; klo1 = lo_i >> 5; khi1 = (bq + 31 * 4 + 64) >> 5;  if (khi1 > 31) khi1 = 31; }
    { const int bq = r16 + 512 * ib;        int lo_i = bq - 64; if (lo_i < 0) lo_i = 0; klo2 = lo_i >> 5; khi2 = (bq + 31 * 16 + 64) >> 5; if (khi2 > 127) khi2 = 127; }
    int pat = 0, kb = klo0;
    u32x4 kr[8], vr[8];
#define DIL_LOAD(PAT, KB) do { const int sh_ = 4 - 2 * (PAT); const int rc_ = r16 & ((1 << sh_) - 1); \
        _Pragma("unroll") for (int i = 0; i < 8; ++i) { const int tok = rc_ + ((32 * (KB) + lrow + 4 * i) << sh_); const bf16_t* gp = kvg + (size_t)tok * INW; kr[i] = *(const u32x4*)gp; vr[i] = *(const u32x4*)(gp + 1024); } } while (0)
    DIL_LOAD(pat, kb);
    for (;;) {
#pragma unroll
        for (int i = 0; i < 8; ++i) { *(LAS u32x4*)(kst + 4 * i * KP) = kr[i]; *(LAS u32x4*)(vst + 4 * i * VP) = vr[i]; }
        __builtin_amdgcn_fence(__ATOMIC_RELEASE, "wavefront"); __builtin_amdgcn_wave_barrier(); __builtin_amdgcn_fence(__ATOMIC_ACQUIRE, "wavefront");
        const int cpat = pat, ckb = kb;
        { const int hi_c = pat == 0 ? khi0 : (pat == 1 ? khi1 : khi2);
          if (kb < hi_c) ++kb; else { ++pat; kb = pat == 1 ? klo1 : klo2; } }
        const bool more = pat < 3;
        if (more) DIL_LOAD(pat, kb);
        const int sh = 4 - 2 * cpat, sq = 16 >> sh;
        const int qi = (r16 >> sh) + sq * 32 * ib + sq * r32;
        f32x16 p = negm;
#pragma unroll
        for (int ks = 0; ks < 8; ++ks) { const bf16x8 kf = *(const LAS bf16x8*)(kread + ks * 32); p = MFMA32(kf, qf[ks], p); }
        float sa = 0.f;
#pragma unroll
        for (int r = 0; r < 16; ++r) { const int dl = 32 * ckb + crow(r, hh) - qi; const float e = __builtin_amdgcn_exp2f(p[r]); const float pv = (dl <= 64 && dl >= -64) ? e : 0.f; p[r] = pv; sa += pv; }
        lsum += sa;
        bf16x8 pf[2]; pf[0] = packp(p, 0); pf[1] = packp(p, 1);
#pragma unroll
        for (int s = 0; s < 2; ++s)
#pragma unroll
            for (int db = 0; db < 4; ++db) {
                const LAS char* a = vread + s * 16 * VP + db * 64;
                const s16x4 lo = vtr(a), hi = vtr(a + 8 * VP);
                const bf16x8 vf = __builtin_shufflevector(lo, hi, 0, 1, 2, 3, 4, 5, 6, 7);
                o[db] = MFMA32(vf, pf[s], o[db]);
            }
        __builtin_amdgcn_fence(__ATOMIC_RELEASE, "wavefront"); __builtin_amdgcn_wave_barrier(); __builtin_amdgcn_fence(__ATOMIC_ACQUIRE, "wavefront");
        if (!more) break;
    }
#undef DIL_LOAD
    lsum += __shfl_xor(lsum, 32);
    const float inv = 1.0f / lsum; float ss = 0.f;
#pragma unroll
    for (int db = 0; db < 4; ++db)
#pragma unroll
        for (int r = 0; r < 16; ++r) { const float v = o[db][r] * inv; o[db][r] = v; ss += v * v; }
    ss += __shfl_xor(ss, 32);
    const float rn = __builtin_amdgcn_rsqf(ss * (1.0f / 128.0f) + 1e-6f);
    bf16_t* op = MIX + (rowbase + tq) * DMODEL + h * 128;
#pragma unroll
    for (int db = 0; db < 4; ++db)
#pragma unroll
        for (int g4 = 0; g4 < 4; ++g4) { const int d0 = db * 32 + 8 * g4 + 4 * hh; const f32x4 gg = *(const f32x4*)(g_aout + d0);
            u32x2 w; w.x = cvtpk(o[db][4 * g4] * rn * gg[0], o[db][4 * g4 + 1] * rn * gg[1]); w.y = cvtpk(o[db][4 * g4 + 2] * rn * gg[2], o[db][4 * g4 + 3] * rn * gg[3]);
            *(u32x2*)(op + d0) = w; }
}
}

constexpr int NWAVES = 8;
constexpr int DM = 2048, NBATCH = 2, SEQ = 4096, MROWS = NBATCH * SEQ, DFF = 5632, INW = 6144;
constexpr size_t MiB = 1u << 20;
constexpr size_t WS_CTL = 0;
constexpr size_t OFF_GTAB = 1 * MiB - 4096;
constexpr size_t OFF_RS1 = 0, OFF_RS2 = 32768, OFF_ROPEA = 65536, OFF_ROPEB = OFF_ROPEA + 2 * 4096 * 16 * 4;
constexpr size_t WS_W1A = 1 * MiB, WS_W1B = WS_W1A + 44 * MiB, WS_WIN = WS_W1B + 22 * MiB, WS_WOUT = WS_WIN + 24 * MiB, WS_W2A = WS_WOUT + 8 * MiB, WS_W2B = WS_W2A + 44 * MiB;
constexpr size_t WS_XN = WS_W2B + 22 * MiB;
constexpr size_t WS_ACT = WS_XN + 32 * MiB;
constexpr size_t WS_MIX = WS_ACT + 96 * MiB;
constexpr size_t WS_END = WS_MIX + 32 * MiB;
constexpr int LDS_BYTES = 155648;
constexpr int XCH_OFF = 131072;
static_assert(att::DIL_WAVE * 8 <= LDS_BYTES && 2 * att::DIFF_TILE <= LDS_BYTES && XCH_OFF + 8192 <= LDS_BYTES, "LDS map");

#define LAS __attribute__((address_space(3)))
typedef unsigned short bf16;
typedef unsigned v4u __attribute__((ext_vector_type(4)));
typedef unsigned v2u __attribute__((ext_vector_type(2)));
typedef float f32x4 __attribute__((ext_vector_type(4)));
__device__ __forceinline__ unsigned f2bf(float f) { unsigned u = __builtin_bit_cast(unsigned, f); return (u + 0x7fffu + ((u >> 16) & 1u)) >> 16; }
__device__ __forceinline__ unsigned pk2(float lo, float hi) { return f2bf(lo) | (f2bf(hi) << 16); }
__device__ __forceinline__ float wave_sum(float v) {
#pragma unroll
    for (int o = 1; o < 64; o <<= 1) v += __shfl_xor(v, o);
    return v;
}
__device__ __forceinline__ float wave_max(float v) {
#pragma unroll
    for (int o = 1; o < 64; o <<= 1) v = fmaxf(v, __shfl_xor(v, o));
    return v;
}
template <bool GLU> __device__ __forceinline__ void p0_transpose_item(const float* W, int K, int N, bf16* WT, LAS float* scr, int item, int lane) {
    const int nblk = N / 32, kb = item / nblk, nb = item % nblk, k0 = 64 * kb, n0 = 32 * nb;
    int r0 = n0;
    if (GLU) { const int half = N / 2; r0 = n0 < half ? (n0 >> 7) * 256 + (n0 & 127) : ((n0 - half) >> 7) * 256 + 128 + ((n0 - half) & 127); }
    const int rg = lane >> 3, c4 = lane & 7;
    f32x4 v[8];
    const float* src = W + (size_t)(k0 + rg) * N + n0 + 4 * c4;
#pragma unroll
    for (int i = 0; i < 8; ++i) v[i] = __builtin_nontemporal_load((const f32x4*)(src + (size_t)(8 * i) * N));
#pragma unroll
    for (int i = 0; i < 8; ++i) { LAS float* d = scr + (8 * i + rg) * 33 + 4 * c4; d[0] = v[i][0]; d[1] = v[i][1]; d[2] = v[i][2]; d[3] = v[i][3]; }
    asm volatile("s_waitcnt lgkmcnt(0)" ::: "memory");
    const int c = lane & 7;
#pragma unroll
    for (int j = 0; j < 4; ++j) { const int n = (lane >> 3) + 8 * j; const LAS float* s = scr + (8 * c) * 33 + n;
        v4u o; o.x = pk2(s[0 * 33], s[1 * 33]); o.y = pk2(s[2 * 33], s[3 * 33]); o.z = pk2(s[4 * 33], s[5 * 33]); o.w = pk2(s[6 * 33], s[7 * 33]);
        *(v4u*)(WT + (size_t)(r0 + n) * K + k0 + 8 * c) = o; }
    asm volatile("s_waitcnt lgkmcnt(0)" ::: "memory");
}

struct Args {
    const float* in[20]; float* out; unsigned char* ws;
    float invA[16]; float invB[8];
};

__global__ void __launch_bounds__(NWAVES * 64) hybrid_fwd(Args args) {
    extern __shared__ __attribute__((aligned(16))) unsigned char lds_raw[];
    cg::grid_group grid = cg::this_grid();
    LAS unsigned char* lds = (LAS unsigned char*)lds_raw;
    const int tid = threadIdx.x, lane = tid & 63, wid = __builtin_amdgcn_readfirstlane(tid >> 6);
    const int G = gridDim.x, bx = blockIdx.x;
    unsigned char* ws = args.ws;
    const float* x = args.in[0];
    float* out = args.out;
    float* rowss1 = (float*)(ws + OFF_RS1); float* rowss2 = (float*)(ws + OFF_RS2);
    float* gtab = (float*)(ws + OFF_GTAB); float* ropeA = (float*)(ws + OFF_ROPEA); float* ropeB = (float*)(ws + OFF_ROPEB);
    bf16* W1A = (bf16*)(ws + WS_W1A); bf16* W1B = (bf16*)(ws + WS_W1B); bf16* WIN = (bf16*)(ws + WS_WIN); bf16* WOUT = (bf16*)(ws + WS_WOUT);
    bf16* W2A = (bf16*)(ws + WS_W2A); bf16* W2B = (bf16*)(ws + WS_W2B);
    bf16* XN = (bf16*)(ws + WS_XN); bf16* ACT = (bf16*)(ws + WS_ACT); bf16* QKV = (bf16*)(ws + WS_ACT); bf16* MIX = (bf16*)(ws + WS_MIX);

#ifndef REP_P0
#define REP_P0 1
#endif
#ifndef REP_DIFF
#define REP_DIFF 1
#endif
#ifndef REP_DIL
#define REP_DIL 1
#endif
    for (int rep = 0; rep < REP_P0; ++rep) {
        LAS float* scr = (LAS float*)(lds + wid * 16384);
        const int gw = bx * NWAVES + wid, NGW = G * NWAVES;
        constexpr int I_FA = (DM / 64) * (2 * DFF / 32), I_FB = (DFF / 64) * (DM / 32), I_IN = (DM / 64) * (INW / 32), I_OUT = (DM / 64) * (DM / 32);
        for (int it = gw; it < I_FA; it += NGW) p0_transpose_item<true>(args.in[2], DM, 2 * DFF, W1A, scr, it, lane);
        const float* g1 = args.in[1];
        for (int m = gw; m < MROWS; m += NGW) {
            const f32x4* xr = (const f32x4*)(x + (size_t)m * DM) + lane; f32x4 v[8]; float s = 0.f;
#pragma unroll
            for (int j = 0; j < 8; ++j) { v[j] = xr[64 * j]; s += (v[j][0] * v[j][0] + v[j][1] * v[j][1]) + (v[j][2] * v[j][2] + v[j][3] * v[j][3]); }
            const float rstd = 1.0f / sqrtf(wave_sum(s) * (1.0f / DM) + 1e-6f);
            v2u* o8 = (v2u*)(XN + (size_t)m * DM) + lane;
#pragma unroll
            for (int j = 0; j < 8; ++j) { const f32x4 g = *((const f32x4*)g1 + lane + 64 * j); v2u w; w.x = pk2(v[j][0] * rstd * g[0], v[j][1] * rstd * g[1]); w.y = pk2(v[j][2] * rstd * g[2], v[j][3] * rstd * g[3]); o8[64 * j] = w; }
        }
        const int gt = bx * (NWAVES * 64) + tid, NGT = G * NWAVES * 64;
        for (int i = gt; i < 2 * MROWS; i += NGT) rowss1[i] = 0.f;
        if (gt < 512) { const int t = gt >> 7, d = gt & 127; gtab[gt] = t == 0 ? args.in[6][d] : (t == 1 ? args.in[7][d] : (t == 2 ? args.in[8][d & 63] : args.in[9][d & 63])); }
        for (int i = gt; i < 4096 * 24; i += NGT) {
            const int s = i / 24, k = i % 24; const float inv = k < 16 ? args.invA[k] : args.invB[k - 16];
            const float ang = (float)s * inv; double rev = (double)ang * 0.15915494309189535; rev -= floor(rev);
            const float cs = __builtin_amdgcn_cosf((float)rev), sn = __builtin_amdgcn_sinf((float)rev);
            if (k < 16) { ropeA[s * 16 + k] = cs; ropeA[4096 * 16 + s * 16 + k] = sn; } else { ropeB[s * 8 + k - 16] = cs; ropeB[4096 * 8 + s * 8 + k - 16] = sn; }
        }
    }
    grid.sync();

    { pg8::Gemm g{XN, W1A, MROWS, 2 * DFF, DM}; pg8::StaticOrder S; S.init(MROWS, 2 * DFF, G, bx);
      pg8::EpiSwiGLU E{ACT, DFF, nullptr};
      pg8::gemm_phase<pg8::EpiSwiGLU, pg8::StaticOrder, true, true>(lds, g, S, E); }
    {
        constexpr int NU = (MROWS / 256) * (2 * DFF / 256);
        const int rounds = (NU + G - 1) / G; int first_idle = NU - (rounds - 1) * G, nidle = G - first_idle;
        if (nidle <= 0) { first_idle = 0; nidle = G; }
        if (bx >= first_idle) {
            LAS float* scr = (LAS float*)(lds + wid * 16384);
            const int gw = (bx - first_idle) * NWAVES + wid, NGW = nidle * NWAVES;
            constexpr int I_FA = (DM / 64) * (2 * DFF / 32), I_FB = (DFF / 64) * (DM / 32), I_IN = (DM / 64) * (INW / 32), I_OUT = (DM / 64) * (DM / 32);
            constexpr int NITEMS = I_FA + 2 * I_FB + I_IN + I_OUT;
            for (int it = gw; it < NITEMS; it += NGW) {
                int r = it;
                if (r < I_FB) { p0_transpose_item<false>(args.in[3], DFF, DM, W1B, scr, r, lane); continue; } r -= I_FB;
                if (r < I_IN) { p0_transpose_item<false>(args.in[5], DM, INW, WIN, scr, r, lane); continue; } r -= I_IN;
                if (r < I_OUT) { p0_transpose_item<false>(args.in[16], DM, DM, WOUT, scr, r, lane); continue; } r -= I_OUT;
                if (r < I_FA) { p0_transpose_item<true>(args.in[18], DM, 2 * DFF, W2A, scr, r, lane); continue; } r -= I_FA;
                p0_transpose_item<false>(args.in[19], DFF, DM, W2B, scr, r, lane);
            }
        }
    }
    grid.sync();
    { pg8::Gemm g{ACT, W1B, MROWS, DM, DFF}; pg8::StaticOrder S; S.init(MROWS, DM, G, bx);
      pg8::EpiResid<true> E{x, out, 0.5f, XN, args.in[4], rowss1};
      pg8::gemm_phase<pg8::EpiResid<true>, pg8::StaticOrder, true, true>(lds, g, S, E); }
    grid.sync();
    { pg8::Gemm g{XN, WIN, MROWS, INW, DM}; pg8::StaticOrder S; S.init(MROWS, INW, G, bx);
      pg8::EpiQKV E{QKV, rowss1, gtab, ropeA, ropeB, (LAS float*)(lds + XCH_OFF)};
      pg8::gemm_phase<pg8::EpiQKV, pg8::StaticOrder, true, true>(lds, g, S, E); }
    grid.sync();
    {
        const float L2E = 1.4426950408889634f;
        float gq = fmaxf(fabsf(args.in[6][lane]), fabsf(args.in[6][lane + 64])), gk = fmaxf(fabsf(args.in[7][lane]), fabsf(args.in[7][lane + 64]));
        const float negMA = -1.02f * 11.313708498984761f * wave_max(gq) * wave_max(gk) * L2E;
        const float negMB = -1.02f * 8.0f * wave_max(fabsf(args.in[8][lane])) * wave_max(fabsf(args.in[9][lane])) * L2E;
        const float lam = __expf(wave_sum(args.in[10][lane] * args.in[11][lane])) - __expf(wave_sum(args.in[12][lane] * args.in[13][lane])) + 0.2f;
        for (int rep = 0; rep < REP_DIFF; ++rep)
        for (int u = bx; u < 512; u += G) {
            const int bh = u >> 5, qblk = u & 31;
            att::diff_unit((LAS char*)lds, QKV, MIX, bh >> 3, bh & 7, qblk, lam, negMB, args.in[15], tid, wid, lane);
        }
        for (int rep = 0; rep < REP_DIL; ++rep)
        for (int wu = bx * NWAVES + wid; wu < 2048; wu += G * NWAVES) {
            const int ib = wu & 7, r16 = (wu >> 3) & 15, h = (wu >> 7) & 7, b = wu >> 10;
            att::dil_unit((LAS char*)lds + wid * att::DIL_WAVE, QKV, MIX, b, h, r16, ib, negMA, args.in[14], lane);
        }
    }
    grid.sync();
    { pg8::Gemm g{MIX, WOUT, MROWS, DM, DM}; pg8::StaticOrder S; S.init(MROWS, DM, G, bx);
      pg8::EpiResid<true> E{out, out, 1.0f, XN, args.in[17], rowss2};
      pg8::gemm_phase<pg8::EpiResid<true>, pg8::StaticOrder, true, true>(lds, g, S, E); }
    grid.sync();
    { pg8::Gemm g{XN, W2A, MROWS, 2 * DFF, DM}; pg8::StaticOrder S; S.init(MROWS, 2 * DFF, G, bx);
      pg8::EpiSwiGLU E{ACT, DFF, rowss2};
      pg8::gemm_phase<pg8::EpiSwiGLU, pg8::StaticOrder, true, true>(lds, g, S, E); }
    grid.sync();
    { pg8::Gemm g{ACT, W2B, MROWS, DM, DFF}; pg8::StaticOrder S; S.init(MROWS, DM, G, bx);
      pg8::EpiResid<false> E{out, out, 0.5f, nullptr, nullptr, nullptr};
      pg8::gemm_phase<pg8::EpiResid<false>, pg8::StaticOrder, true, true>(lds, g, S, E); }
}

extern "C" void kernel_launch(void* const* d_in, const int* in_sizes, int n_in, void* d_out, int out_size, void* d_ws, size_t ws_size, hipStream_t stream) {
    static int grid = 0;
    if (grid == 0) {
        if (n_in != 20 || in_sizes[0] != MROWS * DM || out_size != MROWS * DM || ws_size < WS_END) {
            fprintf(stderr, "kernel_launch: unexpected shapes (n_in %d, in0 %d, out %d, ws %zu < %zu)\n", n_in, n_in > 0 ? in_sizes[0] : -1, out_size, ws_size, (size_t)WS_END); grid = -1; return; }
        int dev = 0, cus = 0, per_cu = 0;
        (void)hipGetDevice(&dev); (void)hipDeviceGetAttribute(&cus, hipDeviceAttributeMultiprocessorCount, dev);
        if (hipFuncSetAttribute((const void*)hybrid_fwd, hipFuncAttributeMaxDynamicSharedMemorySize, LDS_BYTES) != hipSuccess) { fprintf(stderr, "kernel_launch: hipFuncSetAttribute failed\n"); grid = -1; return; }
        if (hipOccupancyMaxActiveBlocksPerMultiprocessor(&per_cu, (const void*)hybrid_fwd, NWAVES * 64, LDS_BYTES) != hipSuccess || per_cu < 1) { fprintf(stderr, "kernel_launch: occupancy query says %d\n", per_cu); per_cu = 1; }
        (void)hipGetLastError();
        grid = cus * per_cu;
    }
    if (grid < 0) return;
    Args a{};
    for (int i = 0; i < 20; ++i) a.in[i] = (const float*)d_in[i];
    a.out = (float*)d_out; a.ws = (unsigned char*)d_ws;
    for (int i = 0; i < 16; ++i) a.invA[i] = (float)pow(500000.0, -(double)i / 16.0);
    for (int i = 0; i < 8; ++i) a.invB[i] = (float)pow(500000.0, -(double)i / 8.0);
    void* kargs[] = {&a};
    hipError_t e = hipLaunchCooperativeKernel((const void*)hybrid_fwd, dim3(grid), dim3(NWAVES * 64), kargs, LDS_BYTES, stream);
    if (e != hipSuccess) fprintf(stderr, "kernel_launch: cooperative launch failed: %s (grid %d)\n", hipGetErrorString(e), grid);
}
```

```cpp
#include <hip/hip_runtime.h>
#include <hip/hip_cooperative_groups.h>
#include <cstdio>
#include <cstdint>
#include <cmath>
namespace cg = cooperative_groups;
namespace pg8 {
#define PG8_LAS __attribute__((address_space(3)))
typedef unsigned short bf16_t;
typedef short bf16x8 __attribute__((ext_vector_type(8)));
typedef float f32x4 __attribute__((ext_vector_type(4)));
typedef unsigned u32x4 __attribute__((ext_vector_type(4)));
constexpr int BM = 256, BK = 64, HALF = 128, HTB = HALF * BK * 2  , STAGE_BYTES = 8 * HTB, NXCD = 8, WGM = 8;

__host__ __device__ __forceinline__ int lds_byte(int r, int c) { const int st = (r >> 4) * 2 + (c >> 5), rr = r & 15, cc = c & 31, ob = rr * 64 + cc * 2; return st * 1024 + (ob ^ (((ob >> 9) & 1) << 5)); }
__host__ __device__ __forceinline__ void stage_rc(int b, int& R, int& C) { const int st = b / 1024, sb = b % 1024, swz = sb ^ (((sb >> 9) & 1) << 5); R = (st >> 1) * 16 + swz / 64; C = (st & 1) * 32 + (swz % 64) / 2; }
__host__ __device__ __forceinline__ int perm32(int rho) { const int n = rho >> 4, i = rho & 15; return 8 * (i >> 2) + 4 * n + (i & 3); }

struct Unit { int pm, pn; };
struct Gemm { const bf16_t* A; const bf16_t* Bt; int M, N, K, ld; };

struct StaticOrder {
    int nM, nN, nwg, G, c;
    __host__ __device__ void init(int M, int N, int G_, int c_) { nM = M / BM; nN = N / BM; nwg = nM * nN; G = G_; c = c_; }
    __host__ __device__ bool next(int i, Unit& u) const {
        const long L = (long)i * G + c; if (L >= nwg) return false;
        int wgid = (int)L; { const int q = nwg / NXCD, r = nwg % NXCD, xcd = wgid % NXCD, off = wgid / NXCD; wgid = (xcd < r ? xcd * (q + 1) : r * (q + 1) + (xcd - r) * q) + off; }
        const int nig = WGM * nN, gid = wgid / nig, fm = gid * WGM, gsz = (nM - fm) < WGM ? (nM - fm) : WGM;
        u.pm = fm + ((wgid % nig) % gsz); u.pn = (wgid % nig) / gsz; return true;
    }
    __device__ __forceinline__ void a_ready(const Unit&) const {}
    __device__ __forceinline__ void done(const Unit&) const {}
};

__device__ __forceinline__ unsigned cvt_pk_bf16(float lo, float hi) { unsigned r; asm volatile("v_cvt_pk_bf16_f32 %0, %1, %2" : "=v"(r) : "v"(lo), "v"(hi)); return r; }
typedef float f32x2 __attribute__((ext_vector_type(2)));

typedef unsigned u32x2 __attribute__((ext_vector_type(2)));
constexpr int LDK = 2176, LDQ = 6272;
__device__ __forceinline__ float fast_silu(float g) { return g * __builtin_amdgcn_rcpf(1.0f + __expf(-g)); }

struct EpiSwiGLU {
    static constexpr bool PERM = true, AFTER_DRAIN = false;
    bf16_t* O; int ldc; const float* rowss;
    __device__ __forceinline__ void operator()(f32x4 (&acc)[2][2][4][2], const Unit& u, int wr, int wc, int fr, int fq) const {
        const int row0 = u.pm * BM + wr * 64 + fr; const int col0 = u.pn * HALF + wc * 32 + 8 * fq;
#pragma unroll
        for (int ai = 0; ai < 2; ++ai)
#pragma unroll
            for (int m = 0; m < 4; ++m) {
                const int row = row0 + ai * HALF + m * 16;
                float rs = 1.0f; if (rowss) rs = __builtin_amdgcn_rsqf(rowss[row] * (1.0f / 2048.0f) + 1e-6f);
                f32x4 g0 = acc[ai][0][m][0] * rs, g1 = acc[ai][0][m][1] * rs, u0 = acc[ai][1][m][0] * rs, u1 = acc[ai][1][m][1] * rs;
                u32x4 w;
                w.x = cvt_pk_bf16(fast_silu(g0[0]) * u0[0], fast_silu(g0[1]) * u0[1]); w.y = cvt_pk_bf16(fast_silu(g0[2]) * u0[2], fast_silu(g0[3]) * u0[3]);
                w.z = cvt_pk_bf16(fast_silu(g1[0]) * u1[0], fast_silu(g1[1]) * u1[1]); w.w = cvt_pk_bf16(fast_silu(g1[2]) * u1[2], fast_silu(g1[3]) * u1[3]);
                *(u32x4*)(O + (size_t)row * ldc + col0) = w;
            }
    }
};

template <bool NORMOUT> struct EpiResid {
    static constexpr bool PERM = false, AFTER_DRAIN = false;
    const float* base; float* out; float alpha; bf16_t* xn; const float* gain; float* rowss;
    __device__ __forceinline__ void operator()(f32x4 (&acc)[2][2][4][2], const Unit& u, int wr, int wc, int fr, int fq) const {
        const int row0 = u.pm * BM + wr * 64 + fr; const int col0 = u.pn * BM + wc * 32 + 4 * fq;
        f32x4 gv[2][2];
        if (NORMOUT) {
#pragma unroll
            for (int bj = 0; bj < 2; ++bj)
#pragma unroll
                for (int n = 0; n < 2; ++n) gv[bj][n] = *(const f32x4*)(gain + col0 + bj * HALF + n * 16);
        }
#pragma unroll
        for (int ai = 0; ai < 2; ++ai)
#pragma unroll
            for (int m = 0; m < 4; ++m) {
                const int row = row0 + ai * HALF + m * 16; const size_t off = (size_t)row * 2048 + col0; float ss = 0.f;
#pragma unroll
                for (int bj = 0; bj < 2; ++bj)
#pragma unroll
                    for (int n = 0; n < 2; ++n) {
                        const f32x4 b = *(const f32x4*)(base + off + bj * HALF + n * 16);
                        const f32x4 o = b + acc[ai][bj][m][n] * alpha;
                        *(f32x4*)(out + off + bj * HALF + n * 16) = o;
                        if (NORMOUT) {
                            ss += (o[0] * o[0] + o[1] * o[1]) + (o[2] * o[2] + o[3] * o[3]);
                            const f32x4 t = o * gv[bj][n]; u32x2 w; w.x = cvt_pk_bf16(t[0], t[1]); w.y = cvt_pk_bf16(t[2], t[3]);
                            *(u32x2*)(xn + (size_t)row * LDK + col0 + bj * HALF + n * 16) = w;
                        }
                    }
                if (NORMOUT) { ss += __shfl_xor(ss, 16); ss += __shfl_xor(ss, 32); if (fq == 0) atomicAdd(rowss + row, ss); }
                asm volatile("" ::: "memory");
            }
    }
};

struct EpiQKV {
    static constexpr bool PERM = false, AFTER_DRAIN = false;
    bf16_t* O; const float* rowss; const float* gtab;
    const float* ropeA; const float* ropeB;
    PG8_LAS float* xch;
    __device__ __forceinline__ void operator()(f32x4 (&acc)[2][2][4][2], const Unit& u, int wr, int wc, int fr, int fq) const {
        asm volatile("" : "+v"(fr), "+v"(fq));
        const int region = u.pn >> 2;
        const int row0 = u.pm * BM + wr * 64 + fr;
#pragma unroll
        for (int ai = 0; ai < 2; ++ai)
#pragma unroll
            for (int m = 0; m < 4; ++m) {
                const float rs = __builtin_amdgcn_rsqf(rowss[row0 + ai * HALF + m * 16] * (1.0f / 2048.0f) + 1e-6f);
#pragma unroll
                for (int bj = 0; bj < 2; ++bj)
#pragma unroll
                    for (int n = 0; n < 2; ++n) acc[ai][bj][m][n] = acc[ai][bj][m][n] * rs;
            }
        const bool isv = (region == 2) || (region == 5);
        if (!isv) {
            const bool isA = region < 2;
#pragma unroll
            for (int ai = 0; ai < 2; ++ai)
#pragma unroll
                for (int m = 0; m < 4; ++m)
#pragma unroll
                    for (int bj = 0; bj < 2; ++bj) {
                        const f32x4 a = acc[ai][bj][m][0], b = acc[ai][bj][m][1];
                        float s = ((a[0] * a[0] + a[1] * a[1]) + (a[2] * a[2] + a[3] * a[3])) + ((b[0] * b[0] + b[1] * b[1]) + (b[2] * b[2] + b[3] * b[3]));
                        s += __shfl_xor(s, 16); s += __shfl_xor(s, 32);
                        if (fq == 0) xch[((ai * HALF + wr * 64 + m * 16 + fr) * 2 + bj) * 4 + wc] = s;
                    }
            asm volatile("s_waitcnt lgkmcnt(0)" ::: "memory"); __builtin_amdgcn_s_barrier(); asm volatile("" ::: "memory");
            const float* gptr = gtab + (region < 2 ? region : region - 1) * 128;
            const int dbase = isA ? wc * 32 : (wc & 1) * 32;
            f32x4 gv[2]; gv[0] = *(const f32x4*)(gptr + dbase + 4 * fq); gv[1] = *(const f32x4*)(gptr + dbase + 16 + 4 * fq);
            const float qs = region == 0 ? (0.08838834764831845f * 1.4426950408889634f) : (region == 3 ? (0.125f * 1.4426950408889634f) : 1.0f);
#pragma unroll
            for (int ai = 0; ai < 2; ++ai)
#pragma unroll
                for (int m = 0; m < 4; ++m) {
                    const int rl = ai * HALF + wr * 64 + m * 16 + fr; const int spos = (u.pm * BM + rl) & 4095;
#pragma unroll
                    for (int bj = 0; bj < 2; ++bj) {
                        const f32x4 p = *(const PG8_LAS f32x4*)(xch + (rl * 2 + bj) * 4);
                        float rn;
                        if (isA) rn = __builtin_amdgcn_rsqf(((p[0] + p[1]) + (p[2] + p[3])) * (1.0f / 128.0f) + 1e-6f);
                        else rn = __builtin_amdgcn_rsqf(((wc < 2) ? (p[0] + p[1]) : (p[2] + p[3])) * (1.0f / 64.0f) + 1e-6f);
                        f32x4 v0 = acc[ai][bj][m][0] * rn * gv[0], v1 = acc[ai][bj][m][1] * rn * gv[1];
                        if (isA) {
                            if (wc == 0) {
                                const f32x4 cs = *(const f32x4*)(ropeA + spos * 16 + 4 * fq), sn = *(const f32x4*)(ropeA + 4096 * 16 + spos * 16 + 4 * fq);
                                const f32x4 x1 = v0, x2 = v1; v0 = x1 * cs - x2 * sn; v1 = x2 * cs + x1 * sn;
                            }
                        } else {
                            if ((wc & 1) == 0) {
                                const f32x4 cs = *(const f32x4*)(ropeB + spos * 8 + 4 * (fq & 1)), sn = *(const f32x4*)(ropeB + 4096 * 8 + spos * 8 + 4 * (fq & 1));
                                f32x4 pt; pt[0] = __shfl_xor(v0[0], 32); pt[1] = __shfl_xor(v0[1], 32); pt[2] = __shfl_xor(v0[2], 32); pt[3] = __shfl_xor(v0[3], 32);
                                v0 = (fq < 2) ? (v0 * cs - pt * sn) : (v0 * cs + pt * sn);
                            }
                        }
                        acc[ai][bj][m][0] = v0 * qs; acc[ai][bj][m][1] = v1 * qs;
                    }
                }
        }
        const int col0 = u.pn * BM + wc * 32 + 4 * fq;
#pragma unroll
        for (int ai = 0; ai < 2; ++ai)
#pragma unroll
            for (int m = 0; m < 4; ++m) { bf16_t* rowp = O + (size_t)(row0 + ai * HALF + m * 16) * LDQ + col0;
#pragma unroll
                for (int bj = 0; bj < 2; ++bj)
#pragma unroll
                    for (int n = 0; n < 2; ++n) { const f32x4 v = acc[ai][bj][m][n]; u32x2 w; w.x = cvt_pk_bf16(v[0], v[1]); w.y = cvt_pk_bf16(v[2], v[3]); *(u32x2*)(rowp + bj * HALF + n * 16) = w; } }
    }
};
template <class Epi, class Sched, bool ALIGN_EPI = false, bool SP2 = false>
__device__ __forceinline__ void gemm_phase(PG8_LAS unsigned char* lds, const Gemm g, const Sched& S, const Epi& E) {
    int tid_ = threadIdx.x; asm volatile("" : "+v"(tid_));
    const int tid = tid_, wid = __builtin_amdgcn_readfirstlane(tid >> 6), lane = tid & 63, wr = wid >> 2, wc = wid & 3, fr = lane & 15, fq = lane >> 4;
    const int K = g.ld, nt = g.K / BK;
    unsigned voffA[2], voffB[2];
#pragma unroll
    for (int i = 0; i < 2; ++i) { int R, C; stage_rc(tid * 16 + i * 8192, R, C); const int Rb = Epi::PERM ? ((R & ~31) + perm32(R & 31)) : R;
        voffA[i] = (unsigned)(R * K + C) * 2u; voffB[i] = (unsigned)(Rb * K + C) * 2u; }
    const size_t kstep = (size_t)(BK * 2);
    const size_t hstep = (size_t)HALF * K * 2;
    const size_t tstep = 2 * hstep;
    const unsigned ldsw = (unsigned)wid * 1024u;
    const int aoff = lds_byte(wr * 64 + fr, fq * 8), boff = lds_byte(wc * 32 + fr, fq * 8);
#define PG8_SA(b, h) (((b) * 2 + (h)) * HTB)
#define PG8_SB(b, h) ((4 + (b) * 2 + (h)) * HTB)
#define PG8_STAGE(bufoff, gbase, voff) do { _Pragma("unroll") for (int _i = 0; _i < 2; ++_i) \
        __builtin_amdgcn_global_load_lds((const unsigned*)((const char*)(gbase) + (voff)[_i]), (PG8_LAS unsigned*)(lds + (bufoff) + ldsw + _i * 8192), 16, 0, 0); } while (0)
#define PG8_LDA(dst, b, h) do { _Pragma("unroll") for (int m = 0; m < 4; ++m) _Pragma("unroll") for (int k = 0; k < 2; ++k) dst[m][k] = *(const PG8_LAS bf16x8*)(lds + PG8_SA(b, h) + aoff + m * 2048 + k * 1024); } while (0)
#define PG8_LDB(dst, b, h) do { _Pragma("unroll") for (int n = 0; n < 2; ++n) _Pragma("unroll") for (int k = 0; k < 2; ++k) dst[n][k] = *(const PG8_LAS bf16x8*)(lds + PG8_SB(b, h) + boff + n * 2048 + k * 1024); } while (0)
#define PG8_MMA(ai, bj, At, Bt) do { __builtin_amdgcn_s_setprio(1); _Pragma("unroll") for (int m = 0; m < 4; ++m) _Pragma("unroll") for (int n = 0; n < 2; ++n) _Pragma("unroll") for (int k = 0; k < 2; ++k) \
        acc[ai][bj][m][n] = __builtin_amdgcn_mfma_f32_16x16x32_bf16(Bt[n][k], At[m][k], acc[ai][bj][m][n], 0, 0, 0); __builtin_amdgcn_s_setprio(0); } while (0)
#define PG8_WAIT_V(n) asm volatile("s_waitcnt vmcnt(" #n ")" ::: "memory")
#define PG8_WAIT_L(n) asm volatile("s_waitcnt lgkmcnt(" #n ")" ::: "memory")
#define PG8_BAR __builtin_amdgcn_s_barrier()
#define PG8_SCHED __builtin_amdgcn_sched_barrier(0)
    Unit cur, nxt; int ui = 0;
    if (!S.next(0, cur)) return;
    f32x4 acc[2][2][4][2];
#pragma unroll
    for (int a = 0; a < 2; ++a)
#pragma unroll
        for (int b = 0; b < 2; ++b)
#pragma unroll
            for (int m = 0; m < 4; ++m)
#pragma unroll
                for (int n = 0; n < 2; ++n) acc[a][b][m][n] = (f32x4){0.f, 0.f, 0.f, 0.f};
    bf16x8 At[4][2], B0[2][2], B1[2][2];
    const char* cA = (const char*)g.A + (size_t)cur.pm * tstep; const char* cB = (const char*)g.Bt + (size_t)cur.pn * tstep;
    S.a_ready(cur);
    if constexpr (SP2) {
        PG8_STAGE(PG8_SB(0, 0), cB, voffB); PG8_STAGE(PG8_SB(0, 1), cB + hstep, voffB); PG8_STAGE(PG8_SA(0, 0), cA, voffA); PG8_STAGE(PG8_SA(0, 1), cA + hstep, voffA);
        if (wr == 1) PG8_BAR;
        PG8_WAIT_V(2); PG8_BAR;
        PG8_STAGE(PG8_SB(1, 0), cB + kstep, voffB); PG8_STAGE(PG8_SA(1, 0), cA + kstep, voffA); PG8_STAGE(PG8_SB(1, 1), cB + hstep + kstep, voffB);
        PG8_WAIT_V(6); PG8_BAR;
    } else {
        PG8_STAGE(PG8_SB(0, 0), cB, voffB); PG8_STAGE(PG8_SA(0, 0), cA, voffA); PG8_STAGE(PG8_SB(0, 1), cB + hstep, voffB); PG8_STAGE(PG8_SA(0, 1), cA + hstep, voffA);
        if (wr == 1) PG8_BAR;
        PG8_WAIT_V(4); PG8_BAR;
        PG8_STAGE(PG8_SB(1, 0), cB + kstep, voffB); PG8_STAGE(PG8_SA(1, 0), cA + kstep, voffA); PG8_STAGE(PG8_SB(1, 1), cB + hstep + kstep, voffB);
        PG8_WAIT_V(6); PG8_BAR;
    }
    for (;;) {
        const bool has_next = S.next(ui + 1, nxt);
        const char* nA = has_next ? (const char*)g.A + (size_t)nxt.pm * tstep : cA; const char* nB = has_next ? (const char*)g.Bt + (size_t)nxt.pn * tstep : cB;
        for (int t = 0; t < nt; t += 2) {
            const bool last = (t == nt - 2);
            const char* a1 = cA + (size_t)(t + 1) * kstep;
            const char* a2 = last ? nA : cA + (size_t)(t + 2) * kstep; const char* b2 = last ? nB : cB + (size_t)(t + 2) * kstep;
            const char* a3 = a2 + kstep; const char* b3 = b2 + kstep;
            if (last && has_next) S.a_ready(nxt);
            if constexpr (SP2) {
            PG8_LDB(B0, 0, 0); PG8_LDB(B1, 0, 1); PG8_SCHED; PG8_LDA(At, 0, 0); PG8_STAGE(PG8_SA(1, 1), a1 + hstep, voffA);
            PG8_WAIT_V(8); PG8_WAIT_L(0); PG8_BAR; PG8_MMA(0, 0, At, B0); PG8_MMA(0, 1, At, B1); PG8_BAR; PG8_SCHED;
            PG8_LDA(At, 0, 1); PG8_STAGE(PG8_SB(0, 0), b2, voffB); PG8_STAGE(PG8_SB(0, 1), b2 + hstep, voffB); PG8_STAGE(PG8_SA(0, 0), a2, voffA);
            PG8_WAIT_V(8); PG8_WAIT_L(0); PG8_BAR; PG8_MMA(1, 0, At, B0); PG8_MMA(1, 1, At, B1); PG8_BAR; PG8_SCHED;
            PG8_LDB(B0, 1, 0); PG8_LDB(B1, 1, 1); PG8_SCHED; PG8_LDA(At, 1, 0); PG8_STAGE(PG8_SA(0, 1), a2 + hstep, voffA);
            PG8_WAIT_V(8); PG8_WAIT_L(0); PG8_BAR; PG8_MMA(0, 0, At, B0); PG8_MMA(0, 1, At, B1); PG8_BAR; PG8_SCHED;
            PG8_LDA(At, 1, 1); PG8_STAGE(PG8_SB(1, 0), b3, voffB); PG8_STAGE(PG8_SB(1, 1), b3 + hstep, voffB); PG8_STAGE(PG8_SA(1, 0), a3, voffA);
            PG8_WAIT_V(8); PG8_WAIT_L(0); PG8_BAR; PG8_MMA(1, 0, At, B0); PG8_MMA(1, 1, At, B1); PG8_BAR; PG8_SCHED;
            } else {
            PG8_LDB(B0, 0, 0); PG8_SCHED; PG8_LDA(At, 0, 0); PG8_STAGE(PG8_SA(1, 1), a1 + hstep, voffA);
            PG8_WAIT_L(8); PG8_BAR; PG8_WAIT_L(0); PG8_MMA(0, 0, At, B0); PG8_BAR; PG8_SCHED;
            PG8_LDB(B1, 0, 1); PG8_STAGE(PG8_SB(0, 0), b2, voffB);
            PG8_BAR; PG8_WAIT_L(0); PG8_MMA(0, 1, At, B1); PG8_BAR;
            PG8_LDA(At, 0, 1); PG8_STAGE(PG8_SA(0, 0), a2, voffA);
            PG8_BAR; PG8_WAIT_L(0); PG8_MMA(1, 0, At, B0); PG8_BAR; PG8_SCHED;
            PG8_STAGE(PG8_SB(0, 1), b2 + hstep, voffB);
            PG8_WAIT_V(6); PG8_BAR; PG8_MMA(1, 1, At, B1); PG8_BAR;
            PG8_LDB(B0, 1, 0); PG8_SCHED; PG8_LDA(At, 1, 0); PG8_STAGE(PG8_SA(0, 1), a2 + hstep, voffA);
            PG8_WAIT_L(8); PG8_BAR; PG8_WAIT_L(0); PG8_MMA(0, 0, At, B0); PG8_BAR; PG8_SCHED;
            PG8_LDB(B1, 1, 1); PG8_STAGE(PG8_SB(1, 0), b3, voffB);
            PG8_BAR; PG8_WAIT_L(0); PG8_MMA(0, 1, At, B1); PG8_BAR;
            PG8_LDA(At, 1, 1); PG8_STAGE(PG8_SA(1, 0), a3, voffA);
            PG8_BAR; PG8_WAIT_L(0); PG8_MMA(1, 0, At, B0); PG8_BAR; PG8_SCHED;
            PG8_STAGE(PG8_SB(1, 1), b3 + hstep, voffB);
            PG8_WAIT_V(6); PG8_BAR; PG8_MMA(1, 1, At, B1); PG8_BAR;
            }
        }
        if constexpr (ALIGN_EPI) { if (wr == 0) PG8_BAR; }
        if constexpr (!Epi::AFTER_DRAIN) { E(acc, cur, wr, wc, fr, fq); S.done(cur); }
        if (!has_next) break;
#pragma unroll
        for (int a = 0; a < 2; ++a)
#pragma unroll
            for (int b = 0; b < 2; ++b)
#pragma unroll
                for (int m = 0; m < 4; ++m)
#pragma unroll
                    for (int n = 0; n < 2; ++n) acc[a][b][m][n] = (f32x4){0.f, 0.f, 0.f, 0.f};
        cur = nxt; cA = nA; cB = nB; ++ui;
        if constexpr (ALIGN_EPI) { if (wr == 1) PG8_BAR; }
    }
    PG8_WAIT_V(0);
    if constexpr (!ALIGN_EPI) { if (wr == 0) PG8_BAR; }
    PG8_BAR;
    if constexpr (Epi::AFTER_DRAIN) { E.fused(acc, cur, wr, wc, fr, fq, lds, wid, lane); S.done(cur); }
#undef PG8_SA
#undef PG8_SB
#undef PG8_STAGE
#undef PG8_LDA
#undef PG8_LDB
#undef PG8_MMA
#undef PG8_WAIT_V
#undef PG8_WAIT_L
#undef PG8_BAR
#undef PG8_SCHED
}
}

namespace att {
#define LAS __attribute__((address_space(3)))
typedef unsigned short bf16_t;
typedef short bf16x8 __attribute__((ext_vector_type(8)));
typedef short s16x4 __attribute__((ext_vector_type(4)));
typedef short v4i16_t __attribute__((ext_vector_type(4)));
typedef float f32x16 __attribute__((ext_vector_type(16)));
typedef float f32x4 __attribute__((ext_vector_type(4)));
typedef unsigned u32x4 __attribute__((ext_vector_type(4)));
typedef unsigned u32x2 __attribute__((ext_vector_type(2)));
typedef float f32x2_t __attribute__((ext_vector_type(2))); typedef __bf16 bf16x2_t __attribute__((ext_vector_type(2)));
constexpr int SEQ = 4096, INW = 6272, DMODEL = 2176;
constexpr int KP = 272, VP = 320;
constexpr int DIFF_TILE = 64 * KP + 64 * VP;
constexpr int DIL_WAVE = 32 * KP + 32 * VP;
__device__ __forceinline__ unsigned cvtpk(float lo, float hi) { f32x2_t v = {lo, hi}; bf16x2_t b = __builtin_convertvector(v, bf16x2_t); return __builtin_bit_cast(unsigned, b); }
__device__ __forceinline__ int crow(int r, int hi) { return (r & 3) + 8 * (r >> 2) + 4 * hi; }
__device__ __forceinline__ s16x4 vtr(const LAS char* p) { return __builtin_bit_cast(s16x4, __builtin_amdgcn_ds_read_tr16_b64_v4i16((LAS v4i16_t*)p)); }
__device__ __forceinline__ bf16x8 packp(const f32x16& p, int s) {
    u32x4 w; w.x = cvtpk(p[8 * s], p[8 * s + 1]); w.y = cvtpk(p[8 * s + 2], p[8 * s + 3]); w.z = cvtpk(p[8 * s + 4], p[8 * s + 5]); w.w = cvtpk(p[8 * s + 6], p[8 * s + 7]);
    return __builtin_bit_cast(bf16x8, w);
}
#define MFMA32(a, b, c) __builtin_amdgcn_mfma_f32_32x32x16_bf16((a), (b), (c), 0, 0, 0)

__device__ __forceinline__ void diff_unit(LAS char* lds, const bf16_t* QKV, bf16_t* MIX, int b, int h, int qblk, float lam, float negM, const float* g_bout, int tid, int wid, int lane) {
    const int c = wid >> 2, r32 = lane & 31, hh = lane >> 5, cb = (lane >> 4) & 1, q_ = (lane & 15) >> 2, p_ = lane & 3;
    const size_t rowbase = (size_t)b * SEQ; const int q0 = qblk * 128 + (wid & 3) * 32;
    bf16x8 qf[4];
    { const bf16_t* qp = QKV + (rowbase + q0 + r32) * INW + 3072 + h * 128 + c * 64 + 8 * hh;
#pragma unroll
      for (int ks = 0; ks < 4; ++ks) qf[ks] = *(const bf16x8*)(qp + 16 * ks); }
    const int srow = tid >> 4, sch = tid & 15;
    const bf16_t* kg = QKV + (rowbase + srow) * INW + 4096 + h * 128 + sch * 8;
    const bf16_t* vg = kg + 1024;
    LAS char* kst = lds + srow * KP + sch * 16; LAS char* vst = lds + 64 * KP + srow * VP + sch * 16;
    f32x16 o[4];
#pragma unroll
    for (int i = 0; i < 4; ++i)
#pragma unroll
        for (int r = 0; r < 16; ++r) o[i][r] = 0.f;
    float lsum = 0.f;
    f32x16 negm;
#pragma unroll
    for (int r = 0; r < 16; ++r) negm[r] = negM;
    u32x4 kr0, kr1, vr0, vr1;
    kr0 = *(const u32x4*)(kg); kr1 = *(const u32x4*)(kg + (size_t)32 * INW); vr0 = *(const u32x4*)(vg); vr1 = *(const u32x4*)(vg + (size_t)32 * INW);
    *(LAS u32x4*)(kst) = kr0; *(LAS u32x4*)(kst + 32 * KP) = kr1; *(LAS u32x4*)(vst) = vr0; *(LAS u32x4*)(vst + 32 * VP) = vr1;
    __syncthreads();
    const int NT = SEQ / 64;
    const LAS char* kread = lds + r32 * KP + (c * 64 + 8 * hh) * 2;
    const LAS char* vread = lds + 64 * KP + (4 * hh + q_) * VP + (16 * cb + 4 * p_) * 2;
    for (int t = 0; t < NT; ++t) {
        const int cur = (t & 1) * DIFF_TILE, nxt = DIFF_TILE - cur;
        if (t + 1 < NT) { const size_t go = (size_t)(t + 1) * 64 * INW;
            kr0 = *(const u32x4*)(kg + go); kr1 = *(const u32x4*)(kg + go + (size_t)32 * INW); vr0 = *(const u32x4*)(vg + go); vr1 = *(const u32x4*)(vg + go + (size_t)32 * INW); }
        f32x16 p0 = negm, p1 = negm;
#pragma unroll
        for (int ks = 0; ks < 4; ++ks) {
            const bf16x8 k0 = *(const LAS bf16x8*)(kread + cur + ks * 32), k1 = *(const LAS bf16x8*)(kread + cur + 32 * KP + ks * 32);
            p0 = MFMA32(k0, qf[ks], p0); p1 = MFMA32(k1, qf[ks], p1);
        }
        float sa = 0.f, sb = 0.f;
#pragma unroll
        for (int r = 0; r < 16; ++r) { p0[r] = __builtin_amdgcn_exp2f(p0[r]); p1[r] = __builtin_amdgcn_exp2f(p1[r]); sa += p0[r]; sb += p1[r]; }
        lsum += sa + sb;
        bf16x8 pf[4]; pf[0] = packp(p0, 0); pf[1] = packp(p0, 1); pf[2] = packp(p1, 0); pf[3] = packp(p1, 1);
#pragma unroll
        for (int kst4 = 0; kst4 < 4; ++kst4)
#pragma unroll
            for (int db = 0; db < 4; ++db) {
                const LAS char* a = vread + cur + kst4 * 16 * VP + db * 64;
                const s16x4 lo = vtr(a), hi = vtr(a + 8 * VP);
                const bf16x8 vf = __builtin_shufflevector(lo, hi, 0, 1, 2, 3, 4, 5, 6, 7);
                o[db] = MFMA32(vf, pf[kst4], o[db]);
            }
        if (t + 1 < NT) { *(LAS u32x4*)(kst + nxt) = kr0; *(LAS u32x4*)(kst + nxt + 32 * KP) = kr1; *(LAS u32x4*)(vst + nxt) = vr0; *(LAS u32x4*)(vst + nxt + 32 * VP) = vr1; }
        __syncthreads();
    }
    lsum += __shfl_xor(lsum, 32);
    float inv = 1.0f / lsum; if (c == 1) inv *= lam;
    LAS float* X = (LAS float*)lds + (wid & 3) * 4096;
    if (c == 1) {
#pragma unroll
        for (int db = 0; db < 4; ++db)
#pragma unroll
            for (int r = 0; r < 16; ++r) X[(db * 32 + crow(r, hh)) * 32 + r32] = o[db][r] * inv;
    }
    __syncthreads();
    if (c == 0) {
        float ss = 0.f;
#pragma unroll
        for (int db = 0; db < 4; ++db)
#pragma unroll
            for (int r = 0; r < 16; ++r) { const float v = o[db][r] * inv - X[(db * 32 + crow(r, hh)) * 32 + r32]; o[db][r] = v; ss += v * v; }
        ss += __shfl_xor(ss, 32);
        const float rn = __builtin_amdgcn_rsqf(ss * (1.0f / 128.0f) + 1e-6f) * 0.8f;
        bf16_t* op = MIX + (rowbase + q0 + r32) * DMODEL + 1024 + h * 128;
#pragma unroll
        for (int db = 0; db < 4; ++db)
#pragma unroll
            for (int g4 = 0; g4 < 4; ++g4) { const int d0 = db * 32 + 8 * g4 + 4 * hh; const f32x4 gg = *(const f32x4*)(g_bout + d0);
                u32x2 w; w.x = cvtpk(o[db][4 * g4] * rn * gg[0], o[db][4 * g4 + 1] * rn * gg[1]); w.y = cvtpk(o[db][4 * g4 + 2] * rn * gg[2], o[db][4 * g4 + 3] * rn * gg[3]);
                *(u32x2*)(op + d0) = w; }
    }
    __syncthreads();
}

__device__ __forceinline__ void dil_unit(LAS char* wl, const bf16_t* QKV, bf16_t* MIX, int b, int h, int r16, int ib, float negM, const float* g_aout, int lane) {
    const int r32 = lane & 31, hh = lane >> 5, cb = (lane >> 4) & 1, q_ = (lane & 15) >> 2, p_ = lane & 3;
    const size_t rowbase = (size_t)b * SEQ;
    const int tq = r16 + 16 * (32 * ib + r32);
    bf16x8 qf[8];
    { const bf16_t* qp = QKV + (rowbase + tq) * INW + h * 128 + 8 * hh;
#pragma unroll
      for (int ks = 0; ks < 8; ++ks) qf[ks] = *(const bf16x8*)(qp + 16 * ks); }
    f32x16 o[4];
#pragma unroll
    for (int i = 0; i < 4; ++i)
#pragma unroll
        for (int r = 0; r < 16; ++r) o[i][r] = 0.f;
    float lsum = 0.f;
    f32x16 negm;
#pragma unroll
    for (int r = 0; r < 16; ++r) negm[r] = negM;
    const int lrow = lane >> 4, lch = lane & 15;
    const bf16_t* kvg = QKV + rowbase * INW + 1024 + h * 128 + lch * 8;
    LAS char* kst = wl + lrow * KP + lch * 16; LAS char* vst = wl + 32 * KP + lrow * VP + lch * 16;
    const LAS char* kread = wl + r32 * KP + 8 * hh * 2;
    const LAS char* vread = wl + 32 * KP + (4 * hh + q_) * VP + (16 * cb + 4 * p_) * 2;
    int klo0, khi0, klo1, khi1, klo2, khi2;
    { const int bq = 32 * ib;               int lo_i = bq - 64; if (lo_i < 0) lo_i = 0; klo0 = lo_i >> 5; khi0 = (bq + 31 + 64) >> 5;      if (khi0 > 7) khi0 = 7; }
    { const int bq = (r16 >> 2) + 128 * ib; int lo_i = bq - 64; if (lo_i < 0) lo_i = 0; klo1 = lo_i >> 5; khi1 = (bq + 31 * 4 + 64) >> 5;  if (khi1 > 31) khi1 = 31; }
    { const int bq = r16 + 512 * ib;        int lo_i = bq - 64; if (lo_i < 0) lo_i = 0; klo2 = lo_i >> 5; khi2 = (bq + 31 * 16 + 64) >> 5; if (khi2 > 127) khi2 = 127; }
    int pat = 0, kb = klo0;
    u32x4 kr[8], vr[8];
#define DIL_LOAD(PAT, KB) do { const int sh_ = 4 - 2 * (PAT); const int rc_ = r16 & ((1 << sh_) - 1); \
        _Pragma("unroll") for (int i = 0; i < 8; ++i) { const int tok = rc_ + ((32 * (KB) + lrow + 4 * i) << sh_); const bf16_t* gp = kvg + (size_t)tok * INW; kr[i] = *(const u32x4*)gp; vr[i] = *(const u32x4*)(gp + 1024); } } while (0)
    DIL_LOAD(pat, kb);
    for (;;) {
#pragma unroll
        for (int i = 0; i < 8; ++i) { *(LAS u32x4*)(kst + 4 * i * KP) = kr[i]; *(LAS u32x4*)(vst + 4 * i * VP) = vr[i]; }
        __builtin_amdgcn_fence(__ATOMIC_RELEASE, "wavefront"); __builtin_amdgcn_wave_barrier(); __builtin_amdgcn_fence(__ATOMIC_ACQUIRE, "wavefront");
        const int cpat = pat, ckb = kb;
        { const int hi_c = pat == 0 ? khi0 : (pat == 1 ? khi1 : khi2);
          if (kb < hi_c) ++kb; else { ++pat; kb = pat == 1 ? klo1 : klo2; } }
        const bool more = pat < 3;
        if (more) DIL_LOAD(pat, kb);
        const int sh = 4 - 2 * cpat, sq = 16 >> sh;
        const int qi = (r16 >> sh) + sq * 32 * ib + sq * r32;
        f32x16 p = negm;
#pragma unroll
        for (int ks = 0; ks < 8; ++ks) { const bf16x8 kf = *(const LAS bf16x8*)(kread + ks * 32); p = MFMA32(kf, qf[ks], p); }
        float sa = 0.f;
#pragma unroll
        for (int r = 0; r < 16; ++r) { const int dl = 32 * ckb + crow(r, hh) - qi; const float e = __builtin_amdgcn_exp2f(p[r]); const float pv = (dl <= 64 && dl >= -64) ? e : 0.f; p[r] = pv; sa += pv; }
        lsum += sa;
        bf16x8 pf[2]; pf[0] = packp(p, 0); pf[1] = packp(p, 1);
#pragma unroll
        for (int s = 0; s < 2; ++s)
#pragma unroll
            for (int db = 0; db < 4; ++db) {
                const LAS char* a = vread + s * 16 * VP + db * 64;
                const s16x4 lo = vtr(a), hi = vtr(a + 8 * VP);
                const bf16x8 vf = __builtin_shufflevector(lo, hi, 0, 1, 2, 3, 4, 5, 6, 7);
                o[db] = MFMA32(vf, pf[s], o[db]);
            }
        __builtin_amdgcn_fence(__ATOMIC_RELEASE, "wavefront"); __builtin_amdgcn_wave_barrier(); __builtin_amdgcn_fence(__ATOMIC_ACQUIRE, "wavefront");
        if (!more) break;
    }
#undef DIL_LOAD
    lsum += __shfl_xor(lsum, 32);
    const float inv = 1.0f / lsum; float ss = 0.f;
#pragma unroll
    for (int db = 0; db < 4; ++db)
#pragma unroll
        for (int r = 0; r < 16; ++r) { const float v = o[db][r] * inv; o[db][r] = v; ss += v * v; }
    ss += __shfl_xor(ss, 32);
    const float rn = __builtin_amdgcn_rsqf(ss * (1.0f / 128.0f) + 1e-6f);
    bf16_t* op = MIX + (rowbase + tq) * DMODEL + h * 128;
#pragma unroll
    for (int db = 0; db < 4; ++db)
#pragma unroll
        for (int g4 = 0; g4 < 4; ++g4) { const int d0 = db * 32 + 8 * g4 + 4 * hh; const f32x4 gg = *(const f32x4*)(g_aout + d0);
            u32x2 w; w.x = cvtpk(o[db][4 * g4] * rn * gg[0], o[db][4 * g4 + 1] * rn * gg[1]); w.y = cvtpk(o[db][4 * g4 + 2] * rn * gg[2], o[db][4 * g4 + 3] * rn * gg[3]);
            *(u32x2*)(op + d0) = w; }
}
}

constexpr int NWAVES = 8;
constexpr int DM = 2048, NBATCH = 2, SEQ = 4096, MROWS = NBATCH * SEQ, DFF = 5632, INW = 6144;
constexpr size_t MiB = 1u << 20;
constexpr size_t WS_CTL = 0;
constexpr size_t OFF_GTAB = 1 * MiB - 4096;
constexpr size_t OFF_BAR = 983040, BAR_BYTES = 16384;
constexpr size_t OFF_RS1 = 0, OFF_RS2 = 32768, OFF_ROPEA = 65536, OFF_ROPEB = OFF_ROPEA + 2 * 4096 * 16 * 4;
constexpr int LDK = pg8::LDK, LDQ = pg8::LDQ;
constexpr size_t WS_W1A = 1 * MiB, WS_W1B = WS_W1A + 47 * MiB, WS_WIN = WS_W1B + 22 * MiB, WS_WOUT = WS_WIN + 26 * MiB, WS_W2A = WS_WOUT + 9 * MiB, WS_W2B = WS_W2A + 47 * MiB;
constexpr size_t WS_XN = WS_W2B + 22 * MiB;
constexpr size_t WS_ACT = WS_XN + 34 * MiB;
constexpr size_t WS_MIX = WS_ACT + 98 * MiB;
constexpr size_t WS_END = WS_MIX + 34 * MiB;
constexpr int LDS_BYTES = 155648;
constexpr int XCH_OFF = 131072;
static_assert((size_t)11264 * LDK * 2 <= 47 * MiB && (size_t)6144 * LDK * 2 <= 26 * MiB && (size_t)2048 * LDK * 2 <= 9 * MiB && (size_t)8192 * LDK * 2 <= 34 * MiB && (size_t)8192 * LDQ * 2 <= 98 * MiB && att::INW == LDQ && att::DMODEL == LDK, "ws map");
static_assert(att::DIL_WAVE * 8 <= LDS_BYTES - 64 && 3456 * 4 <= BAR_BYTES && 2 * att::DIFF_TILE <= LDS_BYTES && XCH_OFF + 8192 <= LDS_BYTES, "LDS map");

#define LAS __attribute__((address_space(3)))
typedef unsigned short bf16;
typedef unsigned v4u __attribute__((ext_vector_type(4)));
typedef unsigned v2u __attribute__((ext_vector_type(2)));
typedef float f32x4 __attribute__((ext_vector_type(4)));
__device__ __forceinline__ unsigned f2bf(float f) { unsigned u = __builtin_bit_cast(unsigned, f); return (u + 0x7fffu + ((u >> 16) & 1u)) >> 16; }
__device__ __forceinline__ unsigned pk2(float lo, float hi) { return f2bf(lo) | (f2bf(hi) << 16); }
__device__ __forceinline__ float wave_sum(float v) {
#pragma unroll
    for (int o = 1; o < 64; o <<= 1) v += __shfl_xor(v, o);
    return v;
}
__device__ __forceinline__ float wave_max(float v) {
#pragma unroll
    for (int o = 1; o < 64; o <<= 1) v = fmaxf(v, __shfl_xor(v, o));
    return v;
}
template <bool GLU> __device__ __forceinline__ void p0_transpose_item(const float* W, int K, int N, bf16* WT, int ldw, LAS float* scr, int item, int lane) {
    const int nblk = N / 32, kb = item / nblk, nb = item % nblk, k0 = 64 * kb, n0 = 32 * nb;
    int r0 = n0;
    if (GLU) { const int half = N / 2; r0 = n0 < half ? (n0 >> 7) * 256 + (n0 & 127) : ((n0 - half) >> 7) * 256 + 128 + ((n0 - half) & 127); }
    const int rg = lane >> 3, c4 = lane & 7;
    f32x4 v[8];
    const float* src = W + (size_t)(k0 + rg) * N + n0 + 4 * c4;
#pragma unroll
    for (int i = 0; i < 8; ++i) v[i] = __builtin_nontemporal_load((const f32x4*)(src + (size_t)(8 * i) * N));
#pragma unroll
    for (int i = 0; i < 8; ++i) { LAS float* d = scr + (8 * i + rg) * 33 + 4 * c4; d[0] = v[i][0]; d[1] = v[i][1]; d[2] = v[i][2]; d[3] = v[i][3]; }
    asm volatile("s_waitcnt lgkmcnt(0)" ::: "memory");
    const int c = lane & 7;
#pragma unroll
    for (int j = 0; j < 4; ++j) { const int n = (lane >> 3) + 8 * j; const LAS float* s = scr + (8 * c) * 33 + n;
        v4u o; o.x = pk2(s[0 * 33], s[1 * 33]); o.y = pk2(s[2 * 33], s[3 * 33]); o.z = pk2(s[4 * 33], s[5 * 33]); o.w = pk2(s[6 * 33], s[7 * 33]);
        *(v4u*)(WT + (size_t)(r0 + n) * ldw + k0 + 8 * c) = o; }
    asm volatile("s_waitcnt lgkmcnt(0)" ::: "memory");
}

#define XB_TMO      128
#define XB_XCNT(j)  (256  + 64 * (j))
#define XB_XSUB(j)  (1280 + 64 * (j))
#define XB_XGEN(j)  (2304 + 64 * (j))
#define XB_TOP      3328
#define XB_TOPGEN   3392
#define XCD_BAR_WORDS 3456
#define XB_SPIN_CAP (1u << 18)

__device__ __forceinline__ unsigned xb_ld(unsigned* p)              { return __hip_atomic_load(p, __ATOMIC_RELAXED, __HIP_MEMORY_SCOPE_AGENT); }
__device__ __forceinline__ unsigned xb_add(unsigned* p, unsigned v) { return __hip_atomic_fetch_add(p, v, __ATOMIC_RELAXED, __HIP_MEMORY_SCOPE_AGENT); }
__device__ __forceinline__ unsigned xb_xcc_id() { return (unsigned)__builtin_amdgcn_s_getreg((3 << 11) | 20) & 0xFu; }
#define XB_SPIN(cond, bar) do { unsigned _sp = 0; while (cond) { __builtin_amdgcn_s_sleep(1); \
    if ((++_sp & 255u) == 0u) { if (xb_ld(&(bar)[XB_TMO])) break; if (_sp > XB_SPIN_CAP) { atomicAdd(&(bar)[XB_TMO], 1u); break; } } } } while (0)

struct XcdBarrier {
    unsigned* bar; unsigned x;
    volatile LAS unsigned* st;
};

__device__ __forceinline__ XcdBarrier xcd_barrier_post(unsigned* bar, volatile LAS unsigned* st) {
    XcdBarrier b; b.bar = bar; b.x = xb_xcc_id(); b.st = st;
    if (threadIdx.x == 0) (void)xb_add(&bar[XB_XCNT(b.x)], 1u);
    return b;
}
__device__ __forceinline__ void xcd_barrier_complete(unsigned* bar, unsigned x, unsigned& nloc, unsigned& nx) {
    const unsigned G = gridDim.x * gridDim.y * gridDim.z;
    unsigned sum, cnt, mine, sp = 0u;
    for (;;) {
        sum = 0u; cnt = 0u; mine = 0u;
#pragma unroll
        for (unsigned j = 0; j < 16; ++j) { const unsigned c = xb_ld(&bar[XB_XCNT(j)]); sum += c; cnt += (c > 0u) ? 1u : 0u; mine = (j == x) ? c : mine; }
        if (sum == G) break;
        __builtin_amdgcn_s_sleep(1);
        if ((++sp & 255u) == 0u) { if (xb_ld(&bar[XB_TMO])) break; if (sp > XB_SPIN_CAP) { atomicAdd(&bar[XB_TMO], 1u); break; } }
    }
    nloc = mine > 0u ? mine : 1u; nx = cnt > 0u ? cnt : 1u;
}

__device__ __forceinline__ void xcd_barrier(const XcdBarrier& b) {
    asm volatile("s_waitcnt vmcnt(0)" ::: "memory");
    __syncthreads();
    if (threadIdx.x == 0) {
        unsigned* bar = b.bar;
        __builtin_amdgcn_s_waitcnt(0);
        unsigned nloc = b.st[0], nx = b.st[1];
        if (nloc == 0u) { xcd_barrier_complete(bar, b.x, nloc, nx); b.st[0] = nloc; b.st[1] = nx; }
        const unsigned old = xb_add(&bar[XB_XSUB(b.x)], 1u);
        const unsigned gen = old / nloc;
        if (old + 1u == (gen + 1u) * nloc) {
            __builtin_amdgcn_fence(__ATOMIC_RELEASE, "agent");
            asm volatile("s_waitcnt vmcnt(0)" ::: "memory");
            const unsigned og = xb_add(&bar[XB_TOP], 1u);
            const unsigned tg = og / nx;
            if (og + 1u == (tg + 1u) * nx) xb_add(&bar[XB_TOPGEN], 1u);
            else XB_SPIN(xb_ld(&bar[XB_TOPGEN]) == tg, bar);
            __builtin_amdgcn_fence(__ATOMIC_ACQUIRE, "agent");
            xb_add(&bar[XB_XGEN(b.x)], 1u);
            asm volatile("s_waitcnt vmcnt(0)" ::: "memory");
        } else {
            XB_SPIN(xb_ld(&bar[XB_XGEN(b.x)]) == gen, bar);
            __builtin_amdgcn_fence(__ATOMIC_ACQUIRE, "agent");
            asm volatile("s_waitcnt vmcnt(0)" ::: "memory");
        }
    }
    __syncthreads();
}

struct Args {
    const float* in[20]; float* out; unsigned char* ws;
    float invA[16]; float invB[8];
};

__global__ void __launch_bounds__(NWAVES * 64) hybrid_fwd(Args args) {
    extern __shared__ __attribute__((aligned(16))) unsigned char lds_raw[];
    cg::grid_group grid = cg::this_grid();
    LAS unsigned char* lds = (LAS unsigned char*)lds_raw;
    const int tid = threadIdx.x, lane = tid & 63, wid = __builtin_amdgcn_readfirstlane(tid >> 6);
    const int G = gridDim.x, bx = blockIdx.x;
    unsigned char* ws = args.ws;
    volatile LAS unsigned* MISC = (volatile LAS unsigned*)(lds + LDS_BYTES - 64);
    if (tid < 16) MISC[tid] = 0u;
    __syncthreads();
    const XcdBarrier bar = xcd_barrier_post((unsigned*)(ws + OFF_BAR), MISC + 8);
    if (G == 0x7fffffff) grid.sync();
    const float* x = args.in[0];
    float* out = args.out;
    float* rowss1 = (float*)(ws + OFF_RS1); float* rowss2 = (float*)(ws + OFF_RS2);
    float* gtab = (float*)(ws + OFF_GTAB); float* ropeA = (float*)(ws + OFF_ROPEA); float* ropeB = (float*)(ws + OFF_ROPEB);
    bf16* W1A = (bf16*)(ws + WS_W1A); bf16* W1B = (bf16*)(ws + WS_W1B); bf16* WIN = (bf16*)(ws + WS_WIN); bf16* WOUT = (bf16*)(ws + WS_WOUT);
    bf16* W2A = (bf16*)(ws + WS_W2A); bf16* W2B = (bf16*)(ws + WS_W2B);
    bf16* XN = (bf16*)(ws + WS_XN); bf16* ACT = (bf16*)(ws + WS_ACT); bf16* QKV = (bf16*)(ws + WS_ACT); bf16* MIX = (bf16*)(ws + WS_MIX);

#ifndef REP_P0
#define REP_P0 1
#endif
#ifndef REP_DIFF
#define REP_DIFF 1
#endif
#ifndef REP_DIL
#define REP_DIL 1
#endif
#define REP_G1 1
#define REP_SHADOW 1
#define REP_G2 1
#define REP_G3 1
#define REP_G5 1
#define REP_G6 1
#define REP_G7 1
    for (int rep = 0; rep < REP_P0; ++rep) {
        LAS float* scr = (LAS float*)(lds + wid * 16384);
        const int gw = bx * NWAVES + wid, NGW = G * NWAVES;
        constexpr int I_FA = (DM / 64) * (2 * DFF / 32), I_FB = (DFF / 64) * (DM / 32), I_IN = (DM / 64) * (INW / 32), I_OUT = (DM / 64) * (DM / 32);
        for (int it = gw; it < I_FA; it += NGW) p0_transpose_item<true>(args.in[2], DM, 2 * DFF, W1A, LDK, scr, it, lane);
        const float* g1 = args.in[1];
        for (int m = gw; m < MROWS; m += NGW) {
            const f32x4* xr = (const f32x4*)(x + (size_t)m * DM) + lane; f32x4 v[8]; float s = 0.f;
#pragma unroll
            for (int j = 0; j < 8; ++j) { v[j] = xr[64 * j]; s += (v[j][0] * v[j][0] + v[j][1] * v[j][1]) + (v[j][2] * v[j][2] + v[j][3] * v[j][3]); }
            const float rstd = 1.0f / sqrtf(wave_sum(s) * (1.0f / DM) + 1e-6f);
            v2u* o8 = (v2u*)(XN + (size_t)m * LDK) + lane;
#pragma unroll
            for (int j = 0; j < 8; ++j) { const f32x4 g = *((const f32x4*)g1 + lane + 64 * j); v2u w; w.x = pk2(v[j][0] * rstd * g[0], v[j][1] * rstd * g[1]); w.y = pk2(v[j][2] * rstd * g[2], v[j][3] * rstd * g[3]); o8[64 * j] = w; }
        }
        const int gt = bx * (NWAVES * 64) + tid, NGT = G * NWAVES * 64;
        for (int i = gt; i < 2 * MROWS; i += NGT) rowss1[i] = 0.f;
        if (gt < 512) { const int t = gt >> 7, d = gt & 127; gtab[gt] = t == 0 ? args.in[6][d] : (t == 1 ? args.in[7][d] : (t == 2 ? args.in[8][d & 63] : args.in[9][d & 63])); }
        for (int i = gt; i < 4096 * 24; i += NGT) {
            const int s = i / 24, k = i % 24; const float inv = k < 16 ? args.invA[k] : args.invB[k - 16];
            const float ang = (float)s * inv; double rev = (double)ang * 0.15915494309189535; rev -= floor(rev);
            const float cs = __builtin_amdgcn_cosf((float)rev), sn = __builtin_amdgcn_sinf((float)rev);
            if (k < 16) { ropeA[s * 16 + k] = cs; ropeA[4096 * 16 + s * 16 + k] = sn; } else { ropeB[s * 8 + k - 16] = cs; ropeB[4096 * 8 + s * 8 + k - 16] = sn; }
        }
    }
    xcd_barrier(bar);

    { pg8::Gemm g{XN, W1A, MROWS, 2 * DFF, DM, LDK}; pg8::StaticOrder S; S.init(MROWS, 2 * DFF, G, bx);
      pg8::EpiSwiGLU E{ACT, DFF, nullptr};
      for (int rep = 0; rep < REP_G1; ++rep)
      pg8::gemm_phase<pg8::EpiSwiGLU, pg8::StaticOrder, true, true>(lds, g, S, E); }
    {
        constexpr int NU = (MROWS / 256) * (2 * DFF / 256);
        const int rounds = (NU + G - 1) / G; int first_idle = NU - (rounds - 1) * G, nidle = G - first_idle;
        if (nidle <= 0) { first_idle = 0; nidle = G; }
        if (bx >= first_idle) {
            LAS float* scr = (LAS float*)(lds + wid * 16384);
            const int gw = (bx - first_idle) * NWAVES + wid, NGW = nidle * NWAVES;
            constexpr int I_FA = (DM / 64) * (2 * DFF / 32), I_FB = (DFF / 64) * (DM / 32), I_IN = (DM / 64) * (INW / 32), I_OUT = (DM / 64) * (DM / 32);
            constexpr int NITEMS = I_FA + 2 * I_FB + I_IN + I_OUT;
            for (int rep = 0; rep < REP_SHADOW; ++rep)
            for (int it = gw; it < NITEMS; it += NGW) {
                int r = it;
                if (r < I_FB) { p0_transpose_item<false>(args.in[3], DFF, DM, W1B, DFF, scr, r, lane); continue; } r -= I_FB;
                if (r < I_IN) { p0_transpose_item<false>(args.in[5], DM, INW, WIN, LDK, scr, r, lane); continue; } r -= I_IN;
                if (r < I_OUT) { p0_transpose_item<false>(args.in[16], DM, DM, WOUT, LDK, scr, r, lane); continue; } r -= I_OUT;
                if (r < I_FA) { p0_transpose_item<true>(args.in[18], DM, 2 * DFF, W2A, LDK, scr, r, lane); continue; } r -= I_FA;
                p0_transpose_item<false>(args.in[19], DFF, DM, W2B, DFF, scr, r, lane);
            }
        }
    }
    xcd_barrier(bar);
    { pg8::Gemm g{ACT, W1B, MROWS, DM, DFF, DFF}; pg8::StaticOrder S; S.init(MROWS, DM, G, bx);
      if (REP_G2 > 1) { pg8::EpiResid<true> E2{x, out, 0.5f, XN, args.in[4], (float*)(ws + 900000)}; pg8::gemm_phase<pg8::EpiResid<true>, pg8::StaticOrder, true, true>(lds, g, S, E2); }
      pg8::EpiResid<true> E{x, out, 0.5f, XN, args.in[4], rowss1};
      pg8::gemm_phase<pg8::EpiResid<true>, pg8::StaticOrder, true, true>(lds, g, S, E); }
    xcd_barrier(bar);
    { pg8::Gemm g{XN, WIN, MROWS, INW, DM, LDK}; pg8::StaticOrder S; S.init(MROWS, INW, G, bx);
      pg8::EpiQKV E{QKV, rowss1, gtab, ropeA, ropeB, (LAS float*)(lds + XCH_OFF)};
      for (int rep = 0; rep < REP_G3; ++rep)
      pg8::gemm_phase<pg8::EpiQKV, pg8::StaticOrder, true, true>(lds, g, S, E); }
    xcd_barrier(bar);
    {
        const float L2E = 1.4426950408889634f;
        float gq = fmaxf(fabsf(args.in[6][lane]), fabsf(args.in[6][lane + 64])), gk = fmaxf(fabsf(args.in[7][lane]), fabsf(args.in[7][lane + 64]));
        const float negMA = -1.02f * 11.313708498984761f * wave_max(gq) * wave_max(gk) * L2E;
        const float negMB = -1.02f * 8.0f * wave_max(fabsf(args.in[8][lane])) * wave_max(fabsf(args.in[9][lane])) * L2E;
        const float lam = __expf(wave_sum(args.in[10][lane] * args.in[11][lane])) - __expf(wave_sum(args.in[12][lane] * args.in[13][lane])) + 0.2f;
        for (int rep = 0; rep < REP_DIFF; ++rep)
        for (int u = bx; u < 512; u += G) {
            const int bh = u >> 5, qblk = u & 31;
            att::diff_unit((LAS char*)lds, QKV, MIX, bh >> 3, bh & 7, qblk, lam, negMB, args.in[15], tid, wid, lane);
        }
        for (int rep = 0; rep < REP_DIL; ++rep)
        for (int wu = bx * NWAVES + wid; wu < 2048; wu += G * NWAVES) {
            const int ib = wu & 7, r16 = (wu >> 3) & 15, h = (wu >> 7) & 7, b = wu >> 10;
            att::dil_unit((LAS char*)lds + wid * att::DIL_WAVE, QKV, MIX, b, h, r16, ib, negMA, args.in[14], lane);
        }
    }
    xcd_barrier(bar);
    { pg8::Gemm g{MIX, WOUT, MROWS, DM, DM, LDK}; pg8::StaticOrder S; S.init(MROWS, DM, G, bx);
      if (REP_G5 > 1) { pg8::EpiResid<true> E2{out, (float*)(ws + WS_W1A), 1.0f, XN, args.in[17], (float*)(ws + 900000)}; pg8::gemm_phase<pg8::EpiResid<true>, pg8::StaticOrder, true, true>(lds, g, S, E2); }
      pg8::EpiResid<true> E{out, out, 1.0f, XN, args.in[17], rowss2};
      pg8::gemm_phase<pg8::EpiResid<true>, pg8::StaticOrder, true, true>(lds, g, S, E); }
    xcd_barrier(bar);
    { pg8::Gemm g{XN, W2A, MROWS, 2 * DFF, DM, LDK}; pg8::StaticOrder S; S.init(MROWS, 2 * DFF, G, bx);
      pg8::EpiSwiGLU E{ACT, DFF, rowss2};
      for (int rep = 0; rep < REP_G6; ++rep)
      pg8::gemm_phase<pg8::EpiSwiGLU, pg8::StaticOrder, true, true>(lds, g, S, E); }
    xcd_barrier(bar);
    { pg8::Gemm g{ACT, W2B, MROWS, DM, DFF, DFF}; pg8::StaticOrder S; S.init(MROWS, DM, G, bx);
      if (REP_G7 > 1) { pg8::EpiResid<false> E2{out, (float*)(ws + WS_W1A), 0.5f, nullptr, nullptr, nullptr}; pg8::gemm_phase<pg8::EpiResid<false>, pg8::StaticOrder, true, true>(lds, g, S, E2); }
      pg8::EpiResid<false> E{out, out, 0.5f, nullptr, nullptr, nullptr};
      pg8::gemm_phase<pg8::EpiResid<false>, pg8::StaticOrder, true, true>(lds, g, S, E); }
}

extern "C" void kernel_launch(void* const* d_in, const int* in_sizes, int n_in, void* d_out, int out_size, void* d_ws, size_t ws_size, hipStream_t stream) {
    static int grid = 0;
    if (grid == 0) {
        if (n_in != 20 || in_sizes[0] != MROWS * DM || out_size != MROWS * DM || ws_size < WS_END) {
            fprintf(stderr, "kernel_launch: unexpected shapes (n_in %d, in0 %d, out %d, ws %zu < %zu)\n", n_in, n_in > 0 ? in_sizes[0] : -1, out_size, ws_size, (size_t)WS_END); grid = -1; return; }
        int dev = 0, cus = 0, per_cu = 0;
        (void)hipGetDevice(&dev); (void)hipDeviceGetAttribute(&cus, hipDeviceAttributeMultiprocessorCount, dev);
        if (hipFuncSetAttribute((const void*)hybrid_fwd, hipFuncAttributeMaxDynamicSharedMemorySize, LDS_BYTES) != hipSuccess) { fprintf(stderr, "kernel_launch: hipFuncSetAttribute failed\n"); grid = -1; return; }
        if (hipOccupancyMaxActiveBlocksPerMultiprocessor(&per_cu, (const void*)hybrid_fwd, NWAVES * 64, LDS_BYTES) != hipSuccess || per_cu < 1) { fprintf(stderr, "kernel_launch: occupancy query says %d\n", per_cu); per_cu = 1; }
        (void)hipGetLastError();
        grid = cus * per_cu;
    }
    if (grid < 0) return;
    Args a{};
    for (int i = 0; i < 20; ++i) a.in[i] = (const float*)d_in[i];
    a.out = (float*)d_out; a.ws = (unsigned char*)d_ws;
    for (int i = 0; i < 16; ++i) a.invA[i] = (float)pow(500000.0, -(double)i / 16.0);
    for (int i = 0; i < 8; ++i) a.invB[i] = (float)pow(500000.0, -(double)i / 8.0);
    if (hipMemsetAsync((char*)d_ws + OFF_BAR, 0, BAR_BYTES, stream) != hipSuccess) { fprintf(stderr, "kernel_launch: memset failed\n"); return; }
    void* kargs[] = {&a};
    hipError_t e = hipLaunchCooperativeKernel((const void*)hybrid_fwd, dim3(grid), dim3(NWAVES * 64), kargs, LDS_BYTES, stream);
    if (e != hipSuccess) fprintf(stderr, "kernel_launch: cooperative launch failed: %s (grid %d)\n", hipGetErrorString(e), grid);
}
```

```cpp
#include <hip/hip_runtime.h>
#include <hip/hip_cooperative_groups.h>
#include <cstdio>
#include <cstdint>
#include <cmath>
namespace cg = cooperative_groups;
__device__ __forceinline__ int lane_opaque() { unsigned z = 0u; asm volatile("" : "+v"(z)); return (int)__builtin_amdgcn_mbcnt_hi(~0u, __builtin_amdgcn_mbcnt_lo(~0u, z)); }
__device__ __forceinline__ float shflx(float v, int mask, int lane) { return __builtin_bit_cast(float, __builtin_amdgcn_ds_bpermute((lane ^ mask) << 2, __builtin_bit_cast(int, v))); }
namespace pg8 {
#define PG8_LAS __attribute__((address_space(3)))
typedef unsigned short bf16_t;
typedef short bf16x8 __attribute__((ext_vector_type(8)));
typedef float f32x4 __attribute__((ext_vector_type(4)));
typedef unsigned u32x4 __attribute__((ext_vector_type(4)));
constexpr int BM = 256, BK = 64, HALF = 128, HTB = HALF * BK * 2  , STAGE_BYTES = 8 * HTB, NXCD = 8, WGM = 8;

__host__ __device__ __forceinline__ int lds_byte(int r, int c) { const int st = (r >> 4) * 2 + (c >> 5), rr = r & 15, cc = c & 31, ob = rr * 64 + cc * 2; return st * 1024 + (ob ^ (((ob >> 9) & 1) << 5)); }
__host__ __device__ __forceinline__ void stage_rc(int b, int& R, int& C) { const int st = b / 1024, sb = b % 1024, swz = sb ^ (((sb >> 9) & 1) << 5); R = (st >> 1) * 16 + swz / 64; C = (st & 1) * 32 + (swz % 64) / 2; }
__host__ __device__ __forceinline__ int perm32(int rho) { const int n = rho >> 4, i = rho & 15; return 8 * (i >> 2) + 4 * n + (i & 3); }

struct Unit { int pm, pn; };
struct Gemm { const bf16_t* A; const bf16_t* Bt; int M, N, K, ld; };

struct StaticOrder {
    int nM, nN, nwg, G, c;
    __host__ __device__ void init(int M, int N, int G_, int c_) { nM = M / BM; nN = N / BM; nwg = nM * nN; G = G_; c = c_; }
    __host__ __device__ bool next(int i, Unit& u) const {
        const long L = (long)i * G + c; if (L >= nwg) return false;
        int wgid = (int)L; { const int q = nwg / NXCD, r = nwg % NXCD, xcd = wgid % NXCD, off = wgid / NXCD; wgid = (xcd < r ? xcd * (q + 1) : r * (q + 1) + (xcd - r) * q) + off; }
        const int nig = WGM * nN, gid = wgid / nig, fm = gid * WGM, gsz = (nM - fm) < WGM ? (nM - fm) : WGM;
        u.pm = fm + ((wgid % nig) % gsz); u.pn = (wgid % nig) / gsz; return true;
    }
    __device__ __forceinline__ void a_ready(const Unit&) const {}
    __device__ __forceinline__ void done(const Unit&) const {}
};

__device__ __forceinline__ unsigned cvt_pk_bf16(float lo, float hi) { unsigned r; asm volatile("v_cvt_pk_bf16_f32 %0, %1, %2" : "=v"(r) : "v"(lo), "v"(hi)); return r; }
typedef float f32x2 __attribute__((ext_vector_type(2)));

typedef unsigned u32x2 __attribute__((ext_vector_type(2)));
constexpr int LDK = 2176, LDQ = 6272;
__device__ __forceinline__ float fast_silu(float g) { return g * __builtin_amdgcn_rcpf(1.0f + __expf(-g)); }

struct EpiSwiGLU {
    static constexpr bool PERM = true, AFTER_DRAIN = false;
    bf16_t* O; int ldc; const float* rowss;
    __device__ __forceinline__ void operator()(f32x4 (&acc)[2][2][4][2], const Unit& u, int wr, int wc, int fr, int fq) const {
        const int row0 = u.pm * BM + wr * 64 + fr; const int col0 = u.pn * HALF + wc * 32 + 8 * fq;
#pragma unroll
        for (int ai = 0; ai < 2; ++ai)
#pragma unroll
            for (int m = 0; m < 4; ++m) {
                const int row = row0 + ai * HALF + m * 16;
                float rs = 1.0f; if (rowss) rs = __builtin_amdgcn_rsqf(rowss[row] * (1.0f / 2048.0f) + 1e-6f);
                f32x4 g0 = acc[ai][0][m][0] * rs, g1 = acc[ai][0][m][1] * rs, u0 = acc[ai][1][m][0] * rs, u1 = acc[ai][1][m][1] * rs;
                u32x4 w;
                w.x = cvt_pk_bf16(fast_silu(g0[0]) * u0[0], fast_silu(g0[1]) * u0[1]); w.y = cvt_pk_bf16(fast_silu(g0[2]) * u0[2], fast_silu(g0[3]) * u0[3]);
                w.z = cvt_pk_bf16(fast_silu(g1[0]) * u1[0], fast_silu(g1[1]) * u1[1]); w.w = cvt_pk_bf16(fast_silu(g1[2]) * u1[2], fast_silu(g1[3]) * u1[3]);
                *(u32x4*)(O + (size_t)row * ldc + col0) = w;
            }
    }
};

template <bool NORMOUT> struct EpiResid {
    static constexpr bool PERM = false, AFTER_DRAIN = false;
    const float* base; float* out; bf16_t* xn; const float* gain; float* rowss; float alpha;
    __device__ __forceinline__ void operator()(f32x4 (&acc)[2][2][4][2], const Unit& u, int wr, int wc, int fr, int fq) const {
        const int row0 = u.pm * BM + wr * 64 + fr; const int col0 = u.pn * BM + wc * 32 + 4 * fq;
        f32x4 gv[2][2];
        if (NORMOUT) {
#pragma unroll
            for (int bj = 0; bj < 2; ++bj)
#pragma unroll
                for (int n = 0; n < 2; ++n) gv[bj][n] = *(const f32x4*)(gain + col0 + bj * HALF + n * 16);
        }
#pragma unroll
        for (int ai = 0; ai < 2; ++ai) {
            f32x4 bpre[4][2][2];
#pragma unroll
            for (int m = 0; m < 4; ++m) { const size_t off = (size_t)(row0 + ai * HALF + m * 16) * 2048 + col0;
#pragma unroll
                for (int bj = 0; bj < 2; ++bj)
#pragma unroll
                    for (int n = 0; n < 2; ++n) bpre[m][bj][n] = *(const f32x4*)(base + off + bj * HALF + n * 16); }
#pragma unroll
            for (int m = 0; m < 4; ++m) {
                const int row = row0 + ai * HALF + m * 16; const size_t off = (size_t)row * 2048 + col0; float ss = 0.f;
#pragma unroll
                for (int bj = 0; bj < 2; ++bj)
#pragma unroll
                    for (int n = 0; n < 2; ++n) {
                        const f32x4 o = bpre[m][bj][n] + acc[ai][bj][m][n] * alpha;
                        *(f32x4*)(out + off + bj * HALF + n * 16) = o;
                        if (NORMOUT) {
                            ss += (o[0] * o[0] + o[1] * o[1]) + (o[2] * o[2] + o[3] * o[3]);
                            const f32x4 t = o * gv[bj][n]; u32x2 w; w.x = cvt_pk_bf16(t[0], t[1]); w.y = cvt_pk_bf16(t[2], t[3]);
                            *(u32x2*)(xn + (size_t)row * LDK + col0 + bj * HALF + n * 16) = w;
                        }
                    }
                if (NORMOUT) { ss += shflx(ss, 16, fq * 16 + fr); ss += shflx(ss, 32, fq * 16 + fr); if (fq == 0) atomicAdd(rowss + row, ss); }
            }
            asm volatile("" ::: "memory");
        }
    }
};

struct EpiQKV {
    static constexpr bool PERM = false, AFTER_DRAIN = false;
    bf16_t* O; const float* rowss; const float* gtab;
    const float* ropeA; const float* ropeB;
    PG8_LAS float* xch;
    __device__ __forceinline__ void operator()(f32x4 (&acc)[2][2][4][2], const Unit& u, int wr, int wc, int fr, int fq) const {
        asm volatile("" : "+v"(fr), "+v"(fq));
        const int region = u.pn >> 2;
        const int row0 = u.pm * BM + wr * 64 + fr;
#pragma unroll
        for (int ai = 0; ai < 2; ++ai)
#pragma unroll
            for (int m = 0; m < 4; ++m) {
                const float rs = __builtin_amdgcn_rsqf(rowss[row0 + ai * HALF + m * 16] * (1.0f / 2048.0f) + 1e-6f);
#pragma unroll
                for (int bj = 0; bj < 2; ++bj)
#pragma unroll
                    for (int n = 0; n < 2; ++n) acc[ai][bj][m][n] = acc[ai][bj][m][n] * rs;
            }
        const bool isv = (region == 2) || (region == 5);
        if (!isv) {
            const bool isA = region < 2;
#pragma unroll
            for (int ai = 0; ai < 2; ++ai)
#pragma unroll
                for (int m = 0; m < 4; ++m)
#pragma unroll
                    for (int bj = 0; bj < 2; ++bj) {
                        const f32x4 a = acc[ai][bj][m][0], b = acc[ai][bj][m][1];
                        float s = ((a[0] * a[0] + a[1] * a[1]) + (a[2] * a[2] + a[3] * a[3])) + ((b[0] * b[0] + b[1] * b[1]) + (b[2] * b[2] + b[3] * b[3]));
                        s += shflx(s, 16, fq * 16 + fr); s += shflx(s, 32, fq * 16 + fr);
                        if (fq == 0) xch[((ai * HALF + wr * 64 + m * 16 + fr) * 2 + bj) * 4 + wc] = s;
                    }
            asm volatile("s_waitcnt lgkmcnt(0)" ::: "memory"); __builtin_amdgcn_s_barrier(); asm volatile("" ::: "memory");
            const float* gptr = gtab + (region < 2 ? region : region - 1) * 128;
            const int dbase = isA ? wc * 32 : (wc & 1) * 32;
            f32x4 gv[2]; gv[0] = *(const f32x4*)(gptr + dbase + 4 * fq); gv[1] = *(const f32x4*)(gptr + dbase + 16 + 4 * fq);
            const float qs = region == 0 ? (0.08838834764831845f * 1.4426950408889634f) : (region == 3 ? (0.125f * 1.4426950408889634f) : 1.0f);
#pragma unroll
            for (int ai = 0; ai < 2; ++ai)
#pragma unroll
                for (int m = 0; m < 4; ++m) {
                    const int rl = ai * HALF + wr * 64 + m * 16 + fr; const int spos = (u.pm * BM + rl) & 4095;
#pragma unroll
                    for (int bj = 0; bj < 2; ++bj) {
                        const f32x4 p = *(const PG8_LAS f32x4*)(xch + (rl * 2 + bj) * 4);
                        float rn;
                        if (isA) rn = __builtin_amdgcn_rsqf(((p[0] + p[1]) + (p[2] + p[3])) * (1.0f / 128.0f) + 1e-6f);
                        else rn = __builtin_amdgcn_rsqf(((wc < 2) ? (p[0] + p[1]) : (p[2] + p[3])) * (1.0f / 64.0f) + 1e-6f);
                        f32x4 v0 = acc[ai][bj][m][0] * rn * gv[0], v1 = acc[ai][bj][m][1] * rn * gv[1];
                        if (isA) {
                            if (wc == 0) {
                                const f32x4 cs = *(const f32x4*)(ropeA + spos * 16 + 4 * fq), sn = *(const f32x4*)(ropeA + 4096 * 16 + spos * 16 + 4 * fq);
                                const f32x4 x1 = v0, x2 = v1; v0 = x1 * cs - x2 * sn; v1 = x2 * cs + x1 * sn;
                            }
                        } else {
                            if ((wc & 1) == 0) {
                                const f32x4 cs = *(const f32x4*)(ropeB + spos * 8 + 4 * (fq & 1)), sn = *(const f32x4*)(ropeB + 4096 * 8 + spos * 8 + 4 * (fq & 1));
                                f32x4 pt; pt[0] = shflx(v0[0], 32, fq * 16 + fr); pt[1] = shflx(v0[1], 32, fq * 16 + fr); pt[2] = shflx(v0[2], 32, fq * 16 + fr); pt[3] = shflx(v0[3], 32, fq * 16 + fr);
                                v0 = (fq < 2) ? (v0 * cs - pt * sn) : (v0 * cs + pt * sn);
                            }
                        }
                        acc[ai][bj][m][0] = v0 * qs; acc[ai][bj][m][1] = v1 * qs;
                    }
                }
        }
        const int col0 = u.pn * BM + wc * 32 + 4 * fq;
#pragma unroll
        for (int ai = 0; ai < 2; ++ai)
#pragma unroll
            for (int m = 0; m < 4; ++m) { bf16_t* rowp = O + (size_t)(row0 + ai * HALF + m * 16) * LDQ + col0;
#pragma unroll
                for (int bj = 0; bj < 2; ++bj)
#pragma unroll
                    for (int n = 0; n < 2; ++n) { const f32x4 v = acc[ai][bj][m][n]; u32x2 w; w.x = cvt_pk_bf16(v[0], v[1]); w.y = cvt_pk_bf16(v[2], v[3]); *(u32x2*)(rowp + bj * HALF + n * 16) = w; } }
    }
};
template <class Epi, class Sched, bool ALIGN_EPI = false, bool SP2 = false>
__device__ __forceinline__ void gemm_phase(PG8_LAS unsigned char* lds, const Gemm g, const Sched& S, const Epi& E, const int wid_s) {
    const int lane_ = lane_opaque();
    const int tid = wid_s * 64 + lane_, wid = wid_s, lane = tid & 63, wr = wid >> 2, wc = wid & 3, fr = lane & 15, fq = lane >> 4;
    const int K = g.ld, nt = g.K / BK;
    unsigned voffA[2], voffB[2];
#pragma unroll
    for (int i = 0; i < 2; ++i) { int R, C; stage_rc(tid * 16 + i * 8192, R, C); const int Rb = Epi::PERM ? ((R & ~31) + perm32(R & 31)) : R;
        voffA[i] = (unsigned)(R * K + C) * 2u; voffB[i] = (unsigned)(Rb * K + C) * 2u; }
    const size_t kstep = (size_t)(BK * 2);
    const size_t hstep = (size_t)HALF * K * 2;
    const size_t tstep = 2 * hstep;
    const unsigned ldsw = (unsigned)wid * 1024u;
    const int aoff = lds_byte(wr * 64 + fr, fq * 8), boff = lds_byte(wc * 32 + fr, fq * 8);
#define PG8_SA(b, h) (((b) * 2 + (h)) * HTB)
#define PG8_SB(b, h) ((4 + (b) * 2 + (h)) * HTB)
#define PG8_STAGE(bufoff, gbase, voff) do { _Pragma("unroll") for (int _i = 0; _i < 2; ++_i) \
        __builtin_amdgcn_global_load_lds((const unsigned*)((const char*)(gbase) + (voff)[_i]), (PG8_LAS unsigned*)(lds + (bufoff) + ldsw + _i * 8192), 16, 0, 0); } while (0)
#define PG8_LDA(dst, b, h) do { _Pragma("unroll") for (int m = 0; m < 4; ++m) _Pragma("unroll") for (int k = 0; k < 2; ++k) dst[m][k] = *(const PG8_LAS bf16x8*)(lds + PG8_SA(b, h) + aoff + m * 2048 + k * 1024); } while (0)
#define PG8_LDB(dst, b, h) do { _Pragma("unroll") for (int n = 0; n < 2; ++n) _Pragma("unroll") for (int k = 0; k < 2; ++k) dst[n][k] = *(const PG8_LAS bf16x8*)(lds + PG8_SB(b, h) + boff + n * 2048 + k * 1024); } while (0)
#define PG8_MMA(ai, bj, At, Bt) do { __builtin_amdgcn_s_setprio(1); _Pragma("unroll") for (int m = 0; m < 4; ++m) _Pragma("unroll") for (int n = 0; n < 2; ++n) _Pragma("unroll") for (int k = 0; k < 2; ++k) \
        acc[ai][bj][m][n] = __builtin_amdgcn_mfma_f32_16x16x32_bf16(Bt[n][k], At[m][k], acc[ai][bj][m][n], 0, 0, 0); __builtin_amdgcn_s_setprio(0); } while (0)
#define PG8_WAIT_V(n) asm volatile("s_waitcnt vmcnt(" #n ")" ::: "memory")
#define PG8_WAIT_L(n) asm volatile("s_waitcnt lgkmcnt(" #n ")" ::: "memory")
#define PG8_BAR __builtin_amdgcn_s_barrier()
#define PG8_SCHED __builtin_amdgcn_sched_barrier(0)
    Unit cur, nxt; int ui = 0;
    if (!S.next(0, cur)) return;
    f32x4 acc[2][2][4][2];
#pragma unroll
    for (int a = 0; a < 2; ++a)
#pragma unroll
        for (int b = 0; b < 2; ++b)
#pragma unroll
            for (int m = 0; m < 4; ++m)
#pragma unroll
                for (int n = 0; n < 2; ++n) acc[a][b][m][n] = (f32x4){0.f, 0.f, 0.f, 0.f};
    bf16x8 At[4][2], B0[2][2], B1[2][2];
    const char* cA = (const char*)g.A + (size_t)cur.pm * tstep; const char* cB = (const char*)g.Bt + (size_t)cur.pn * tstep;
    S.a_ready(cur);
    if constexpr (SP2) {
        PG8_STAGE(PG8_SB(0, 0), cB, voffB); PG8_STAGE(PG8_SB(0, 1), cB + hstep, voffB); PG8_STAGE(PG8_SA(0, 0), cA, voffA); PG8_STAGE(PG8_SA(0, 1), cA + hstep, voffA);
        if (wr == 1) PG8_BAR;
        PG8_WAIT_V(2); PG8_BAR;
        PG8_STAGE(PG8_SB(1, 0), cB + kstep, voffB); PG8_STAGE(PG8_SA(1, 0), cA + kstep, voffA); PG8_STAGE(PG8_SB(1, 1), cB + hstep + kstep, voffB);
        PG8_WAIT_V(6); PG8_BAR;
    } else {
        PG8_STAGE(PG8_SB(0, 0), cB, voffB); PG8_STAGE(PG8_SA(0, 0), cA, voffA); PG8_STAGE(PG8_SB(0, 1), cB + hstep, voffB); PG8_STAGE(PG8_SA(0, 1), cA + hstep, voffA);
        if (wr == 1) PG8_BAR;
        PG8_WAIT_V(4); PG8_BAR;
        PG8_STAGE(PG8_SB(1, 0), cB + kstep, voffB); PG8_STAGE(PG8_SA(1, 0), cA + kstep, voffA); PG8_STAGE(PG8_SB(1, 1), cB + hstep + kstep, voffB);
        PG8_WAIT_V(6); PG8_BAR;
    }
    for (;;) {
        const bool has_next = S.next(ui + 1, nxt);
        const char* nA = has_next ? (const char*)g.A + (size_t)nxt.pm * tstep : cA; const char* nB = has_next ? (const char*)g.Bt + (size_t)nxt.pn * tstep : cB;
        for (int t = 0; t < nt; t += 2) {
            const bool last = (t == nt - 2);
            const char* a1 = cA + (size_t)(t + 1) * kstep;
            const char* a2 = last ? nA : cA + (size_t)(t + 2) * kstep; const char* b2 = last ? nB : cB + (size_t)(t + 2) * kstep;
            const char* a3 = a2 + kstep; const char* b3 = b2 + kstep;
            if (last && has_next) S.a_ready(nxt);
            if constexpr (SP2) {
            PG8_LDB(B0, 0, 0); PG8_LDB(B1, 0, 1); PG8_SCHED; PG8_LDA(At, 0, 0); PG8_STAGE(PG8_SA(1, 1), a1 + hstep, voffA);
            PG8_WAIT_V(8); PG8_WAIT_L(0); PG8_BAR; PG8_MMA(0, 0, At, B0); PG8_MMA(0, 1, At, B1); PG8_BAR; PG8_SCHED;
            PG8_LDA(At, 0, 1); PG8_STAGE(PG8_SB(0, 0), b2, voffB); PG8_STAGE(PG8_SB(0, 1), b2 + hstep, voffB); PG8_STAGE(PG8_SA(0, 0), a2, voffA);
            PG8_WAIT_V(8); PG8_WAIT_L(0); PG8_BAR; PG8_MMA(1, 0, At, B0); PG8_MMA(1, 1, At, B1); PG8_BAR; PG8_SCHED;
            PG8_LDB(B0, 1, 0); PG8_LDB(B1, 1, 1); PG8_SCHED; PG8_LDA(At, 1, 0); PG8_STAGE(PG8_SA(0, 1), a2 + hstep, voffA);
            PG8_WAIT_V(8); PG8_WAIT_L(0); PG8_BAR; PG8_MMA(0, 0, At, B0); PG8_MMA(0, 1, At, B1); PG8_BAR; PG8_SCHED;
            PG8_LDA(At, 1, 1); PG8_STAGE(PG8_SB(1, 0), b3, voffB); PG8_STAGE(PG8_SB(1, 1), b3 + hstep, voffB); PG8_STAGE(PG8_SA(1, 0), a3, voffA);
            PG8_WAIT_V(8); PG8_WAIT_L(0); PG8_BAR; PG8_MMA(1, 0, At, B0); PG8_MMA(1, 1, At, B1); PG8_BAR; PG8_SCHED;
            } else {
            PG8_LDB(B0, 0, 0); PG8_SCHED; PG8_LDA(At, 0, 0); PG8_STAGE(PG8_SA(1, 1), a1 + hstep, voffA);
            PG8_WAIT_L(8); PG8_BAR; PG8_WAIT_L(0); PG8_MMA(0, 0, At, B0); PG8_BAR; PG8_SCHED;
            PG8_LDB(B1, 0, 1); PG8_STAGE(PG8_SB(0, 0), b2, voffB);
            PG8_BAR; PG8_WAIT_L(0); PG8_MMA(0, 1, At, B1); PG8_BAR;
            PG8_LDA(At, 0, 1); PG8_STAGE(PG8_SA(0, 0), a2, voffA);
            PG8_BAR; PG8_WAIT_L(0); PG8_MMA(1, 0, At, B0); PG8_BAR; PG8_SCHED;
            PG8_STAGE(PG8_SB(0, 1), b2 + hstep, voffB);
            PG8_WAIT_V(6); PG8_BAR; PG8_MMA(1, 1, At, B1); PG8_BAR;
            PG8_LDB(B0, 1, 0); PG8_SCHED; PG8_LDA(At, 1, 0); PG8_STAGE(PG8_SA(0, 1), a2 + hstep, voffA);
            PG8_WAIT_L(8); PG8_BAR; PG8_WAIT_L(0); PG8_MMA(0, 0, At, B0); PG8_BAR; PG8_SCHED;
            PG8_LDB(B1, 1, 1); PG8_STAGE(PG8_SB(1, 0), b3, voffB);
            PG8_BAR; PG8_WAIT_L(0); PG8_MMA(0, 1, At, B1); PG8_BAR;
            PG8_LDA(At, 1, 1); PG8_STAGE(PG8_SA(1, 0), a3, voffA);
            PG8_BAR; PG8_WAIT_L(0); PG8_MMA(1, 0, At, B0); PG8_BAR; PG8_SCHED;
            PG8_STAGE(PG8_SB(1, 1), b3 + hstep, voffB);
            PG8_WAIT_V(6); PG8_BAR; PG8_MMA(1, 1, At, B1); PG8_BAR;
            }
        }
        if constexpr (ALIGN_EPI) { if (wr == 0) PG8_BAR; }
        if constexpr (!Epi::AFTER_DRAIN) { E(acc, cur, wr, wc, fr, fq); S.done(cur); }
        if (!has_next) break;
#pragma unroll
        for (int a = 0; a < 2; ++a)
#pragma unroll
            for (int b = 0; b < 2; ++b)
#pragma unroll
                for (int m = 0; m < 4; ++m)
#pragma unroll
                    for (int n = 0; n < 2; ++n) acc[a][b][m][n] = (f32x4){0.f, 0.f, 0.f, 0.f};
        cur = nxt; cA = nA; cB = nB; ++ui;
        if constexpr (ALIGN_EPI) { if (wr == 1) PG8_BAR; }
    }
    PG8_WAIT_V(0);
    if constexpr (!ALIGN_EPI) { if (wr == 0) PG8_BAR; }
    PG8_BAR;
    if constexpr (Epi::AFTER_DRAIN) { E.fused(acc, cur, wr, wc, fr, fq, lds, wid, lane); S.done(cur); }
#undef PG8_SA
#undef PG8_SB
#undef PG8_STAGE
#undef PG8_LDA
#undef PG8_LDB
#undef PG8_MMA
#undef PG8_WAIT_V
#undef PG8_WAIT_L
#undef PG8_BAR
#undef PG8_SCHED
}
}

namespace att {
#define LAS __attribute__((address_space(3)))
typedef unsigned short bf16_t;
typedef short bf16x8 __attribute__((ext_vector_type(8)));
typedef short s16x4 __attribute__((ext_vector_type(4)));
typedef short v4i16_t __attribute__((ext_vector_type(4)));
typedef float f32x16 __attribute__((ext_vector_type(16)));
typedef float f32x4 __attribute__((ext_vector_type(4)));
typedef unsigned u32x4 __attribute__((ext_vector_type(4)));
typedef unsigned u32x2 __attribute__((ext_vector_type(2)));
typedef float f32x2_t __attribute__((ext_vector_type(2))); typedef __bf16 bf16x2_t __attribute__((ext_vector_type(2)));
constexpr int SEQ = 4096, INW = 6272, DMODEL = 2176;
constexpr int KP = 272, VP = 320;
constexpr int DIFF_TILE = 128 * KP + 128 * VP;
constexpr int DIL_WAVE = 32 * KP + 32 * VP;
__device__ __forceinline__ unsigned cvtpk(float lo, float hi) { f32x2_t v = {lo, hi}; bf16x2_t b = __builtin_convertvector(v, bf16x2_t); return __builtin_bit_cast(unsigned, b); }
__device__ __forceinline__ int crow(int r, int hi) { return (r & 3) + 8 * (r >> 2) + 4 * hi; }
__device__ __forceinline__ s16x4 vtr(const LAS char* p) { return __builtin_bit_cast(s16x4, __builtin_amdgcn_ds_read_tr16_b64_v4i16((LAS v4i16_t*)p)); }
__device__ __forceinline__ bf16x8 packp(const f32x16& p, int s) {
    u32x4 w; w.x = cvtpk(p[8 * s], p[8 * s + 1]); w.y = cvtpk(p[8 * s + 2], p[8 * s + 3]); w.z = cvtpk(p[8 * s + 4], p[8 * s + 5]); w.w = cvtpk(p[8 * s + 6], p[8 * s + 7]);
    return __builtin_bit_cast(bf16x8, w);
}
#define MFMA32(a, b, c) __builtin_amdgcn_mfma_f32_32x32x16_bf16((a), (b), (c), 0, 0, 0)

__device__ __forceinline__ void diff_unit(LAS char* lds, const bf16_t* QKV, bf16_t* MIX, int b, int h, int qblk, float lam, float negM, const float* g_bout, int tid, int wid, int lane) {
    const int c = wid >> 2, r32 = lane & 31, hh = lane >> 5, cb = (lane >> 4) & 1, q_ = (lane & 15) >> 2, p_ = lane & 3;
    const size_t rowbase = (size_t)b * SEQ; const int q0 = qblk * 128 + (wid & 3) * 32;
    bf16x8 qf[4];
    { const bf16_t* qp = QKV + (rowbase + q0 + r32) * INW + 3072 + h * 128 + c * 64 + 8 * hh;
#pragma unroll
      for (int ks = 0; ks < 4; ++ks) qf[ks] = *(const bf16x8*)(qp + 16 * ks); }
    const int srow = tid >> 4, sch = tid & 15;
    const bf16_t* kg = QKV + (rowbase + srow) * INW + 4096 + h * 128 + sch * 8;
    const bf16_t* vg = kg + 1024;
    LAS char* kst = lds + srow * KP + sch * 16; LAS char* vst = lds + 128 * KP + srow * VP + sch * 16;
    f32x16 o[4];
#pragma unroll
    for (int i = 0; i < 4; ++i)
#pragma unroll
        for (int r = 0; r < 16; ++r) o[i][r] = 0.f;
    float lsum = 0.f;
    f32x16 negm;
#pragma unroll
    for (int r = 0; r < 16; ++r) negm[r] = negM;
    u32x4 kr[4], vr[4];
#pragma unroll
    for (int i = 0; i < 4; ++i) { kr[i] = *(const u32x4*)(kg + (size_t)(32 * i) * INW); vr[i] = *(const u32x4*)(vg + (size_t)(32 * i) * INW); }
#pragma unroll
    for (int i = 0; i < 4; ++i) { *(LAS u32x4*)(kst + 32 * i * KP) = kr[i]; *(LAS u32x4*)(vst + 32 * i * VP) = vr[i]; }
    __syncthreads();
    const int NT = SEQ / 128;
    const LAS char* kread = lds + r32 * KP + (c * 64 + 8 * hh) * 2;
    const LAS char* vread = lds + 128 * KP + (4 * hh + q_) * VP + (16 * cb + 4 * p_) * 2;
    for (int t = 0; t < NT; ++t) {
        const int cur = (t & 1) * DIFF_TILE, nxt = DIFF_TILE - cur;
        const size_t go = (size_t)(t + 1) * 128 * INW; const bool more = t + 1 < NT;
        if (more) {
#pragma unroll
            for (int i = 0; i < 4; ++i) kr[i] = *(const u32x4*)(kg + go + (size_t)(32 * i) * INW); }
        f32x16 pA0 = negm, pA1 = negm, pB0 = negm, pB1 = negm;
#pragma unroll
        for (int ks = 0; ks < 4; ++ks) {
            const bf16x8 k0 = *(const LAS bf16x8*)(kread + cur + ks * 32), k1 = *(const LAS bf16x8*)(kread + cur + 32 * KP + ks * 32);
            pA0 = MFMA32(k0, qf[ks], pA0); pA1 = MFMA32(k1, qf[ks], pA1);
        }
#pragma unroll
        for (int ks = 0; ks < 4; ++ks) {
            const bf16x8 k0 = *(const LAS bf16x8*)(kread + cur + 64 * KP + ks * 32), k1 = *(const LAS bf16x8*)(kread + cur + 96 * KP + ks * 32);
            pB0 = MFMA32(k0, qf[ks], pB0); pB1 = MFMA32(k1, qf[ks], pB1);
        }
        if (more) {
#pragma unroll
            for (int i = 0; i < 4; ++i) *(LAS u32x4*)(kst + nxt + 32 * i * KP) = kr[i];
#pragma unroll
            for (int i = 0; i < 4; ++i) kr[i] = *(const u32x4*)(vg + go + (size_t)(32 * i) * INW); }
        float sa = 0.f, sb = 0.f;
#pragma unroll
        for (int r = 0; r < 16; ++r) { pA0[r] = __builtin_amdgcn_exp2f(pA0[r]); pA1[r] = __builtin_amdgcn_exp2f(pA1[r]); sa += pA0[r]; sb += pA1[r]; }
        bf16x8 pf[4]; pf[0] = packp(pA0, 0); pf[1] = packp(pA0, 1); pf[2] = packp(pA1, 0); pf[3] = packp(pA1, 1);
#pragma unroll
        for (int kst4 = 0; kst4 < 4; ++kst4)
#pragma unroll
            for (int db = 0; db < 4; ++db) {
                const LAS char* a = vread + cur + kst4 * 16 * VP + db * 64;
                const s16x4 lo = vtr(a), hi = vtr(a + 8 * VP);
                const bf16x8 vf = __builtin_shufflevector(lo, hi, 0, 1, 2, 3, 4, 5, 6, 7);
                o[db] = MFMA32(vf, pf[kst4], o[db]);
            }
#pragma unroll
        for (int r = 0; r < 16; ++r) { pB0[r] = __builtin_amdgcn_exp2f(pB0[r]); pB1[r] = __builtin_amdgcn_exp2f(pB1[r]); sa += pB0[r]; sb += pB1[r]; }
        lsum += sa + sb;
        pf[0] = packp(pB0, 0); pf[1] = packp(pB0, 1); pf[2] = packp(pB1, 0); pf[3] = packp(pB1, 1);
#pragma unroll
        for (int kst4 = 0; kst4 < 4; ++kst4)
#pragma unroll
            for (int db = 0; db < 4; ++db) {
                const LAS char* a = vread + cur + (64 + kst4 * 16) * VP + db * 64;
                const s16x4 lo = vtr(a), hi = vtr(a + 8 * VP);
                const bf16x8 vf = __builtin_shufflevector(lo, hi, 0, 1, 2, 3, 4, 5, 6, 7);
                o[db] = MFMA32(vf, pf[kst4], o[db]);
            }
        if (more) {
#pragma unroll
            for (int i = 0; i < 4; ++i) *(LAS u32x4*)(vst + nxt + 32 * i * VP) = kr[i]; }
        __syncthreads();
    }
    const int lane_e = lane_opaque();
    lsum += shflx(lsum, 32, lane_e);
    float inv = 1.0f / lsum; if (c == 1) inv *= lam;
    const int r32e = lane_e & 31, hhe = lane_e >> 5;
    LAS float* X = (LAS float*)lds + (wid & 3) * 4096;
    if (c == 1) {
#pragma unroll
        for (int db = 0; db < 4; ++db)
#pragma unroll
            for (int r = 0; r < 16; ++r) X[(db * 32 + crow(r, hhe)) * 32 + r32e] = o[db][r] * inv;
    }
    __syncthreads();
    if (c == 0) {
        float ss = 0.f;
#pragma unroll
        for (int db = 0; db < 4; ++db)
#pragma unroll
            for (int r = 0; r < 16; ++r) { const float v = o[db][r] * inv - X[(db * 32 + crow(r, hhe)) * 32 + r32e]; o[db][r] = v; ss += v * v; }
        ss += shflx(ss, 32, lane_e);
        const float rn = __builtin_amdgcn_rsqf(ss * (1.0f / 128.0f) + 1e-6f) * 0.8f;
        bf16_t* op = MIX + (rowbase + q0 + r32e) * DMODEL + 1024 + h * 128;
#pragma unroll
        for (int db = 0; db < 4; ++db)
#pragma unroll
            for (int g4 = 0; g4 < 4; ++g4) { const int d0 = db * 32 + 8 * g4 + 4 * hhe; const f32x4 gg = *(const f32x4*)(g_bout + d0);
                u32x2 w; w.x = cvtpk(o[db][4 * g4] * rn * gg[0], o[db][4 * g4 + 1] * rn * gg[1]); w.y = cvtpk(o[db][4 * g4 + 2] * rn * gg[2], o[db][4 * g4 + 3] * rn * gg[3]);
                *(u32x2*)(op + d0) = w; }
    }
    __syncthreads();
}

__device__ __forceinline__ void dil_unit(LAS char* wl, const bf16_t* QKV, bf16_t* MIX, int b, int h, int r16, int ib, float negM, const float* g_aout, int lane) {
    const int r32 = lane & 31, hh = lane >> 5, cb = (lane >> 4) & 1, q_ = (lane & 15) >> 2, p_ = lane & 3;
    const size_t rowbase = (size_t)b * SEQ;
    const int tq = r16 + 16 * (32 * ib + r32);
    bf16x8 qf[8];
    { const bf16_t* qp = QKV + (rowbase + tq) * INW + h * 128 + 8 * hh;
#pragma unroll
      for (int ks = 0; ks < 8; ++ks) qf[ks] = *(const bf16x8*)(qp + 16 * ks); }
    f32x16 o[4];
#pragma unroll
    for (int i = 0; i < 4; ++i)
#pragma unroll
        for (int r = 0; r < 16; ++r) o[i][r] = 0.f;
    float lsum = 0.f;
    f32x16 negm;
#pragma unroll
    for (int r = 0; r < 16; ++r) negm[r] = negM;
    const int lrow = lane >> 4, lch = lane & 15;
    const bf16_t* kvg = QKV + rowbase * INW + 1024 + h * 128 + lch * 8;
    LAS char* kst = wl + lrow * KP + lch * 16; LAS char* vst = wl + 32 * KP + lrow * VP + lch * 16;
    const LAS char* kread = wl + r32 * KP + 8 * hh * 2;
    const LAS char* vread = wl + 32 * KP + (4 * hh + q_) * VP + (16 * cb + 4 * p_) * 2;
    int klo0, khi0, klo1, khi1, klo2, khi2;
    { const int bq = 32 * ib;               int lo_i = bq - 64; if (lo_i < 0) lo_i = 0; klo0 = lo_i >> 5; khi0 = (bq + 31 + 64) >> 5;      if (khi0 > 7) khi0 = 7; }
    { const int bq = (r16 >> 2) + 128 * ib; int lo_i = bq - 64; if (lo_i < 0) lo_i = 0; klo1 = lo_i >> 5; khi1 = (bq + 31 * 4 + 64) >> 5;  if (khi1 > 31) khi1 = 31; }
    { const int bq = r16 + 512 * ib;        int lo_i = bq - 64; if (lo_i < 0) lo_i = 0; klo2 = lo_i >> 5; khi2 = (bq + 31 * 16 + 64) >> 5; if (khi2 > 127) khi2 = 127; }
    int pat = 0, kb = klo0;
    u32x4 kr[8], vr[8];
#define DIL_LOAD(PAT, KB) do { const int sh_ = 4 - 2 * (PAT); const int rc_ = r16 & ((1 << sh_) - 1); \
        _Pragma("unroll") for (int i = 0; i < 8; ++i) { const int tok = rc_ + ((32 * (KB) + lrow + 4 * i) << sh_); const bf16_t* gp = kvg + (size_t)tok * INW; kr[i] = *(const u32x4*)gp; vr[i] = *(const u32x4*)(gp + 1024); } } while (0)
    DIL_LOAD(pat, kb);
    for (;;) {
#pragma unroll
        for (int i = 0; i < 8; ++i) { *(LAS u32x4*)(kst + 4 * i * KP) = kr[i]; *(LAS u32x4*)(vst + 4 * i * VP) = vr[i]; }
        __builtin_amdgcn_fence(__ATOMIC_RELEASE, "wavefront"); __builtin_amdgcn_wave_barrier(); __builtin_amdgcn_fence(__ATOMIC_ACQUIRE, "wavefront");
        const int cpat = pat, ckb = kb;
        { const int hi_c = pat == 0 ? khi0 : (pat == 1 ? khi1 : khi2);
          if (kb < hi_c) ++kb; else { ++pat; kb = pat == 1 ? klo1 : klo2; } }
        const bool more = pat < 3;
        if (more) DIL_LOAD(pat, kb);
        const int sh = 4 - 2 * cpat, sq = 16 >> sh;
        const int qi = (r16 >> sh) + sq * 32 * ib + sq * r32;
        f32x16 p = negm;
#pragma unroll
        for (int ks = 0; ks < 8; ++ks) { const bf16x8 kf = *(const LAS bf16x8*)(kread + ks * 32); p = MFMA32(kf, qf[ks], p); }
        float sa = 0.f;
#pragma unroll
        for (int r = 0; r < 16; ++r) { const int dl = 32 * ckb + crow(r, hh) - qi; const float e = __builtin_amdgcn_exp2f(p[r]); const float pv = (dl <= 64 && dl >= -64) ? e : 0.f; p[r] = pv; sa += pv; }
        lsum += sa;
        bf16x8 pf[2]; pf[0] = packp(p, 0); pf[1] = packp(p, 1);
#pragma unroll
        for (int s = 0; s < 2; ++s)
#pragma unroll
            for (int db = 0; db < 4; ++db) {
                const LAS char* a = vread + s * 16 * VP + db * 64;
                const s16x4 lo = vtr(a), hi = vtr(a + 8 * VP);
                const bf16x8 vf = __builtin_shufflevector(lo, hi, 0, 1, 2, 3, 4, 5, 6, 7);
                o[db] = MFMA32(vf, pf[s], o[db]);
            }
        __builtin_amdgcn_fence(__ATOMIC_RELEASE, "wavefront"); __builtin_amdgcn_wave_barrier(); __builtin_amdgcn_fence(__ATOMIC_ACQUIRE, "wavefront");
        if (!more) break;
    }
#undef DIL_LOAD
    lsum += shflx(lsum, 32, lane);
    const float inv = 1.0f / lsum; float ss = 0.f;
#pragma unroll
    for (int db = 0; db < 4; ++db)
#pragma unroll
        for (int r = 0; r < 16; ++r) { const float v = o[db][r] * inv; o[db][r] = v; ss += v * v; }
    ss += shflx(ss, 32, lane);
    const float rn = __builtin_amdgcn_rsqf(ss * (1.0f / 128.0f) + 1e-6f);
    bf16_t* op = MIX + (rowbase + tq) * DMODEL + h * 128;
#pragma unroll
    for (int db = 0; db < 4; ++db)
#pragma unroll
        for (int g4 = 0; g4 < 4; ++g4) { const int d0 = db * 32 + 8 * g4 + 4 * hh; const f32x4 gg = *(const f32x4*)(g_aout + d0);
            u32x2 w; w.x = cvtpk(o[db][4 * g4] * rn * gg[0], o[db][4 * g4 + 1] * rn * gg[1]); w.y = cvtpk(o[db][4 * g4 + 2] * rn * gg[2], o[db][4 * g4 + 3] * rn * gg[3]);
            *(u32x2*)(op + d0) = w; }
}
}

constexpr int NWAVES = 8;
constexpr int DM = 2048, NBATCH = 2, SEQ = 4096, MROWS = NBATCH * SEQ, DFF = 5632, INW = 6144;
constexpr size_t MiB = 1u << 20;
constexpr size_t WS_CTL = 0;
constexpr size_t OFF_GTAB = 1 * MiB - 4096;
constexpr size_t OFF_BAR = 983040, BAR_BYTES = 16384;
constexpr size_t OFF_RS1 = 0, OFF_RS2 = 32768, OFF_ROPEA = 65536, OFF_ROPEB = OFF_ROPEA + 2 * 4096 * 16 * 4;
constexpr int LDK = pg8::LDK, LDQ = pg8::LDQ;
constexpr size_t WS_W1A = 1 * MiB, WS_W1B = WS_W1A + 47 * MiB, WS_WIN = WS_W1B + 22 * MiB, WS_WOUT = WS_WIN + 26 * MiB, WS_W2A = WS_WOUT + 9 * MiB, WS_W2B = WS_W2A + 47 * MiB;
constexpr size_t WS_XN = WS_W2B + 22 * MiB;
constexpr size_t WS_ACT = WS_XN + 34 * MiB;
constexpr size_t WS_MIX = WS_ACT + 98 * MiB;
constexpr size_t WS_END = WS_MIX + 34 * MiB;
constexpr int LDS_BYTES = 155648;
constexpr int XCH_OFF = 131072;
static_assert((size_t)11264 * LDK * 2 <= 47 * MiB && (size_t)6144 * LDK * 2 <= 26 * MiB && (size_t)2048 * LDK * 2 <= 9 * MiB && (size_t)8192 * LDK * 2 <= 34 * MiB && (size_t)8192 * LDQ * 2 <= 98 * MiB && att::INW == LDQ && att::DMODEL == LDK, "ws map");
static_assert(att::DIL_WAVE * 8 <= LDS_BYTES - 64 && 3456 * 4 <= BAR_BYTES && 2 * att::DIFF_TILE <= LDS_BYTES - 64 && XCH_OFF + 8192 <= LDS_BYTES, "LDS map");

#define LAS __attribute__((address_space(3)))
typedef unsigned short bf16;
typedef unsigned v4u __attribute__((ext_vector_type(4)));
typedef unsigned v2u __attribute__((ext_vector_type(2)));
typedef float f32x4 __attribute__((ext_vector_type(4)));
__device__ __forceinline__ unsigned f2bf(float f) { unsigned u = __builtin_bit_cast(unsigned, f); return (u + 0x7fffu + ((u >> 16) & 1u)) >> 16; }
__device__ __forceinline__ unsigned pk2(float lo, float hi) { return f2bf(lo) | (f2bf(hi) << 16); }
__device__ __forceinline__ float wave_sum(float v, int lane) {
#pragma unroll
    for (int o = 1; o < 64; o <<= 1) v += shflx(v, o, lane);
    return v;
}
__device__ __forceinline__ float wave_max(float v, int lane) {
#pragma unroll
    for (int o = 1; o < 64; o <<= 1) v = fmaxf(v, shflx(v, o, lane));
    return v;
}
template <bool GLU> __device__ __forceinline__ void tr_load(const float* W, int N, int item, int lane, f32x4 (&v)[8]) {
    const int nblk = N / 32, kb = item / nblk, nb = item % nblk, k0 = 64 * kb, n0 = 32 * nb;
    const float* src = W + (size_t)(k0 + (lane >> 3)) * N + n0 + 4 * (lane & 7);
#pragma unroll
    for (int i = 0; i < 8; ++i) v[i] = __builtin_nontemporal_load((const f32x4*)(src + (size_t)(8 * i) * N));
}
template <bool GLU> __device__ __forceinline__ void tr_store(int K, int N, bf16* WT, int ldw, LAS float* scr, int item, int lane, const f32x4 (&v)[8]) {
    const int nblk = N / 32, kb = item / nblk, nb = item % nblk, k0 = 64 * kb, n0 = 32 * nb;
    int r0 = n0;
    if (GLU) { const int half = N / 2; r0 = n0 < half ? (n0 >> 7) * 256 + (n0 & 127) : ((n0 - half) >> 7) * 256 + 128 + ((n0 - half) & 127); }
    const int rg = lane >> 3, c4 = lane & 7;
#pragma unroll
    for (int i = 0; i < 8; ++i) { LAS float* d = scr + (8 * i + rg) * 33 + 4 * c4; d[0] = v[i][0]; d[1] = v[i][1]; d[2] = v[i][2]; d[3] = v[i][3]; }
    asm volatile("s_waitcnt lgkmcnt(0)" ::: "memory");
    const int c = lane & 7;
#pragma unroll
    for (int j = 0; j < 4; ++j) { const int n = (lane >> 3) + 8 * j; const LAS float* s = scr + (8 * c) * 33 + n;
        v4u o; o.x = pk2(s[0 * 33], s[1 * 33]); o.y = pk2(s[2 * 33], s[3 * 33]); o.z = pk2(s[4 * 33], s[5 * 33]); o.w = pk2(s[6 * 33], s[7 * 33]);
        *(v4u*)(WT + (size_t)(r0 + n) * ldw + k0 + 8 * c) = o; }
    asm volatile("s_waitcnt lgkmcnt(0)" ::: "memory");
}
template <bool GLU> __device__ __forceinline__ void tr_matrix(const float* W, int K, int N, bf16* WT, int ldw, LAS float* scr, int gw, int NGW, int lane) {
    const int nitems = (K / 64) * (N / 32);
    for (int it = gw; it < nitems; it += 2 * NGW) {
        f32x4 va[8], vb[8]; const int it2 = it + NGW; const bool two = it2 < nitems;
        tr_load<GLU>(W, N, it, lane, va);
        if (two) tr_load<GLU>(W, N, it2, lane, vb);
        tr_store<GLU>(K, N, WT, ldw, scr, it, lane, va);
        if (two) tr_store<GLU>(K, N, WT, ldw, scr, it2, lane, vb);
    }
}

#define XB_TMO      128
#define XB_XCNT(j)  (256  + 64 * (j))
#define XB_XSUB(j)  (1280 + 64 * (j))
#define XB_XGEN(j)  (2304 + 64 * (j))
#define XB_TOP      3328
#define XB_TOPGEN   3392
#define XCD_BAR_WORDS 3456
#define XB_SPIN_CAP (1u << 18)

__device__ __forceinline__ unsigned xb_ld(unsigned* p)              { return __hip_atomic_load(p, __ATOMIC_RELAXED, __HIP_MEMORY_SCOPE_AGENT); }
__device__ __forceinline__ unsigned xb_add(unsigned* p, unsigned v) { return __hip_atomic_fetch_add(p, v, __ATOMIC_RELAXED, __HIP_MEMORY_SCOPE_AGENT); }
__device__ __forceinline__ unsigned xb_xcc_id() { return (unsigned)__builtin_amdgcn_s_getreg((3 << 11) | 20) & 0xFu; }
#define XB_SPIN(cond, bar) do { unsigned _sp = 0; while (cond) { __builtin_amdgcn_s_sleep(1); \
    if ((++_sp & 255u) == 0u) { if (xb_ld(&(bar)[XB_TMO])) break; if (_sp > XB_SPIN_CAP) { atomicAdd(&(bar)[XB_TMO], 1u); break; } } } } while (0)

struct XcdBarrier {
    unsigned* bar; unsigned x; int wid;
    volatile LAS unsigned* st;
};

__device__ __forceinline__ bool xb_lane0() { return lane_opaque() == 0; }
__device__ __forceinline__ XcdBarrier xcd_barrier_post(unsigned* bar, volatile LAS unsigned* st, int wid) {
    XcdBarrier b; b.bar = bar; b.x = xb_xcc_id(); b.st = st; b.wid = wid;
    if (wid == 0 && xb_lane0()) (void)xb_add(&bar[XB_XCNT(b.x)], 1u);
    return b;
}
__device__ __forceinline__ void xcd_barrier_complete(unsigned* bar, unsigned x, unsigned& nloc, unsigned& nx) {
    const unsigned G = gridDim.x * gridDim.y * gridDim.z;
    unsigned sum, cnt, mine, sp = 0u;
    for (;;) {
        sum = 0u; cnt = 0u; mine = 0u;
#pragma unroll
        for (unsigned j = 0; j < 16; ++j) { const unsigned c = xb_ld(&bar[XB_XCNT(j)]); sum += c; cnt += (c > 0u) ? 1u : 0u; mine = (j == x) ? c : mine; }
        if (sum == G) break;
        __builtin_amdgcn_s_sleep(1);
        if ((++sp & 255u) == 0u) { if (xb_ld(&bar[XB_TMO])) break; if (sp > XB_SPIN_CAP) { atomicAdd(&bar[XB_TMO], 1u); break; } }
    }
    nloc = mine > 0u ? mine : 1u; nx = cnt > 0u ? cnt : 1u;
}

__device__ __forceinline__ void xcd_barrier(const XcdBarrier& b) {
    asm volatile("s_waitcnt vmcnt(0)" ::: "memory");
    __syncthreads();
    if (b.wid == 0 && xb_lane0()) {
        unsigned* bar = b.bar;
        __builtin_amdgcn_s_waitcnt(0);
        unsigned nloc = b.st[0], nx = b.st[1];
        if (nloc == 0u) { xcd_barrier_complete(bar, b.x, nloc, nx); b.st[0] = nloc; b.st[1] = nx; }
        const unsigned old = xb_add(&bar[XB_XSUB(b.x)], 1u);
        const unsigned gen = old / nloc;
        if (old + 1u == (gen + 1u) * nloc) {
            __builtin_amdgcn_fence(__ATOMIC_RELEASE, "agent");
            asm volatile("s_waitcnt vmcnt(0)" ::: "memory");
            const unsigned og = xb_add(&bar[XB_TOP], 1u);
            const unsigned tg = og / nx;
            if (og + 1u == (tg + 1u) * nx) xb_add(&bar[XB_TOPGEN], 1u);
            else XB_SPIN(xb_ld(&bar[XB_TOPGEN]) == tg, bar);
            __builtin_amdgcn_fence(__ATOMIC_ACQUIRE, "agent");
            xb_add(&bar[XB_XGEN(b.x)], 1u);
            asm volatile("s_waitcnt vmcnt(0)" ::: "memory");
        } else {
            XB_SPIN(xb_ld(&bar[XB_XGEN(b.x)]) == gen, bar);
            __builtin_amdgcn_fence(__ATOMIC_ACQUIRE, "agent");
            asm volatile("s_waitcnt vmcnt(0)" ::: "memory");
        }
    }
    __syncthreads();
}

struct Args {
    const float* in[20]; float* out; unsigned char* ws;
    float invA[16]; float invB[8];
};

__global__ void __launch_bounds__(NWAVES * 64) hybrid_fwd(Args args) {
    extern __shared__ __attribute__((aligned(16))) unsigned char lds_raw[];
    cg::grid_group grid = cg::this_grid();
    LAS unsigned char* lds = (LAS unsigned char*)lds_raw;
    const int wid = __builtin_amdgcn_readfirstlane((int)threadIdx.x >> 6);
#define fresh_lane() lane_opaque()
    const int lane = fresh_lane(), tid = wid * 64 + lane;
    const int G = gridDim.x, bx = blockIdx.x;
    unsigned char* ws = args.ws;
    volatile LAS unsigned* MISC = (volatile LAS unsigned*)(lds + LDS_BYTES - 64);
    if (tid < 16) MISC[tid] = 0u;
    __syncthreads();
    const XcdBarrier bar = xcd_barrier_post((unsigned*)(ws + OFF_BAR), MISC + 8, wid);
    if (G == 0x7fffffff) grid.sync();
    const float* x = args.in[0];
    float* out = args.out;
    float* rowss1 = (float*)(ws + OFF_RS1); float* rowss2 = (float*)(ws + OFF_RS2);
    float* gtab = (float*)(ws + OFF_GTAB); float* ropeA = (float*)(ws + OFF_ROPEA); float* ropeB = (float*)(ws + OFF_ROPEB);
    bf16* W1A = (bf16*)(ws + WS_W1A); bf16* W1B = (bf16*)(ws + WS_W1B); bf16* WIN = (bf16*)(ws + WS_WIN); bf16* WOUT = (bf16*)(ws + WS_WOUT);
    bf16* W2A = (bf16*)(ws + WS_W2A); bf16* W2B = (bf16*)(ws + WS_W2B);
    bf16* XN = (bf16*)(ws + WS_XN); bf16* ACT = (bf16*)(ws + WS_ACT); bf16* QKV = (bf16*)(ws + WS_ACT); bf16* MIX = (bf16*)(ws + WS_MIX);

#ifndef REP_P0
#define REP_P0 1
#endif
#ifndef REP_DIFF
#define REP_DIFF 1
#endif
#ifndef REP_DIL
#define REP_DIL 1
#endif
#define REP_G1 1
#define REP_SHADOW 1
#define REP_G2 1
#define REP_G3 1
#define REP_G5 1
#define REP_G6 1
#define REP_G7 1
    for (int rep = 0; rep < REP_P0; ++rep) {
        LAS float* scr = (LAS float*)(lds + wid * 16384);
        const int gw = bx * NWAVES + wid, NGW = G * NWAVES;
        constexpr int I_FA = (DM / 64) * (2 * DFF / 32), I_FB = (DFF / 64) * (DM / 32), I_IN = (DM / 64) * (INW / 32), I_OUT = (DM / 64) * (DM / 32);
        tr_matrix<true>(args.in[2], DM, 2 * DFF, W1A, LDK, scr, gw, NGW, lane);
        const float* g1 = args.in[1];
        for (int m = gw; m < MROWS; m += NGW) {
            const f32x4* xr = (const f32x4*)(x + (size_t)m * DM) + lane; f32x4 v[8]; float s = 0.f;
#pragma unroll
            for (int j = 0; j < 8; ++j) { v[j] = xr[64 * j]; s += (v[j][0] * v[j][0] + v[j][1] * v[j][1]) + (v[j][2] * v[j][2] + v[j][3] * v[j][3]); }
            const float rstd = 1.0f / sqrtf(wave_sum(s, lane) * (1.0f / DM) + 1e-6f);
            v2u* o8 = (v2u*)(XN + (size_t)m * LDK) + lane;
#pragma unroll
            for (int j = 0; j < 8; ++j) { const f32x4 g = *((const f32x4*)g1 + lane + 64 * j); v2u w; w.x = pk2(v[j][0] * rstd * g[0], v[j][1] * rstd * g[1]); w.y = pk2(v[j][2] * rstd * g[2], v[j][3] * rstd * g[3]); o8[64 * j] = w; }
        }
        const int gt = bx * (NWAVES * 64) + tid, NGT = G * NWAVES * 64;
        for (int i = gt; i < 2 * MROWS; i += NGT) rowss1[i] = 0.f;
        if (gt < 512) { const int t = gt >> 7, d = gt & 127; gtab[gt] = t == 0 ? args.in[6][d] : (t == 1 ? args.in[7][d] : (t == 2 ? args.in[8][d & 63] : args.in[9][d & 63])); }
        for (int i = gt; i < 4096 * 24; i += NGT) {
            const int s = i / 24, k = i % 24; const float inv = k < 16 ? args.invA[k] : args.invB[k - 16];
            const float ang = (float)s * inv; double rev = (double)ang * 0.15915494309189535; rev -= floor(rev);
            const float cs = __builtin_amdgcn_cosf((float)rev), sn = __builtin_amdgcn_sinf((float)rev);
            if (k < 16) { ropeA[s * 16 + k] = cs; ropeA[4096 * 16 + s * 16 + k] = sn; } else { ropeB[s * 8 + k - 16] = cs; ropeB[4096 * 8 + s * 8 + k - 16] = sn; }
        }
    }
    xcd_barrier(bar);

    { pg8::Gemm g{XN, W1A, MROWS, 2 * DFF, DM, LDK}; pg8::StaticOrder S; S.init(MROWS, 2 * DFF, G, bx);
      pg8::EpiSwiGLU E{ACT, DFF, nullptr};
      for (int rep = 0; rep < REP_G1; ++rep)
      pg8::gemm_phase<pg8::EpiSwiGLU, pg8::StaticOrder, true, true>(lds, g, S, E, wid); }
    {
        constexpr int NU = (MROWS / 256) * (2 * DFF / 256);
        const int rounds = (NU + G - 1) / G; int first_idle = NU - (rounds - 1) * G, nidle = G - first_idle;
        if (nidle <= 0) { first_idle = 0; nidle = G; }
        if (bx >= first_idle) {
            LAS float* scr = (LAS float*)(lds + wid * 16384);
            const int gw = (bx - first_idle) * NWAVES + wid, NGW = nidle * NWAVES;
            for (int rep = 0; rep < REP_SHADOW; ++rep) {
            tr_matrix<false>(args.in[3], DFF, DM, W1B, DFF, scr, gw, NGW, lane);
            tr_matrix<false>(args.in[5], DM, INW, WIN, LDK, scr, gw, NGW, lane);
            tr_matrix<false>(args.in[16], DM, DM, WOUT, LDK, scr, gw, NGW, lane);
            tr_matrix<true>(args.in[18], DM, 2 * DFF, W2A, LDK, scr, gw, NGW, lane);
            }
        }
    }
    xcd_barrier(bar);
    { pg8::Gemm g{ACT, W1B, MROWS, DM, DFF, DFF}; pg8::StaticOrder S; S.init(MROWS, DM, G, bx);
      if (REP_G2 > 1) { pg8::EpiResid<true> E2{x, out, XN, args.in[4], (float*)(ws + 900000), 0.5f}; pg8::gemm_phase<pg8::EpiResid<true>, pg8::StaticOrder, true, true>(lds, g, S, E2, wid); }
      pg8::EpiResid<true> E{x, out, XN, args.in[4], rowss1, 0.5f};
      pg8::gemm_phase<pg8::EpiResid<true>, pg8::StaticOrder, true, true>(lds, g, S, E, wid); }
    xcd_barrier(bar);
    { pg8::Gemm g{XN, WIN, MROWS, INW, DM, LDK}; pg8::StaticOrder S; S.init(MROWS, INW, G, bx);
      pg8::EpiQKV E{QKV, rowss1, gtab, ropeA, ropeB, (LAS float*)(lds + XCH_OFF)};
      for (int rep = 0; rep < REP_G3; ++rep)
      pg8::gemm_phase<pg8::EpiQKV, pg8::StaticOrder, true, true>(lds, g, S, E, wid); }
    xcd_barrier(bar);
    {
        const float L2E = 1.4426950408889634f;
        const int lane_a = fresh_lane();
        const float gq = fmaxf(fabsf(args.in[6][lane_a]), fabsf(args.in[6][lane_a + 64])), gk = fmaxf(fabsf(args.in[7][lane_a]), fabsf(args.in[7][lane_a + 64]));
        const float negMA = __builtin_bit_cast(float, __builtin_amdgcn_readfirstlane(__builtin_bit_cast(int, -1.02f * 11.313708498984761f * wave_max(gq, lane_a) * wave_max(gk, lane_a) * L2E)));
        const float negMB = __builtin_bit_cast(float, __builtin_amdgcn_readfirstlane(__builtin_bit_cast(int, -1.02f * 8.0f * wave_max(fabsf(args.in[8][lane_a]), lane_a) * wave_max(fabsf(args.in[9][lane_a]), lane_a) * L2E)));
        const float lam = __builtin_bit_cast(float, __builtin_amdgcn_readfirstlane(__builtin_bit_cast(int, __expf(wave_sum(args.in[10][lane_a] * args.in[11][lane_a], lane_a)) - __expf(wave_sum(args.in[12][lane_a] * args.in[13][lane_a], lane_a)) + 0.2f)));
        {
            const int tid_a = wid * 64 + fresh_lane();
            for (int rep = 0; rep < REP_DIFF; ++rep)
            for (int u = bx; u < 512; u += G) {
                const int bh = u >> 5, qblk = u & 31;
                att::diff_unit((LAS char*)lds, QKV, MIX, bh >> 3, bh & 7, qblk, lam, negMB, args.in[15], tid_a, wid, tid_a & 63);
            }
        }
        {
            const int lane_d = fresh_lane();
            for (int rep = 0; rep < REP_DIL; ++rep)
            for (int wu = bx * NWAVES + wid; wu < 2048; wu += G * NWAVES) {
                const int ib = wu & 7, r16 = (wu >> 3) & 15, h = (wu >> 7) & 7, b = wu >> 10;
                att::dil_unit((LAS char*)lds + wid * att::DIL_WAVE, QKV, MIX, b, h, r16, ib, negMA, args.in[14], lane_d);
            }
        }
    }
    xcd_barrier(bar);
    { pg8::Gemm g{MIX, WOUT, MROWS, DM, DM, LDK}; pg8::StaticOrder S; S.init(MROWS, DM, G, bx);
      if (REP_G5 > 1) { pg8::EpiResid<true> E2{out, (float*)(ws + WS_W1A), XN, args.in[17], (float*)(ws + 900000), 1.0f}; pg8::gemm_phase<pg8::EpiResid<true>, pg8::StaticOrder, true, true>(lds, g, S, E2, wid); }
      pg8::EpiResid<true> E{out, out, XN, args.in[17], rowss2, 1.0f};
      pg8::gemm_phase<pg8::EpiResid<true>, pg8::StaticOrder, true, true>(lds, g, S, E, wid); }
    xcd_barrier(bar);
    { pg8::Gemm g{XN, W2A, MROWS, 2 * DFF, DM, LDK}; pg8::StaticOrder S; S.init(MROWS, 2 * DFF, G, bx);
      pg8::EpiSwiGLU E{ACT, DFF, rowss2};
      for (int rep = 0; rep < REP_G6; ++rep)
      pg8::gemm_phase<pg8::EpiSwiGLU, pg8::StaticOrder, true, true>(lds, g, S, E, wid); }
    {
        constexpr int NU = (MROWS / 256) * (2 * DFF / 256);
        const int rounds = (NU + G - 1) / G; int first_idle = NU - (rounds - 1) * G, nidle = G - first_idle;
        if (nidle <= 0) { first_idle = 0; nidle = G; }
        if (bx >= first_idle) tr_matrix<false>(args.in[19], DFF, DM, W2B, DFF, (LAS float*)(lds + wid * 16384), (bx - first_idle) * NWAVES + wid, nidle * NWAVES, fresh_lane());
    }
    xcd_barrier(bar);
    { pg8::Gemm g{ACT, W2B, MROWS, DM, DFF, DFF}; pg8::StaticOrder S; S.init(MROWS, DM, G, bx);
      if (REP_G7 > 1) { pg8::EpiResid<false> E2{out, (float*)(ws + WS_W1A), nullptr, nullptr, nullptr, 0.5f}; pg8::gemm_phase<pg8::EpiResid<false>, pg8::StaticOrder, true, true>(lds, g, S, E2, wid); }
      pg8::EpiResid<false> E{out, out, nullptr, nullptr, nullptr, 0.5f};
      pg8::gemm_phase<pg8::EpiResid<false>, pg8::StaticOrder, true, true>(lds, g, S, E, wid); }
}

extern "C" void kernel_launch(void* const* d_in, const int* in_sizes, int n_in, void* d_out, int out_size, void* d_ws, size_t ws_size, hipStream_t stream) {
    static int grid = 0;
    if (grid == 0) {
        if (n_in != 20 || in_sizes[0] != MROWS * DM || out_size != MROWS * DM || ws_size < WS_END) {
            fprintf(stderr, "kernel_launch: unexpected shapes (n_in %d, in0 %d, out %d, ws %zu < %zu)\n", n_in, n_in > 0 ? in_sizes[0] : -1, out_size, ws_size, (size_t)WS_END); grid = -1; return; }
        int dev = 0, cus = 0, per_cu = 0;
        (void)hipGetDevice(&dev); (void)hipDeviceGetAttribute(&cus, hipDeviceAttributeMultiprocessorCount, dev);
        if (hipFuncSetAttribute((const void*)hybrid_fwd, hipFuncAttributeMaxDynamicSharedMemorySize, LDS_BYTES) != hipSuccess) { fprintf(stderr, "kernel_launch: hipFuncSetAttribute failed\n"); grid = -1; return; }
        if (hipOccupancyMaxActiveBlocksPerMultiprocessor(&per_cu, (const void*)hybrid_fwd, NWAVES * 64, LDS_BYTES) != hipSuccess || per_cu < 1) { fprintf(stderr, "kernel_launch: occupancy query says %d\n", per_cu); per_cu = 1; }
        (void)hipGetLastError();
        grid = cus * per_cu;
    }
    if (grid < 0) return;
    Args a{};
    for (int i = 0; i < 20; ++i) a.in[i] = (const float*)d_in[i];
    a.out = (float*)d_out; a.ws = (unsigned char*)d_ws;
    for (int i = 0; i < 16; ++i) a.invA[i] = (float)pow(500000.0, -(double)i / 16.0);
    for (int i = 0; i < 8; ++i) a.invB[i] = (float)pow(500000.0, -(double)i / 8.0);
    if (hipMemsetAsync((char*)d_ws + OFF_BAR, 0, BAR_BYTES, stream) != hipSuccess) { fprintf(stderr, "kernel_launch: memset failed\n"); return; }
    void* kargs[] = {&a};
    hipError_t e = hipLaunchCooperativeKernel((const void*)hybrid_fwd, dim3(grid), dim3(NWAVES * 64), kargs, LDS_BYTES, stream);
    if (e != hipSuccess) fprintf(stderr, "kernel_launch: cooperative launch failed: %s (grid %d)\n", hipGetErrorString(e), grid);
}
```

```cpp
#include <hip/hip_runtime.h>
#include <hip/hip_cooperative_groups.h>
#include <cstdio>
#include <cstdint>
#include <cmath>
namespace cg = cooperative_groups;
__device__ __forceinline__ int lane_opaque() { unsigned z = 0u; asm volatile("" : "+v"(z)); return (int)__builtin_amdgcn_mbcnt_hi(~0u, __builtin_amdgcn_mbcnt_lo(~0u, z)); }
__device__ __forceinline__ float shflx(float v, int mask, int lane) { return __builtin_bit_cast(float, __builtin_amdgcn_ds_bpermute((lane ^ mask) << 2, __builtin_bit_cast(int, v))); }
namespace pg8 {
#define PG8_LAS __attribute__((address_space(3)))
typedef unsigned short bf16_t;
typedef short bf16x8 __attribute__((ext_vector_type(8)));
typedef float f32x4 __attribute__((ext_vector_type(4)));
typedef unsigned u32x4 __attribute__((ext_vector_type(4)));
constexpr int BM = 256, BK = 64, HALF = 128, HTB = HALF * BK * 2  , STAGE_BYTES = 8 * HTB, NXCD = 8, WGM = 8;

__host__ __device__ __forceinline__ int lds_byte(int r, int c) { const int st = (r >> 4) * 2 + (c >> 5), rr = r & 15, cc = c & 31, ob = rr * 64 + cc * 2; return st * 1024 + (ob ^ (((ob >> 9) & 1) << 5)); }
__host__ __device__ __forceinline__ void stage_rc(int b, int& R, int& C) { const int st = b / 1024, sb = b % 1024, swz = sb ^ (((sb >> 9) & 1) << 5); R = (st >> 1) * 16 + swz / 64; C = (st & 1) * 32 + (swz % 64) / 2; }
__host__ __device__ __forceinline__ int perm32(int rho) { const int n = rho >> 4, i = rho & 15; return 8 * (i >> 2) + 4 * n + (i & 3); }

struct Unit { int pm, pn; };
struct Gemm { const bf16_t* A; const bf16_t* Bt; int M, N, K, ld; };

struct StaticOrder {
    int nM, nN, nwg, G, c;
    __host__ __device__ void init(int M, int N, int G_, int c_) { nM = M / BM; nN = N / BM; nwg = nM * nN; G = G_; c = c_; }
    __host__ __device__ bool next(int i, Unit& u) const {
        const long L = (long)i * G + c; if (L >= nwg) return false;
        int wgid = (int)L; { const int q = nwg / NXCD, r = nwg % NXCD, xcd = wgid % NXCD, off = wgid / NXCD; wgid = (xcd < r ? xcd * (q + 1) : r * (q + 1) + (xcd - r) * q) + off; }
        const int nig = WGM * nN, gid = wgid / nig, fm = gid * WGM, gsz = (nM - fm) < WGM ? (nM - fm) : WGM;
        u.pm = fm + ((wgid % nig) % gsz); u.pn = (wgid % nig) / gsz; return true;
    }
    __device__ __forceinline__ void a_ready(const Unit&) const {}
    __device__ __forceinline__ void done(const Unit&) const {}
};

__device__ __forceinline__ unsigned cvt_pk_bf16(float lo, float hi) { unsigned r; asm volatile("v_cvt_pk_bf16_f32 %0, %1, %2" : "=v"(r) : "v"(lo), "v"(hi)); return r; }
typedef float f32x2 __attribute__((ext_vector_type(2)));

typedef unsigned u32x2 __attribute__((ext_vector_type(2)));
constexpr int LDK = 2176, LDQ = 6272;
__device__ __forceinline__ float fast_silu(float g) { return g * __builtin_amdgcn_rcpf(1.0f + __expf(-g)); }

struct EpiSwiGLU {
    static constexpr bool PERM = true, AFTER_DRAIN = false;
    bf16_t* O; int ldc; const float* rowss;
    __device__ __forceinline__ void operator()(f32x4 (&acc)[2][2][4][2], const Unit& u, int wr, int wc, int fr, int fq) const {
        const int row0 = u.pm * BM + wr * 64 + fr; const int col0 = u.pn * HALF + wc * 32 + 8 * fq;
#pragma unroll
        for (int ai = 0; ai < 2; ++ai)
#pragma unroll
            for (int m = 0; m < 4; ++m) {
                const int row = row0 + ai * HALF + m * 16;
                float rs = 1.0f; if (rowss) rs = __builtin_amdgcn_rsqf(rowss[row] * (1.0f / 2048.0f) + 1e-6f);
                f32x4 g0 = acc[ai][0][m][0] * rs, g1 = acc[ai][0][m][1] * rs, u0 = acc[ai][1][m][0] * rs, u1 = acc[ai][1][m][1] * rs;
                u32x4 w;
                w.x = cvt_pk_bf16(fast_silu(g0[0]) * u0[0], fast_silu(g0[1]) * u0[1]); w.y = cvt_pk_bf16(fast_silu(g0[2]) * u0[2], fast_silu(g0[3]) * u0[3]);
                w.z = cvt_pk_bf16(fast_silu(g1[0]) * u1[0], fast_silu(g1[1]) * u1[1]); w.w = cvt_pk_bf16(fast_silu(g1[2]) * u1[2], fast_silu(g1[3]) * u1[3]);
                *(u32x4*)(O + (size_t)row * ldc + col0) = w;
            }
    }
};

template <bool BASE_F32, bool WRITE_XN, bool WRITE_OUT> struct EpiResid {
    static constexpr bool PERM = false, AFTER_DRAIN = false;
    const float* base; float* out; bf16_t* xn; float* rowss; float alpha;
    __device__ __forceinline__ void operator()(f32x4 (&acc)[2][2][4][2], const Unit& u, int wr, int wc, int fr, int fq) const {
        const int row0 = u.pm * BM + wr * 64 + fr; const int col0 = u.pn * BM + wc * 32 + 4 * fq;
#pragma unroll
        for (int ai = 0; ai < 2; ++ai) {
            f32x4 bpre[4][2][2];
#pragma unroll
            for (int m = 0; m < 4; ++m) { const int row = row0 + ai * HALF + m * 16;
#pragma unroll
                for (int bj = 0; bj < 2; ++bj)
#pragma unroll
                    for (int n = 0; n < 2; ++n) {
                        if (BASE_F32) bpre[m][bj][n] = *(const f32x4*)(base + (size_t)row * 2048 + col0 + bj * HALF + n * 16);
                        else { const u32x2 w = *(const u32x2*)(xn + (size_t)row * LDK + col0 + bj * HALF + n * 16);
                               bpre[m][bj][n] = (f32x4){__builtin_bit_cast(float, w.x << 16), __builtin_bit_cast(float, w.x & 0xffff0000u), __builtin_bit_cast(float, w.y << 16), __builtin_bit_cast(float, w.y & 0xffff0000u)}; }
                    } }
#pragma unroll
            for (int m = 0; m < 4; ++m) {
                const int row = row0 + ai * HALF + m * 16; float ss = 0.f;
#pragma unroll
                for (int bj = 0; bj < 2; ++bj)
#pragma unroll
                    for (int n = 0; n < 2; ++n) {
                        const f32x4 o = bpre[m][bj][n] + acc[ai][bj][m][n] * alpha;
                        if (WRITE_OUT) *(f32x4*)(out + (size_t)row * 2048 + col0 + bj * HALF + n * 16) = o;
                        if (WRITE_XN) {
                            ss += (o[0] * o[0] + o[1] * o[1]) + (o[2] * o[2] + o[3] * o[3]);
                            u32x2 w; w.x = cvt_pk_bf16(o[0], o[1]); w.y = cvt_pk_bf16(o[2], o[3]);
                            *(u32x2*)(xn + (size_t)row * LDK + col0 + bj * HALF + n * 16) = w;
                        }
                    }
                if (WRITE_XN) { ss += shflx(ss, 16, fq * 16 + fr); ss += shflx(ss, 32, fq * 16 + fr); if (fq == 0) atomicAdd(rowss + row, ss); }
            }
            asm volatile("" ::: "memory");
        }
    }
};

struct EpiQKV {
    static constexpr bool PERM = false, AFTER_DRAIN = false;
    bf16_t* O; const float* rowss; const float* gtab;
    const float* ropeA; const float* ropeB;
    PG8_LAS float* xch;
    __device__ __forceinline__ void operator()(f32x4 (&acc)[2][2][4][2], const Unit& u, int wr, int wc, int fr, int fq) const {
        asm volatile("" : "+v"(fr), "+v"(fq));
        const int region = u.pn >> 2;
        const int row0 = u.pm * BM + wr * 64 + fr;
#pragma unroll
        for (int ai = 0; ai < 2; ++ai)
#pragma unroll
            for (int m = 0; m < 4; ++m) {
                const float rs = __builtin_amdgcn_rsqf(rowss[row0 + ai * HALF + m * 16] * (1.0f / 2048.0f) + 1e-6f);
#pragma unroll
                for (int bj = 0; bj < 2; ++bj)
#pragma unroll
                    for (int n = 0; n < 2; ++n) acc[ai][bj][m][n] = acc[ai][bj][m][n] * rs;
            }
        const bool isv = (region == 2) || (region == 5);
        if (!isv) {
            const bool isA = region < 2;
#pragma unroll
            for (int ai = 0; ai < 2; ++ai)
#pragma unroll
                for (int m = 0; m < 4; ++m)
#pragma unroll
                    for (int bj = 0; bj < 2; ++bj) {
                        const f32x4 a = acc[ai][bj][m][0], b = acc[ai][bj][m][1];
                        float s = ((a[0] * a[0] + a[1] * a[1]) + (a[2] * a[2] + a[3] * a[3])) + ((b[0] * b[0] + b[1] * b[1]) + (b[2] * b[2] + b[3] * b[3]));
                        s += shflx(s, 16, fq * 16 + fr); s += shflx(s, 32, fq * 16 + fr);
                        if (fq == 0) xch[((ai * HALF + wr * 64 + m * 16 + fr) * 2 + bj) * 4 + wc] = s;
                    }
            asm volatile("s_waitcnt lgkmcnt(0)" ::: "memory"); __builtin_amdgcn_s_barrier(); asm volatile("" ::: "memory");
            const float* gptr = gtab + (region < 2 ? region : region - 1) * 128;
            const int dbase = isA ? wc * 32 : (wc & 1) * 32;
            f32x4 gv[2]; gv[0] = *(const f32x4*)(gptr + dbase + 4 * fq); gv[1] = *(const f32x4*)(gptr + dbase + 16 + 4 * fq);
            const float qs = region == 0 ? (0.08838834764831845f * 1.4426950408889634f) : (region == 3 ? (0.125f * 1.4426950408889634f) : 1.0f);
#pragma unroll
            for (int ai = 0; ai < 2; ++ai)
#pragma unroll
                for (int m = 0; m < 4; ++m) {
                    const int rl = ai * HALF + wr * 64 + m * 16 + fr; const int spos = (u.pm * BM + rl) & 4095;
#pragma unroll
                    for (int bj = 0; bj < 2; ++bj) {
                        const f32x4 p = *(const PG8_LAS f32x4*)(xch + (rl * 2 + bj) * 4);
                        float rn;
                        if (isA) rn = __builtin_amdgcn_rsqf(((p[0] + p[1]) + (p[2] + p[3])) * (1.0f / 128.0f) + 1e-6f);
                        else rn = __builtin_amdgcn_rsqf(((wc < 2) ? (p[0] + p[1]) : (p[2] + p[3])) * (1.0f / 64.0f) + 1e-6f);
                        f32x4 v0 = acc[ai][bj][m][0] * rn * gv[0], v1 = acc[ai][bj][m][1] * rn * gv[1];
                        if (isA) {
                            if (wc == 0) {
                                const f32x4 cs = *(const f32x4*)(ropeA + spos * 16 + 4 * fq), sn = *(const f32x4*)(ropeA + 4096 * 16 + spos * 16 + 4 * fq);
                                const f32x4 x1 = v0, x2 = v1; v0 = x1 * cs - x2 * sn; v1 = x2 * cs + x1 * sn;
                            }
                        } else {
                            if ((wc & 1) == 0) {
                                const f32x4 cs = *(const f32x4*)(ropeB + spos * 8 + 4 * (fq & 1)), sn = *(const f32x4*)(ropeB + 4096 * 8 + spos * 8 + 4 * (fq & 1));
                                f32x4 pt; pt[0] = shflx(v0[0], 32, fq * 16 + fr); pt[1] = shflx(v0[1], 32, fq * 16 + fr); pt[2] = shflx(v0[2], 32, fq * 16 + fr); pt[3] = shflx(v0[3], 32, fq * 16 + fr);
                                v0 = (fq < 2) ? (v0 * cs - pt * sn) : (v0 * cs + pt * sn);
                            }
                        }
                        acc[ai][bj][m][0] = v0 * qs; acc[ai][bj][m][1] = v1 * qs;
                    }
                }
        }
        const int col0 = u.pn * BM + wc * 32 + 4 * fq;
#pragma unroll
        for (int ai = 0; ai < 2; ++ai)
#pragma unroll
            for (int m = 0; m < 4; ++m) { bf16_t* rowp = O + (size_t)(row0 + ai * HALF + m * 16) * LDQ + col0;
#pragma unroll
                for (int bj = 0; bj < 2; ++bj)
#pragma unroll
                    for (int n = 0; n < 2; ++n) { const f32x4 v = acc[ai][bj][m][n]; u32x2 w; w.x = cvt_pk_bf16(v[0], v[1]); w.y = cvt_pk_bf16(v[2], v[3]); *(u32x2*)(rowp + bj * HALF + n * 16) = w; } }
    }
};
template <class Epi, class Sched, bool ALIGN_EPI = false, bool SP2 = false>
__device__ __forceinline__ void gemm_phase(PG8_LAS unsigned char* lds, const Gemm g, const Sched& S, const Epi& E, const int wid_s) {
    const int lane_ = lane_opaque();
    const int tid = wid_s * 64 + lane_, wid = wid_s, lane = tid & 63, wr = wid >> 2, wc = wid & 3, fr = lane & 15, fq = lane >> 4;
    const int K = g.ld, nt = g.K / BK;
    unsigned voffA[2], voffB[2];
#pragma unroll
    for (int i = 0; i < 2; ++i) { int R, C; stage_rc(tid * 16 + i * 8192, R, C); const int Rb = Epi::PERM ? ((R & ~31) + perm32(R & 31)) : R;
        voffA[i] = (unsigned)(R * K + C) * 2u; voffB[i] = (unsigned)(Rb * K + C) * 2u; }
    const size_t kstep = (size_t)(BK * 2);
    const size_t hstep = (size_t)HALF * K * 2;
    const size_t tstep = 2 * hstep;
    const unsigned ldsw = (unsigned)wid * 1024u;
    const int aoff = lds_byte(wr * 64 + fr, fq * 8), boff = lds_byte(wc * 32 + fr, fq * 8);
#define PG8_SA(b, h) (((b) * 2 + (h)) * HTB)
#define PG8_SB(b, h) ((4 + (b) * 2 + (h)) * HTB)
#define PG8_STAGE(bufoff, gbase, voff) do { _Pragma("unroll") for (int _i = 0; _i < 2; ++_i) \
        __builtin_amdgcn_global_load_lds((const unsigned*)((const char*)(gbase) + (voff)[_i]), (PG8_LAS unsigned*)(lds + (bufoff) + ldsw + _i * 8192), 16, 0, 0); } while (0)
#define PG8_LDA(dst, b, h) do { _Pragma("unroll") for (int m = 0; m < 4; ++m) _Pragma("unroll") for (int k = 0; k < 2; ++k) dst[m][k] = *(const PG8_LAS bf16x8*)(lds + PG8_SA(b, h) + aoff + m * 2048 + k * 1024); } while (0)
#define PG8_LDB(dst, b, h) do { _Pragma("unroll") for (int n = 0; n < 2; ++n) _Pragma("unroll") for (int k = 0; k < 2; ++k) dst[n][k] = *(const PG8_LAS bf16x8*)(lds + PG8_SB(b, h) + boff + n * 2048 + k * 1024); } while (0)
#define PG8_MMA(ai, bj, At, Bt) do { __builtin_amdgcn_s_setprio(1); _Pragma("unroll") for (int m = 0; m < 4; ++m) _Pragma("unroll") for (int n = 0; n < 2; ++n) _Pragma("unroll") for (int k = 0; k < 2; ++k) \
        acc[ai][bj][m][n] = __builtin_amdgcn_mfma_f32_16x16x32_bf16(Bt[n][k], At[m][k], acc[ai][bj][m][n], 0, 0, 0); __builtin_amdgcn_s_setprio(0); } while (0)
#define PG8_WAIT_V(n) asm volatile("s_waitcnt vmcnt(" #n ")" ::: "memory")
#define PG8_WAIT_L(n) asm volatile("s_waitcnt lgkmcnt(" #n ")" ::: "memory")
#define PG8_BAR __builtin_amdgcn_s_barrier()
#define PG8_SCHED __builtin_amdgcn_sched_barrier(0)
    Unit cur, nxt; int ui = 0;
    if (!S.next(0, cur)) return;
    f32x4 acc[2][2][4][2];
#pragma unroll
    for (int a = 0; a < 2; ++a)
#pragma unroll
        for (int b = 0; b < 2; ++b)
#pragma unroll
            for (int m = 0; m < 4; ++m)
#pragma unroll
                for (int n = 0; n < 2; ++n) acc[a][b][m][n] = (f32x4){0.f, 0.f, 0.f, 0.f};
    bf16x8 At[4][2], B0[2][2], B1[2][2];
    const char* cA = (const char*)g.A + (size_t)cur.pm * tstep; const char* cB = (const char*)g.Bt + (size_t)cur.pn * tstep;
    S.a_ready(cur);
    if constexpr (SP2) {
        PG8_STAGE(PG8_SB(0, 0), cB, voffB); PG8_STAGE(PG8_SB(0, 1), cB + hstep, voffB); PG8_STAGE(PG8_SA(0, 0), cA, voffA); PG8_STAGE(PG8_SA(0, 1), cA + hstep, voffA);
        if (wr == 1) PG8_BAR;
        PG8_WAIT_V(2); PG8_BAR;
        PG8_STAGE(PG8_SB(1, 0), cB + kstep, voffB); PG8_STAGE(PG8_SA(1, 0), cA + kstep, voffA); PG8_STAGE(PG8_SB(1, 1), cB + hstep + kstep, voffB);
        PG8_WAIT_V(6); PG8_BAR;
    } else {
        PG8_STAGE(PG8_SB(0, 0), cB, voffB); PG8_STAGE(PG8_SA(0, 0), cA, voffA); PG8_STAGE(PG8_SB(0, 1), cB + hstep, voffB); PG8_STAGE(PG8_SA(0, 1), cA + hstep, voffA);
        if (wr == 1) PG8_BAR;
        PG8_WAIT_V(4); PG8_BAR;
        PG8_STAGE(PG8_SB(1, 0), cB + kstep, voffB); PG8_STAGE(PG8_SA(1, 0), cA + kstep, voffA); PG8_STAGE(PG8_SB(1, 1), cB + hstep + kstep, voffB);
        PG8_WAIT_V(6); PG8_BAR;
    }
    for (;;) {
        const bool has_next = S.next(ui + 1, nxt);
        const char* nA = has_next ? (const char*)g.A + (size_t)nxt.pm * tstep : cA; const char* nB = has_next ? (const char*)g.Bt + (size_t)nxt.pn * tstep : cB;
        for (int t = 0; t < nt; t += 2) {
            const bool last = (t == nt - 2);
            const char* a1 = cA + (size_t)(t + 1) * kstep;
            const char* a2 = last ? nA : cA + (size_t)(t + 2) * kstep; const char* b2 = last ? nB : cB + (size_t)(t + 2) * kstep;
            const char* a3 = a2 + kstep; const char* b3 = b2 + kstep;
            if (last && has_next) S.a_ready(nxt);
            if constexpr (SP2) {
            PG8_LDB(B0, 0, 0); PG8_LDB(B1, 0, 1); PG8_SCHED; PG8_LDA(At, 0, 0); PG8_STAGE(PG8_SA(1, 1), a1 + hstep, voffA);
            PG8_WAIT_V(8); PG8_WAIT_L(0); PG8_BAR; PG8_MMA(0, 0, At, B0); PG8_MMA(0, 1, At, B1); PG8_BAR; PG8_SCHED;
            PG8_LDA(At, 0, 1); PG8_STAGE(PG8_SB(0, 0), b2, voffB); PG8_STAGE(PG8_SB(0, 1), b2 + hstep, voffB); PG8_STAGE(PG8_SA(0, 0), a2, voffA);
            PG8_WAIT_V(8); PG8_WAIT_L(0); PG8_BAR; PG8_MMA(1, 0, At, B0); PG8_MMA(1, 1, At, B1); PG8_BAR; PG8_SCHED;
            PG8_LDB(B0, 1, 0); PG8_LDB(B1, 1, 1); PG8_SCHED; PG8_LDA(At, 1, 0); PG8_STAGE(PG8_SA(0, 1), a2 + hstep, voffA);
            PG8_WAIT_V(8); PG8_WAIT_L(0); PG8_BAR; PG8_MMA(0, 0, At, B0); PG8_MMA(0, 1, At, B1); PG8_BAR; PG8_SCHED;
            PG8_LDA(At, 1, 1); PG8_STAGE(PG8_SB(1, 0), b3, voffB); PG8_STAGE(PG8_SB(1, 1), b3 + hstep, voffB); PG8_STAGE(PG8_SA(1, 0), a3, voffA);
            PG8_WAIT_V(8); PG8_WAIT_L(0); PG8_BAR; PG8_MMA(1, 0, At, B0); PG8_MMA(1, 1, At, B1); PG8_BAR; PG8_SCHED;
            } else {
            PG8_LDB(B0, 0, 0); PG8_SCHED; PG8_LDA(At, 0, 0); PG8_STAGE(PG8_SA(1, 1), a1 + hstep, voffA);
            PG8_WAIT_L(8); PG8_BAR; PG8_WAIT_L(0); PG8_MMA(0, 0, At, B0); PG8_BAR; PG8_SCHED;
            PG8_LDB(B1, 0, 1); PG8_STAGE(PG8_SB(0, 0), b2, voffB);
            PG8_BAR; PG8_WAIT_L(0); PG8_MMA(0, 1, At, B1); PG8_BAR;
            PG8_LDA(At, 0, 1); PG8_STAGE(PG8_SA(0, 0), a2, voffA);
            PG8_BAR; PG8_WAIT_L(0); PG8_MMA(1, 0, At, B0); PG8_BAR; PG8_SCHED;
            PG8_STAGE(PG8_SB(0, 1), b2 + hstep, voffB);
            PG8_WAIT_V(6); PG8_BAR; PG8_MMA(1, 1, At, B1); PG8_BAR;
            PG8_LDB(B0, 1, 0); PG8_SCHED; PG8_LDA(At, 1, 0); PG8_STAGE(PG8_SA(0, 1), a2 + hstep, voffA);
            PG8_WAIT_L(8); PG8_BAR; PG8_WAIT_L(0); PG8_MMA(0, 0, At, B0); PG8_BAR; PG8_SCHED;
            PG8_LDB(B1, 1, 1); PG8_STAGE(PG8_SB(1, 0), b3, voffB);
            PG8_BAR; PG8_WAIT_L(0); PG8_MMA(0, 1, At, B1); PG8_BAR;
            PG8_LDA(At, 1, 1); PG8_STAGE(PG8_SA(1, 0), a3, voffA);
            PG8_BAR; PG8_WAIT_L(0); PG8_MMA(1, 0, At, B0); PG8_BAR; PG8_SCHED;
            PG8_STAGE(PG8_SB(1, 1), b3 + hstep, voffB);
            PG8_WAIT_V(6); PG8_BAR; PG8_MMA(1, 1, At, B1); PG8_BAR;
            }
        }
        if constexpr (ALIGN_EPI) { if (wr == 0) PG8_BAR; }
        if constexpr (!Epi::AFTER_DRAIN) { E(acc, cur, wr, wc, fr, fq); S.done(cur); }
        if (!has_next) break;
#pragma unroll
        for (int a = 0; a < 2; ++a)
#pragma unroll
            for (int b = 0; b < 2; ++b)
#pragma unroll
                for (int m = 0; m < 4; ++m)
#pragma unroll
                    for (int n = 0; n < 2; ++n) acc[a][b][m][n] = (f32x4){0.f, 0.f, 0.f, 0.f};
        cur = nxt; cA = nA; cB = nB; ++ui;
        if constexpr (ALIGN_EPI) { if (wr == 1) PG8_BAR; }
    }
    PG8_WAIT_V(0);
    if constexpr (!ALIGN_EPI) { if (wr == 0) PG8_BAR; }
    PG8_BAR;
    if constexpr (Epi::AFTER_DRAIN) { E.fused(acc, cur, wr, wc, fr, fq, lds, wid, lane); S.done(cur); }
#undef PG8_SA
#undef PG8_SB
#undef PG8_STAGE
#undef PG8_LDA
#undef PG8_LDB
#undef PG8_MMA
#undef PG8_WAIT_V
#undef PG8_WAIT_L
#undef PG8_BAR
#undef PG8_SCHED
}
}

namespace att {
#define LAS __attribute__((address_space(3)))
typedef unsigned short bf16_t;
typedef short bf16x8 __attribute__((ext_vector_type(8)));
typedef short s16x4 __attribute__((ext_vector_type(4)));
typedef short v4i16_t __attribute__((ext_vector_type(4)));
typedef float f32x16 __attribute__((ext_vector_type(16)));
typedef float f32x4 __attribute__((ext_vector_type(4)));
typedef unsigned u32x4 __attribute__((ext_vector_type(4)));
typedef unsigned u32x2 __attribute__((ext_vector_type(2)));
typedef float f32x2_t __attribute__((ext_vector_type(2))); typedef __bf16 bf16x2_t __attribute__((ext_vector_type(2)));
constexpr int SEQ = 4096, INW = 6272, DMODEL = 2176;
constexpr int KP = 272, VP = 320;
constexpr int DIFF_TILE = 128 * KP + 128 * VP;
constexpr int DIL_WAVE = 32 * KP + 32 * VP;
__device__ __forceinline__ unsigned cvtpk(float lo, float hi) { f32x2_t v = {lo, hi}; bf16x2_t b = __builtin_convertvector(v, bf16x2_t); return __builtin_bit_cast(unsigned, b); }
__device__ __forceinline__ int crow(int r, int hi) { return (r & 3) + 8 * (r >> 2) + 4 * hi; }
__device__ __forceinline__ s16x4 vtr(const LAS char* p) { return __builtin_bit_cast(s16x4, __builtin_amdgcn_ds_read_tr16_b64_v4i16((LAS v4i16_t*)p)); }
__device__ __forceinline__ bf16x8 packp(const f32x16& p, int s) {
    u32x4 w; w.x = cvtpk(p[8 * s], p[8 * s + 1]); w.y = cvtpk(p[8 * s + 2], p[8 * s + 3]); w.z = cvtpk(p[8 * s + 4], p[8 * s + 5]); w.w = cvtpk(p[8 * s + 6], p[8 * s + 7]);
    return __builtin_bit_cast(bf16x8, w);
}
#define MFMA32(a, b, c) __builtin_amdgcn_mfma_f32_32x32x16_bf16((a), (b), (c), 0, 0, 0)

__device__ __forceinline__ void diff_unit(LAS char* lds, const bf16_t* QKV, bf16_t* MIX, int b, int h, int qblk, float lam, float negM, const float* g_bout, int tid, int wid, int lane) {
    const int c = wid >> 2, r32 = lane & 31, hh = lane >> 5, cb = (lane >> 4) & 1, q_ = (lane & 15) >> 2, p_ = lane & 3;
    const size_t rowbase = (size_t)b * SEQ; const int q0 = qblk * 128 + (wid & 3) * 32;
    bf16x8 qf[4];
    { const bf16_t* qp = QKV + (rowbase + q0 + r32) * INW + 3072 + h * 128 + c * 64 + 8 * hh;
#pragma unroll
      for (int ks = 0; ks < 4; ++ks) qf[ks] = *(const bf16x8*)(qp + 16 * ks); }
    const int srow = tid >> 4, sch = tid & 15;
    const bf16_t* kg = QKV + (rowbase + srow) * INW + 4096 + h * 128 + sch * 8;
    const bf16_t* vg = kg + 1024;
    LAS char* kst = lds + srow * KP + sch * 16; LAS char* vst = lds + 128 * KP + srow * VP + sch * 16;
    f32x16 o[4];
#pragma unroll
    for (int i = 0; i < 4; ++i)
#pragma unroll
        for (int r = 0; r < 16; ++r) o[i][r] = 0.f;
    float lsum = 0.f;
    f32x16 negm;
#pragma unroll
    for (int r = 0; r < 16; ++r) negm[r] = negM;
    u32x4 kr[4], vr[4];
#pragma unroll
    for (int i = 0; i < 4; ++i) { kr[i] = *(const u32x4*)(kg + (size_t)(32 * i) * INW); vr[i] = *(const u32x4*)(vg + (size_t)(32 * i) * INW); }
#pragma unroll
    for (int i = 0; i < 4; ++i) { *(LAS u32x4*)(kst + 32 * i * KP) = kr[i]; *(LAS u32x4*)(vst + 32 * i * VP) = vr[i]; }
    __syncthreads();
    const int NT = SEQ / 128;
    const LAS char* kread = lds + r32 * KP + (c * 64 + 8 * hh) * 2;
    const LAS char* vread = lds + 128 * KP + (4 * hh + q_) * VP + (16 * cb + 4 * p_) * 2;
    for (int t = 0; t < NT; ++t) {
        const int cur = (t & 1) * DIFF_TILE, nxt = DIFF_TILE - cur;
        const size_t go = (size_t)(t + 1) * 128 * INW; const bool more = t + 1 < NT;
        if (more) {
#pragma unroll
            for (int i = 0; i < 4; ++i) kr[i] = *(const u32x4*)(kg + go + (size_t)(32 * i) * INW); }
        f32x16 pA0 = negm, pA1 = negm, pB0 = negm, pB1 = negm;
#pragma unroll
        for (int ks = 0; ks < 4; ++ks) {
            const bf16x8 k0 = *(const LAS bf16x8*)(kread + cur + ks * 32), k1 = *(const LAS bf16x8*)(kread + cur + 32 * KP + ks * 32);
            pA0 = MFMA32(k0, qf[ks], pA0); pA1 = MFMA32(k1, qf[ks], pA1);
        }
#pragma unroll
        for (int ks = 0; ks < 4; ++ks) {
            const bf16x8 k0 = *(const LAS bf16x8*)(kread + cur + 64 * KP + ks * 32), k1 = *(const LAS bf16x8*)(kread + cur + 96 * KP + ks * 32);
            pB0 = MFMA32(k0, qf[ks], pB0); pB1 = MFMA32(k1, qf[ks], pB1);
        }
        if (more) {
#pragma unroll
            for (int i = 0; i < 4; ++i) *(LAS u32x4*)(kst + nxt + 32 * i * KP) = kr[i];
#pragma unroll
            for (int i = 0; i < 4; ++i) kr[i] = *(const u32x4*)(vg + go + (size_t)(32 * i) * INW); }
        float sa = 0.f, sb = 0.f;
#pragma unroll
        for (int r = 0; r < 16; ++r) { pA0[r] = __builtin_amdgcn_exp2f(pA0[r]); pA1[r] = __builtin_amdgcn_exp2f(pA1[r]); sa += pA0[r]; sb += pA1[r]; }
        bf16x8 pf[4]; pf[0] = packp(pA0, 0); pf[1] = packp(pA0, 1); pf[2] = packp(pA1, 0); pf[3] = packp(pA1, 1);
#pragma unroll
        for (int kst4 = 0; kst4 < 4; ++kst4)
#pragma unroll
            for (int db = 0; db < 4; ++db) {
                const LAS char* a = vread + cur + kst4 * 16 * VP + db * 64;
                const s16x4 lo = vtr(a), hi = vtr(a + 8 * VP);
                const bf16x8 vf = __builtin_shufflevector(lo, hi, 0, 1, 2, 3, 4, 5, 6, 7);
                o[db] = MFMA32(vf, pf[kst4], o[db]);
            }
#pragma unroll
        for (int r = 0; r < 16; ++r) { pB0[r] = __builtin_amdgcn_exp2f(pB0[r]); pB1[r] = __builtin_amdgcn_exp2f(pB1[r]); sa += pB0[r]; sb += pB1[r]; }
        lsum += sa + sb;
        pf[0] = packp(pB0, 0); pf[1] = packp(pB0, 1); pf[2] = packp(pB1, 0); pf[3] = packp(pB1, 1);
#pragma unroll
        for (int kst4 = 0; kst4 < 4; ++kst4)
#pragma unroll
            for (int db = 0; db < 4; ++db) {
                const LAS char* a = vread + cur + (64 + kst4 * 16) * VP + db * 64;
                const s16x4 lo = vtr(a), hi = vtr(a + 8 * VP);
                const bf16x8 vf = __builtin_shufflevector(lo, hi, 0, 1, 2, 3, 4, 5, 6, 7);
                o[db] = MFMA32(vf, pf[kst4], o[db]);
            }
        if (more) {
#pragma unroll
            for (int i = 0; i < 4; ++i) *(LAS u32x4*)(vst + nxt + 32 * i * VP) = kr[i]; }
        __syncthreads();
    }
    const int lane_e = lane_opaque();
    lsum += shflx(lsum, 32, lane_e);
    float inv = 1.0f / lsum; if (c == 1) inv *= lam;
    const int r32e = lane_e & 31, hhe = lane_e >> 5;
    LAS float* X = (LAS float*)lds + (wid & 3) * 4096;
    if (c == 1) {
#pragma unroll
        for (int db = 0; db < 4; ++db)
#pragma unroll
            for (int r = 0; r < 16; ++r) X[(db * 32 + crow(r, hhe)) * 32 + r32e] = o[db][r] * inv;
    }
    __syncthreads();
    if (c == 0) {
        float ss = 0.f;
#pragma unroll
        for (int db = 0; db < 4; ++db)
#pragma unroll
            for (int r = 0; r < 16; ++r) { const float v = o[db][r] * inv - X[(db * 32 + crow(r, hhe)) * 32 + r32e]; o[db][r] = v; ss += v * v; }
        ss += shflx(ss, 32, lane_e);
        const float rn = __builtin_amdgcn_rsqf(ss * (1.0f / 128.0f) + 1e-6f) * 0.8f;
        bf16_t* op = MIX + (rowbase + q0 + r32e) * DMODEL + 1024 + h * 128;
#pragma unroll
        for (int db = 0; db < 4; ++db)
#pragma unroll
            for (int g4 = 0; g4 < 4; ++g4) { const int d0 = db * 32 + 8 * g4 + 4 * hhe; const f32x4 gg = *(const f32x4*)(g_bout + d0);
                u32x2 w; w.x = cvtpk(o[db][4 * g4] * rn * gg[0], o[db][4 * g4 + 1] * rn * gg[1]); w.y = cvtpk(o[db][4 * g4 + 2] * rn * gg[2], o[db][4 * g4 + 3] * rn * gg[3]);
                *(u32x2*)(op + d0) = w; }
    }
    __syncthreads();
}

__device__ __forceinline__ void dil_unit(LAS char* wl, const bf16_t* QKV, bf16_t* MIX, int b, int h, int r16, int ib, float negM, const float* g_aout, int lane) {
    const int r32 = lane & 31, hh = lane >> 5, cb = (lane >> 4) & 1, q_ = (lane & 15) >> 2, p_ = lane & 3;
    const size_t rowbase = (size_t)b * SEQ;
    const int tq = r16 + 16 * (32 * ib + r32);
    bf16x8 qf[8];
    { const bf16_t* qp = QKV + (rowbase + tq) * INW + h * 128 + 8 * hh;
#pragma unroll
      for (int ks = 0; ks < 8; ++ks) qf[ks] = *(const bf16x8*)(qp + 16 * ks); }
    f32x16 o[4];
#pragma unroll
    for (int i = 0; i < 4; ++i)
#pragma unroll
        for (int r = 0; r < 16; ++r) o[i][r] = 0.f;
    float lsum = 0.f;
    f32x16 negm;
#pragma unroll
    for (int r = 0; r < 16; ++r) negm[r] = negM;
    const int lrow = lane >> 4, lch = lane & 15;
    const bf16_t* kvg = QKV + rowbase * INW + 1024 + h * 128 + lch * 8;
    LAS char* kst = wl + lrow * KP + lch * 16; LAS char* vst = wl + 32 * KP + lrow * VP + lch * 16;
    const LAS char* kread = wl + r32 * KP + 8 * hh * 2;
    const LAS char* vread = wl + 32 * KP + (4 * hh + q_) * VP + (16 * cb + 4 * p_) * 2;
    int klo0, khi0, klo1, khi1, klo2, khi2;
    { const int bq = 32 * ib;               int lo_i = bq - 64; if (lo_i < 0) lo_i = 0; klo0 = lo_i >> 5; khi0 = (bq + 31 + 64) >> 5;      if (khi0 > 7) khi0 = 7; }
    { const int bq = (r16 >> 2) + 128 * ib; int lo_i = bq - 64; if (lo_i < 0) lo_i = 0; klo1 = lo_i >> 5; khi1 = (bq + 31 * 4 + 64) >> 5;  if (khi1 > 31) khi1 = 31; }
    { const int bq = r16 + 512 * ib;        int lo_i = bq - 64; if (lo_i < 0) lo_i = 0; klo2 = lo_i >> 5; khi2 = (bq + 31 * 16 + 64) >> 5; if (khi2 > 127) khi2 = 127; }
    int pat = 0, kb = klo0;
    u32x4 kr[8], vr[8];
#define DIL_LOAD(PAT, KB) do { const int sh_ = 4 - 2 * (PAT); const int rc_ = r16 & ((1 << sh_) - 1); \
        _Pragma("unroll") for (int i = 0; i < 8; ++i) { const int tok = rc_ + ((32 * (KB) + lrow + 4 * i) << sh_); const bf16_t* gp = kvg + (size_t)tok * INW; kr[i] = *(const u32x4*)gp; vr[i] = *(const u32x4*)(gp + 1024); } } while (0)
    DIL_LOAD(pat, kb);
    for (;;) {
#pragma unroll
        for (int i = 0; i < 8; ++i) { *(LAS u32x4*)(kst + 4 * i * KP) = kr[i]; *(LAS u32x4*)(vst + 4 * i * VP) = vr[i]; }
        __builtin_amdgcn_fence(__ATOMIC_RELEASE, "wavefront"); __builtin_amdgcn_wave_barrier(); __builtin_amdgcn_fence(__ATOMIC_ACQUIRE, "wavefront");
        const int cpat = pat, ckb = kb;
        { const int hi_c = pat == 0 ? khi0 : (pat == 1 ? khi1 : khi2);
          if (kb < hi_c) ++kb; else { ++pat; kb = pat == 1 ? klo1 : klo2; } }
        const bool more = pat < 3;
        if (more) DIL_LOAD(pat, kb);
        const int sh = 4 - 2 * cpat, sq = 16 >> sh;
        const int qi = (r16 >> sh) + sq * 32 * ib + sq * r32;
        f32x16 p = negm;
#pragma unroll
        for (int ks = 0; ks < 8; ++ks) { const bf16x8 kf = *(const LAS bf16x8*)(kread + ks * 32); p = MFMA32(kf, qf[ks], p); }
        float sa = 0.f;
#pragma unroll
        for (int r = 0; r < 16; ++r) { const int dl = 32 * ckb + crow(r, hh) - qi; const float e = __builtin_amdgcn_exp2f(p[r]); const float pv = (dl <= 64 && dl >= -64) ? e : 0.f; p[r] = pv; sa += pv; }
        lsum += sa;
        bf16x8 pf[2]; pf[0] = packp(p, 0); pf[1] = packp(p, 1);
#pragma unroll
        for (int s = 0; s < 2; ++s)
#pragma unroll
            for (int db = 0; db < 4; ++db) {
                const LAS char* a = vread + s * 16 * VP + db * 64;
                const s16x4 lo = vtr(a), hi = vtr(a + 8 * VP);
                const bf16x8 vf = __builtin_shufflevector(lo, hi, 0, 1, 2, 3, 4, 5, 6, 7);
                o[db] = MFMA32(vf, pf[s], o[db]);
            }
        __builtin_amdgcn_fence(__ATOMIC_RELEASE, "wavefront"); __builtin_amdgcn_wave_barrier(); __builtin_amdgcn_fence(__ATOMIC_ACQUIRE, "wavefront");
        if (!more) break;
    }
#undef DIL_LOAD
    lsum += shflx(lsum, 32, lane);
    const float inv = 1.0f / lsum; float ss = 0.f;
#pragma unroll
    for (int db = 0; db < 4; ++db)
#pragma unroll
        for (int r = 0; r < 16; ++r) { const float v = o[db][r] * inv; o[db][r] = v; ss += v * v; }
    ss += shflx(ss, 32, lane);
    const float rn = __builtin_amdgcn_rsqf(ss * (1.0f / 128.0f) + 1e-6f);
    bf16_t* op = MIX + (rowbase + tq) * DMODEL + h * 128;
#pragma unroll
    for (int db = 0; db < 4; ++db)
#pragma unroll
        for (int g4 = 0; g4 < 4; ++g4) { const int d0 = db * 32 + 8 * g4 + 4 * hh; const f32x4 gg = *(const f32x4*)(g_aout + d0);
            u32x2 w; w.x = cvtpk(o[db][4 * g4] * rn * gg[0], o[db][4 * g4 + 1] * rn * gg[1]); w.y = cvtpk(o[db][4 * g4 + 2] * rn * gg[2], o[db][4 * g4 + 3] * rn * gg[3]);
            *(u32x2*)(op + d0) = w; }
}
}

constexpr int NWAVES = 8;
constexpr int DM = 2048, NBATCH = 2, SEQ = 4096, MROWS = NBATCH * SEQ, DFF = 5632, INW = 6144;
constexpr size_t MiB = 1u << 20;
constexpr size_t WS_CTL = 0;
constexpr size_t OFF_GTAB = 1 * MiB - 4096;
constexpr size_t OFF_RS0 = 917504;
constexpr size_t OFF_BAR = 983040, BAR_BYTES = 16384;
constexpr size_t OFF_RS1 = 0, OFF_RS2 = 32768, OFF_ROPEA = 65536, OFF_ROPEB = OFF_ROPEA + 2 * 4096 * 16 * 4;
constexpr int LDK = pg8::LDK, LDQ = pg8::LDQ;
constexpr size_t WS_W1A = 1 * MiB, WS_W1B = WS_W1A + 47 * MiB, WS_WIN = WS_W1B + 22 * MiB, WS_WOUT = WS_WIN + 26 * MiB, WS_W2A = WS_WOUT + 9 * MiB, WS_W2B = WS_W2A + 47 * MiB;
constexpr size_t WS_XN = WS_W2B + 22 * MiB;
constexpr size_t WS_ACT = WS_XN + 34 * MiB;
constexpr size_t WS_MIX = WS_ACT + 98 * MiB;
constexpr size_t WS_END = WS_MIX + 34 * MiB;
constexpr int LDS_BYTES = 155648;
constexpr int XCH_OFF = 131072;
static_assert((size_t)11264 * LDK * 2 <= 47 * MiB && (size_t)6144 * LDK * 2 <= 26 * MiB && (size_t)2048 * LDK * 2 <= 9 * MiB && (size_t)8192 * LDK * 2 <= 34 * MiB && (size_t)8192 * LDQ * 2 <= 98 * MiB && att::INW == LDQ && att::DMODEL == LDK, "ws map");
static_assert(att::DIL_WAVE * 8 <= LDS_BYTES - 64 && 3456 * 4 <= BAR_BYTES && 2 * att::DIFF_TILE <= LDS_BYTES - 64 && XCH_OFF + 8192 <= LDS_BYTES, "LDS map");

#define LAS __attribute__((address_space(3)))
typedef unsigned short bf16;
typedef unsigned v4u __attribute__((ext_vector_type(4)));
typedef unsigned v2u __attribute__((ext_vector_type(2)));
typedef float f32x4 __attribute__((ext_vector_type(4)));
__device__ __forceinline__ unsigned f2bf(float f) { unsigned u = __builtin_bit_cast(unsigned, f); return (u + 0x7fffu + ((u >> 16) & 1u)) >> 16; }
__device__ __forceinline__ unsigned pk2(float lo, float hi) { return f2bf(lo) | (f2bf(hi) << 16); }
__device__ __forceinline__ float wave_sum(float v, int lane) {
#pragma unroll
    for (int o = 1; o < 64; o <<= 1) v += shflx(v, o, lane);
    return v;
}
__device__ __forceinline__ float wave_max(float v, int lane) {
#pragma unroll
    for (int o = 1; o < 64; o <<= 1) v = fmaxf(v, shflx(v, o, lane));
    return v;
}
template <bool GLU> __device__ __forceinline__ void tr_load(const float* W, int N, int item, int lane, f32x4 (&v)[8], const float* gk) {
    const int nblk = N / 32, kb = item / nblk, nb = item % nblk, k0 = 64 * kb, n0 = 32 * nb;
    const float* src = W + (size_t)(k0 + (lane >> 3)) * N + n0 + 4 * (lane & 7);
#pragma unroll
    for (int i = 0; i < 8; ++i) v[i] = __builtin_nontemporal_load((const f32x4*)(src + (size_t)(8 * i) * N));
    if (gk) {
#pragma unroll
        for (int i = 0; i < 8; ++i) v[i] = v[i] * gk[k0 + (lane >> 3) + 8 * i]; }
}
template <bool GLU> __device__ __forceinline__ void tr_store(int K, int N, bf16* WT, int ldw, LAS float* scr, int item, int lane, const f32x4 (&v)[8]) {
    const int nblk = N / 32, kb = item / nblk, nb = item % nblk, k0 = 64 * kb, n0 = 32 * nb;
    int r0 = n0;
    if (GLU) { const int half = N / 2; r0 = n0 < half ? (n0 >> 7) * 256 + (n0 & 127) : ((n0 - half) >> 7) * 256 + 128 + ((n0 - half) & 127); }
    const int rg = lane >> 3, c4 = lane & 7;
#pragma unroll
    for (int i = 0; i < 8; ++i) { LAS float* d = scr + (8 * i + rg) * 33 + 4 * c4; d[0] = v[i][0]; d[1] = v[i][1]; d[2] = v[i][2]; d[3] = v[i][3]; }
    asm volatile("s_waitcnt lgkmcnt(0)" ::: "memory");
    const int c = lane & 7;
#pragma unroll
    for (int j = 0; j < 4; ++j) { const int n = (lane >> 3) + 8 * j; const LAS float* s = scr + (8 * c) * 33 + n;
        v4u o; o.x = pk2(s[0 * 33], s[1 * 33]); o.y = pk2(s[2 * 33], s[3 * 33]); o.z = pk2(s[4 * 33], s[5 * 33]); o.w = pk2(s[6 * 33], s[7 * 33]);
        *(v4u*)(WT + (size_t)(r0 + n) * ldw + k0 + 8 * c) = o; }
    asm volatile("s_waitcnt lgkmcnt(0)" ::: "memory");
}
template <bool GLU, int NIF> __device__ __forceinline__ void tr_matrix(const float* W, int K, int N, bf16* WT, int ldw, LAS float* scr, int gw, int NGW, int lane, const float* gk) {
    const int nitems = (K / 64) * (N / 32);
    for (int it = gw; it < nitems; it += NIF * NGW) {
        f32x4 v[NIF][8];
#pragma unroll
        for (int j = 0; j < NIF; ++j) if (it + j * NGW < nitems) tr_load<GLU>(W, N, it + j * NGW, lane, v[j], gk);
#pragma unroll
        for (int j = 0; j < NIF; ++j) if (it + j * NGW < nitems) tr_store<GLU>(K, N, WT, ldw, scr, it + j * NGW, lane, v[j]);
    }
}

#define XB_TMO      128
#define XB_XCNT(j)  (256  + 64 * (j))
#define XB_XSUB(j)  (1280 + 64 * (j))
#define XB_XGEN(j)  (2304 + 64 * (j))
#define XB_TOP      3328
#define XB_TOPGEN   3392
#define XCD_BAR_WORDS 3456
#define XB_SPIN_CAP (1u << 18)

__device__ __forceinline__ unsigned xb_ld(unsigned* p)              { return __hip_atomic_load(p, __ATOMIC_RELAXED, __HIP_MEMORY_SCOPE_AGENT); }
__device__ __forceinline__ unsigned xb_add(unsigned* p, unsigned v) { return __hip_atomic_fetch_add(p, v, __ATOMIC_RELAXED, __HIP_MEMORY_SCOPE_AGENT); }
__device__ __forceinline__ unsigned xb_xcc_id() { return (unsigned)__builtin_amdgcn_s_getreg((3 << 11) | 20) & 0xFu; }
#define XB_SPIN(cond, bar) do { unsigned _sp = 0; while (cond) { __builtin_amdgcn_s_sleep(1); \
    if ((++_sp & 255u) == 0u) { if (xb_ld(&(bar)[XB_TMO])) break; if (_sp > XB_SPIN_CAP) { atomicAdd(&(bar)[XB_TMO], 1u); break; } } } } while (0)

struct XcdBarrier {
    unsigned* bar; unsigned x; int wid;
    volatile LAS unsigned* st;
};

__device__ __forceinline__ bool xb_lane0() { return lane_opaque() == 0; }
__device__ __forceinline__ XcdBarrier xcd_barrier_post(unsigned* bar, volatile LAS unsigned* st, int wid) {
    XcdBarrier b; b.bar = bar; b.x = xb_xcc_id(); b.st = st; b.wid = wid;
    if (wid == 0 && xb_lane0()) (void)xb_add(&bar[XB_XCNT(b.x)], 1u);
    return b;
}
__device__ __forceinline__ void xcd_barrier_complete(unsigned* bar, unsigned x, unsigned& nloc, unsigned& nx) {
    const unsigned G = gridDim.x * gridDim.y * gridDim.z;
    unsigned sum, cnt, mine, sp = 0u;
    for (;;) {
        sum = 0u; cnt = 0u; mine = 0u;
#pragma unroll
        for (unsigned j = 0; j < 16; ++j) { const unsigned c = xb_ld(&bar[XB_XCNT(j)]); sum += c; cnt += (c > 0u) ? 1u : 0u; mine = (j == x) ? c : mine; }
        if (sum == G) break;
        __builtin_amdgcn_s_sleep(1);
        if ((++sp & 255u) == 0u) { if (xb_ld(&bar[XB_TMO])) break; if (sp > XB_SPIN_CAP) { atomicAdd(&bar[XB_TMO], 1u); break; } }
    }
    nloc = mine > 0u ? mine : 1u; nx = cnt > 0u ? cnt : 1u;
}

__device__ __forceinline__ void xcd_barrier(const XcdBarrier& b) {
    asm volatile("s_waitcnt vmcnt(0)" ::: "memory");
    __syncthreads();
    if (b.wid == 0 && xb_lane0()) {
        unsigned* bar = b.bar;
        __builtin_amdgcn_s_waitcnt(0);
        unsigned nloc = b.st[0], nx = b.st[1];
        if (nloc == 0u) { xcd_barrier_complete(bar, b.x, nloc, nx); b.st[0] = nloc; b.st[1] = nx; }
        const unsigned old = xb_add(&bar[XB_XSUB(b.x)], 1u);
        const unsigned gen = old / nloc;
        if (old + 1u == (gen + 1u) * nloc) {
            __builtin_amdgcn_fence(__ATOMIC_RELEASE, "agent");
            asm volatile("s_waitcnt vmcnt(0)" ::: "memory");
            const unsigned og = xb_add(&bar[XB_TOP], 1u);
            const unsigned tg = og / nx;
            if (og + 1u == (tg + 1u) * nx) xb_add(&bar[XB_TOPGEN], 1u);
            else XB_SPIN(xb_ld(&bar[XB_TOPGEN]) == tg, bar);
            __builtin_amdgcn_fence(__ATOMIC_ACQUIRE, "agent");
            xb_add(&bar[XB_XGEN(b.x)], 1u);
            asm volatile("s_waitcnt vmcnt(0)" ::: "memory");
        } else {
            XB_SPIN(xb_ld(&bar[XB_XGEN(b.x)]) == gen, bar);
            __builtin_amdgcn_fence(__ATOMIC_ACQUIRE, "agent");
            asm volatile("s_waitcnt vmcnt(0)" ::: "memory");
        }
    }
    __syncthreads();
}

struct Args {
    const float* in[20]; float* out; unsigned char* ws;
    float invA[16]; float invB[8];
};

__global__ void __launch_bounds__(NWAVES * 64) hybrid_fwd(Args args) {
    extern __shared__ __attribute__((aligned(16))) unsigned char lds_raw[];
    cg::grid_group grid = cg::this_grid();
    LAS unsigned char* lds = (LAS unsigned char*)lds_raw;
    const int wid = __builtin_amdgcn_readfirstlane((int)threadIdx.x >> 6);
#define fresh_lane() lane_opaque()
    const int lane = fresh_lane(), tid = wid * 64 + lane;
    const int G = gridDim.x, bx = blockIdx.x;
    unsigned char* ws = args.ws;
    volatile LAS unsigned* MISC = (volatile LAS unsigned*)(lds + LDS_BYTES - 64);
    if (tid < 16) MISC[tid] = 0u;
    __syncthreads();
    const XcdBarrier bar = xcd_barrier_post((unsigned*)(ws + OFF_BAR), MISC + 8, wid);
    if (G == 0x7fffffff) grid.sync();
    const float* x = args.in[0];
    float* out = args.out;
    float* rowss1 = (float*)(ws + OFF_RS1); float* rowss2 = (float*)(ws + OFF_RS2);
    float* gtab = (float*)(ws + OFF_GTAB); float* ropeA = (float*)(ws + OFF_ROPEA); float* ropeB = (float*)(ws + OFF_ROPEB);
    bf16* W1A = (bf16*)(ws + WS_W1A); bf16* W1B = (bf16*)(ws + WS_W1B); bf16* WIN = (bf16*)(ws + WS_WIN); bf16* WOUT = (bf16*)(ws + WS_WOUT);
    bf16* W2A = (bf16*)(ws + WS_W2A); bf16* W2B = (bf16*)(ws + WS_W2B);
    bf16* XN = (bf16*)(ws + WS_XN); bf16* ACT = (bf16*)(ws + WS_ACT); bf16* QKV = (bf16*)(ws + WS_ACT); bf16* MIX = (bf16*)(ws + WS_MIX);

#ifndef REP_P0
#define REP_P0 1
#endif
#ifndef REP_DIFF
#define REP_DIFF 1
#endif
#ifndef REP_DIL
#define REP_DIL 1
#endif
#define REP_G1 1
#define REP_SHADOW 1
#define REP_G2 1
#define REP_G3 1
#define REP_G5 1
#define REP_G6 1
#define REP_G7 1
    for (int rep = 0; rep < REP_P0; ++rep) {
        LAS float* scr = (LAS float*)(lds + wid * 16384);
        const int gw = bx * NWAVES + wid, NGW = G * NWAVES;
        constexpr int I_FA = (DM / 64) * (2 * DFF / 32), I_FB = (DFF / 64) * (DM / 32), I_IN = (DM / 64) * (INW / 32), I_OUT = (DM / 64) * (DM / 32);
        tr_matrix<true, 2>(args.in[2], DM, 2 * DFF, W1A, LDK, scr, gw, NGW, lane, args.in[1]);
        float* rowss0 = (float*)(ws + OFF_RS0);
        for (int m = gw; m < MROWS; m += NGW) {
            const f32x4* xr = (const f32x4*)(x + (size_t)m * DM) + lane; f32x4 v[8]; float s = 0.f;
#pragma unroll
            for (int j = 0; j < 8; ++j) { v[j] = xr[64 * j]; s += (v[j][0] * v[j][0] + v[j][1] * v[j][1]) + (v[j][2] * v[j][2] + v[j][3] * v[j][3]); }
            s = wave_sum(s, lane); if (lane == 0) rowss0[m] = s;
            v2u* o8 = (v2u*)(XN + (size_t)m * LDK) + lane;
#pragma unroll
            for (int j = 0; j < 8; ++j) { v2u w; w.x = pk2(v[j][0], v[j][1]); w.y = pk2(v[j][2], v[j][3]); o8[64 * j] = w; }
        }
        const int gt = bx * (NWAVES * 64) + tid, NGT = G * NWAVES * 64;
        for (int i = gt; i < 2 * MROWS; i += NGT) rowss1[i] = 0.f;
        if (gt < 512) { const int t = gt >> 7, d = gt & 127; gtab[gt] = t == 0 ? args.in[6][d] : (t == 1 ? args.in[7][d] : (t == 2 ? args.in[8][d & 63] : args.in[9][d & 63])); }
        for (int i = gt; i < 4096 * 24; i += NGT) {
            const int s = i / 24, k = i % 24; const float inv = k < 16 ? args.invA[k] : args.invB[k - 16];
            const float ang = (float)s * inv; double rev = (double)ang * 0.15915494309189535; rev -= floor(rev);
            const float cs = __builtin_amdgcn_cosf((float)rev), sn = __builtin_amdgcn_sinf((float)rev);
            if (k < 16) { ropeA[s * 16 + k] = cs; ropeA[4096 * 16 + s * 16 + k] = sn; } else { ropeB[s * 8 + k - 16] = cs; ropeB[4096 * 8 + s * 8 + k - 16] = sn; }
        }
    }
    xcd_barrier(bar);

    { pg8::Gemm g{XN, W1A, MROWS, 2 * DFF, DM, LDK}; pg8::StaticOrder S; S.init(MROWS, 2 * DFF, G, bx);
      pg8::EpiSwiGLU E{ACT, DFF, (const float*)(ws + OFF_RS0)};
      pg8::gemm_phase<pg8::EpiSwiGLU, pg8::StaticOrder, true, true>(lds, g, S, E, wid); }
    {
        constexpr int NU = (MROWS / 256) * (2 * DFF / 256);
        const int rounds = (NU + G - 1) / G; int first_idle = NU - (rounds - 1) * G, nidle = G - first_idle;
        if (nidle <= 0) { first_idle = 0; nidle = G; }
        if (bx >= first_idle) {
            LAS float* scr = (LAS float*)(lds + wid * 16384); const int lane_c = fresh_lane();
            const int gw = (bx - first_idle) * NWAVES + wid, NGW = nidle * NWAVES;
            for (int rep = 0; rep < REP_SHADOW; ++rep) {
            tr_matrix<false, 2>(args.in[3], DFF, DM, W1B, DFF, scr, gw, NGW, lane_c, nullptr);
            tr_matrix<false, 2>(args.in[5], DM, INW, WIN, LDK, scr, gw, NGW, lane_c, args.in[4]);
            tr_matrix<false, 2>(args.in[16], DM, DM, WOUT, LDK, scr, gw, NGW, lane_c, nullptr);
            tr_matrix<true, 2>(args.in[18], DM, 2 * DFF, W2A, LDK, scr, gw, NGW, lane_c, args.in[17]);
            }
        }
    }
    xcd_barrier(bar);
    { pg8::Gemm g{ACT, W1B, MROWS, DM, DFF, DFF}; pg8::StaticOrder S; S.init(MROWS, DM, G, bx);
      pg8::EpiResid<true, true, false> E{x, nullptr, XN, rowss1, 0.5f};
      pg8::gemm_phase<pg8::EpiResid<true, true, false>, pg8::StaticOrder, true, true>(lds, g, S, E, wid); }
    xcd_barrier(bar);
    { pg8::Gemm g{XN, WIN, MROWS, INW, DM, LDK}; pg8::StaticOrder S; S.init(MROWS, INW, G, bx);
      pg8::EpiQKV E{QKV, rowss1, gtab, ropeA, ropeB, (LAS float*)(lds + XCH_OFF)};
      for (int rep = 0; rep < REP_G3; ++rep)
      pg8::gemm_phase<pg8::EpiQKV, pg8::StaticOrder, true, true>(lds, g, S, E, wid); }
    xcd_barrier(bar);
    {
        const float L2E = 1.4426950408889634f;
        const int lane_a = fresh_lane();
        const float gq = fmaxf(fabsf(args.in[6][lane_a]), fabsf(args.in[6][lane_a + 64])), gk = fmaxf(fabsf(args.in[7][lane_a]), fabsf(args.in[7][lane_a + 64]));
        const float negMA = __builtin_bit_cast(float, __builtin_amdgcn_readfirstlane(__builtin_bit_cast(int, -1.02f * 11.313708498984761f * wave_max(gq, lane_a) * wave_max(gk, lane_a) * L2E)));
        const float negMB = __builtin_bit_cast(float, __builtin_amdgcn_readfirstlane(__builtin_bit_cast(int, -1.02f * 8.0f * wave_max(fabsf(args.in[8][lane_a]), lane_a) * wave_max(fabsf(args.in[9][lane_a]), lane_a) * L2E)));
        const float lam = __builtin_bit_cast(float, __builtin_amdgcn_readfirstlane(__builtin_bit_cast(int, __expf(wave_sum(args.in[10][lane_a] * args.in[11][lane_a], lane_a)) - __expf(wave_sum(args.in[12][lane_a] * args.in[13][lane_a], lane_a)) + 0.2f)));
        {
            const int tid_a = wid * 64 + fresh_lane();
            for (int rep = 0; rep < REP_DIFF; ++rep)
            for (int u = bx; u < 512; u += G) {
                const int bh = u >> 5, qblk = u & 31;
                att::diff_unit((LAS char*)lds, QKV, MIX, bh >> 3, bh & 7, qblk, lam, negMB, args.in[15], tid_a, wid, tid_a & 63);
            }
        }
        {
            const int lane_d = fresh_lane();
            for (int rep = 0; rep < REP_DIL; ++rep)
            for (int wu = bx * NWAVES + wid; wu < 2048; wu += G * NWAVES) {
                const int ib = wu & 7, r16 = (wu >> 3) & 15, h = (wu >> 7) & 7, b = wu >> 10;
                att::dil_unit((LAS char*)lds + wid * att::DIL_WAVE, QKV, MIX, b, h, r16, ib, negMA, args.in[14], lane_d);
            }
        }
    }
    xcd_barrier(bar);
    { pg8::Gemm g{MIX, WOUT, MROWS, DM, DM, LDK}; pg8::StaticOrder S; S.init(MROWS, DM, G, bx);
      pg8::EpiResid<false, true, false> E{nullptr, nullptr, XN, rowss2, 1.0f};
      pg8::gemm_phase<pg8::EpiResid<false, true, false>, pg8::StaticOrder, true, true>(lds, g, S, E, wid); }
    xcd_barrier(bar);
    { pg8::Gemm g{XN, W2A, MROWS, 2 * DFF, DM, LDK}; pg8::StaticOrder S; S.init(MROWS, 2 * DFF, G, bx);
      pg8::EpiSwiGLU E{ACT, DFF, rowss2};
      for (int rep = 0; rep < REP_G6; ++rep)
      pg8::gemm_phase<pg8::EpiSwiGLU, pg8::StaticOrder, true, true>(lds, g, S, E, wid); }
    {
        constexpr int NU = (MROWS / 256) * (2 * DFF / 256);
        const int rounds = (NU + G - 1) / G; int first_idle = NU - (rounds - 1) * G, nidle = G - first_idle;
        if (nidle <= 0) { first_idle = 0; nidle = G; }
        if (bx >= first_idle) tr_matrix<false, 2>(args.in[19], DFF, DM, W2B, DFF, (LAS float*)(lds + wid * 16384), (bx - first_idle) * NWAVES + wid, nidle * NWAVES, fresh_lane(), nullptr);
    }
    xcd_barrier(bar);
    { pg8::Gemm g{ACT, W2B, MROWS, DM, DFF, DFF}; pg8::StaticOrder S; S.init(MROWS, DM, G, bx);
      pg8::EpiResid<false, false, true> E{nullptr, out, XN, nullptr, 0.5f};
      pg8::gemm_phase<pg8::EpiResid<false, false, true>, pg8::StaticOrder, true, true>(lds, g, S, E, wid); }
}

extern "C" void kernel_launch(void* const* d_in, const int* in_sizes, int n_in, void* d_out, int out_size, void* d_ws, size_t ws_size, hipStream_t stream) {
    static int grid = 0;
    if (grid == 0) {
        if (n_in != 20 || in_sizes[0] != MROWS * DM || out_size != MROWS * DM || ws_size < WS_END) {
            fprintf(stderr, "kernel_launch: unexpected shapes (n_in %d, in0 %d, out %d, ws %zu < %zu)\n", n_in, n_in > 0 ? in_sizes[0] : -1, out_size, ws_size, (size_t)WS_END); grid = -1; return; }
        int dev = 0, cus = 0, per_cu = 0;
        (void)hipGetDevice(&dev); (void)hipDeviceGetAttribute(&cus, hipDeviceAttributeMultiprocessorCount, dev);
        if (hipFuncSetAttribute((const void*)hybrid_fwd, hipFuncAttributeMaxDynamicSharedMemorySize, LDS_BYTES) != hipSuccess) { fprintf(stderr, "kernel_launch: hipFuncSetAttribute failed\n"); grid = -1; return; }
        if (hipOccupancyMaxActiveBlocksPerMultiprocessor(&per_cu, (const void*)hybrid_fwd, NWAVES * 64, LDS_BYTES) != hipSuccess || per_cu < 1) { fprintf(stderr, "kernel_launch: occupancy query says %d\n", per_cu); per_cu = 1; }
        (void)hipGetLastError();
        grid = cus * per_cu;
    }
    if (grid < 0) return;
    Args a{};
    for (int i = 0; i < 20; ++i) a.in[i] = (const float*)d_in[i];
    a.out = (float*)d_out; a.ws = (unsigned char*)d_ws;
    for (int i = 0; i < 16; ++i) a.invA[i] = (float)pow(500000.0, -(double)i / 16.0);
    for (int i = 0; i < 8; ++i) a.invB[i] = (float)pow(500000.0, -(double)i / 8.0);
    if (hipMemsetAsync((char*)d_ws + OFF_BAR, 0, BAR_BYTES, stream) != hipSuccess) { fprintf(stderr, "kernel_launch: memset failed\n"); return; }
    void* kargs[] = {&a};
    hipError_t e = hipLaunchCooperativeKernel((const void*)hybrid_fwd, dim3(grid), dim3(NWAVES * 64), kargs, LDS_BYTES, stream);
    if (e != hipSuccess) fprintf(stderr, "kernel_launch: cooperative launch failed: %s (grid %d)\n", hipGetErrorString(e), grid);
}
```

```cpp
#include <hip/hip_runtime.h>
#include <hip/hip_cooperative_groups.h>
#include <cstdio>
#include <cstdint>
#include <cmath>
namespace cg = cooperative_groups;
__device__ __forceinline__ int lane_opaque() { unsigned z = 0u; asm volatile("" : "+v"(z)); return (int)__builtin_amdgcn_mbcnt_hi(~0u, __builtin_amdgcn_mbcnt_lo(~0u, z)); }
__device__ __forceinline__ float shflx(float v, int mask, int lane) { return __builtin_bit_cast(float, __builtin_amdgcn_ds_bpermute((lane ^ mask) << 2, __builtin_bit_cast(int, v))); }
namespace pg8 {
#define PG8_LAS __attribute__((address_space(3)))
typedef unsigned short bf16_t;
typedef short bf16x8 __attribute__((ext_vector_type(8)));
typedef float f32x4 __attribute__((ext_vector_type(4)));
typedef unsigned u32x4 __attribute__((ext_vector_type(4)));
constexpr int BM = 256, BK = 64, HALF = 128, HTB = HALF * BK * 2  , STAGE_BYTES = 8 * HTB, NXCD = 8, WGM = 8;

__host__ __device__ __forceinline__ int lds_byte(int r, int c) { const int st = (r >> 4) * 2 + (c >> 5), rr = r & 15, cc = c & 31, ob = rr * 64 + cc * 2; return st * 1024 + (ob ^ (((ob >> 9) & 1) << 5)); }
__host__ __device__ __forceinline__ void stage_rc(int b, int& R, int& C) { const int st = b / 1024, sb = b % 1024, swz = sb ^ (((sb >> 9) & 1) << 5); R = (st >> 1) * 16 + swz / 64; C = (st & 1) * 32 + (swz % 64) / 2; }
__host__ __device__ __forceinline__ int perm32(int rho) { const int n = rho >> 4, i = rho & 15; return 8 * (i >> 2) + 4 * n + (i & 3); }

struct Unit { int pm, pn; };
struct Gemm { const bf16_t* A; const bf16_t* Bt; int M, N, K, ld; };

struct StaticOrder {
    int nM, nN, nwg, G, c;
    __host__ __device__ void init(int M, int N, int G_, int c_) { nM = M / BM; nN = N / BM; nwg = nM * nN; G = G_; c = c_; }
    __host__ __device__ bool next(int i, Unit& u) const {
        const long L = (long)i * G + c; if (L >= nwg) return false;
        int wgid = (int)L; { const int q = nwg / NXCD, r = nwg % NXCD, xcd = wgid % NXCD, off = wgid / NXCD; wgid = (xcd < r ? xcd * (q + 1) : r * (q + 1) + (xcd - r) * q) + off; }
        const int nig = WGM * nN, gid = wgid / nig, fm = gid * WGM, gsz = (nM - fm) < WGM ? (nM - fm) : WGM;
        u.pm = fm + ((wgid % nig) % gsz); u.pn = (wgid % nig) / gsz; return true;
    }
    __device__ __forceinline__ void a_ready(const Unit&) const {}
    __device__ __forceinline__ void done(const Unit&) const {}
};

__device__ __forceinline__ unsigned cvt_pk_bf16(float lo, float hi) { unsigned r; asm volatile("v_cvt_pk_bf16_f32 %0, %1, %2" : "=v"(r) : "v"(lo), "v"(hi)); return r; }
typedef float f32x2 __attribute__((ext_vector_type(2)));

typedef unsigned u32x2 __attribute__((ext_vector_type(2)));
constexpr int LDK = 2176, LDQ = 6272;
__device__ __forceinline__ float fast_silu(float g) { return g * __builtin_amdgcn_rcpf(1.0f + __expf(-g)); }

struct EpiSwiGLU {
    static constexpr bool PERM = true, AFTER_DRAIN = false;
    bf16_t* O; int ldc; const float* rowss;
    __device__ __forceinline__ void operator()(f32x4 (&acc)[2][2][4][2], const Unit& u, int wr, int wc, int fr, int fq) const {
        const int row0 = u.pm * BM + wr * 64 + fr; const int col0 = u.pn * HALF + wc * 32 + 8 * fq;
        float rsv[2][4];
#pragma unroll
        for (int ai = 0; ai < 2; ++ai)
#pragma unroll
            for (int m = 0; m < 4; ++m) rsv[ai][m] = rowss ? rowss[row0 + ai * HALF + m * 16] : 0.f;
#pragma unroll
        for (int ai = 0; ai < 2; ++ai)
#pragma unroll
            for (int m = 0; m < 4; ++m) rsv[ai][m] = rowss ? __builtin_amdgcn_rsqf(rsv[ai][m] * (1.0f / 2048.0f) + 1e-6f) : 1.0f;
        asm volatile("" : "+v"(rsv[0][0]), "+v"(rsv[0][1]), "+v"(rsv[0][2]), "+v"(rsv[0][3]), "+v"(rsv[1][0]), "+v"(rsv[1][1]), "+v"(rsv[1][2]), "+v"(rsv[1][3]));
#pragma unroll
        for (int ai = 0; ai < 2; ++ai)
#pragma unroll
            for (int m = 0; m < 4; ++m) {
                const int row = row0 + ai * HALF + m * 16;
                const float rs = rsv[ai][m];
                f32x4 g0 = acc[ai][0][m][0] * rs, g1 = acc[ai][0][m][1] * rs, u0 = acc[ai][1][m][0] * rs, u1 = acc[ai][1][m][1] * rs;
                u32x4 w;
                w.x = cvt_pk_bf16(fast_silu(g0[0]) * u0[0], fast_silu(g0[1]) * u0[1]); w.y = cvt_pk_bf16(fast_silu(g0[2]) * u0[2], fast_silu(g0[3]) * u0[3]);
                w.z = cvt_pk_bf16(fast_silu(g1[0]) * u1[0], fast_silu(g1[1]) * u1[1]); w.w = cvt_pk_bf16(fast_silu(g1[2]) * u1[2], fast_silu(g1[3]) * u1[3]);
                *(u32x4*)(O + (size_t)row * ldc + col0) = w;
            }
    }
};

template <bool BASE_F32, bool WRITE_XN, bool WRITE_OUT> struct EpiResid {
    static constexpr bool PERM = false, AFTER_DRAIN = false;
    const float* base; float* out; bf16_t* xn; float* rowss; float alpha;
    __device__ __forceinline__ void operator()(f32x4 (&acc)[2][2][4][2], const Unit& u, int wr, int wc, int fr, int fq) const {
        const int row0 = u.pm * BM + wr * 64 + fr; const int col0 = u.pn * BM + wc * 32 + 4 * fq;
#pragma unroll
        for (int ai = 0; ai < 2; ++ai) {
            f32x4 bpre[4][2][2];
#pragma unroll
            for (int m = 0; m < 4; ++m) { const int row = row0 + ai * HALF + m * 16;
#pragma unroll
                for (int bj = 0; bj < 2; ++bj)
#pragma unroll
                    for (int n = 0; n < 2; ++n) {
                        if (BASE_F32) bpre[m][bj][n] = *(const f32x4*)(base + (size_t)row * 2048 + col0 + bj * HALF + n * 16);
                        else { const u32x2 w = *(const u32x2*)(xn + (size_t)row * LDK + col0 + bj * HALF + n * 16);
                               bpre[m][bj][n] = (f32x4){__builtin_bit_cast(float, w.x << 16), __builtin_bit_cast(float, w.x & 0xffff0000u), __builtin_bit_cast(float, w.y << 16), __builtin_bit_cast(float, w.y & 0xffff0000u)}; }
                    } }
#pragma unroll
            for (int m = 0; m < 4; ++m) {
                const int row = row0 + ai * HALF + m * 16; float ss = 0.f;
#pragma unroll
                for (int bj = 0; bj < 2; ++bj)
#pragma unroll
                    for (int n = 0; n < 2; ++n) {
                        const f32x4 o = bpre[m][bj][n] + acc[ai][bj][m][n] * alpha;
                        if (WRITE_OUT) *(f32x4*)(out + (size_t)row * 2048 + col0 + bj * HALF + n * 16) = o;
                        if (WRITE_XN) {
                            ss += (o[0] * o[0] + o[1] * o[1]) + (o[2] * o[2] + o[3] * o[3]);
                            u32x2 w; w.x = cvt_pk_bf16(o[0], o[1]); w.y = cvt_pk_bf16(o[2], o[3]);
                            *(u32x2*)(xn + (size_t)row * LDK + col0 + bj * HALF + n * 16) = w;
                        }
                    }
                if (WRITE_XN) { ss += shflx(ss, 16, fq * 16 + fr); ss += shflx(ss, 32, fq * 16 + fr); if (fq == 0) atomicAdd(rowss + row, ss); }
            }
            asm volatile("" ::: "memory");
        }
    }
};

struct EpiQKV {
    static constexpr bool PERM = false, AFTER_DRAIN = false;
    bf16_t* O; const float* rowss; const float* gtab;
    const float* ropeA; const float* ropeB;
    PG8_LAS float* xch;
    __device__ __forceinline__ void operator()(f32x4 (&acc)[2][2][4][2], const Unit& u, int wr, int wc, int fr, int fq) const {
        asm volatile("" : "+v"(fr), "+v"(fq));
        const int region = u.pn >> 2;
        const int row0 = u.pm * BM + wr * 64 + fr;
#pragma unroll
        for (int ai = 0; ai < 2; ++ai)
#pragma unroll
            for (int m = 0; m < 4; ++m) {
                const float rs = __builtin_amdgcn_rsqf(rowss[row0 + ai * HALF + m * 16] * (1.0f / 2048.0f) + 1e-6f);
#pragma unroll
                for (int bj = 0; bj < 2; ++bj)
#pragma unroll
                    for (int n = 0; n < 2; ++n) acc[ai][bj][m][n] = acc[ai][bj][m][n] * rs;
            }
        const bool isv = (region == 2) || (region == 5);
        if (!isv) {
            const bool isA = region < 2;
#pragma unroll
            for (int ai = 0; ai < 2; ++ai)
#pragma unroll
                for (int m = 0; m < 4; ++m)
#pragma unroll
                    for (int bj = 0; bj < 2; ++bj) {
                        const f32x4 a = acc[ai][bj][m][0], b = acc[ai][bj][m][1];
                        float s = ((a[0] * a[0] + a[1] * a[1]) + (a[2] * a[2] + a[3] * a[3])) + ((b[0] * b[0] + b[1] * b[1]) + (b[2] * b[2] + b[3] * b[3]));
                        s += shflx(s, 16, fq * 16 + fr); s += shflx(s, 32, fq * 16 + fr);
                        if (fq == 0) xch[((ai * HALF + wr * 64 + m * 16 + fr) * 2 + bj) * 4 + wc] = s;
                    }
            asm volatile("s_waitcnt lgkmcnt(0)" ::: "memory"); __builtin_amdgcn_s_barrier(); asm volatile("" ::: "memory");
            const float* gptr = gtab + (region < 2 ? region : region - 1) * 128;
            const int dbase = isA ? wc * 32 : (wc & 1) * 32;
            f32x4 gv[2]; gv[0] = *(const f32x4*)(gptr + dbase + 4 * fq); gv[1] = *(const f32x4*)(gptr + dbase + 16 + 4 * fq);
            const float qs = region == 0 ? (0.08838834764831845f * 1.4426950408889634f) : (region == 3 ? (0.125f * 1.4426950408889634f) : 1.0f);
#pragma unroll
            for (int ai = 0; ai < 2; ++ai)
#pragma unroll
                for (int m = 0; m < 4; ++m) {
                    const int rl = ai * HALF + wr * 64 + m * 16 + fr; const int spos = (u.pm * BM + rl) & 4095;
#pragma unroll
                    for (int bj = 0; bj < 2; ++bj) {
                        const f32x4 p = *(const PG8_LAS f32x4*)(xch + (rl * 2 + bj) * 4);
                        float rn;
                        if (isA) rn = __builtin_amdgcn_rsqf(((p[0] + p[1]) + (p[2] + p[3])) * (1.0f / 128.0f) + 1e-6f);
                        else rn = __builtin_amdgcn_rsqf(((wc < 2) ? (p[0] + p[1]) : (p[2] + p[3])) * (1.0f / 64.0f) + 1e-6f);
                        f32x4 v0 = acc[ai][bj][m][0] * rn * gv[0], v1 = acc[ai][bj][m][1] * rn * gv[1];
                        if (isA) {
                            if (wc == 0) {
                                const f32x4 cs = *(const f32x4*)(ropeA + spos * 16 + 4 * fq), sn = *(const f32x4*)(ropeA + 4096 * 16 + spos * 16 + 4 * fq);
                                const f32x4 x1 = v0, x2 = v1; v0 = x1 * cs - x2 * sn; v1 = x2 * cs + x1 * sn;
                            }
                        } else {
                            if ((wc & 1) == 0) {
                                const f32x4 cs = *(const f32x4*)(ropeB + spos * 8 + 4 * (fq & 1)), sn = *(const f32x4*)(ropeB + 4096 * 8 + spos * 8 + 4 * (fq & 1));
                                f32x4 pt; pt[0] = shflx(v0[0], 32, fq * 16 + fr); pt[1] = shflx(v0[1], 32, fq * 16 + fr); pt[2] = shflx(v0[2], 32, fq * 16 + fr); pt[3] = shflx(v0[3], 32, fq * 16 + fr);
                                v0 = (fq < 2) ? (v0 * cs - pt * sn) : (v0 * cs + pt * sn);
                            }
                        }
                        acc[ai][bj][m][0] = v0 * qs; acc[ai][bj][m][1] = v1 * qs;
                    }
                }
        }
        const int col0 = u.pn * BM + wc * 32 + 4 * fq;
#pragma unroll
        for (int ai = 0; ai < 2; ++ai)
#pragma unroll
            for (int m = 0; m < 4; ++m) { bf16_t* rowp = O + (size_t)(row0 + ai * HALF + m * 16) * LDQ + col0;
#pragma unroll
                for (int bj = 0; bj < 2; ++bj)
#pragma unroll
                    for (int n = 0; n < 2; ++n) { const f32x4 v = acc[ai][bj][m][n]; u32x2 w; w.x = cvt_pk_bf16(v[0], v[1]); w.y = cvt_pk_bf16(v[2], v[3]); *(u32x2*)(rowp + bj * HALF + n * 16) = w; } }
    }
};
template <class Epi, class Sched, bool ALIGN_EPI = false, bool SP2 = false>
__device__ __forceinline__ void gemm_phase(PG8_LAS unsigned char* lds, const Gemm g, const Sched& S, const Epi& E, const int wid_s) {
    const int lane_ = lane_opaque();
    const int tid = wid_s * 64 + lane_, wid = wid_s, lane = tid & 63, wr = wid >> 2, wc = wid & 3, fr = lane & 15, fq = lane >> 4;
    const int K = g.ld, nt = g.K / BK;
    unsigned voffA[2], voffB[2];
#pragma unroll
    for (int i = 0; i < 2; ++i) { int R, C; stage_rc(tid * 16 + i * 8192, R, C); const int Rb = Epi::PERM ? ((R & ~31) + perm32(R & 31)) : R;
        voffA[i] = (unsigned)(R * K + C) * 2u; voffB[i] = (unsigned)(Rb * K + C) * 2u; }
    const size_t kstep = (size_t)(BK * 2);
    const size_t hstep = (size_t)HALF * K * 2;
    const size_t tstep = 2 * hstep;
    const unsigned ldsw = (unsigned)wid * 1024u;
    const int aoff = lds_byte(wr * 64 + fr, fq * 8), boff = lds_byte(wc * 32 + fr, fq * 8);
#define PG8_SA(b, h) (((b) * 2 + (h)) * HTB)
#define PG8_SB(b, h) ((4 + (b) * 2 + (h)) * HTB)
#define PG8_STAGE(bufoff, gbase, voff) do { _Pragma("unroll") for (int _i = 0; _i < 2; ++_i) \
        __builtin_amdgcn_global_load_lds((const unsigned*)((const char*)(gbase) + (voff)[_i]), (PG8_LAS unsigned*)(lds + (bufoff) + ldsw + _i * 8192), 16, 0, 0); } while (0)
#define PG8_LDA(dst, b, h) do { _Pragma("unroll") for (int m = 0; m < 4; ++m) _Pragma("unroll") for (int k = 0; k < 2; ++k) dst[m][k] = *(const PG8_LAS bf16x8*)(lds + PG8_SA(b, h) + aoff + m * 2048 + k * 1024); } while (0)
#define PG8_LDB(dst, b, h) do { _Pragma("unroll") for (int n = 0; n < 2; ++n) _Pragma("unroll") for (int k = 0; k < 2; ++k) dst[n][k] = *(const PG8_LAS bf16x8*)(lds + PG8_SB(b, h) + boff + n * 2048 + k * 1024); } while (0)
#define PG8_MMA(ai, bj, At, Bt) do { __builtin_amdgcn_s_setprio(1); _Pragma("unroll") for (int m = 0; m < 4; ++m) _Pragma("unroll") for (int n = 0; n < 2; ++n) _Pragma("unroll") for (int k = 0; k < 2; ++k) \
        acc[ai][bj][m][n] = __builtin_amdgcn_mfma_f32_16x16x32_bf16(Bt[n][k], At[m][k], acc[ai][bj][m][n], 0, 0, 0); __builtin_amdgcn_s_setprio(0); } while (0)
#define PG8_WAIT_V(n) asm volatile("s_waitcnt vmcnt(" #n ")" ::: "memory")
#define PG8_WAIT_L(n) asm volatile("s_waitcnt lgkmcnt(" #n ")" ::: "memory")
#define PG8_BAR __builtin_amdgcn_s_barrier()
#define PG8_SCHED __builtin_amdgcn_sched_barrier(0)
    Unit cur, nxt; int ui = 0;
    if (!S.next(0, cur)) return;
    f32x4 acc[2][2][4][2];
#pragma unroll
    for (int a = 0; a < 2; ++a)
#pragma unroll
        for (int b = 0; b < 2; ++b)
#pragma unroll
            for (int m = 0; m < 4; ++m)
#pragma unroll
                for (int n = 0; n < 2; ++n) acc[a][b][m][n] = (f32x4){0.f, 0.f, 0.f, 0.f};
    bf16x8 At[4][2], B0[2][2], B1[2][2];
    const char* cA = (const char*)g.A + (size_t)cur.pm * tstep; const char* cB = (const char*)g.Bt + (size_t)cur.pn * tstep;
    S.a_ready(cur);
    if constexpr (SP2) {
        PG8_STAGE(PG8_SB(0, 0), cB, voffB); PG8_STAGE(PG8_SB(0, 1), cB + hstep, voffB); PG8_STAGE(PG8_SA(0, 0), cA, voffA); PG8_STAGE(PG8_SA(0, 1), cA + hstep, voffA);
        if (wr == 1) PG8_BAR;
        PG8_WAIT_V(2); PG8_BAR;
        PG8_STAGE(PG8_SB(1, 0), cB + kstep, voffB); PG8_STAGE(PG8_SA(1, 0), cA + kstep, voffA); PG8_STAGE(PG8_SB(1, 1), cB + hstep + kstep, voffB);
        PG8_WAIT_V(6); PG8_BAR;
    } else {
        PG8_STAGE(PG8_SB(0, 0), cB, voffB); PG8_STAGE(PG8_SA(0, 0), cA, voffA); PG8_STAGE(PG8_SB(0, 1), cB + hstep, voffB); PG8_STAGE(PG8_SA(0, 1), cA + hstep, voffA);
        if (wr == 1) PG8_BAR;
        PG8_WAIT_V(4); PG8_BAR;
        PG8_STAGE(PG8_SB(1, 0), cB + kstep, voffB); PG8_STAGE(PG8_SA(1, 0), cA + kstep, voffA); PG8_STAGE(PG8_SB(1, 1), cB + hstep + kstep, voffB);
        PG8_WAIT_V(6); PG8_BAR;
    }
    for (;;) {
        const bool has_next = S.next(ui + 1, nxt);
        const char* nA = has_next ? (const char*)g.A + (size_t)nxt.pm * tstep : cA; const char* nB = has_next ? (const char*)g.Bt + (size_t)nxt.pn * tstep : cB;
        for (int t = 0; t < nt; t += 2) {
            const bool last = (t == nt - 2);
            const char* a1 = cA + (size_t)(t + 1) * kstep;
            const char* a2 = last ? nA : cA + (size_t)(t + 2) * kstep; const char* b2 = last ? nB : cB + (size_t)(t + 2) * kstep;
            const char* a3 = a2 + kstep; const char* b3 = b2 + kstep;
            if (last && has_next) S.a_ready(nxt);
            if constexpr (SP2) {
            PG8_LDB(B0, 0, 0); PG8_LDB(B1, 0, 1); PG8_SCHED; PG8_LDA(At, 0, 0); PG8_STAGE(PG8_SA(1, 1), a1 + hstep, voffA);
            PG8_WAIT_V(8); PG8_WAIT_L(0); PG8_BAR; PG8_MMA(0, 0, At, B0); PG8_MMA(0, 1, At, B1); PG8_BAR; PG8_SCHED;
            PG8_LDA(At, 0, 1); PG8_STAGE(PG8_SB(0, 0), b2, voffB); PG8_STAGE(PG8_SB(0, 1), b2 + hstep, voffB); PG8_STAGE(PG8_SA(0, 0), a2, voffA);
            PG8_WAIT_V(8); PG8_WAIT_L(0); PG8_BAR; PG8_MMA(1, 0, At, B0); PG8_MMA(1, 1, At, B1); PG8_BAR; PG8_SCHED;
            PG8_LDB(B0, 1, 0); PG8_LDB(B1, 1, 1); PG8_SCHED; PG8_LDA(At, 1, 0); PG8_STAGE(PG8_SA(0, 1), a2 + hstep, voffA);
            PG8_WAIT_V(8); PG8_WAIT_L(0); PG8_BAR; PG8_MMA(0, 0, At, B0); PG8_MMA(0, 1, At, B1); PG8_BAR; PG8_SCHED;
            PG8_LDA(At, 1, 1); PG8_STAGE(PG8_SB(1, 0), b3, voffB); PG8_STAGE(PG8_SB(1, 1), b3 + hstep, voffB); PG8_STAGE(PG8_SA(1, 0), a3, voffA);
            PG8_WAIT_V(8); PG8_WAIT_L(0); PG8_BAR; PG8_MMA(1, 0, At, B0); PG8_MMA(1, 1, At, B1); PG8_BAR; PG8_SCHED;
            } else {
            PG8_LDB(B0, 0, 0); PG8_SCHED; PG8_LDA(At, 0, 0); PG8_STAGE(PG8_SA(1, 1), a1 + hstep, voffA);
            PG8_WAIT_L(8); PG8_BAR; PG8_WAIT_L(0); PG8_MMA(0, 0, At, B0); PG8_BAR; PG8_SCHED;
            PG8_LDB(B1, 0, 1); PG8_STAGE(PG8_SB(0, 0), b2, voffB);
            PG8_BAR; PG8_WAIT_L(0); PG8_MMA(0, 1, At, B1); PG8_BAR;
            PG8_LDA(At, 0, 1); PG8_STAGE(PG8_SA(0, 0), a2, voffA);
            PG8_BAR; PG8_WAIT_L(0); PG8_MMA(1, 0, At, B0); PG8_BAR; PG8_SCHED;
            PG8_STAGE(PG8_SB(0, 1), b2 + hstep, voffB);
            PG8_WAIT_V(6); PG8_BAR; PG8_MMA(1, 1, At, B1); PG8_BAR;
            PG8_LDB(B0, 1, 0); PG8_SCHED; PG8_LDA(At, 1, 0); PG8_STAGE(PG8_SA(0, 1), a2 + hstep, voffA);
            PG8_WAIT_L(8); PG8_BAR; PG8_WAIT_L(0); PG8_MMA(0, 0, At, B0); PG8_BAR; PG8_SCHED;
            PG8_LDB(B1, 1, 1); PG8_STAGE(PG8_SB(1, 0), b3, voffB);
            PG8_BAR; PG8_WAIT_L(0); PG8_MMA(0, 1, At, B1); PG8_BAR;
            PG8_LDA(At, 1, 1); PG8_STAGE(PG8_SA(1, 0), a3, voffA);
            PG8_BAR; PG8_WAIT_L(0); PG8_MMA(1, 0, At, B0); PG8_BAR; PG8_SCHED;
            PG8_STAGE(PG8_SB(1, 1), b3 + hstep, voffB);
            PG8_WAIT_V(6); PG8_BAR; PG8_MMA(1, 1, At, B1); PG8_BAR;
            }
        }
        if constexpr (ALIGN_EPI) { if (wr == 0) PG8_BAR; }
        if constexpr (!Epi::AFTER_DRAIN) { E(acc, cur, wr, wc, fr, fq); S.done(cur); }
        if (!has_next) break;
#pragma unroll
        for (int a = 0; a < 2; ++a)
#pragma unroll
            for (int b = 0; b < 2; ++b)
#pragma unroll
                for (int m = 0; m < 4; ++m)
#pragma unroll
                    for (int n = 0; n < 2; ++n) acc[a][b][m][n] = (f32x4){0.f, 0.f, 0.f, 0.f};
        cur = nxt; cA = nA; cB = nB; ++ui;
        if constexpr (ALIGN_EPI) { if (wr == 1) PG8_BAR; }
    }
    PG8_WAIT_V(0);
    if constexpr (!ALIGN_EPI) { if (wr == 0) PG8_BAR; }
    PG8_BAR;
    if constexpr (Epi::AFTER_DRAIN) { E.fused(acc, cur, wr, wc, fr, fq, lds, wid, lane); S.done(cur); }
#undef PG8_SA
#undef PG8_SB
#undef PG8_STAGE
#undef PG8_LDA
#undef PG8_LDB
#undef PG8_MMA
#undef PG8_WAIT_V
#undef PG8_WAIT_L
#undef PG8_BAR
#undef PG8_SCHED
}
}

namespace att {
#define LAS __attribute__((address_space(3)))
typedef unsigned short bf16_t;
typedef short bf16x8 __attribute__((ext_vector_type(8)));
typedef short s16x4 __attribute__((ext_vector_type(4)));
typedef short v4i16_t __attribute__((ext_vector_type(4)));
typedef float f32x16 __attribute__((ext_vector_type(16)));
typedef float f32x4 __attribute__((ext_vector_type(4)));
typedef unsigned u32x4 __attribute__((ext_vector_type(4)));
typedef unsigned u32x2 __attribute__((ext_vector_type(2)));
typedef float f32x2_t __attribute__((ext_vector_type(2))); typedef __bf16 bf16x2_t __attribute__((ext_vector_type(2)));
constexpr int SEQ = 4096, INW = 6272, DMODEL = 2176;
constexpr int KP = 272, VP = 320;
constexpr int DIFF_TILE = 128 * KP + 128 * VP;
constexpr int DIL_WAVE = 32 * KP + 32 * VP;
__device__ __forceinline__ unsigned cvtpk(float lo, float hi) { f32x2_t v = {lo, hi}; bf16x2_t b = __builtin_convertvector(v, bf16x2_t); return __builtin_bit_cast(unsigned, b); }
__device__ __forceinline__ int crow(int r, int hi) { return (r & 3) + 8 * (r >> 2) + 4 * hi; }
__device__ __forceinline__ s16x4 vtr(const LAS char* p) { return __builtin_bit_cast(s16x4, __builtin_amdgcn_ds_read_tr16_b64_v4i16((LAS v4i16_t*)p)); }
__device__ __forceinline__ bf16x8 packp(const f32x16& p, int s) {
    u32x4 w; w.x = cvtpk(p[8 * s], p[8 * s + 1]); w.y = cvtpk(p[8 * s + 2], p[8 * s + 3]); w.z = cvtpk(p[8 * s + 4], p[8 * s + 5]); w.w = cvtpk(p[8 * s + 6], p[8 * s + 7]);
    return __builtin_bit_cast(bf16x8, w);
}
#define MFMA32(a, b, c) __builtin_amdgcn_mfma_f32_32x32x16_bf16((a), (b), (c), 0, 0, 0)

__device__ __forceinline__ void diff_unit(LAS char* lds, const bf16_t* QKV, bf16_t* MIX, int b, int h, int qblk, float lam, float negM, const float* g_bout, int tid, int wid, int lane) {
    const int c = wid >> 2, r32 = lane & 31, hh = lane >> 5, cb = (lane >> 4) & 1, q_ = (lane & 15) >> 2, p_ = lane & 3;
    const size_t rowbase = (size_t)b * SEQ; const int q0 = qblk * 128 + (wid & 3) * 32;
    bf16x8 qf[4];
    { const bf16_t* qp = QKV + (rowbase + q0 + r32) * INW + 3072 + h * 128 + c * 64 + 8 * hh;
#pragma unroll
      for (int ks = 0; ks < 4; ++ks) qf[ks] = *(const bf16x8*)(qp + 16 * ks); }
    const int srow = tid >> 4, sch = tid & 15;
    const bf16_t* kg = QKV + (rowbase + srow) * INW + 4096 + h * 128 + sch * 8;
    const bf16_t* vg = kg + 1024;
    LAS char* kst = lds + srow * KP + sch * 16; LAS char* vst = lds + 128 * KP + srow * VP + sch * 16;
    f32x16 o[4];
#pragma unroll
    for (int i = 0; i < 4; ++i)
#pragma unroll
        for (int r = 0; r < 16; ++r) o[i][r] = 0.f;
    float lsum = 0.f;
    f32x16 negm;
#pragma unroll
    for (int r = 0; r < 16; ++r) negm[r] = negM;
    u32x4 kr[4], vr[4];
#pragma unroll
    for (int i = 0; i < 4; ++i) { kr[i] = *(const u32x4*)(kg + (size_t)(32 * i) * INW); vr[i] = *(const u32x4*)(vg + (size_t)(32 * i) * INW); }
#pragma unroll
    for (int i = 0; i < 4; ++i) { *(LAS u32x4*)(kst + 32 * i * KP) = kr[i]; *(LAS u32x4*)(vst + 32 * i * VP) = vr[i]; }
    __syncthreads();
    const int NT = SEQ / 128;
    const LAS char* kread = lds + r32 * KP + (c * 64 + 8 * hh) * 2;
    const LAS char* vread = lds + 128 * KP + (4 * hh + q_) * VP + (16 * cb + 4 * p_) * 2;
    for (int t = 0; t < NT; ++t) {
        const int cur = (t & 1) * DIFF_TILE, nxt = DIFF_TILE - cur;
        const size_t go = (size_t)(t + 1) * 128 * INW; const bool more = t + 1 < NT;
        if (more) {
#pragma unroll
            for (int i = 0; i < 4; ++i) kr[i] = *(const u32x4*)(kg + go + (size_t)(32 * i) * INW); }
        f32x16 pA0 = negm, pA1 = negm, pB0 = negm, pB1 = negm;
#pragma unroll
        for (int ks = 0; ks < 4; ++ks) {
            const bf16x8 k0 = *(const LAS bf16x8*)(kread + cur + ks * 32), k1 = *(const LAS bf16x8*)(kread + cur + 32 * KP + ks * 32);
            pA0 = MFMA32(k0, qf[ks], pA0); pA1 = MFMA32(k1, qf[ks], pA1);
        }
#pragma unroll
        for (int ks = 0; ks < 4; ++ks) {
            const bf16x8 k0 = *(const LAS bf16x8*)(kread + cur + 64 * KP + ks * 32), k1 = *(const LAS bf16x8*)(kread + cur + 96 * KP + ks * 32);
            pB0 = MFMA32(k0, qf[ks], pB0); pB1 = MFMA32(k1, qf[ks], pB1);
        }
        if (more) {
#pragma unroll
            for (int i = 0; i < 4; ++i) *(LAS u32x4*)(kst + nxt + 32 * i * KP) = kr[i];
#pragma unroll
            for (int i = 0; i < 4; ++i) kr[i] = *(const u32x4*)(vg + go + (size_t)(32 * i) * INW); }
        float sa = 0.f, sb = 0.f;
#pragma unroll
        for (int r = 0; r < 16; ++r) { pA0[r] = __builtin_amdgcn_exp2f(pA0[r]); pA1[r] = __builtin_amdgcn_exp2f(pA1[r]); sa += pA0[r]; sb += pA1[r]; }
        bf16x8 pf[4]; pf[0] = packp(pA0, 0); pf[1] = packp(pA0, 1); pf[2] = packp(pA1, 0); pf[3] = packp(pA1, 1);
#pragma unroll
        for (int kst4 = 0; kst4 < 4; ++kst4)
#pragma unroll
            for (int db = 0; db < 4; ++db) {
                const LAS char* a = vread + cur + kst4 * 16 * VP + db * 64;
                const s16x4 lo = vtr(a), hi = vtr(a + 8 * VP);
                const bf16x8 vf = __builtin_shufflevector(lo, hi, 0, 1, 2, 3, 4, 5, 6, 7);
                o[db] = MFMA32(vf, pf[kst4], o[db]);
            }
#pragma unroll
        for (int r = 0; r < 16; ++r) { pB0[r] = __builtin_amdgcn_exp2f(pB0[r]); pB1[r] = __builtin_amdgcn_exp2f(pB1[r]); sa += pB0[r]; sb += pB1[r]; }
        lsum += sa + sb;
        pf[0] = packp(pB0, 0); pf[1] = packp(pB0, 1); pf[2] = packp(pB1, 0); pf[3] = packp(pB1, 1);
#pragma unroll
        for (int kst4 = 0; kst4 < 4; ++kst4)
#pragma unroll
            for (int db = 0; db < 4; ++db) {
                const LAS char* a = vread + cur + (64 + kst4 * 16) * VP + db * 64;
                const s16x4 lo = vtr(a), hi = vtr(a + 8 * VP);
                const bf16x8 vf = __builtin_shufflevector(lo, hi, 0, 1, 2, 3, 4, 5, 6, 7);
                o[db] = MFMA32(vf, pf[kst4], o[db]);
            }
        if (more) {
#pragma unroll
            for (int i = 0; i < 4; ++i) *(LAS u32x4*)(vst + nxt + 32 * i * VP) = kr[i]; }
        __syncthreads();
    }
    const int lane_e = lane_opaque();
    lsum += shflx(lsum, 32, lane_e);
    float inv = 1.0f / lsum; if (c == 1) inv *= lam;
    const int r32e = lane_e & 31, hhe = lane_e >> 5;
    LAS float* X = (LAS float*)lds + (wid & 3) * 4096;
    if (c == 1) {
#pragma unroll
        for (int db = 0; db < 4; ++db)
#pragma unroll
            for (int r = 0; r < 16; ++r) X[(db * 32 + crow(r, hhe)) * 32 + r32e] = o[db][r] * inv;
    }
    __syncthreads();
    if (c == 0) {
        float ss = 0.f;
#pragma unroll
        for (int db = 0; db < 4; ++db)
#pragma unroll
            for (int r = 0; r < 16; ++r) { const float v = o[db][r] * inv - X[(db * 32 + crow(r, hhe)) * 32 + r32e]; o[db][r] = v; ss += v * v; }
        ss += shflx(ss, 32, lane_e);
        const float rn = __builtin_amdgcn_rsqf(ss * (1.0f / 128.0f) + 1e-6f) * 0.8f;
        bf16_t* op = MIX + (rowbase + q0 + r32e) * DMODEL + 1024 + h * 128;
#pragma unroll
        for (int db = 0; db < 4; ++db)
#pragma unroll
            for (int g4 = 0; g4 < 4; ++g4) { const int d0 = db * 32 + 8 * g4 + 4 * hhe; const f32x4 gg = *(const f32x4*)(g_bout + d0);
                u32x2 w; w.x = cvtpk(o[db][4 * g4] * rn * gg[0], o[db][4 * g4 + 1] * rn * gg[1]); w.y = cvtpk(o[db][4 * g4 + 2] * rn * gg[2], o[db][4 * g4 + 3] * rn * gg[3]);
                *(u32x2*)(op + d0) = w; }
    }
    __syncthreads();
}

__device__ __forceinline__ void dil_unit(LAS char* wl, const bf16_t* QKV, bf16_t* MIX, int b, int h, int r16, int ib, float negM, const float* g_aout, int lane) {
    const int r32 = lane & 31, hh = lane >> 5, cb = (lane >> 4) & 1, q_ = (lane & 15) >> 2, p_ = lane & 3;
    const size_t rowbase = (size_t)b * SEQ;
    const int tq = r16 + 16 * (32 * ib + r32);
    bf16x8 qf[8];
    { const bf16_t* qp = QKV + (rowbase + tq) * INW + h * 128 + 8 * hh;
#pragma unroll
      for (int ks = 0; ks < 8; ++ks) qf[ks] = *(const bf16x8*)(qp + 16 * ks); }
    f32x16 o[4];
#pragma unroll
    for (int i = 0; i < 4; ++i)
#pragma unroll
        for (int r = 0; r < 16; ++r) o[i][r] = 0.f;
    float lsum = 0.f;
    f32x16 negm;
#pragma unroll
    for (int r = 0; r < 16; ++r) negm[r] = negM;
    const int lrow = lane >> 4, lch = lane & 15;
    const bf16_t* kvg = QKV + rowbase * INW + 1024 + h * 128 + lch * 8;
    LAS char* kst = wl + lrow * KP + lch * 16; LAS char* vst = wl + 32 * KP + lrow * VP + lch * 16;
    const LAS char* kread = wl + r32 * KP + 8 * hh * 2;
    const LAS char* vread = wl + 32 * KP + (4 * hh + q_) * VP + (16 * cb + 4 * p_) * 2;
    int klo0, khi0, klo1, khi1, klo2, khi2;
    { const int bq = 32 * ib;               int lo_i = bq - 64; if (lo_i < 0) lo_i = 0; klo0 = lo_i >> 5; khi0 = (bq + 31 + 64) >> 5;      if (khi0 > 7) khi0 = 7; }
    { const int bq = (r16 >> 2) + 128 * ib; int lo_i = bq - 64; if (lo_i < 0) lo_i = 0; klo1 = lo_i >> 5; khi1 = (bq + 31 * 4 + 64) >> 5;  if (khi1 > 31) khi1 = 31; }
    { const int bq = r16 + 512 * ib;        int lo_i = bq - 64; if (lo_i < 0) lo_i = 0; klo2 = lo_i >> 5; khi2 = (bq + 31 * 16 + 64) >> 5; if (khi2 > 127) khi2 = 127; }
    int pat = 0, kb = klo0;
    u32x4 kr[8], vr[8];
#define DIL_LOAD(PAT, KB) do { const int sh_ = 4 - 2 * (PAT); const int rc_ = r16 & ((1 << sh_) - 1); \
        _Pragma("unroll") for (int i = 0; i < 8; ++i) { const int tok = rc_ + ((32 * (KB) + lrow + 4 * i) << sh_); const bf16_t* gp = kvg + (size_t)tok * INW; kr[i] = *(const u32x4*)gp; vr[i] = *(const u32x4*)(gp + 1024); } } while (0)
    DIL_LOAD(pat, kb);
    for (;;) {
#pragma unroll
        for (int i = 0; i < 8; ++i) { *(LAS u32x4*)(kst + 4 * i * KP) = kr[i]; *(LAS u32x4*)(vst + 4 * i * VP) = vr[i]; }
        __builtin_amdgcn_fence(__ATOMIC_RELEASE, "wavefront"); __builtin_amdgcn_wave_barrier(); __builtin_amdgcn_fence(__ATOMIC_ACQUIRE, "wavefront");
        const int cpat = pat, ckb = kb;
        { const int hi_c = pat == 0 ? khi0 : (pat == 1 ? khi1 : khi2);
          if (kb < hi_c) ++kb; else { ++pat; kb = pat == 1 ? klo1 : klo2; } }
        const bool more = pat < 3;
        if (more) DIL_LOAD(pat, kb);
        const int sh = 4 - 2 * cpat, sq = 16 >> sh;
        const int qi = (r16 >> sh) + sq * 32 * ib + sq * r32;
        f32x16 p = negm;
#pragma unroll
        for (int ks = 0; ks < 8; ++ks) { const bf16x8 kf = *(const LAS bf16x8*)(kread + ks * 32); p = MFMA32(kf, qf[ks], p); }
        float sa = 0.f;
#pragma unroll
        for (int r = 0; r < 16; ++r) { const int dl = 32 * ckb + crow(r, hh) - qi; const float e = __builtin_amdgcn_exp2f(p[r]); const float pv = (dl <= 64 && dl >= -64) ? e : 0.f; p[r] = pv; sa += pv; }
        lsum += sa;
        bf16x8 pf[2]; pf[0] = packp(p, 0); pf[1] = packp(p, 1);
#pragma unroll
        for (int s = 0; s < 2; ++s)
#pragma unroll
            for (int db = 0; db < 4; ++db) {
                const LAS char* a = vread + s * 16 * VP + db * 64;
                const s16x4 lo = vtr(a), hi = vtr(a + 8 * VP);
                const bf16x8 vf = __builtin_shufflevector(lo, hi, 0, 1, 2, 3, 4, 5, 6, 7);
                o[db] = MFMA32(vf, pf[s], o[db]);
            }
        __builtin_amdgcn_fence(__ATOMIC_RELEASE, "wavefront"); __builtin_amdgcn_wave_barrier(); __builtin_amdgcn_fence(__ATOMIC_ACQUIRE, "wavefront");
        if (!more) break;
    }
#undef DIL_LOAD
    lsum += shflx(lsum, 32, lane);
    const float inv = 1.0f / lsum; float ss = 0.f;
#pragma unroll
    for (int db = 0; db < 4; ++db)
#pragma unroll
        for (int r = 0; r < 16; ++r) { const float v = o[db][r] * inv; o[db][r] = v; ss += v * v; }
    ss += shflx(ss, 32, lane);
    const float rn = __builtin_amdgcn_rsqf(ss * (1.0f / 128.0f) + 1e-6f);
    bf16_t* op = MIX + (rowbase + tq) * DMODEL + h * 128;
#pragma unroll
    for (int db = 0; db < 4; ++db)
#pragma unroll
        for (int g4 = 0; g4 < 4; ++g4) { const int d0 = db * 32 + 8 * g4 + 4 * hh; const f32x4 gg = *(const f32x4*)(g_aout + d0);
            u32x2 w; w.x = cvtpk(o[db][4 * g4] * rn * gg[0], o[db][4 * g4 + 1] * rn * gg[1]); w.y = cvtpk(o[db][4 * g4 + 2] * rn * gg[2], o[db][4 * g4 + 3] * rn * gg[3]);
            *(u32x2*)(op + d0) = w; }
}
}

constexpr int NWAVES = 8;
constexpr int DM = 2048, NBATCH = 2, SEQ = 4096, MROWS = NBATCH * SEQ, DFF = 5632, INW = 6144;
constexpr size_t MiB = 1u << 20;
constexpr size_t WS_CTL = 0;
constexpr size_t OFF_GTAB = 1 * MiB - 4096;
constexpr size_t OFF_RS0 = 917504;
constexpr size_t OFF_BAR = 983040, BAR_BYTES = 16384;
constexpr size_t OFF_RS1 = 0, OFF_RS2 = 32768, OFF_ROPEA = 65536, OFF_ROPEB = OFF_ROPEA + 2 * 4096 * 16 * 4;
constexpr int LDK = pg8::LDK, LDQ = pg8::LDQ;
constexpr size_t WS_W1A = 1 * MiB, WS_W1B = WS_W1A + 47 * MiB, WS_WIN = WS_W1B + 22 * MiB, WS_WOUT = WS_WIN + 26 * MiB, WS_W2A = WS_WOUT + 9 * MiB, WS_W2B = WS_W2A + 47 * MiB;
constexpr size_t WS_XN = WS_W2B + 22 * MiB;
constexpr size_t WS_ACT = WS_XN + 34 * MiB;
constexpr size_t WS_MIX = WS_ACT + 98 * MiB;
constexpr size_t WS_END = WS_MIX + 34 * MiB;
constexpr int LDS_BYTES = 155648;
constexpr int XCH_OFF = 131072;
static_assert((size_t)11264 * LDK * 2 <= 47 * MiB && (size_t)6144 * LDK * 2 <= 26 * MiB && (size_t)2048 * LDK * 2 <= 9 * MiB && (size_t)8192 * LDK * 2 <= 34 * MiB && (size_t)8192 * LDQ * 2 <= 98 * MiB && att::INW == LDQ && att::DMODEL == LDK, "ws map");
static_assert(att::DIL_WAVE * 8 <= LDS_BYTES - 64 && 3456 * 4 <= BAR_BYTES && 2 * att::DIFF_TILE <= LDS_BYTES - 64 && XCH_OFF + 8192 <= LDS_BYTES, "LDS map");

#define LAS __attribute__((address_space(3)))
typedef unsigned short bf16;
typedef unsigned v4u __attribute__((ext_vector_type(4)));
typedef unsigned v2u __attribute__((ext_vector_type(2)));
typedef float f32x4 __attribute__((ext_vector_type(4)));
__device__ __forceinline__ unsigned f2bf(float f) { unsigned u = __builtin_bit_cast(unsigned, f); return (u + 0x7fffu + ((u >> 16) & 1u)) >> 16; }
__device__ __forceinline__ unsigned pk2(float lo, float hi) { return f2bf(lo) | (f2bf(hi) << 16); }
__device__ __forceinline__ float wave_sum(float v, int lane) {
#pragma unroll
    for (int o = 1; o < 64; o <<= 1) v += shflx(v, o, lane);
    return v;
}
__device__ __forceinline__ float wave_max(float v, int lane) {
#pragma unroll
    for (int o = 1; o < 64; o <<= 1) v = fmaxf(v, shflx(v, o, lane));
    return v;
}
template <bool GLU> __device__ __forceinline__ void tr_load(const float* W, int N, int item, int lane, f32x4 (&v)[8], const float* gk) {
    const int nblk = N / 32, kb = item / nblk, nb = item % nblk, k0 = 64 * kb, n0 = 32 * nb;
    const float* src = W + (size_t)(k0 + (lane >> 3)) * N + n0 + 4 * (lane & 7);
#pragma unroll
    for (int i = 0; i < 8; ++i) v[i] = __builtin_nontemporal_load((const f32x4*)(src + (size_t)(8 * i) * N));
    if (gk) {
#pragma unroll
        for (int i = 0; i < 8; ++i) v[i] = v[i] * gk[k0 + (lane >> 3) + 8 * i]; }
}
template <bool GLU> __device__ __forceinline__ void tr_store(int K, int N, bf16* WT, int ldw, LAS float* scr, int item, int lane, const f32x4 (&v)[8]) {
    const int nblk = N / 32, kb = item / nblk, nb = item % nblk, k0 = 64 * kb, n0 = 32 * nb;
    int r0 = n0;
    if (GLU) { const int half = N / 2; r0 = n0 < half ? (n0 >> 7) * 256 + (n0 & 127) : ((n0 - half) >> 7) * 256 + 128 + ((n0 - half) & 127); }
    const int rg = lane >> 3, c4 = lane & 7;
#pragma unroll
    for (int i = 0; i < 8; ++i) { LAS float* d = scr + (8 * i + rg) * 33 + 4 * c4; d[0] = v[i][0]; d[1] = v[i][1]; d[2] = v[i][2]; d[3] = v[i][3]; }
    asm volatile("s_waitcnt lgkmcnt(0)" ::: "memory");
    const int c = lane & 7;
#pragma unroll
    for (int j = 0; j < 4; ++j) { const int n = (lane >> 3) + 8 * j; const LAS float* s = scr + (8 * c) * 33 + n;
        v4u o; o.x = pk2(s[0 * 33], s[1 * 33]); o.y = pk2(s[2 * 33], s[3 * 33]); o.z = pk2(s[4 * 33], s[5 * 33]); o.w = pk2(s[6 * 33], s[7 * 33]);
        *(v4u*)(WT + (size_t)(r0 + n) * ldw + k0 + 8 * c) = o; }
    asm volatile("s_waitcnt lgkmcnt(0)" ::: "memory");
}
template <bool GLU, int NIF> __device__ __forceinline__ void tr_matrix(const float* W, int K, int N, bf16* WT, int ldw, LAS float* scr, int gw, int NGW, int lane, const float* gk) {
    const int nitems = (K / 64) * (N / 32);
    for (int it = gw; it < nitems; it += NIF * NGW) {
        f32x4 v[NIF][8];
#pragma unroll
        for (int j = 0; j < NIF; ++j) if (it + j * NGW < nitems) tr_load<GLU>(W, N, it + j * NGW, lane, v[j], gk);
#pragma unroll
        for (int j = 0; j < NIF; ++j) if (it + j * NGW < nitems) tr_store<GLU>(K, N, WT, ldw, scr, it + j * NGW, lane, v[j]);
    }
}

#define XB_TMO      128
#define XB_XCNT(j)  (256  + 64 * (j))
#define XB_XSUB(j)  (1280 + 64 * (j))
#define XB_XGEN(j)  (2304 + 64 * (j))
#define XB_TOP      3328
#define XB_TOPGEN   3392
#define XCD_BAR_WORDS 3456
#define XB_SPIN_CAP (1u << 18)

__device__ __forceinline__ unsigned xb_ld(unsigned* p)              { return __hip_atomic_load(p, __ATOMIC_RELAXED, __HIP_MEMORY_SCOPE_AGENT); }
__device__ __forceinline__ unsigned xb_add(unsigned* p, unsigned v) { return __hip_atomic_fetch_add(p, v, __ATOMIC_RELAXED, __HIP_MEMORY_SCOPE_AGENT); }
__device__ __forceinline__ unsigned xb_xcc_id() { return (unsigned)__builtin_amdgcn_s_getreg((3 << 11) | 20) & 0xFu; }
#define XB_SPIN(cond, bar) do { unsigned _sp = 0; while (cond) { __builtin_amdgcn_s_sleep(1); \
    if ((++_sp & 255u) == 0u) { if (xb_ld(&(bar)[XB_TMO])) break; if (_sp > XB_SPIN_CAP) { atomicAdd(&(bar)[XB_TMO], 1u); break; } } } } while (0)

struct XcdBarrier {
    unsigned* bar; unsigned x; int wid;
    volatile LAS unsigned* st;
};

__device__ __forceinline__ bool xb_lane0() { return lane_opaque() == 0; }
__device__ __forceinline__ XcdBarrier xcd_barrier_post(unsigned* bar, volatile LAS unsigned* st, int wid) {
    XcdBarrier b; b.bar = bar; b.x = xb_xcc_id(); b.st = st; b.wid = wid;
    if (wid == 0 && xb_lane0()) (void)xb_add(&bar[XB_XCNT(b.x)], 1u);
    return b;
}
__device__ __forceinline__ void xcd_barrier_complete(unsigned* bar, unsigned x, unsigned& nloc, unsigned& nx) {
    const unsigned G = gridDim.x * gridDim.y * gridDim.z;
    unsigned sum, cnt, mine, sp = 0u;
    for (;;) {
        sum = 0u; cnt = 0u; mine = 0u;
#pragma unroll
        for (unsigned j = 0; j < 16; ++j) { const unsigned c = xb_ld(&bar[XB_XCNT(j)]); sum += c; cnt += (c > 0u) ? 1u : 0u; mine = (j == x) ? c : mine; }
        if (sum == G) break;
        __builtin_amdgcn_s_sleep(1);
        if ((++sp & 255u) == 0u) { if (xb_ld(&bar[XB_TMO])) break; if (sp > XB_SPIN_CAP) { atomicAdd(&bar[XB_TMO], 1u); break; } }
    }
    nloc = mine > 0u ? mine : 1u; nx = cnt > 0u ? cnt : 1u;
}

__device__ __forceinline__ void xcd_barrier(const XcdBarrier& b) {
    asm volatile("s_waitcnt vmcnt(0)" ::: "memory");
    __syncthreads();
    if (b.wid == 0 && xb_lane0()) {
        unsigned* bar = b.bar;
        __builtin_amdgcn_s_waitcnt(0);
        unsigned nloc = b.st[0], nx = b.st[1];
        if (nloc == 0u) { xcd_barrier_complete(bar, b.x, nloc, nx); b.st[0] = nloc; b.st[1] = nx; }
        const unsigned old = xb_add(&bar[XB_XSUB(b.x)], 1u);
        const unsigned gen = old / nloc;
        if (old + 1u == (gen + 1u) * nloc) {
            __builtin_amdgcn_fence(__ATOMIC_RELEASE, "agent");
            asm volatile("s_waitcnt vmcnt(0)" ::: "memory");
            const unsigned og = xb_add(&bar[XB_TOP], 1u);
            const unsigned tg = og / nx;
            if (og + 1u == (tg + 1u) * nx) xb_add(&bar[XB_TOPGEN], 1u);
            else XB_SPIN(xb_ld(&bar[XB_TOPGEN]) == tg, bar);
            __builtin_amdgcn_fence(__ATOMIC_ACQUIRE, "agent");
            xb_add(&bar[XB_XGEN(b.x)], 1u);
            asm volatile("s_waitcnt vmcnt(0)" ::: "memory");
        } else {
            XB_SPIN(xb_ld(&bar[XB_XGEN(b.x)]) == gen, bar);
            __builtin_amdgcn_fence(__ATOMIC_ACQUIRE, "agent");
            asm volatile("s_waitcnt vmcnt(0)" ::: "memory");
        }
    }
    __syncthreads();
}

struct Args {
    const float* in[20]; float* out; unsigned char* ws;
    float invA[16]; float invB[8];
};

__global__ void __launch_bounds__(NWAVES * 64) hybrid_fwd(Args args) {
    extern __shared__ __attribute__((aligned(16))) unsigned char lds_raw[];
    cg::grid_group grid = cg::this_grid();
    LAS unsigned char* lds = (LAS unsigned char*)lds_raw;
    const int wid = __builtin_amdgcn_readfirstlane((int)threadIdx.x >> 6);
#define fresh_lane() lane_opaque()
    const int lane = fresh_lane(), tid = wid * 64 + lane;
    const int G = gridDim.x, bx = blockIdx.x;
    unsigned char* ws = args.ws;
    volatile LAS unsigned* MISC = (volatile LAS unsigned*)(lds + LDS_BYTES - 64);
    if (tid < 16) MISC[tid] = 0u;
    __syncthreads();
    const XcdBarrier bar = xcd_barrier_post((unsigned*)(ws + OFF_BAR), MISC + 8, wid);
    if (G == 0x7fffffff) grid.sync();
    const float* x = args.in[0];
    float* out = args.out;
    float* rowss1 = (float*)(ws + OFF_RS1); float* rowss2 = (float*)(ws + OFF_RS2);
    float* gtab = (float*)(ws + OFF_GTAB); float* ropeA = (float*)(ws + OFF_ROPEA); float* ropeB = (float*)(ws + OFF_ROPEB);
    bf16* W1A = (bf16*)(ws + WS_W1A); bf16* W1B = (bf16*)(ws + WS_W1B); bf16* WIN = (bf16*)(ws + WS_WIN); bf16* WOUT = (bf16*)(ws + WS_WOUT);
    bf16* W2A = (bf16*)(ws + WS_W2A); bf16* W2B = (bf16*)(ws + WS_W2B);
    bf16* XN = (bf16*)(ws + WS_XN); bf16* ACT = (bf16*)(ws + WS_ACT); bf16* QKV = (bf16*)(ws + WS_ACT); bf16* MIX = (bf16*)(ws + WS_MIX);

#ifndef REP_P0
#define REP_P0 1
#endif
#ifndef REP_DIFF
#define REP_DIFF 1
#endif
#ifndef REP_DIL
#define REP_DIL 1
#endif
#define REP_G1 1
#define REP_SHADOW 1
#define REP_G2 1
#define REP_G3 1
#define REP_G5 1
#define REP_G6 1
#define REP_G7 1
    for (int rep = 0; rep < REP_P0; ++rep) {
        LAS float* scr = (LAS float*)(lds + wid * 16384);
        const int gw = bx * NWAVES + wid, NGW = G * NWAVES;
        constexpr int I_FA = (DM / 64) * (2 * DFF / 32), I_FB = (DFF / 64) * (DM / 32), I_IN = (DM / 64) * (INW / 32), I_OUT = (DM / 64) * (DM / 32);
        tr_matrix<true, 2>(args.in[2], DM, 2 * DFF, W1A, LDK, scr, gw, NGW, lane, args.in[1]);
        tr_matrix<true, 2>(args.in[18], DM, 2 * DFF, W2A, LDK, scr, gw, NGW, lane, args.in[17]);
        float* rowss0 = (float*)(ws + OFF_RS0);
        for (int m = gw; m < MROWS; m += NGW) {
            const f32x4* xr = (const f32x4*)(x + (size_t)m * DM) + lane; f32x4 v[8]; float s = 0.f;
#pragma unroll
            for (int j = 0; j < 8; ++j) { v[j] = xr[64 * j]; s += (v[j][0] * v[j][0] + v[j][1] * v[j][1]) + (v[j][2] * v[j][2] + v[j][3] * v[j][3]); }
            s = wave_sum(s, lane); if (lane == 0) rowss0[m] = s;
            v2u* o8 = (v2u*)(XN + (size_t)m * LDK) + lane;
#pragma unroll
            for (int j = 0; j < 8; ++j) { v2u w; w.x = pk2(v[j][0], v[j][1]); w.y = pk2(v[j][2], v[j][3]); o8[64 * j] = w; }
        }
        const int gt = bx * (NWAVES * 64) + tid, NGT = G * NWAVES * 64;
        for (int i = gt; i < 2 * MROWS; i += NGT) rowss1[i] = 0.f;
        if (gt < 512) { const int t = gt >> 7, d = gt & 127; gtab[gt] = t == 0 ? args.in[6][d] : (t == 1 ? args.in[7][d] : (t == 2 ? args.in[8][d & 63] : args.in[9][d & 63])); }
        for (int i = gt; i < 4096 * 24; i += NGT) {
            const int s = i / 24, k = i % 24; const float inv = k < 16 ? args.invA[k] : args.invB[k - 16];
            const float ang = (float)s * inv; double rev = (double)ang * 0.15915494309189535; rev -= floor(rev);
            const float cs = __builtin_amdgcn_cosf((float)rev), sn = __builtin_amdgcn_sinf((float)rev);
            if (k < 16) { ropeA[s * 16 + k] = cs; ropeA[4096 * 16 + s * 16 + k] = sn; } else { ropeB[s * 8 + k - 16] = cs; ropeB[4096 * 8 + s * 8 + k - 16] = sn; }
        }
    }
    xcd_barrier(bar);

    { pg8::Gemm g{XN, W1A, MROWS, 2 * DFF, DM, LDK}; pg8::StaticOrder S; S.init(MROWS, 2 * DFF, G, bx);
      pg8::EpiSwiGLU E{ACT, DFF, (const float*)(ws + OFF_RS0)};
      pg8::gemm_phase<pg8::EpiSwiGLU, pg8::StaticOrder, true, true>(lds, g, S, E, wid); }
    {
        constexpr int NU = (MROWS / 256) * (2 * DFF / 256);
        const int rounds = (NU + G - 1) / G; int first_idle = NU - (rounds - 1) * G, nidle = G - first_idle;
        if (nidle <= 0) { first_idle = 0; nidle = G; }
        if (bx >= first_idle) {
            LAS float* scr = (LAS float*)(lds + wid * 16384); const int lane_c = fresh_lane();
            const int gw = (bx - first_idle) * NWAVES + wid, NGW = nidle * NWAVES;
            for (int rep = 0; rep < REP_SHADOW; ++rep) {
            tr_matrix<false, 2>(args.in[3], DFF, DM, W1B, DFF, scr, gw, NGW, lane_c, nullptr);
            tr_matrix<false, 2>(args.in[5], DM, INW, WIN, LDK, scr, gw, NGW, lane_c, args.in[4]);
            tr_matrix<false, 2>(args.in[16], DM, DM, WOUT, LDK, scr, gw, NGW, lane_c, nullptr);
            }
        }
    }
    xcd_barrier(bar);
    { pg8::Gemm g{ACT, W1B, MROWS, DM, DFF, DFF}; pg8::StaticOrder S; S.init(MROWS, DM, G, bx);
      pg8::EpiResid<false, true, false> E{nullptr, nullptr, XN, rowss1, 0.5f};
      pg8::gemm_phase<pg8::EpiResid<false, true, false>, pg8::StaticOrder, true, true>(lds, g, S, E, wid); }
    xcd_barrier(bar);
    { pg8::Gemm g{XN, WIN, MROWS, INW, DM, LDK}; pg8::StaticOrder S; S.init(MROWS, INW, G, bx);
      pg8::EpiQKV E{QKV, rowss1, gtab, ropeA, ropeB, (LAS float*)(lds + XCH_OFF)};
      for (int rep = 0; rep < REP_G3; ++rep)
      pg8::gemm_phase<pg8::EpiQKV, pg8::StaticOrder, true, true>(lds, g, S, E, wid); }
    xcd_barrier(bar);
    {
        const float L2E = 1.4426950408889634f;
        const int lane_a = fresh_lane();
        const float gq = fmaxf(fabsf(args.in[6][lane_a]), fabsf(args.in[6][lane_a + 64])), gk = fmaxf(fabsf(args.in[7][lane_a]), fabsf(args.in[7][lane_a + 64]));
        const float negMA = __builtin_bit_cast(float, __builtin_amdgcn_readfirstlane(__builtin_bit_cast(int, -1.02f * 11.313708498984761f * wave_max(gq, lane_a) * wave_max(gk, lane_a) * L2E)));
        const float negMB = __builtin_bit_cast(float, __builtin_amdgcn_readfirstlane(__builtin_bit_cast(int, -1.02f * 8.0f * wave_max(fabsf(args.in[8][lane_a]), lane_a) * wave_max(fabsf(args.in[9][lane_a]), lane_a) * L2E)));
        const float lam = __builtin_bit_cast(float, __builtin_amdgcn_readfirstlane(__builtin_bit_cast(int, __expf(wave_sum(args.in[10][lane_a] * args.in[11][lane_a], lane_a)) - __expf(wave_sum(args.in[12][lane_a] * args.in[13][lane_a], lane_a)) + 0.2f)));
        {
            const int tid_a = wid * 64 + fresh_lane();
            for (int rep = 0; rep < REP_DIFF; ++rep)
            for (int u = bx; u < 512; u += G) {
                const int bh = u >> 5, qblk = u & 31;
                att::diff_unit((LAS char*)lds, QKV, MIX, bh >> 3, bh & 7, qblk, lam, negMB, args.in[15], tid_a, wid, tid_a & 63);
            }
        }
        {
            const int lane_d = fresh_lane();
            for (int rep = 0; rep < REP_DIL; ++rep)
            for (int wu = bx * NWAVES + wid; wu < 2048; wu += G * NWAVES) {
                const int ib = wu & 7, r16 = (wu >> 3) & 15, h = (wu >> 7) & 7, b = wu >> 10;
                att::dil_unit((LAS char*)lds + wid * att::DIL_WAVE, QKV, MIX, b, h, r16, ib, negMA, args.in[14], lane_d);
            }
        }
    }
    xcd_barrier(bar);
    { pg8::Gemm g{MIX, WOUT, MROWS, DM, DM, LDK}; pg8::StaticOrder S; S.init(MROWS, DM, G, bx);
      pg8::EpiResid<false, true, false> E{nullptr, nullptr, XN, rowss2, 1.0f};
      pg8::gemm_phase<pg8::EpiResid<false, true, false>, pg8::StaticOrder, true, true>(lds, g, S, E, wid); }
    xcd_barrier(bar);
    { pg8::Gemm g{XN, W2A, MROWS, 2 * DFF, DM, LDK}; pg8::StaticOrder S; S.init(MROWS, 2 * DFF, G, bx);
      pg8::EpiSwiGLU E{ACT, DFF, rowss2};
      for (int rep = 0; rep < REP_G6; ++rep)
      pg8::gemm_phase<pg8::EpiSwiGLU, pg8::StaticOrder, true, true>(lds, g, S, E, wid); }
    {
        constexpr int NU = (MROWS / 256) * (2 * DFF / 256);
        const int rounds = (NU + G - 1) / G; int first_idle = NU - (rounds - 1) * G, nidle = G - first_idle;
        if (nidle <= 0) { first_idle = 0; nidle = G; }
        if (bx >= first_idle) tr_matrix<false, 2>(args.in[19], DFF, DM, W2B, DFF, (LAS float*)(lds + wid * 16384), (bx - first_idle) * NWAVES + wid, nidle * NWAVES, fresh_lane(), nullptr);
    }
    xcd_barrier(bar);
    { pg8::Gemm g{ACT, W2B, MROWS, DM, DFF, DFF}; pg8::StaticOrder S; S.init(MROWS, DM, G, bx);
      pg8::EpiResid<false, false, true> E{nullptr, out, XN, nullptr, 0.5f};
      pg8::gemm_phase<pg8::EpiResid<false, false, true>, pg8::StaticOrder, true, true>(lds, g, S, E, wid); }
}

extern "C" void kernel_launch(void* const* d_in, const int* in_sizes, int n_in, void* d_out, int out_size, void* d_ws, size_t ws_size, hipStream_t stream) {
    static int grid = 0;
    if (grid == 0) {
        if (n_in != 20 || in_sizes[0] != MROWS * DM || out_size != MROWS * DM || ws_size < WS_END) {
            fprintf(stderr, "kernel_launch: unexpected shapes (n_in %d, in0 %d, out %d, ws %zu < %zu)\n", n_in, n_in > 0 ? in_sizes[0] : -1, out_size, ws_size, (size_t)WS_END); grid = -1; return; }
        int dev = 0, cus = 0, per_cu = 0;
        (void)hipGetDevice(&dev); (void)hipDeviceGetAttribute(&cus, hipDeviceAttributeMultiprocessorCount, dev);
        if (hipFuncSetAttribute((const void*)hybrid_fwd, hipFuncAttributeMaxDynamicSharedMemorySize, LDS_BYTES) != hipSuccess) { fprintf(stderr, "kernel_launch: hipFuncSetAttribute failed\n"); grid = -1; return; }
        if (hipOccupancyMaxActiveBlocksPerMultiprocessor(&per_cu, (const void*)hybrid_fwd, NWAVES * 64, LDS_BYTES) != hipSuccess || per_cu < 1) { fprintf(stderr, "kernel_launch: occupancy query says %d\n", per_cu); per_cu = 1; }
        (void)hipGetLastError();
        grid = cus * per_cu;
    }
    if (grid < 0) return;
    Args a{};
    for (int i = 0; i < 20; ++i) a.in[i] = (const float*)d_in[i];
    a.out = (float*)d_out; a.ws = (unsigned char*)d_ws;
    for (int i = 0; i < 16; ++i) a.invA[i] = (float)pow(500000.0, -(double)i / 16.0);
    for (int i = 0; i < 8; ++i) a.invB[i] = (float)pow(500000.0, -(double)i / 8.0);
    if (hipMemsetAsync((char*)d_ws + OFF_BAR, 0, BAR_BYTES, stream) != hipSuccess) { fprintf(stderr, "kernel_launch: memset failed\n"); return; }
    void* kargs[] = {&a};
    hipError_t e = hipLaunchCooperativeKernel((const void*)hybrid_fwd, dim3(grid), dim3(NWAVES * 64), kargs, LDS_BYTES, stream);
    if (e != hipSuccess) fprintf(stderr, "kernel_launch: cooperative launch failed: %s (grid %d)\n", hipGetErrorString(e), grid);
}
```

```cpp
#include <hip/hip_runtime.h>
#include <hip/hip_cooperative_groups.h>
#include <cstdio>
#include <cstdint>
#include <cmath>
namespace cg = cooperative_groups;
__device__ __forceinline__ int lane_opaque() { unsigned z = 0u; asm volatile("" : "+v"(z)); return (int)__builtin_amdgcn_mbcnt_hi(~0u, __builtin_amdgcn_mbcnt_lo(~0u, z)); }
__device__ __forceinline__ float shflx(float v, int mask, int lane) { return __builtin_bit_cast(float, __builtin_amdgcn_ds_bpermute((lane ^ mask) << 2, __builtin_bit_cast(int, v))); }
namespace pg8 {
#define PG8_LAS __attribute__((address_space(3)))
typedef unsigned short bf16_t;
typedef short bf16x8 __attribute__((ext_vector_type(8)));
typedef float f32x4 __attribute__((ext_vector_type(4)));
typedef unsigned u32x4 __attribute__((ext_vector_type(4)));
constexpr int BM = 256, BK = 64, HALF = 128, HTB = HALF * BK * 2  , STAGE_BYTES = 8 * HTB, NXCD = 8, WGM = 8;

__host__ __device__ __forceinline__ int lds_byte(int r, int c) { const int st = (r >> 4) * 2 + (c >> 5), rr = r & 15, cc = c & 31, ob = rr * 64 + cc * 2; return st * 1024 + (ob ^ (((ob >> 9) & 1) << 5)); }
__host__ __device__ __forceinline__ void stage_rc(int b, int& R, int& C) { const int st = b / 1024, sb = b % 1024, swz = sb ^ (((sb >> 9) & 1) << 5); R = (st >> 1) * 16 + swz / 64; C = (st & 1) * 32 + (swz % 64) / 2; }
__host__ __device__ __forceinline__ int perm32(int rho) { const int n = rho >> 4, i = rho & 15; return 8 * (i >> 2) + 4 * n + (i & 3); }

struct Unit { int pm, pn; };
struct Gemm { const bf16_t* A; const bf16_t* Bt; int M, N, K, ld; };

struct StaticOrder {
    int nM, nN, nwg, G, c;
    __host__ __device__ void init(int M, int N, int G_, int c_) { nM = M / BM; nN = N / BM; nwg = nM * nN; G = G_; c = c_; }
    __host__ __device__ bool next(int i, Unit& u) const {
        const long L = (long)i * G + c; if (L >= nwg) return false;
        int wgid = (int)L; { const int q = nwg / NXCD, r = nwg % NXCD, xcd = wgid % NXCD, off = wgid / NXCD; wgid = (xcd < r ? xcd * (q + 1) : r * (q + 1) + (xcd - r) * q) + off; }
        const int nig = WGM * nN, gid = wgid / nig, fm = gid * WGM, gsz = (nM - fm) < WGM ? (nM - fm) : WGM;
        u.pm = fm + ((wgid % nig) % gsz); u.pn = (wgid % nig) / gsz; return true;
    }
    __device__ __forceinline__ void a_ready(const Unit&) const {}
    __device__ __forceinline__ void done(const Unit&) const {}
};

__device__ __forceinline__ unsigned cvt_pk_bf16(float lo, float hi) { unsigned r; asm volatile("v_cvt_pk_bf16_f32 %0, %1, %2" : "=v"(r) : "v"(lo), "v"(hi)); return r; }
typedef float f32x2 __attribute__((ext_vector_type(2)));

typedef unsigned u32x2 __attribute__((ext_vector_type(2)));
constexpr int LDK = 2176, LDQ = 6272;
__device__ __forceinline__ float fast_silu(float g) { return g * __builtin_amdgcn_rcpf(1.0f + __expf(-g)); }

struct EpiSwiGLU {
    static constexpr bool PERM = true, AFTER_DRAIN = false;
    bf16_t* O; int ldc; const float* rowss;
    __device__ __forceinline__ void operator()(f32x4 (&acc)[2][2][4][2], const Unit& u, int wr, int wc, int fr, int fq) const {
        const int row0 = u.pm * BM + wr * 64 + fr; const int col0 = u.pn * HALF + wc * 32 + 8 * fq;
        float rsv[2][4];
#pragma unroll
        for (int ai = 0; ai < 2; ++ai)
#pragma unroll
            for (int m = 0; m < 4; ++m) rsv[ai][m] = rowss ? rowss[row0 + ai * HALF + m * 16] : 0.f;
#pragma unroll
        for (int ai = 0; ai < 2; ++ai)
#pragma unroll
            for (int m = 0; m < 4; ++m) rsv[ai][m] = rowss ? __builtin_amdgcn_rsqf(rsv[ai][m] * (1.0f / 2048.0f) + 1e-6f) : 1.0f;
        asm volatile("" : "+v"(rsv[0][0]), "+v"(rsv[0][1]), "+v"(rsv[0][2]), "+v"(rsv[0][3]), "+v"(rsv[1][0]), "+v"(rsv[1][1]), "+v"(rsv[1][2]), "+v"(rsv[1][3]));
#pragma unroll
        for (int ai = 0; ai < 2; ++ai)
#pragma unroll
            for (int m = 0; m < 4; ++m) {
                const int row = row0 + ai * HALF + m * 16;
                const float rs = rsv[ai][m];
                f32x4 g0 = acc[ai][0][m][0] * rs, g1 = acc[ai][0][m][1] * rs, u0 = acc[ai][1][m][0] * rs, u1 = acc[ai][1][m][1] * rs;
                u32x4 w;
                w.x = cvt_pk_bf16(fast_silu(g0[0]) * u0[0], fast_silu(g0[1]) * u0[1]); w.y = cvt_pk_bf16(fast_silu(g0[2]) * u0[2], fast_silu(g0[3]) * u0[3]);
                w.z = cvt_pk_bf16(fast_silu(g1[0]) * u1[0], fast_silu(g1[1]) * u1[1]); w.w = cvt_pk_bf16(fast_silu(g1[2]) * u1[2], fast_silu(g1[3]) * u1[3]);
                *(u32x4*)(O + (size_t)row * ldc + col0) = w;
            }
    }
};

template <bool BASE_F32, bool WRITE_XN, bool WRITE_OUT> struct EpiResid {
    static constexpr bool PERM = false, AFTER_DRAIN = false;
    const float* base; float* out; bf16_t* xn; float* rowss; float alpha;
    __device__ __forceinline__ void operator()(f32x4 (&acc)[2][2][4][2], const Unit& u, int wr, int wc, int fr, int fq) const {
        const int row0 = u.pm * BM + wr * 64 + fr; const int col0 = u.pn * BM + wc * 32 + 4 * fq;
#pragma unroll
        for (int ai = 0; ai < 2; ++ai) {
            f32x4 bpre[4][2][2];
#pragma unroll
            for (int m = 0; m < 4; ++m) { const int row = row0 + ai * HALF + m * 16;
#pragma unroll
                for (int bj = 0; bj < 2; ++bj)
#pragma unroll
                    for (int n = 0; n < 2; ++n) {
                        if (BASE_F32) bpre[m][bj][n] = *(const f32x4*)(base + (size_t)row * 2048 + col0 + bj * HALF + n * 16);
                        else { const u32x2 w = *(const u32x2*)(xn + (size_t)row * LDK + col0 + bj * HALF + n * 16);
                               bpre[m][bj][n] = (f32x4){__builtin_bit_cast(float, w.x << 16), __builtin_bit_cast(float, w.x & 0xffff0000u), __builtin_bit_cast(float, w.y << 16), __builtin_bit_cast(float, w.y & 0xffff0000u)}; }
                    } }
#pragma unroll
            for (int m = 0; m < 4; ++m) {
                const int row = row0 + ai * HALF + m * 16; float ss = 0.f;
#pragma unroll
                for (int bj = 0; bj < 2; ++bj)
#pragma unroll
                    for (int n = 0; n < 2; ++n) {
                        const f32x4 o = bpre[m][bj][n] + acc[ai][bj][m][n] * alpha;
                        if (WRITE_OUT) *(f32x4*)(out + (size_t)row * 2048 + col0 + bj * HALF + n * 16) = o;
                        if (WRITE_XN) {
                            ss += (o[0] * o[0] + o[1] * o[1]) + (o[2] * o[2] + o[3] * o[3]);
                            u32x2 w; w.x = cvt_pk_bf16(o[0], o[1]); w.y = cvt_pk_bf16(o[2], o[3]);
                            *(u32x2*)(xn + (size_t)row * LDK + col0 + bj * HALF + n * 16) = w;
                        }
                    }
                if (WRITE_XN) { ss += shflx(ss, 16, fq * 16 + fr); ss += shflx(ss, 32, fq * 16 + fr); if (fq == 0) atomicAdd(rowss + row, ss); }
            }
            asm volatile("" ::: "memory");
        }
    }
};

struct EpiQKV {
    static constexpr bool PERM = false, AFTER_DRAIN = false;
    bf16_t* O; const float* rowss; const float* gtab;
    const float* ropeA; const float* ropeB;
    PG8_LAS float* xch;
    __device__ __forceinline__ void operator()(f32x4 (&acc)[2][2][4][2], const Unit& u, int wr, int wc, int, int) const {
        const int lane_q = lane_opaque(), fr = lane_q & 15, fq = lane_q >> 4;
        const int region = u.pn >> 2;
        const int row0 = u.pm * BM + wr * 64 + fr;
#pragma unroll
        for (int ai = 0; ai < 2; ++ai)
#pragma unroll
            for (int m = 0; m < 4; ++m) {
                const float rs = __builtin_amdgcn_rsqf(rowss[row0 + ai * HALF + m * 16] * (1.0f / 2048.0f) + 1e-6f);
#pragma unroll
                for (int bj = 0; bj < 2; ++bj)
#pragma unroll
                    for (int n = 0; n < 2; ++n) acc[ai][bj][m][n] = acc[ai][bj][m][n] * rs;
            }
        const bool isv = (region == 2) || (region == 5);
        if (!isv) {
            const bool isA = region < 2;
            const bool do_rope = isA ? (wc == 0) : ((wc & 1) == 0);
#pragma unroll
            for (int ai = 0; ai < 2; ++ai)
#pragma unroll
                for (int m = 0; m < 4; ++m)
#pragma unroll
                    for (int bj = 0; bj < 2; ++bj) {
                        const f32x4 a = acc[ai][bj][m][0], b = acc[ai][bj][m][1];
                        float s = ((a[0] * a[0] + a[1] * a[1]) + (a[2] * a[2] + a[3] * a[3])) + ((b[0] * b[0] + b[1] * b[1]) + (b[2] * b[2] + b[3] * b[3]));
                        s += shflx(s, 16, fq * 16 + fr); s += shflx(s, 32, fq * 16 + fr);
                        if (fq == 0) xch[((ai * HALF + wr * 64 + m * 16 + fr) * 2 + bj) * 4 + wc] = s;
                    }
            asm volatile("s_waitcnt lgkmcnt(0)" ::: "memory"); __builtin_amdgcn_s_barrier(); asm volatile("" ::: "memory");
            const float* gptr = gtab + (region < 2 ? region : region - 1) * 128;
            const int dbase = isA ? wc * 32 : (wc & 1) * 32;
            f32x4 gv[2]; gv[0] = *(const f32x4*)(gptr + dbase + 4 * fq); gv[1] = *(const f32x4*)(gptr + dbase + 16 + 4 * fq);
            const float qs = region == 0 ? (0.08838834764831845f * 1.4426950408889634f) : (region == 3 ? (0.125f * 1.4426950408889634f) : 1.0f);
#pragma unroll
            for (int ai = 0; ai < 2; ++ai) {
                f32x4 csv[4], snv[4];
                if (do_rope) {
#pragma unroll
                    for (int m = 0; m < 4; ++m) { const int spos = (u.pm * BM + ai * HALF + wr * 64 + m * 16 + fr) & 4095;
                        const float* rp = isA ? ropeA + spos * 16 + 4 * fq : ropeB + spos * 8 + 4 * (fq & 1);
                        csv[m] = *(const f32x4*)rp; snv[m] = *(const f32x4*)(rp + (isA ? 4096 * 16 : 4096 * 8)); }
                }
#pragma unroll
                for (int m = 0; m < 4; ++m) {
                    const int rl = ai * HALF + wr * 64 + m * 16 + fr;
#pragma unroll
                    for (int bj = 0; bj < 2; ++bj) {
                        const f32x4 p = *(const PG8_LAS f32x4*)(xch + (rl * 2 + bj) * 4);
                        float rn;
                        if (isA) rn = __builtin_amdgcn_rsqf(((p[0] + p[1]) + (p[2] + p[3])) * (1.0f / 128.0f) + 1e-6f);
                        else rn = __builtin_amdgcn_rsqf(((wc < 2) ? (p[0] + p[1]) : (p[2] + p[3])) * (1.0f / 64.0f) + 1e-6f);
                        f32x4 v0 = acc[ai][bj][m][0] * rn * gv[0], v1 = acc[ai][bj][m][1] * rn * gv[1];
                        if (isA) {
                            if (do_rope) {
                                const f32x4 cs = csv[m], sn = snv[m];
                                const f32x4 x1 = v0, x2 = v1; v0 = x1 * cs - x2 * sn; v1 = x2 * cs + x1 * sn;
                            }
                        } else {
                            if (do_rope) {
                                const f32x4 cs = csv[m], sn = snv[m];
                                f32x4 pt; pt[0] = shflx(v0[0], 32, fq * 16 + fr); pt[1] = shflx(v0[1], 32, fq * 16 + fr); pt[2] = shflx(v0[2], 32, fq * 16 + fr); pt[3] = shflx(v0[3], 32, fq * 16 + fr);
                                v0 = (fq < 2) ? (v0 * cs - pt * sn) : (v0 * cs + pt * sn);
                            }
                        }
                        acc[ai][bj][m][0] = v0 * qs; acc[ai][bj][m][1] = v1 * qs;
                    }
                }
                asm volatile("" ::: "memory");
            }
        }
        const int col0 = u.pn * BM + wc * 32 + 4 * fq;
#pragma unroll
        for (int ai = 0; ai < 2; ++ai)
#pragma unroll
            for (int m = 0; m < 4; ++m) { bf16_t* rowp = O + (size_t)(row0 + ai * HALF + m * 16) * LDQ + col0;
#pragma unroll
                for (int bj = 0; bj < 2; ++bj)
#pragma unroll
                    for (int n = 0; n < 2; ++n) { const f32x4 v = acc[ai][bj][m][n]; u32x2 w; w.x = cvt_pk_bf16(v[0], v[1]); w.y = cvt_pk_bf16(v[2], v[3]); *(u32x2*)(rowp + bj * HALF + n * 16) = w; } }
    }
};
template <class Epi, class Sched, bool ALIGN_EPI = false, bool SP2 = false>
__device__ __forceinline__ void gemm_phase(PG8_LAS unsigned char* lds, const Gemm g, const Sched& S, const Epi& E, const int wid_s) {
    const int lane_ = lane_opaque();
    const int tid = wid_s * 64 + lane_, wid = wid_s, lane = tid & 63, wr = wid >> 2, wc = wid & 3, fr = lane & 15, fq = lane >> 4;
    const int K = g.ld, nt = g.K / BK;
    unsigned voffA[2], voffB[2];
#pragma unroll
    for (int i = 0; i < 2; ++i) { int R, C; stage_rc(tid * 16 + i * 8192, R, C); const int Rb = Epi::PERM ? ((R & ~31) + perm32(R & 31)) : R;
        voffA[i] = (unsigned)(R * K + C) * 2u; voffB[i] = (unsigned)(Rb * K + C) * 2u; }
    const size_t kstep = (size_t)(BK * 2);
    const size_t hstep = (size_t)HALF * K * 2;
    const size_t tstep = 2 * hstep;
    const unsigned ldsw = (unsigned)wid * 1024u;
    const int aoff = lds_byte(wr * 64 + fr, fq * 8), boff = lds_byte(wc * 32 + fr, fq * 8);
#define PG8_SA(b, h) (((b) * 2 + (h)) * HTB)
#define PG8_SB(b, h) ((4 + (b) * 2 + (h)) * HTB)
#define PG8_STAGE(bufoff, gbase, voff) do { _Pragma("unroll") for (int _i = 0; _i < 2; ++_i) \
        __builtin_amdgcn_global_load_lds((const unsigned*)((const char*)(gbase) + (voff)[_i]), (PG8_LAS unsigned*)(lds + (bufoff) + ldsw + _i * 8192), 16, 0, 0); } while (0)
#define PG8_LDA(dst, b, h) do { _Pragma("unroll") for (int m = 0; m < 4; ++m) _Pragma("unroll") for (int k = 0; k < 2; ++k) dst[m][k] = *(const PG8_LAS bf16x8*)(lds + PG8_SA(b, h) + aoff + m * 2048 + k * 1024); } while (0)
#define PG8_LDB(dst, b, h) do { _Pragma("unroll") for (int n = 0; n < 2; ++n) _Pragma("unroll") for (int k = 0; k < 2; ++k) dst[n][k] = *(const PG8_LAS bf16x8*)(lds + PG8_SB(b, h) + boff + n * 2048 + k * 1024); } while (0)
#define PG8_MMA(ai, bj, At, Bt) do { __builtin_amdgcn_s_setprio(1); _Pragma("unroll") for (int m = 0; m < 4; ++m) _Pragma("unroll") for (int n = 0; n < 2; ++n) _Pragma("unroll") for (int k = 0; k < 2; ++k) \
        acc[ai][bj][m][n] = __builtin_amdgcn_mfma_f32_16x16x32_bf16(Bt[n][k], At[m][k], acc[ai][bj][m][n], 0, 0, 0); __builtin_amdgcn_s_setprio(0); } while (0)
#define PG8_WAIT_V(n) asm volatile("s_waitcnt vmcnt(" #n ")" ::: "memory")
#define PG8_WAIT_L(n) asm volatile("s_waitcnt lgkmcnt(" #n ")" ::: "memory")
#define PG8_BAR __builtin_amdgcn_s_barrier()
#define PG8_SCHED __builtin_amdgcn_sched_barrier(0)
    Unit cur, nxt; int ui = 0;
    if (!S.next(0, cur)) return;
    f32x4 acc[2][2][4][2];
#pragma unroll
    for (int a = 0; a < 2; ++a)
#pragma unroll
        for (int b = 0; b < 2; ++b)
#pragma unroll
            for (int m = 0; m < 4; ++m)
#pragma unroll
                for (int n = 0; n < 2; ++n) acc[a][b][m][n] = (f32x4){0.f, 0.f, 0.f, 0.f};
    bf16x8 At[4][2], B0[2][2], B1[2][2];
    const char* cA = (const char*)g.A + (size_t)cur.pm * tstep; const char* cB = (const char*)g.Bt + (size_t)cur.pn * tstep;
    S.a_ready(cur);
    if constexpr (SP2) {
        PG8_STAGE(PG8_SB(0, 0), cB, voffB); PG8_STAGE(PG8_SB(0, 1), cB + hstep, voffB); PG8_STAGE(PG8_SA(0, 0), cA, voffA); PG8_STAGE(PG8_SA(0, 1), cA + hstep, voffA);
        if (wr == 1) PG8_BAR;
        PG8_WAIT_V(2); PG8_BAR;
        PG8_STAGE(PG8_SB(1, 0), cB + kstep, voffB); PG8_STAGE(PG8_SA(1, 0), cA + kstep, voffA); PG8_STAGE(PG8_SB(1, 1), cB + hstep + kstep, voffB);
        PG8_WAIT_V(6); PG8_BAR;
    } else {
        PG8_STAGE(PG8_SB(0, 0), cB, voffB); PG8_STAGE(PG8_SA(0, 0), cA, voffA); PG8_STAGE(PG8_SB(0, 1), cB + hstep, voffB); PG8_STAGE(PG8_SA(0, 1), cA + hstep, voffA);
        if (wr == 1) PG8_BAR;
        PG8_WAIT_V(4); PG8_BAR;
        PG8_STAGE(PG8_SB(1, 0), cB + kstep, voffB); PG8_STAGE(PG8_SA(1, 0), cA + kstep, voffA); PG8_STAGE(PG8_SB(1, 1), cB + hstep + kstep, voffB);
        PG8_WAIT_V(6); PG8_BAR;
    }
    for (;;) {
        const bool has_next = S.next(ui + 1, nxt);
        const char* nA = has_next ? (const char*)g.A + (size_t)nxt.pm * tstep : cA; const char* nB = has_next ? (const char*)g.Bt + (size_t)nxt.pn * tstep : cB;
        for (int t = 0; t < nt; t += 2) {
            const bool last = (t == nt - 2);
            const char* a1 = cA + (size_t)(t + 1) * kstep;
            const char* a2 = last ? nA : cA + (size_t)(t + 2) * kstep; const char* b2 = last ? nB : cB + (size_t)(t + 2) * kstep;
            const char* a3 = a2 + kstep; const char* b3 = b2 + kstep;
            if (last && has_next) S.a_ready(nxt);
            if constexpr (SP2) {
            PG8_LDB(B0, 0, 0); PG8_LDB(B1, 0, 1); PG8_SCHED; PG8_LDA(At, 0, 0); PG8_STAGE(PG8_SA(1, 1), a1 + hstep, voffA);
            PG8_WAIT_V(8); PG8_WAIT_L(0); PG8_BAR; PG8_MMA(0, 0, At, B0); PG8_MMA(0, 1, At, B1); PG8_BAR; PG8_SCHED;
            PG8_LDA(At, 0, 1); PG8_STAGE(PG8_SB(0, 0), b2, voffB); PG8_STAGE(PG8_SB(0, 1), b2 + hstep, voffB); PG8_STAGE(PG8_SA(0, 0), a2, voffA);
            PG8_WAIT_V(8); PG8_WAIT_L(0); PG8_BAR; PG8_MMA(1, 0, At, B0); PG8_MMA(1, 1, At, B1); PG8_BAR; PG8_SCHED;
            PG8_LDB(B0, 1, 0); PG8_LDB(B1, 1, 1); PG8_SCHED; PG8_LDA(At, 1, 0); PG8_STAGE(PG8_SA(0, 1), a2 + hstep, voffA);
            PG8_WAIT_V(8); PG8_WAIT_L(0); PG8_BAR; PG8_MMA(0, 0, At, B0); PG8_MMA(0, 1, At, B1); PG8_BAR; PG8_SCHED;
            PG8_LDA(At, 1, 1); PG8_STAGE(PG8_SB(1, 0), b3, voffB); PG8_STAGE(PG8_SB(1, 1), b3 + hstep, voffB); PG8_STAGE(PG8_SA(1, 0), a3, voffA);
            PG8_WAIT_V(8); PG8_WAIT_L(0); PG8_BAR; PG8_MMA(1, 0, At, B0); PG8_MMA(1, 1, At, B1); PG8_BAR; PG8_SCHED;
            } else {
            PG8_LDB(B0, 0, 0); PG8_SCHED; PG8_LDA(At, 0, 0); PG8_STAGE(PG8_SA(1, 1), a1 + hstep, voffA);
            PG8_WAIT_L(8); PG8_BAR; PG8_WAIT_L(0); PG8_MMA(0, 0, At, B0); PG8_BAR; PG8_SCHED;
            PG8_LDB(B1, 0, 1); PG8_STAGE(PG8_SB(0, 0), b2, voffB);
            PG8_BAR; PG8_WAIT_L(0); PG8_MMA(0, 1, At, B1); PG8_BAR;
            PG8_LDA(At, 0, 1); PG8_STAGE(PG8_SA(0, 0), a2, voffA);
            PG8_BAR; PG8_WAIT_L(0); PG8_MMA(1, 0, At, B0); PG8_BAR; PG8_SCHED;
            PG8_STAGE(PG8_SB(0, 1), b2 + hstep, voffB);
            PG8_WAIT_V(6); PG8_BAR; PG8_MMA(1, 1, At, B1); PG8_BAR;
            PG8_LDB(B0, 1, 0); PG8_SCHED; PG8_LDA(At, 1, 0); PG8_STAGE(PG8_SA(0, 1), a2 + hstep, voffA);
            PG8_WAIT_L(8); PG8_BAR; PG8_WAIT_L(0); PG8_MMA(0, 0, At, B0); PG8_BAR; PG8_SCHED;
            PG8_LDB(B1, 1, 1); PG8_STAGE(PG8_SB(1, 0), b3, voffB);
            PG8_BAR; PG8_WAIT_L(0); PG8_MMA(0, 1, At, B1); PG8_BAR;
            PG8_LDA(At, 1, 1); PG8_STAGE(PG8_SA(1, 0), a3, voffA);
            PG8_BAR; PG8_WAIT_L(0); PG8_MMA(1, 0, At, B0); PG8_BAR; PG8_SCHED;
            PG8_STAGE(PG8_SB(1, 1), b3 + hstep, voffB);
            PG8_WAIT_V(6); PG8_BAR; PG8_MMA(1, 1, At, B1); PG8_BAR;
            }
        }
        if constexpr (ALIGN_EPI) { if (wr == 0) PG8_BAR; }
        if constexpr (!Epi::AFTER_DRAIN) { E(acc, cur, wr, wc, fr, fq); S.done(cur); }
        if (!has_next) break;
#pragma unroll
        for (int a = 0; a < 2; ++a)
#pragma unroll
            for (int b = 0; b < 2; ++b)
#pragma unroll
                for (int m = 0; m < 4; ++m)
#pragma unroll
                    for (int n = 0; n < 2; ++n) acc[a][b][m][n] = (f32x4){0.f, 0.f, 0.f, 0.f};
        cur = nxt; cA = nA; cB = nB; ++ui;
        if constexpr (ALIGN_EPI) { if (wr == 1) PG8_BAR; }
    }
    PG8_WAIT_V(0);
    if constexpr (!ALIGN_EPI) { if (wr == 0) PG8_BAR; }
    PG8_BAR;
    if constexpr (Epi::AFTER_DRAIN) { E.fused(acc, cur, wr, wc, fr, fq, lds, wid, lane); S.done(cur); }
#undef PG8_SA
#undef PG8_SB
#undef PG8_STAGE
#undef PG8_LDA
#undef PG8_LDB
#undef PG8_MMA
#undef PG8_WAIT_V
#undef PG8_WAIT_L
#undef PG8_BAR
#undef PG8_SCHED
}
}

namespace att {
#define LAS __attribute__((address_space(3)))
typedef unsigned short bf16_t;
typedef short bf16x8 __attribute__((ext_vector_type(8)));
typedef short s16x4 __attribute__((ext_vector_type(4)));
typedef short v4i16_t __attribute__((ext_vector_type(4)));
typedef float f32x16 __attribute__((ext_vector_type(16)));
typedef float f32x4 __attribute__((ext_vector_type(4)));
typedef unsigned u32x4 __attribute__((ext_vector_type(4)));
typedef unsigned u32x2 __attribute__((ext_vector_type(2)));
typedef float f32x2_t __attribute__((ext_vector_type(2))); typedef __bf16 bf16x2_t __attribute__((ext_vector_type(2)));
constexpr int SEQ = 4096, INW = 6272, DMODEL = 2176;
constexpr int KP = 272, VP = 320;
constexpr int DIFF_TILE = 128 * KP + 128 * VP;
constexpr int DIL_WAVE = 32 * KP + 32 * VP;
__device__ __forceinline__ unsigned cvtpk(float lo, float hi) { f32x2_t v = {lo, hi}; bf16x2_t b = __builtin_convertvector(v, bf16x2_t); return __builtin_bit_cast(unsigned, b); }
__device__ __forceinline__ int crow(int r, int hi) { return (r & 3) + 8 * (r >> 2) + 4 * hi; }
__device__ __forceinline__ s16x4 vtr(const LAS char* p) { return __builtin_bit_cast(s16x4, __builtin_amdgcn_ds_read_tr16_b64_v4i16((LAS v4i16_t*)p)); }
__device__ __forceinline__ bf16x8 packp(const f32x16& p, int s) {
    u32x4 w; w.x = cvtpk(p[8 * s], p[8 * s + 1]); w.y = cvtpk(p[8 * s + 2], p[8 * s + 3]); w.z = cvtpk(p[8 * s + 4], p[8 * s + 5]); w.w = cvtpk(p[8 * s + 6], p[8 * s + 7]);
    return __builtin_bit_cast(bf16x8, w);
}
#define MFMA32(a, b, c) __builtin_amdgcn_mfma_f32_32x32x16_bf16((a), (b), (c), 0, 0, 0)

__device__ __forceinline__ void diff_unit(LAS char* lds, const bf16_t* QKV, bf16_t* MIX, int b, int h, int qblk, float lam, float negM, const float* g_bout, int tid, int wid, int lane) {
    const int c = wid >> 2, r32 = lane & 31, hh = lane >> 5, cb = (lane >> 4) & 1, q_ = (lane & 15) >> 2, p_ = lane & 3;
    const size_t rowbase = (size_t)b * SEQ; const int q0 = qblk * 128 + (wid & 3) * 32;
    bf16x8 qf[4];
    { const bf16_t* qp = QKV + (rowbase + q0 + r32) * INW + 3072 + h * 128 + c * 64 + 8 * hh;
#pragma unroll
      for (int ks = 0; ks < 4; ++ks) qf[ks] = *(const bf16x8*)(qp + 16 * ks); }
    const int srow = tid >> 4, sch = tid & 15;
    const bf16_t* kg = QKV + (rowbase + srow) * INW + 4096 + h * 128 + sch * 8;
    const bf16_t* vg = kg + 1024;
    LAS char* kst = lds + srow * KP + sch * 16; LAS char* vst = lds + 128 * KP + srow * VP + sch * 16;
    f32x16 o[4];
#pragma unroll
    for (int i = 0; i < 4; ++i)
#pragma unroll
        for (int r = 0; r < 16; ++r) o[i][r] = 0.f;
    float lsum = 0.f;
    f32x16 negm;
#pragma unroll
    for (int r = 0; r < 16; ++r) negm[r] = negM;
    u32x4 kr[4], vr[4];
#pragma unroll
    for (int i = 0; i < 4; ++i) { kr[i] = *(const u32x4*)(kg + (size_t)(32 * i) * INW); vr[i] = *(const u32x4*)(vg + (size_t)(32 * i) * INW); }
#pragma unroll
    for (int i = 0; i < 4; ++i) { *(LAS u32x4*)(kst + 32 * i * KP) = kr[i]; *(LAS u32x4*)(vst + 32 * i * VP) = vr[i]; }
    __syncthreads();
    const int NT = SEQ / 128;
    const LAS char* kread = lds + r32 * KP + (c * 64 + 8 * hh) * 2;
    const LAS char* vread = lds + 128 * KP + (4 * hh + q_) * VP + (16 * cb + 4 * p_) * 2;
    for (int t = 0; t < NT; ++t) {
        const int cur = (t & 1) * DIFF_TILE, nxt = DIFF_TILE - cur;
        const size_t go = (size_t)(t + 1) * 128 * INW; const bool more = t + 1 < NT;
        if (more) {
#pragma unroll
            for (int i = 0; i < 4; ++i) kr[i] = *(const u32x4*)(kg + go + (size_t)(32 * i) * INW); }
        f32x16 pA0 = negm, pA1 = negm, pB0 = negm, pB1 = negm;
#pragma unroll
        for (int ks = 0; ks < 4; ++ks) {
            const bf16x8 k0 = *(const LAS bf16x8*)(kread + cur + ks * 32), k1 = *(const LAS bf16x8*)(kread + cur + 32 * KP + ks * 32);
            pA0 = MFMA32(k0, qf[ks], pA0); pA1 = MFMA32(k1, qf[ks], pA1);
        }
#pragma unroll
        for (int ks = 0; ks < 4; ++ks) {
            const bf16x8 k0 = *(const LAS bf16x8*)(kread + cur + 64 * KP + ks * 32), k1 = *(const LAS bf16x8*)(kread + cur + 96 * KP + ks * 32);
            pB0 = MFMA32(k0, qf[ks], pB0); pB1 = MFMA32(k1, qf[ks], pB1);
        }
        if (more) {
#pragma unroll
            for (int i = 0; i < 4; ++i) *(LAS u32x4*)(kst + nxt + 32 * i * KP) = kr[i];
#pragma unroll
            for (int i = 0; i < 4; ++i) kr[i] = *(const u32x4*)(vg + go + (size_t)(32 * i) * INW); }
        float sa = 0.f, sb = 0.f;
#pragma unroll
        for (int r = 0; r < 16; ++r) { pA0[r] = __builtin_amdgcn_exp2f(pA0[r]); pA1[r] = __builtin_amdgcn_exp2f(pA1[r]); sa += pA0[r]; sb += pA1[r]; }
        bf16x8 pf[4]; pf[0] = packp(pA0, 0); pf[1] = packp(pA0, 1); pf[2] = packp(pA1, 0); pf[3] = packp(pA1, 1);
#pragma unroll
        for (int kst4 = 0; kst4 < 4; ++kst4)
#pragma unroll
            for (int db = 0; db < 4; ++db) {
                const LAS char* a = vread + cur + kst4 * 16 * VP + db * 64;
                const s16x4 lo = vtr(a), hi = vtr(a + 8 * VP);
                const bf16x8 vf = __builtin_shufflevector(lo, hi, 0, 1, 2, 3, 4, 5, 6, 7);
                o[db] = MFMA32(vf, pf[kst4], o[db]);
            }
#pragma unroll
        for (int r = 0; r < 16; ++r) { pB0[r] = __builtin_amdgcn_exp2f(pB0[r]); pB1[r] = __builtin_amdgcn_exp2f(pB1[r]); sa += pB0[r]; sb += pB1[r]; }
        lsum += sa + sb;
        pf[0] = packp(pB0, 0); pf[1] = packp(pB0, 1); pf[2] = packp(pB1, 0); pf[3] = packp(pB1, 1);
#pragma unroll
        for (int kst4 = 0; kst4 < 4; ++kst4)
#pragma unroll
            for (int db = 0; db < 4; ++db) {
                const LAS char* a = vread + cur + (64 + kst4 * 16) * VP + db * 64;
                const s16x4 lo = vtr(a), hi = vtr(a + 8 * VP);
                const bf16x8 vf = __builtin_shufflevector(lo, hi, 0, 1, 2, 3, 4, 5, 6, 7);
                o[db] = MFMA32(vf, pf[kst4], o[db]);
            }
        if (more) {
#pragma unroll
            for (int i = 0; i < 4; ++i) *(LAS u32x4*)(vst + nxt + 32 * i * VP) = kr[i]; }
        __syncthreads();
    }
    const int lane_e = lane_opaque();
    lsum += shflx(lsum, 32, lane_e);
    float inv = 1.0f / lsum; if (c == 1) inv *= lam;
    const int r32e = lane_e & 31, hhe = lane_e >> 5;
    LAS float* X = (LAS float*)lds + (wid & 3) * 4096;
    if (c == 1) {
#pragma unroll
        for (int db = 0; db < 4; ++db)
#pragma unroll
            for (int r = 0; r < 16; ++r) X[(db * 32 + crow(r, hhe)) * 32 + r32e] = o[db][r] * inv;
    }
    __syncthreads();
    if (c == 0) {
        float ss = 0.f;
#pragma unroll
        for (int db = 0; db < 4; ++db)
#pragma unroll
            for (int r = 0; r < 16; ++r) { const float v = o[db][r] * inv - X[(db * 32 + crow(r, hhe)) * 32 + r32e]; o[db][r] = v; ss += v * v; }
        ss += shflx(ss, 32, lane_e);
        const float rn = __builtin_amdgcn_rsqf(ss * (1.0f / 128.0f) + 1e-6f) * 0.8f;
        bf16_t* op = MIX + (rowbase + q0 + r32e) * DMODEL + 1024 + h * 128;
#pragma unroll
        for (int db = 0; db < 4; ++db)
#pragma unroll
            for (int g4 = 0; g4 < 4; ++g4) { const int d0 = db * 32 + 8 * g4 + 4 * hhe; const f32x4 gg = *(const f32x4*)(g_bout + d0);
                u32x2 w; w.x = cvtpk(o[db][4 * g4] * rn * gg[0], o[db][4 * g4 + 1] * rn * gg[1]); w.y = cvtpk(o[db][4 * g4 + 2] * rn * gg[2], o[db][4 * g4 + 3] * rn * gg[3]);
                *(u32x2*)(op + d0) = w; }
    }
    __syncthreads();
}

__device__ __forceinline__ void dil_unit(LAS char* wl, const bf16_t* QKV, bf16_t* MIX, int b, int h, int r16, int ib, float negM, const float* g_aout, int lane) {
    const int r32 = lane & 31, hh = lane >> 5, cb = (lane >> 4) & 1, q_ = (lane & 15) >> 2, p_ = lane & 3;
    const size_t rowbase = (size_t)b * SEQ;
    const int tq = r16 + 16 * (32 * ib + r32);
    bf16x8 qf[8];
    { const bf16_t* qp = QKV + (rowbase + tq) * INW + h * 128 + 8 * hh;
#pragma unroll
      for (int ks = 0; ks < 8; ++ks) qf[ks] = *(const bf16x8*)(qp + 16 * ks); }
    f32x16 o[4];
#pragma unroll
    for (int i = 0; i < 4; ++i)
#pragma unroll
        for (int r = 0; r < 16; ++r) o[i][r] = 0.f;
    float lsum = 0.f;
    f32x16 negm;
#pragma unroll
    for (int r = 0; r < 16; ++r) negm[r] = negM;
    const int lrow = lane >> 4, lch = lane & 15;
    const bf16_t* kvg = QKV + rowbase * INW + 1024 + h * 128 + lch * 8;
    LAS char* kst = wl + lrow * KP + lch * 16; LAS char* vst = wl + 32 * KP + lrow * VP + lch * 16;
    const LAS char* kread = wl + r32 * KP + 8 * hh * 2;
    const LAS char* vread = wl + 32 * KP + (4 * hh + q_) * VP + (16 * cb + 4 * p_) * 2;
    int klo0, khi0, klo1, khi1, klo2, khi2;
    { const int bq = 32 * ib;               int lo_i = bq - 64; if (lo_i < 0) lo_i = 0; klo0 = lo_i >> 5; khi0 = (bq + 31 + 64) >> 5;      if (khi0 > 7) khi0 = 7; }
    { const int bq = (r16 >> 2) + 128 * ib; int lo_i = bq - 64; if (lo_i < 0) lo_i = 0; klo1 = lo_i >> 5; khi1 = (bq + 31 * 4 + 64) >> 5;  if (khi1 > 31) khi1 = 31; }
    { const int bq = r16 + 512 * ib;        int lo_i = bq - 64; if (lo_i < 0) lo_i = 0; klo2 = lo_i >> 5; khi2 = (bq + 31 * 16 + 64) >> 5; if (khi2 > 127) khi2 = 127; }
    int pat = 0, kb = klo0;
    u32x4 kr[8], vr[8];
#define DIL_LOADK(PAT, KB) do { const int sh_ = 4 - 2 * (PAT); const int rc_ = r16 & ((1 << sh_) - 1); \
        _Pragma("unroll") for (int i = 0; i < 8; ++i) { const int tok = rc_ + ((32 * (KB) + lrow + 4 * i) << sh_); kr[i] = *(const u32x4*)(kvg + (size_t)tok * INW); } } while (0)
#define DIL_LOADV(PAT, KB) do { const int sh_ = 4 - 2 * (PAT); const int rc_ = r16 & ((1 << sh_) - 1); \
        _Pragma("unroll") for (int i = 0; i < 8; ++i) { const int tok = rc_ + ((32 * (KB) + lrow + 4 * i) << sh_); vr[i] = *(const u32x4*)(kvg + (size_t)tok * INW + 1024); } } while (0)
#define DIL_ADV() do { const int hi_c = pat == 0 ? khi0 : (pat == 1 ? khi1 : khi2); if (kb < hi_c) ++kb; else { ++pat; kb = pat == 1 ? klo1 : klo2; } } while (0)
#define DIL_WFENCE() do { __builtin_amdgcn_fence(__ATOMIC_RELEASE, "wavefront"); __builtin_amdgcn_wave_barrier(); __builtin_amdgcn_fence(__ATOMIC_ACQUIRE, "wavefront"); } while (0)
#define DIL_S(P) do { P = negm; _Pragma("unroll") for (int ks = 0; ks < 8; ++ks) { const bf16x8 kf = *(const LAS bf16x8*)(kread + ks * 32); P = MFMA32(kf, qf[ks], P); } } while (0)
    int cpat = pat, ckb = kb;
    DIL_LOADK(pat, kb); DIL_LOADV(pat, kb);
#pragma unroll
    for (int i = 0; i < 8; ++i) { *(LAS u32x4*)(kst + 4 * i * KP) = kr[i]; *(LAS u32x4*)(vst + 4 * i * VP) = vr[i]; }
    DIL_ADV();
    bool have1 = pat < 3;
    int npat = pat, nkb = kb;
    if (have1) { DIL_LOADK(pat, kb); DIL_LOADV(pat, kb); DIL_ADV(); }
    DIL_WFENCE();
    f32x16 p, pn;
    DIL_S(p);
    for (;;) {
        const bool have2 = have1 && pat < 3;
        if (have1) {
            DIL_WFENCE();
#pragma unroll
            for (int i = 0; i < 8; ++i) *(LAS u32x4*)(kst + 4 * i * KP) = kr[i];
            if (have2) DIL_LOADK(pat, kb);
            DIL_WFENCE();
            DIL_S(pn);
        }
        const int sh = 4 - 2 * cpat, sq = 16 >> sh;
        const int qi = (r16 >> sh) + sq * 32 * ib + sq * r32;
        float sa = 0.f;
#pragma unroll
        for (int r = 0; r < 16; ++r) { const int dl = 32 * ckb + crow(r, hh) - qi; const float e = __builtin_amdgcn_exp2f(p[r]); const float pv = (dl <= 64 && dl >= -64) ? e : 0.f; p[r] = pv; sa += pv; }
        lsum += sa;
        bf16x8 pf[2]; pf[0] = packp(p, 0); pf[1] = packp(p, 1);
#pragma unroll
        for (int s = 0; s < 2; ++s)
#pragma unroll
            for (int db = 0; db < 4; ++db) {
                const LAS char* a = vread + s * 16 * VP + db * 64;
                const s16x4 lo = vtr(a), hi = vtr(a + 8 * VP);
                const bf16x8 vf = __builtin_shufflevector(lo, hi, 0, 1, 2, 3, 4, 5, 6, 7);
                o[db] = MFMA32(vf, pf[s], o[db]);
            }
        if (!have1) break;
        DIL_WFENCE();
#pragma unroll
        for (int i = 0; i < 8; ++i) *(LAS u32x4*)(vst + 4 * i * VP) = vr[i];
        if (have2) DIL_LOADV(pat, kb);
        DIL_WFENCE();
        p = pn; cpat = npat; ckb = nkb; npat = pat; nkb = kb; have1 = have2;
        if (have2) DIL_ADV();
    }
#undef DIL_LOADK
#undef DIL_LOADV
#undef DIL_ADV
#undef DIL_WFENCE
#undef DIL_S
    lsum += shflx(lsum, 32, lane);
    const float inv = 1.0f / lsum; float ss = 0.f;
#pragma unroll
    for (int db = 0; db < 4; ++db)
#pragma unroll
        for (int r = 0; r < 16; ++r) { const float v = o[db][r] * inv; o[db][r] = v; ss += v * v; }
    ss += shflx(ss, 32, lane);
    const float rn = __builtin_amdgcn_rsqf(ss * (1.0f / 128.0f) + 1e-6f);
    bf16_t* op = MIX + (rowbase + tq) * DMODEL + h * 128;
#pragma unroll
    for (int db = 0; db < 4; ++db)
#pragma unroll
        for (int g4 = 0; g4 < 4; ++g4) { const int d0 = db * 32 + 8 * g4 + 4 * hh; const f32x4 gg = *(const f32x4*)(g_aout + d0);
            u32x2 w; w.x = cvtpk(o[db][4 * g4] * rn * gg[0], o[db][4 * g4 + 1] * rn * gg[1]); w.y = cvtpk(o[db][4 * g4 + 2] * rn * gg[2], o[db][4 * g4 + 3] * rn * gg[3]);
            *(u32x2*)(op + d0) = w; }
}
}

constexpr int NWAVES = 8;
constexpr int DM = 2048, NBATCH = 2, SEQ = 4096, MROWS = NBATCH * SEQ, DFF = 5632, INW = 6144;
constexpr size_t MiB = 1u << 20;
constexpr size_t WS_CTL = 0;
constexpr size_t OFF_GTAB = 1 * MiB - 4096;
constexpr size_t OFF_RS0 = 917504;
constexpr size_t OFF_BAR = 983040, BAR_BYTES = 16384;
constexpr size_t OFF_RS1 = 0, OFF_RS2 = 32768, OFF_ROPEA = 65536, OFF_ROPEB = OFF_ROPEA + 2 * 4096 * 16 * 4;
constexpr int LDK = pg8::LDK, LDQ = pg8::LDQ;
constexpr size_t WS_W1A = 1 * MiB, WS_W1B = WS_W1A + 47 * MiB, WS_WIN = WS_W1B + 22 * MiB, WS_WOUT = WS_WIN + 26 * MiB, WS_W2A = WS_WOUT + 9 * MiB, WS_W2B = WS_W2A + 47 * MiB;
constexpr size_t WS_XN = WS_W2B + 22 * MiB;
constexpr size_t WS_ACT = WS_XN + 34 * MiB;
constexpr size_t WS_MIX = WS_ACT + 98 * MiB;
constexpr size_t WS_END = WS_MIX + 34 * MiB;
constexpr int LDS_BYTES = 155648;
constexpr int XCH_OFF = 131072;
static_assert((size_t)11264 * LDK * 2 <= 47 * MiB && (size_t)6144 * LDK * 2 <= 26 * MiB && (size_t)2048 * LDK * 2 <= 9 * MiB && (size_t)8192 * LDK * 2 <= 34 * MiB && (size_t)8192 * LDQ * 2 <= 98 * MiB && att::INW == LDQ && att::DMODEL == LDK, "ws map");
static_assert(att::DIL_WAVE * 8 <= LDS_BYTES - 64 && 3456 * 4 <= BAR_BYTES && 2 * att::DIFF_TILE <= LDS_BYTES - 64 && XCH_OFF + 8192 <= LDS_BYTES, "LDS map");

#define LAS __attribute__((address_space(3)))
typedef unsigned short bf16;
typedef unsigned v4u __attribute__((ext_vector_type(4)));
typedef unsigned v2u __attribute__((ext_vector_type(2)));
typedef float f32x4 __attribute__((ext_vector_type(4)));
__device__ __forceinline__ unsigned f2bf(float f) { unsigned u = __builtin_bit_cast(unsigned, f); return (u + 0x7fffu + ((u >> 16) & 1u)) >> 16; }
__device__ __forceinline__ unsigned pk2(float lo, float hi) { return f2bf(lo) | (f2bf(hi) << 16); }
__device__ __forceinline__ float wave_sum(float v, int lane) {
#pragma unroll
    for (int o = 1; o < 64; o <<= 1) v += shflx(v, o, lane);
    return v;
}
__device__ __forceinline__ float wave_max(float v, int lane) {
#pragma unroll
    for (int o = 1; o < 64; o <<= 1) v = fmaxf(v, shflx(v, o, lane));
    return v;
}
template <bool GLU> __device__ __forceinline__ void tr_load(const float* W, int N, int item, int lane, f32x4 (&v)[8], const float* gk) {
    const int nblk = N / 32, kb = item / nblk, nb = item % nblk, k0 = 64 * kb, n0 = 32 * nb;
    const float* src = W + (size_t)(k0 + (lane >> 3)) * N + n0 + 4 * (lane & 7);
#pragma unroll
    for (int i = 0; i < 8; ++i) v[i] = __builtin_nontemporal_load((const f32x4*)(src + (size_t)(8 * i) * N));
    if (gk) {
#pragma unroll
        for (int i = 0; i < 8; ++i) v[i] = v[i] * gk[k0 + (lane >> 3) + 8 * i]; }
}
template <bool GLU> __device__ __forceinline__ void tr_store(int K, int N, bf16* WT, int ldw, LAS float* scr, int item, int lane, const f32x4 (&v)[8]) {
    const int nblk = N / 32, kb = item / nblk, nb = item % nblk, k0 = 64 * kb, n0 = 32 * nb;
    int r0 = n0;
    if (GLU) { const int half = N / 2; r0 = n0 < half ? (n0 >> 7) * 256 + (n0 & 127) : ((n0 - half) >> 7) * 256 + 128 + ((n0 - half) & 127); }
    const int rg = lane >> 3, c4 = lane & 7;
#pragma unroll
    for (int i = 0; i < 8; ++i) { LAS float* d = scr + (8 * i + rg) * 33 + 4 * c4; d[0] = v[i][0]; d[1] = v[i][1]; d[2] = v[i][2]; d[3] = v[i][3]; }
    asm volatile("s_waitcnt lgkmcnt(0)" ::: "memory");
    const int c = lane & 7;
#pragma unroll
    for (int j = 0; j < 4; ++j) { const int n = (lane >> 3) + 8 * j; const LAS float* s = scr + (8 * c) * 33 + n;
        v4u o; o.x = pk2(s[0 * 33], s[1 * 33]); o.y = pk2(s[2 * 33], s[3 * 33]); o.z = pk2(s[4 * 33], s[5 * 33]); o.w = pk2(s[6 * 33], s[7 * 33]);
        *(v4u*)(WT + (size_t)(r0 + n) * ldw + k0 + 8 * c) = o; }
    asm volatile("s_waitcnt lgkmcnt(0)" ::: "memory");
}
template <bool GLU, int NIF> __device__ __forceinline__ void tr_matrix(const float* W, int K, int N, bf16* WT, int ldw, LAS float* scr, int gw, int NGW, int lane, const float* gk) {
    const int nitems = (K / 64) * (N / 32);
    for (int it = gw; it < nitems; it += NIF * NGW) {
        f32x4 v[NIF][8];
#pragma unroll
        for (int j = 0; j < NIF; ++j) if (it + j * NGW < nitems) tr_load<GLU>(W, N, it + j * NGW, lane, v[j], gk);
#pragma unroll
        for (int j = 0; j < NIF; ++j) if (it + j * NGW < nitems) tr_store<GLU>(K, N, WT, ldw, scr, it + j * NGW, lane, v[j]);
    }
}

#define XB_TMO      128
#define XB_XCNT(j)  (256  + 64 * (j))
#define XB_XSUB(j)  (1280 + 64 * (j))
#define XB_XGEN(j)  (2304 + 64 * (j))
#define XB_TOP      3328
#define XB_TOPGEN   3392
#define XCD_BAR_WORDS 3456
#define XB_SPIN_CAP (1u << 18)

__device__ __forceinline__ unsigned xb_ld(unsigned* p)              { return __hip_atomic_load(p, __ATOMIC_RELAXED, __HIP_MEMORY_SCOPE_AGENT); }
__device__ __forceinline__ unsigned xb_add(unsigned* p, unsigned v) { return __hip_atomic_fetch_add(p, v, __ATOMIC_RELAXED, __HIP_MEMORY_SCOPE_AGENT); }
__device__ __forceinline__ unsigned xb_xcc_id() { return (unsigned)__builtin_amdgcn_s_getreg((3 << 11) | 20) & 0xFu; }
#define XB_SPIN(cond, bar) do { unsigned _sp = 0; while (cond) { __builtin_amdgcn_s_sleep(1); \
    if ((++_sp & 255u) == 0u) { if (xb_ld(&(bar)[XB_TMO])) break; if (_sp > XB_SPIN_CAP) { atomicAdd(&(bar)[XB_TMO], 1u); break; } } } } while (0)

struct XcdBarrier {
    unsigned* bar; unsigned x; int wid;
    volatile LAS unsigned* st;
};

__device__ __forceinline__ bool xb_lane0() { return lane_opaque() == 0; }
__device__ __forceinline__ XcdBarrier xcd_barrier_post(unsigned* bar, volatile LAS unsigned* st, int wid) {
    XcdBarrier b; b.bar = bar; b.x = xb_xcc_id(); b.st = st; b.wid = wid;
    if (wid == 0 && xb_lane0()) (void)xb_add(&bar[XB_XCNT(b.x)], 1u);
    return b;
}
__device__ __forceinline__ void xcd_barrier_complete(unsigned* bar, unsigned x, unsigned& nloc, unsigned& nx) {
    const unsigned G = gridDim.x * gridDim.y * gridDim.z;
    unsigned sum, cnt, mine, sp = 0u;
    for (;;) {
        sum = 0u; cnt = 0u; mine = 0u;
#pragma unroll
        for (unsigned j = 0; j < 16; ++j) { const unsigned c = xb_ld(&bar[XB_XCNT(j)]); sum += c; cnt += (c > 0u) ? 1u : 0u; mine = (j == x) ? c : mine; }
        if (sum == G) break;
        __builtin_amdgcn_s_sleep(1);
        if ((++sp & 255u) == 0u) { if (xb_ld(&bar[XB_TMO])) break; if (sp > XB_SPIN_CAP) { atomicAdd(&bar[XB_TMO], 1u); break; } }
    }
    nloc = mine > 0u ? mine : 1u; nx = cnt > 0u ? cnt : 1u;
}

__device__ __forceinline__ void xcd_barrier(const XcdBarrier& b) {
    asm volatile("s_waitcnt vmcnt(0)" ::: "memory");
    __syncthreads();
    if (b.wid == 0 && xb_lane0()) {
        unsigned* bar = b.bar;
        __builtin_amdgcn_s_waitcnt(0);
        unsigned nloc = b.st[0], nx = b.st[1];
        if (nloc == 0u) { xcd_barrier_complete(bar, b.x, nloc, nx); b.st[0] = nloc; b.st[1] = nx; }
        const unsigned old = xb_add(&bar[XB_XSUB(b.x)], 1u);
        const unsigned gen = old / nloc;
        if (old + 1u == (gen + 1u) * nloc) {
            __builtin_amdgcn_fence(__ATOMIC_RELEASE, "agent");
            asm volatile("s_waitcnt vmcnt(0)" ::: "memory");
            const unsigned og = xb_add(&bar[XB_TOP], 1u);
            const unsigned tg = og / nx;
            if (og + 1u == (tg + 1u) * nx) xb_add(&bar[XB_TOPGEN], 1u);
            else XB_SPIN(xb_ld(&bar[XB_TOPGEN]) == tg, bar);
            __builtin_amdgcn_fence(__ATOMIC_ACQUIRE, "agent");
            xb_add(&bar[XB_XGEN(b.x)], 1u);
            asm volatile("s_waitcnt vmcnt(0)" ::: "memory");
        } else {
            XB_SPIN(xb_ld(&bar[XB_XGEN(b.x)]) == gen, bar);
            __builtin_amdgcn_fence(__ATOMIC_ACQUIRE, "agent");
            asm volatile("s_waitcnt vmcnt(0)" ::: "memory");
        }
    }
    __syncthreads();
}

struct Args {
    const float* in[20]; float* out; unsigned char* ws;
    float invA[16]; float invB[8];
};

__global__ void __launch_bounds__(NWAVES * 64) hybrid_fwd(Args args) {
    extern __shared__ __attribute__((aligned(16))) unsigned char lds_raw[];
    cg::grid_group grid = cg::this_grid();
    LAS unsigned char* lds = (LAS unsigned char*)lds_raw;
    const int wid = __builtin_amdgcn_readfirstlane((int)threadIdx.x >> 6);
#define fresh_lane() lane_opaque()
    const int lane = fresh_lane(), tid = wid * 64 + lane;
    const int G = gridDim.x, bx = blockIdx.x;
    unsigned char* ws = args.ws;
    volatile LAS unsigned* MISC = (volatile LAS unsigned*)(lds + LDS_BYTES - 64);
    if (tid < 16) MISC[tid] = 0u;
    __syncthreads();
    const XcdBarrier bar = xcd_barrier_post((unsigned*)(ws + OFF_BAR), MISC + 8, wid);
    if (G == 0x7fffffff) grid.sync();
    const float* x = args.in[0];
    float* out = args.out;
    float* rowss1 = (float*)(ws + OFF_RS1); float* rowss2 = (float*)(ws + OFF_RS2);
    float* gtab = (float*)(ws + OFF_GTAB); float* ropeA = (float*)(ws + OFF_ROPEA); float* ropeB = (float*)(ws + OFF_ROPEB);
    bf16* W1A = (bf16*)(ws + WS_W1A); bf16* W1B = (bf16*)(ws + WS_W1B); bf16* WIN = (bf16*)(ws + WS_WIN); bf16* WOUT = (bf16*)(ws + WS_WOUT);
    bf16* W2A = (bf16*)(ws + WS_W2A); bf16* W2B = (bf16*)(ws + WS_W2B);
    bf16* XN = (bf16*)(ws + WS_XN); bf16* ACT = (bf16*)(ws + WS_ACT); bf16* QKV = (bf16*)(ws + WS_ACT); bf16* MIX = (bf16*)(ws + WS_MIX);

#ifndef REP_P0
#define REP_P0 1
#endif
#ifndef REP_DIFF
#define REP_DIFF 1
#endif
#ifndef REP_DIL
#define REP_DIL 1
#endif
#define REP_G1 1
#define REP_SHADOW 1
#define REP_G2 1
#define REP_G3 1
#define REP_G5 1
#define REP_G6 1
#define REP_G7 1
    for (int rep = 0; rep < REP_P0; ++rep) {
        LAS float* scr = (LAS float*)(lds + wid * 16384);
        const int gw = bx * NWAVES + wid, NGW = G * NWAVES;
        constexpr int I_FA = (DM / 64) * (2 * DFF / 32), I_FB = (DFF / 64) * (DM / 32), I_IN = (DM / 64) * (INW / 32), I_OUT = (DM / 64) * (DM / 32);
        tr_matrix<true, 2>(args.in[2], DM, 2 * DFF, W1A, LDK, scr, gw, NGW, lane, args.in[1]);
        tr_matrix<true, 2>(args.in[18], DM, 2 * DFF, W2A, LDK, scr, gw, NGW, lane, args.in[17]);
        float* rowss0 = (float*)(ws + OFF_RS0);
        for (int m = gw; m < MROWS; m += NGW) {
            const f32x4* xr = (const f32x4*)(x + (size_t)m * DM) + lane; f32x4 v[8]; float s = 0.f;
#pragma unroll
            for (int j = 0; j < 8; ++j) { v[j] = xr[64 * j]; s += (v[j][0] * v[j][0] + v[j][1] * v[j][1]) + (v[j][2] * v[j][2] + v[j][3] * v[j][3]); }
            s = wave_sum(s, lane); if (lane == 0) rowss0[m] = s;
            v2u* o8 = (v2u*)(XN + (size_t)m * LDK) + lane;
#pragma unroll
            for (int j = 0; j < 8; ++j) { v2u w; w.x = pk2(v[j][0], v[j][1]); w.y = pk2(v[j][2], v[j][3]); o8[64 * j] = w; }
        }
        const int gt = bx * (NWAVES * 64) + tid, NGT = G * NWAVES * 64;
        for (int i = gt; i < 2 * MROWS; i += NGT) rowss1[i] = 0.f;
        if (gt < 512) { const int t = gt >> 7, d = gt & 127; gtab[gt] = t == 0 ? args.in[6][d] : (t == 1 ? args.in[7][d] : (t == 2 ? args.in[8][d & 63] : args.in[9][d & 63])); }
        for (int i = gt; i < 4096 * 24; i += NGT) {
            const int s = i / 24, k = i % 24; const float inv = k < 16 ? args.invA[k] : args.invB[k - 16];
            const float ang = (float)s * inv; double rev = (double)ang * 0.15915494309189535; rev -= floor(rev);
            const float cs = __builtin_amdgcn_cosf((float)rev), sn = __builtin_amdgcn_sinf((float)rev);
            if (k < 16) { ropeA[s * 16 + k] = cs; ropeA[4096 * 16 + s * 16 + k] = sn; } else { ropeB[s * 8 + k - 16] = cs; ropeB[4096 * 8 + s * 8 + k - 16] = sn; }
        }
    }
    xcd_barrier(bar);

    { pg8::Gemm g{XN, W1A, MROWS, 2 * DFF, DM, LDK}; pg8::StaticOrder S; S.init(MROWS, 2 * DFF, G, bx);
      pg8::EpiSwiGLU E{ACT, DFF, (const float*)(ws + OFF_RS0)};
      pg8::gemm_phase<pg8::EpiSwiGLU, pg8::StaticOrder, true, true>(lds, g, S, E, wid); }
    {
        constexpr int NU = (MROWS / 256) * (2 * DFF / 256);
        const int rounds = (NU + G - 1) / G; int first_idle = NU - (rounds - 1) * G, nidle = G - first_idle;
        if (nidle <= 0) { first_idle = 0; nidle = G; }
        if (bx >= first_idle) {
            LAS float* scr = (LAS float*)(lds + wid * 16384); const int lane_c = fresh_lane();
            const int gw = (bx - first_idle) * NWAVES + wid, NGW = nidle * NWAVES;
            for (int rep = 0; rep < REP_SHADOW; ++rep) {
            tr_matrix<false, 2>(args.in[3], DFF, DM, W1B, DFF, scr, gw, NGW, lane_c, nullptr);
            tr_matrix<false, 2>(args.in[5], DM, INW, WIN, LDK, scr, gw, NGW, lane_c, args.in[4]);
            tr_matrix<false, 2>(args.in[16], DM, DM, WOUT, LDK, scr, gw, NGW, lane_c, nullptr);
            }
        }
    }
    xcd_barrier(bar);
    { pg8::Gemm g{ACT, W1B, MROWS, DM, DFF, DFF}; pg8::StaticOrder S; S.init(MROWS, DM, G, bx);
      pg8::EpiResid<false, true, false> E{nullptr, nullptr, XN, rowss1, 0.5f};
      pg8::gemm_phase<pg8::EpiResid<false, true, false>, pg8::StaticOrder, true, true>(lds, g, S, E, wid); }
    xcd_barrier(bar);
    { pg8::Gemm g{XN, WIN, MROWS, INW, DM, LDK}; pg8::StaticOrder S; S.init(MROWS, INW, G, bx);
      pg8::EpiQKV E{QKV, rowss1, gtab, ropeA, ropeB, (LAS float*)(lds + XCH_OFF)};
      for (int rep = 0; rep < REP_G3; ++rep)
      pg8::gemm_phase<pg8::EpiQKV, pg8::StaticOrder, true, true>(lds, g, S, E, wid); }
    xcd_barrier(bar);
    {
        const float L2E = 1.4426950408889634f;
        const int lane_a = fresh_lane();
        const float gq = fmaxf(fabsf(args.in[6][lane_a]), fabsf(args.in[6][lane_a + 64])), gk = fmaxf(fabsf(args.in[7][lane_a]), fabsf(args.in[7][lane_a + 64]));
        const float negMA = __builtin_bit_cast(float, __builtin_amdgcn_readfirstlane(__builtin_bit_cast(int, -1.02f * 11.313708498984761f * wave_max(gq, lane_a) * wave_max(gk, lane_a) * L2E)));
        const float negMB = __builtin_bit_cast(float, __builtin_amdgcn_readfirstlane(__builtin_bit_cast(int, -1.02f * 8.0f * wave_max(fabsf(args.in[8][lane_a]), lane_a) * wave_max(fabsf(args.in[9][lane_a]), lane_a) * L2E)));
        const float lam = __builtin_bit_cast(float, __builtin_amdgcn_readfirstlane(__builtin_bit_cast(int, __expf(wave_sum(args.in[10][lane_a] * args.in[11][lane_a], lane_a)) - __expf(wave_sum(args.in[12][lane_a] * args.in[13][lane_a], lane_a)) + 0.2f)));
        {
            const int tid_a = wid * 64 + fresh_lane();
            for (int rep = 0; rep < REP_DIFF; ++rep)
            for (int u = bx; u < 512; u += G) {
                const int bh = u >> 5, qblk = u & 31;
                att::diff_unit((LAS char*)lds, QKV, MIX, bh >> 3, bh & 7, qblk, lam, negMB, args.in[15], tid_a, wid, tid_a & 63);
            }
        }
        {
            const int lane_d = fresh_lane();
            for (int rep = 0; rep < REP_DIL; ++rep)
            for (int wu = bx * NWAVES + wid; wu < 2048; wu += G * NWAVES) {
                const int ib = wu & 7, r16 = (wu >> 3) & 15, h = (wu >> 7) & 7, b = wu >> 10;
                att::dil_unit((LAS char*)lds + wid * att::DIL_WAVE, QKV, MIX, b, h, r16, ib, negMA, args.in[14], lane_d);
            }
        }
    }
    xcd_barrier(bar);
    { pg8::Gemm g{MIX, WOUT, MROWS, DM, DM, LDK}; pg8::StaticOrder S; S.init(MROWS, DM, G, bx);
      pg8::EpiResid<false, true, false> E{nullptr, nullptr, XN, rowss2, 1.0f};
      pg8::gemm_phase<pg8::EpiResid<false, true, false>, pg8::StaticOrder, true, true>(lds, g, S, E, wid); }
    xcd_barrier(bar);
    { pg8::Gemm g{XN, W2A, MROWS, 2 * DFF, DM, LDK}; pg8::StaticOrder S; S.init(MROWS, 2 * DFF, G, bx);
      pg8::EpiSwiGLU E{ACT, DFF, rowss2};
      for (int rep = 0; rep < REP_G6; ++rep)
      pg8::gemm_phase<pg8::EpiSwiGLU, pg8::StaticOrder, true, true>(lds, g, S, E, wid); }
    {
        constexpr int NU = (MROWS / 256) * (2 * DFF / 256);
        const int rounds = (NU + G - 1) / G; int first_idle = NU - (rounds - 1) * G, nidle = G - first_idle;
        if (nidle <= 0) { first_idle = 0; nidle = G; }
        if (bx >= first_idle) tr_matrix<false, 2>(args.in[19], DFF, DM, W2B, DFF, (LAS float*)(lds + wid * 16384), (bx - first_idle) * NWAVES + wid, nidle * NWAVES, fresh_lane(), nullptr);
    }
    xcd_barrier(bar);
    { pg8::Gemm g{ACT, W2B, MROWS, DM, DFF, DFF}; pg8::StaticOrder S; S.init(MROWS, DM, G, bx);
      pg8::EpiResid<false, false, true> E{nullptr, out, XN, nullptr, 0.5f};
      pg8::gemm_phase<pg8::EpiResid<false, false, true>, pg8::StaticOrder, true, true>(lds, g, S, E, wid); }
}

extern "C" void kernel_launch(void* const* d_in, const int* in_sizes, int n_in, void* d_out, int out_size, void* d_ws, size_t ws_size, hipStream_t stream) {
    static int grid = 0;
    if (grid == 0) {
        if (n_in != 20 || in_sizes[0] != MROWS * DM || out_size != MROWS * DM || ws_size < WS_END) {
            fprintf(stderr, "kernel_launch: unexpected shapes (n_in %d, in0 %d, out %d, ws %zu < %zu)\n", n_in, n_in > 0 ? in_sizes[0] : -1, out_size, ws_size, (size_t)WS_END); grid = -1; return; }
        int dev = 0, cus = 0, per_cu = 0;
        (void)hipGetDevice(&dev); (void)hipDeviceGetAttribute(&cus, hipDeviceAttributeMultiprocessorCount, dev);
        if (hipFuncSetAttribute((const void*)hybrid_fwd, hipFuncAttributeMaxDynamicSharedMemorySize, LDS_BYTES) != hipSuccess) { fprintf(stderr, "kernel_launch: hipFuncSetAttribute failed\n"); grid = -1; return; }
        if (hipOccupancyMaxActiveBlocksPerMultiprocessor(&per_cu, (const void*)hybrid_fwd, NWAVES * 64, LDS_BYTES) != hipSuccess || per_cu < 1) { fprintf(stderr, "kernel_launch: occupancy query says %d\n", per_cu); per_cu = 1; }
        (void)hipGetLastError();
        grid = cus * per_cu;
    }
    if (grid < 0) return;
    Args a{};
    for (int i = 0; i < 20; ++i) a.in[i] = (const float*)d_in[i];
    a.out = (float*)d_out; a.ws = (unsigned char*)d_ws;
    for (int i = 0; i < 16; ++i) a.invA[i] = (float)pow(500000.0, -(double)i / 16.0);
    for (int i = 0; i < 8; ++i) a.invB[i] = (float)pow(500000.0, -(double)i / 8.0);
    if (hipMemsetAsync((char*)d_ws + OFF_BAR, 0, BAR_BYTES, stream) != hipSuccess) { fprintf(stderr, "kernel_launch: memset failed\n"); return; }
    void* kargs[] = {&a};
    hipError_t e = hipLaunchCooperativeKernel((const void*)hybrid_fwd, dim3(grid), dim3(NWAVES * 64), kargs, LDS_BYTES, stream);
    if (e != hipSuccess) fprintf(stderr, "kernel_launch: cooperative launch failed: %s (grid %d)\n", hipGetErrorString(e), grid);
}
```

```cpp
#include <hip/hip_runtime.h>
#include <hip/hip_cooperative_groups.h>
#include <cstdio>
#include <cstdint>
#include <cmath>
namespace cg = cooperative_groups;
__device__ __forceinline__ int lane_opaque() { unsigned z = 0u; asm volatile("" : "+v"(z)); return (int)__builtin_amdgcn_mbcnt_hi(~0u, __builtin_amdgcn_mbcnt_lo(~0u, z)); }
__device__ __forceinline__ float shflx(float v, int mask, int lane) { return __builtin_bit_cast(float, __builtin_amdgcn_ds_bpermute((lane ^ mask) << 2, __builtin_bit_cast(int, v))); }
namespace pg8 {
#define PG8_LAS __attribute__((address_space(3)))
typedef unsigned short bf16_t;
typedef short bf16x8 __attribute__((ext_vector_type(8)));
typedef float f32x4 __attribute__((ext_vector_type(4)));
typedef unsigned u32x4 __attribute__((ext_vector_type(4)));
constexpr int BM = 256, BK = 64, HALF = 128, HTB = HALF * BK * 2  , STAGE_BYTES = 8 * HTB, NXCD = 8, WGM = 8;

__host__ __device__ __forceinline__ int lds_byte(int r, int c) { const int st = (r >> 4) * 2 + (c >> 5), rr = r & 15, cc = c & 31, ob = rr * 64 + cc * 2; return st * 1024 + (ob ^ (((ob >> 9) & 1) << 5)); }
__host__ __device__ __forceinline__ void stage_rc(int b, int& R, int& C) { const int st = b / 1024, sb = b % 1024, swz = sb ^ (((sb >> 9) & 1) << 5); R = (st >> 1) * 16 + swz / 64; C = (st & 1) * 32 + (swz % 64) / 2; }
__host__ __device__ __forceinline__ int perm32(int rho) { const int n = rho >> 4, i = rho & 15; return 8 * (i >> 2) + 4 * n + (i & 3); }

struct Unit { int pm, pn; };
struct Gemm { const bf16_t* A; const bf16_t* Bt; int M, N, K, ld; };

struct StaticOrder {
    int nM, nN, nwg, G, c;
    __host__ __device__ void init(int M, int N, int G_, int c_) { nM = M / BM; nN = N / BM; nwg = nM * nN; G = G_; c = c_; }
    __host__ __device__ bool next(int i, Unit& u) const {
        const long L = (long)i * G + c; if (L >= nwg) return false;
        int wgid = (int)L; { const int q = nwg / NXCD, r = nwg % NXCD, xcd = wgid % NXCD, off = wgid / NXCD; wgid = (xcd < r ? xcd * (q + 1) : r * (q + 1) + (xcd - r) * q) + off; }
        const int nig = WGM * nN, gid = wgid / nig, fm = gid * WGM, gsz = (nM - fm) < WGM ? (nM - fm) : WGM;
        u.pm = fm + ((wgid % nig) % gsz); u.pn = (wgid % nig) / gsz; return true;
    }
    __device__ __forceinline__ void a_ready(const Unit&) const {}
    __device__ __forceinline__ void done(const Unit&) const {}
};

__device__ __forceinline__ unsigned cvt_pk_bf16(float lo, float hi) { unsigned r; asm volatile("v_cvt_pk_bf16_f32 %0, %1, %2" : "=v"(r) : "v"(lo), "v"(hi)); return r; }
typedef float f32x2 __attribute__((ext_vector_type(2)));

typedef unsigned u32x2 __attribute__((ext_vector_type(2)));
constexpr int LDK = 2176, LDQ = 6272;
__device__ __forceinline__ float fast_silu(float g) { return g * __builtin_amdgcn_rcpf(1.0f + __expf(-g)); }

struct EpiSwiGLU {
    static constexpr bool PERM = true, AFTER_DRAIN = false;
    bf16_t* O; int ldc; const float* rowss;
    __device__ __forceinline__ void operator()(f32x4 (&acc)[2][2][4][2], const Unit& u, int wr, int wc, int fr, int fq) const {
        const int row0 = u.pm * BM + wr * 64 + fr; const int col0 = u.pn * HALF + wc * 32 + 8 * fq;
        float rsv[2][4];
#pragma unroll
        for (int ai = 0; ai < 2; ++ai)
#pragma unroll
            for (int m = 0; m < 4; ++m) rsv[ai][m] = rowss ? rowss[row0 + ai * HALF + m * 16] : 0.f;
#pragma unroll
        for (int ai = 0; ai < 2; ++ai)
#pragma unroll
            for (int m = 0; m < 4; ++m) rsv[ai][m] = rowss ? __builtin_amdgcn_rsqf(rsv[ai][m] * (1.0f / 2048.0f) + 1e-6f) : 1.0f;
        asm volatile("" : "+v"(rsv[0][0]), "+v"(rsv[0][1]), "+v"(rsv[0][2]), "+v"(rsv[0][3]), "+v"(rsv[1][0]), "+v"(rsv[1][1]), "+v"(rsv[1][2]), "+v"(rsv[1][3]));
#pragma unroll
        for (int ai = 0; ai < 2; ++ai)
#pragma unroll
            for (int m = 0; m < 4; ++m) {
                const int row = row0 + ai * HALF + m * 16;
                const float rs = rsv[ai][m];
                f32x4 g0 = acc[ai][0][m][0] * rs, g1 = acc[ai][0][m][1] * rs, u0 = acc[ai][1][m][0] * rs, u1 = acc[ai][1][m][1] * rs;
                u32x4 w;
                w.x = cvt_pk_bf16(fast_silu(g0[0]) * u0[0], fast_silu(g0[1]) * u0[1]); w.y = cvt_pk_bf16(fast_silu(g0[2]) * u0[2], fast_silu(g0[3]) * u0[3]);
                w.z = cvt_pk_bf16(fast_silu(g1[0]) * u1[0], fast_silu(g1[1]) * u1[1]); w.w = cvt_pk_bf16(fast_silu(g1[2]) * u1[2], fast_silu(g1[3]) * u1[3]);
                *(u32x4*)(O + (size_t)row * ldc + col0) = w;
            }
    }
};

template <bool BASE_F32, bool WRITE_XN, bool WRITE_OUT> struct EpiResid {
    static constexpr bool PERM = false, AFTER_DRAIN = false;
    const float* base; float* out; bf16_t* xn; float* rowss; float alpha;
    __device__ __forceinline__ void operator()(f32x4 (&acc)[2][2][4][2], const Unit& u, int wr, int wc, int fr, int fq) const {
        const int row0 = u.pm * BM + wr * 64 + fr; const int col0 = u.pn * BM + wc * 32 + 4 * fq;
#pragma unroll
        for (int ai = 0; ai < 2; ++ai) {
            f32x4 bpre[4][2][2];
#pragma unroll
            for (int m = 0; m < 4; ++m) { const int row = row0 + ai * HALF + m * 16;
#pragma unroll
                for (int bj = 0; bj < 2; ++bj)
#pragma unroll
                    for (int n = 0; n < 2; ++n) {
                        if (BASE_F32) bpre[m][bj][n] = *(const f32x4*)(base + (size_t)row * 2048 + col0 + bj * HALF + n * 16);
                        else { const u32x2 w = *(const u32x2*)(xn + (size_t)row * LDK + col0 + bj * HALF + n * 16);
                               bpre[m][bj][n] = (f32x4){__builtin_bit_cast(float, w.x << 16), __builtin_bit_cast(float, w.x & 0xffff0000u), __builtin_bit_cast(float, w.y << 16), __builtin_bit_cast(float, w.y & 0xffff0000u)}; }
                    } }
#pragma unroll
            for (int m = 0; m < 4; ++m) {
                const int row = row0 + ai * HALF + m * 16; float ss = 0.f;
#pragma unroll
                for (int bj = 0; bj < 2; ++bj)
#pragma unroll
                    for (int n = 0; n < 2; ++n) {
                        const f32x4 o = bpre[m][bj][n] + acc[ai][bj][m][n] * alpha;
                        if (WRITE_OUT) *(f32x4*)(out + (size_t)row * 2048 + col0 + bj * HALF + n * 16) = o;
                        if (WRITE_XN) {
                            ss += (o[0] * o[0] + o[1] * o[1]) + (o[2] * o[2] + o[3] * o[3]);
                            u32x2 w; w.x = cvt_pk_bf16(o[0], o[1]); w.y = cvt_pk_bf16(o[2], o[3]);
                            *(u32x2*)(xn + (size_t)row * LDK + col0 + bj * HALF + n * 16) = w;
                        }
                    }
                if (WRITE_XN) { ss += shflx(ss, 16, fq * 16 + fr); ss += shflx(ss, 32, fq * 16 + fr); if (fq == 0) atomicAdd(rowss + row, ss); }
            }
            asm volatile("" ::: "memory");
        }
    }
};

struct EpiQKV {
    static constexpr bool PERM = false, AFTER_DRAIN = false;
    bf16_t* O; const float* rowss; const float* gtab;
    const float* ropeA; const float* ropeB;
    PG8_LAS float* xch;
    __device__ __forceinline__ void operator()(f32x4 (&acc)[2][2][4][2], const Unit& u, int wr, int wc, int, int) const {
        const int lane_q = lane_opaque(), fr = lane_q & 15, fq = lane_q >> 4;
        const int region = u.pn >> 2;
        const int row0 = u.pm * BM + wr * 64 + fr;
#pragma unroll
        for (int ai = 0; ai < 2; ++ai)
#pragma unroll
            for (int m = 0; m < 4; ++m) {
                const float rs = __builtin_amdgcn_rsqf(rowss[row0 + ai * HALF + m * 16] * (1.0f / 2048.0f) + 1e-6f);
#pragma unroll
                for (int bj = 0; bj < 2; ++bj)
#pragma unroll
                    for (int n = 0; n < 2; ++n) acc[ai][bj][m][n] = acc[ai][bj][m][n] * rs;
            }
        const bool isv = (region == 2) || (region == 5);
        if (!isv) {
            const bool isA = region < 2;
            const bool do_rope = isA ? (wc == 0) : ((wc & 1) == 0);
#pragma unroll
            for (int ai = 0; ai < 2; ++ai)
#pragma unroll
                for (int m = 0; m < 4; ++m)
#pragma unroll
                    for (int bj = 0; bj < 2; ++bj) {
                        const f32x4 a = acc[ai][bj][m][0], b = acc[ai][bj][m][1];
                        float s = ((a[0] * a[0] + a[1] * a[1]) + (a[2] * a[2] + a[3] * a[3])) + ((b[0] * b[0] + b[1] * b[1]) + (b[2] * b[2] + b[3] * b[3]));
                        s += shflx(s, 16, fq * 16 + fr); s += shflx(s, 32, fq * 16 + fr);
                        if (fq == 0) xch[((ai * HALF + wr * 64 + m * 16 + fr) * 2 + bj) * 4 + wc] = s;
                    }
            asm volatile("s_waitcnt lgkmcnt(0)" ::: "memory"); __builtin_amdgcn_s_barrier(); asm volatile("" ::: "memory");
            const float* gptr = gtab + (region < 2 ? region : region - 1) * 128;
            const int dbase = isA ? wc * 32 : (wc & 1) * 32;
            f32x4 gv[2]; gv[0] = *(const f32x4*)(gptr + dbase + 4 * fq); gv[1] = *(const f32x4*)(gptr + dbase + 16 + 4 * fq);
            const float qs = region == 0 ? (0.08838834764831845f * 1.4426950408889634f) : (region == 3 ? (0.125f * 1.4426950408889634f) : 1.0f);
#pragma unroll
            for (int ai = 0; ai < 2; ++ai) {
                f32x4 csv[4], snv[4];
                if (do_rope) {
#pragma unroll
                    for (int m = 0; m < 4; ++m) { const int spos = (u.pm * BM + ai * HALF + wr * 64 + m * 16 + fr) & 4095;
                        const float* rp = isA ? ropeA + spos * 16 + 4 * fq : ropeB + spos * 8 + 4 * (fq & 1);
                        csv[m] = *(const f32x4*)rp; snv[m] = *(const f32x4*)(rp + (isA ? 4096 * 16 : 4096 * 8)); }
                }
#pragma unroll
                for (int m = 0; m < 4; ++m) {
                    const int rl = ai * HALF + wr * 64 + m * 16 + fr;
#pragma unroll
                    for (int bj = 0; bj < 2; ++bj) {
                        const f32x4 p = *(const PG8_LAS f32x4*)(xch + (rl * 2 + bj) * 4);
                        float rn;
                        if (isA) rn = __builtin_amdgcn_rsqf(((p[0] + p[1]) + (p[2] + p[3])) * (1.0f / 128.0f) + 1e-6f);
                        else rn = __builtin_amdgcn_rsqf(((wc < 2) ? (p[0] + p[1]) : (p[2] + p[3])) * (1.0f / 64.0f) + 1e-6f);
                        f32x4 v0 = acc[ai][bj][m][0] * rn * gv[0], v1 = acc[ai][bj][m][1] * rn * gv[1];
                        if (isA) {
                            if (do_rope) {
                                const f32x4 cs = csv[m], sn = snv[m];
                                const f32x4 x1 = v0, x2 = v1; v0 = x1 * cs - x2 * sn; v1 = x2 * cs + x1 * sn;
                            }
                        } else {
                            if (do_rope) {
                                const f32x4 cs = csv[m], sn = snv[m];
                                f32x4 pt; pt[0] = shflx(v0[0], 32, fq * 16 + fr); pt[1] = shflx(v0[1], 32, fq * 16 + fr); pt[2] = shflx(v0[2], 32, fq * 16 + fr); pt[3] = shflx(v0[3], 32, fq * 16 + fr);
                                v0 = (fq < 2) ? (v0 * cs - pt * sn) : (v0 * cs + pt * sn);
                            }
                        }
                        acc[ai][bj][m][0] = v0 * qs; acc[ai][bj][m][1] = v1 * qs;
                    }
                }
                asm volatile("" ::: "memory");
            }
        }
        const int col0 = u.pn * BM + wc * 32 + 4 * fq;
#pragma unroll
        for (int ai = 0; ai < 2; ++ai)
#pragma unroll
            for (int m = 0; m < 4; ++m) { bf16_t* rowp = O + (size_t)(row0 + ai * HALF + m * 16) * LDQ + col0;
#pragma unroll
                for (int bj = 0; bj < 2; ++bj)
#pragma unroll
                    for (int n = 0; n < 2; ++n) { const f32x4 v = acc[ai][bj][m][n]; u32x2 w; w.x = cvt_pk_bf16(v[0], v[1]); w.y = cvt_pk_bf16(v[2], v[3]); *(u32x2*)(rowp + bj * HALF + n * 16) = w; } }
    }
};
template <class Epi, class Sched, bool ALIGN_EPI = false, bool SP2 = false>
__device__ __forceinline__ void gemm_phase(PG8_LAS unsigned char* lds, const Gemm g, const Sched& S, const Epi& E, const int wid_s) {
    const int lane_ = lane_opaque();
    const int tid = wid_s * 64 + lane_, wid = wid_s, lane = tid & 63, wr = wid >> 2, wc = wid & 3, fr = lane & 15, fq = lane >> 4;
    const int K = g.ld, nt = g.K / BK;
    unsigned voffA[2], voffB[2];
#pragma unroll
    for (int i = 0; i < 2; ++i) { int R, C; stage_rc(tid * 16 + i * 8192, R, C); const int Rb = Epi::PERM ? ((R & ~31) + perm32(R & 31)) : R;
        voffA[i] = (unsigned)(R * K + C) * 2u; voffB[i] = (unsigned)(Rb * K + C) * 2u; }
    const size_t kstep = (size_t)(BK * 2);
    const size_t hstep = (size_t)HALF * K * 2;
    const size_t tstep = 2 * hstep;
    const unsigned ldsw = (unsigned)wid * 1024u;
    const int aoff = lds_byte(wr * 64 + fr, fq * 8), boff = lds_byte(wc * 32 + fr, fq * 8);
#define PG8_SA(b, h) (((b) * 2 + (h)) * HTB)
#define PG8_SB(b, h) ((4 + (b) * 2 + (h)) * HTB)
#define PG8_STAGE(bufoff, gbase, voff) do { _Pragma("unroll") for (int _i = 0; _i < 2; ++_i) \
        __builtin_amdgcn_global_load_lds((const unsigned*)((const char*)(gbase) + (voff)[_i]), (PG8_LAS unsigned*)(lds + (bufoff) + ldsw + _i * 8192), 16, 0, 0); } while (0)
#define PG8_LDA(dst, b, h) do { _Pragma("unroll") for (int m = 0; m < 4; ++m) _Pragma("unroll") for (int k = 0; k < 2; ++k) dst[m][k] = *(const PG8_LAS bf16x8*)(lds + PG8_SA(b, h) + aoff + m * 2048 + k * 1024); } while (0)
#define PG8_LDB(dst, b, h) do { _Pragma("unroll") for (int n = 0; n < 2; ++n) _Pragma("unroll") for (int k = 0; k < 2; ++k) dst[n][k] = *(const PG8_LAS bf16x8*)(lds + PG8_SB(b, h) + boff + n * 2048 + k * 1024); } while (0)
#define PG8_MMA(ai, bj, At, Bt) do { __builtin_amdgcn_s_setprio(1); _Pragma("unroll") for (int m = 0; m < 4; ++m) _Pragma("unroll") for (int n = 0; n < 2; ++n) _Pragma("unroll") for (int k = 0; k < 2; ++k) \
        acc[ai][bj][m][n] = __builtin_amdgcn_mfma_f32_16x16x32_bf16(Bt[n][k], At[m][k], acc[ai][bj][m][n], 0, 0, 0); __builtin_amdgcn_s_setprio(0); } while (0)
#define PG8_WAIT_V(n) asm volatile("s_waitcnt vmcnt(" #n ")" ::: "memory")
#define PG8_WAIT_L(n) asm volatile("s_waitcnt lgkmcnt(" #n ")" ::: "memory")
#define PG8_BAR __builtin_amdgcn_s_barrier()
#define PG8_SCHED __builtin_amdgcn_sched_barrier(0)
    Unit cur, nxt; int ui = 0;
    if (!S.next(0, cur)) return;
    f32x4 acc[2][2][4][2];
#pragma unroll
    for (int a = 0; a < 2; ++a)
#pragma unroll
        for (int b = 0; b < 2; ++b)
#pragma unroll
            for (int m = 0; m < 4; ++m)
#pragma unroll
                for (int n = 0; n < 2; ++n) acc[a][b][m][n] = (f32x4){0.f, 0.f, 0.f, 0.f};
    bf16x8 At[4][2], B0[2][2], B1[2][2];
    const char* cA = (const char*)g.A + (size_t)cur.pm * tstep; const char* cB = (const char*)g.Bt + (size_t)cur.pn * tstep;
    S.a_ready(cur);
    if constexpr (SP2) {
        PG8_STAGE(PG8_SB(0, 0), cB, voffB); PG8_STAGE(PG8_SB(0, 1), cB + hstep, voffB); PG8_STAGE(PG8_SA(0, 0), cA, voffA); PG8_STAGE(PG8_SA(0, 1), cA + hstep, voffA);
        if (wr == 1) PG8_BAR;
        PG8_WAIT_V(2); PG8_BAR;
        PG8_STAGE(PG8_SB(1, 0), cB + kstep, voffB); PG8_STAGE(PG8_SA(1, 0), cA + kstep, voffA); PG8_STAGE(PG8_SB(1, 1), cB + hstep + kstep, voffB);
        PG8_WAIT_V(6); PG8_BAR;
    } else {
        PG8_STAGE(PG8_SB(0, 0), cB, voffB); PG8_STAGE(PG8_SA(0, 0), cA, voffA); PG8_STAGE(PG8_SB(0, 1), cB + hstep, voffB); PG8_STAGE(PG8_SA(0, 1), cA + hstep, voffA);
        if (wr == 1) PG8_BAR;
        PG8_WAIT_V(4); PG8_BAR;
        PG8_STAGE(PG8_SB(1, 0), cB + kstep, voffB); PG8_STAGE(PG8_SA(1, 0), cA + kstep, voffA); PG8_STAGE(PG8_SB(1, 1), cB + hstep + kstep, voffB);
        PG8_WAIT_V(6); PG8_BAR;
    }
    for (;;) {
        const bool has_next = S.next(ui + 1, nxt);
        const char* nA = has_next ? (const char*)g.A + (size_t)nxt.pm * tstep : cA; const char* nB = has_next ? (const char*)g.Bt + (size_t)nxt.pn * tstep : cB;
        for (int t = 0; t < nt; t += 2) {
            const bool last = (t == nt - 2);
            const char* a1 = cA + (size_t)(t + 1) * kstep;
            const char* a2 = last ? nA : cA + (size_t)(t + 2) * kstep; const char* b2 = last ? nB : cB + (size_t)(t + 2) * kstep;
            const char* a3 = a2 + kstep; const char* b3 = b2 + kstep;
            if (last && has_next) S.a_ready(nxt);
            if constexpr (SP2) {
            PG8_LDB(B0, 0, 0); PG8_LDB(B1, 0, 1); PG8_SCHED; PG8_LDA(At, 0, 0); PG8_STAGE(PG8_SA(1, 1), a1 + hstep, voffA);
            PG8_WAIT_V(8); PG8_WAIT_L(0); PG8_BAR; PG8_MMA(0, 0, At, B0); PG8_MMA(0, 1, At, B1); PG8_BAR; PG8_SCHED;
            PG8_LDA(At, 0, 1); PG8_STAGE(PG8_SB(0, 0), b2, voffB); PG8_STAGE(PG8_SB(0, 1), b2 + hstep, voffB); PG8_STAGE(PG8_SA(0, 0), a2, voffA);
            PG8_WAIT_V(8); PG8_WAIT_L(0); PG8_BAR; PG8_MMA(1, 0, At, B0); PG8_MMA(1, 1, At, B1); PG8_BAR; PG8_SCHED;
            PG8_LDB(B0, 1, 0); PG8_LDB(B1, 1, 1); PG8_SCHED; PG8_LDA(At, 1, 0); PG8_STAGE(PG8_SA(0, 1), a2 + hstep, voffA);
            PG8_WAIT_V(8); PG8_WAIT_L(0); PG8_BAR; PG8_MMA(0, 0, At, B0); PG8_MMA(0, 1, At, B1); PG8_BAR; PG8_SCHED;
            PG8_LDA(At, 1, 1); PG8_STAGE(PG8_SB(1, 0), b3, voffB); PG8_STAGE(PG8_SB(1, 1), b3 + hstep, voffB); PG8_STAGE(PG8_SA(1, 0), a3, voffA);
            PG8_WAIT_V(8); PG8_WAIT_L(0); PG8_BAR; PG8_MMA(1, 0, At, B0); PG8_MMA(1, 1, At, B1); PG8_BAR; PG8_SCHED;
            } else {
            PG8_LDB(B0, 0, 0); PG8_SCHED; PG8_LDA(At, 0, 0); PG8_STAGE(PG8_SA(1, 1), a1 + hstep, voffA);
            PG8_WAIT_L(8); PG8_BAR; PG8_WAIT_L(0); PG8_MMA(0, 0, At, B0); PG8_BAR; PG8_SCHED;
            PG8_LDB(B1, 0, 1); PG8_STAGE(PG8_SB(0, 0), b2, voffB);
            PG8_BAR; PG8_WAIT_L(0); PG8_MMA(0, 1, At, B1); PG8_BAR;
            PG8_LDA(At, 0, 1); PG8_STAGE(PG8_SA(0, 0), a2, voffA);
            PG8_BAR; PG8_WAIT_L(0); PG8_MMA(1, 0, At, B0); PG8_BAR; PG8_SCHED;
            PG8_STAGE(PG8_SB(0, 1), b2 + hstep, voffB);
            PG8_WAIT_V(6); PG8_BAR; PG8_MMA(1, 1, At, B1); PG8_BAR;
            PG8_LDB(B0, 1, 0); PG8_SCHED; PG8_LDA(At, 1, 0); PG8_STAGE(PG8_SA(0, 1), a2 + hstep, voffA);
            PG8_WAIT_L(8); PG8_BAR; PG8_WAIT_L(0); PG8_MMA(0, 0, At, B0); PG8_BAR; PG8_SCHED;
            PG8_LDB(B1, 1, 1); PG8_STAGE(PG8_SB(1, 0), b3, voffB);
            PG8_BAR; PG8_WAIT_L(0); PG8_MMA(0, 1, At, B1); PG8_BAR;
            PG8_LDA(At, 1, 1); PG8_STAGE(PG8_SA(1, 0), a3, voffA);
            PG8_BAR; PG8_WAIT_L(0); PG8_MMA(1, 0, At, B0); PG8_BAR; PG8_SCHED;
            PG8_STAGE(PG8_SB(1, 1), b3 + hstep, voffB);
            PG8_WAIT_V(6); PG8_BAR; PG8_MMA(1, 1, At, B1); PG8_BAR;
            }
        }
        if constexpr (ALIGN_EPI) { if (wr == 0) PG8_BAR; }
        if constexpr (!Epi::AFTER_DRAIN) { E(acc, cur, wr, wc, fr, fq); S.done(cur); }
        if (!has_next) break;
#pragma unroll
        for (int a = 0; a < 2; ++a)
#pragma unroll
            for (int b = 0; b < 2; ++b)
#pragma unroll
                for (int m = 0; m < 4; ++m)
#pragma unroll
                    for (int n = 0; n < 2; ++n) acc[a][b][m][n] = (f32x4){0.f, 0.f, 0.f, 0.f};
        cur = nxt; cA = nA; cB = nB; ++ui;
        if constexpr (ALIGN_EPI) { if (wr == 1) PG8_BAR; }
    }
    PG8_WAIT_V(0);
    if constexpr (!ALIGN_EPI) { if (wr == 0) PG8_BAR; }
    PG8_BAR;
    if constexpr (Epi::AFTER_DRAIN) { E.fused(acc, cur, wr, wc, fr, fq, lds, wid, lane); S.done(cur); }
#undef PG8_SA
#undef PG8_SB
#undef PG8_STAGE
#undef PG8_LDA
#undef PG8_LDB
#undef PG8_MMA
#undef PG8_WAIT_V
#undef PG8_WAIT_L
#undef PG8_BAR
#undef PG8_SCHED
}
}

namespace att {
#define LAS __attribute__((address_space(3)))
typedef unsigned short bf16_t;
typedef short bf16x8 __attribute__((ext_vector_type(8)));
typedef short s16x4 __attribute__((ext_vector_type(4)));
typedef short v4i16_t __attribute__((ext_vector_type(4)));
typedef float f32x16 __attribute__((ext_vector_type(16)));
typedef float f32x4 __attribute__((ext_vector_type(4)));
typedef unsigned u32x4 __attribute__((ext_vector_type(4)));
typedef unsigned u32x2 __attribute__((ext_vector_type(2)));
typedef float f32x2_t __attribute__((ext_vector_type(2))); typedef __bf16 bf16x2_t __attribute__((ext_vector_type(2)));
constexpr int SEQ = 4096, INW = 6272, DMODEL = 2176;
constexpr int KP = 272, VP = 320;
constexpr int DIFF_TILE = 128 * KP + 128 * VP;
constexpr int DIL_WAVE = 32 * KP + 32 * VP;
__device__ __forceinline__ unsigned cvtpk(float lo, float hi) { f32x2_t v = {lo, hi}; bf16x2_t b = __builtin_convertvector(v, bf16x2_t); return __builtin_bit_cast(unsigned, b); }
__device__ __forceinline__ int crow(int r, int hi) { return (r & 3) + 8 * (r >> 2) + 4 * hi; }
__device__ __forceinline__ s16x4 vtr(const LAS char* p) { return __builtin_bit_cast(s16x4, __builtin_amdgcn_ds_read_tr16_b64_v4i16((LAS v4i16_t*)p)); }
__device__ __forceinline__ bf16x8 packp(const f32x16& p, int s) {
    u32x4 w; w.x = cvtpk(p[8 * s], p[8 * s + 1]); w.y = cvtpk(p[8 * s + 2], p[8 * s + 3]); w.z = cvtpk(p[8 * s + 4], p[8 * s + 5]); w.w = cvtpk(p[8 * s + 6], p[8 * s + 7]);
    return __builtin_bit_cast(bf16x8, w);
}
#define MFMA32(a, b, c) __builtin_amdgcn_mfma_f32_32x32x16_bf16((a), (b), (c), 0, 0, 0)

__device__ __forceinline__ void diff_unit(LAS char* lds, const bf16_t* QKV, bf16_t* MIX, int b, int h, int qblk, float lam, float negM, const float* g_bout, int tid, int wid, int lane) {
    const int c = wid >> 2, r32 = lane & 31, hh = lane >> 5, cb = (lane >> 4) & 1, q_ = (lane & 15) >> 2, p_ = lane & 3;
    const size_t rowbase = (size_t)b * SEQ; const int q0 = qblk * 128 + (wid & 3) * 32;
    bf16x8 qf[4];
    { const bf16_t* qp = QKV + (rowbase + q0 + r32) * INW + 3072 + h * 128 + c * 64 + 8 * hh;
#pragma unroll
      for (int ks = 0; ks < 4; ++ks) qf[ks] = *(const bf16x8*)(qp + 16 * ks); }
    const int srow = tid >> 4, sch = tid & 15;
    const bf16_t* kg = QKV + (rowbase + srow) * INW + 4096 + h * 128 + sch * 8;
    const bf16_t* vg = kg + 1024;
    LAS char* kst = lds + srow * KP + sch * 16; LAS char* vst = lds + 128 * KP + srow * VP + sch * 16;
    f32x16 o[4];
#pragma unroll
    for (int i = 0; i < 4; ++i)
#pragma unroll
        for (int r = 0; r < 16; ++r) o[i][r] = 0.f;
    float lsum = 0.f;
    f32x16 negm;
#pragma unroll
    for (int r = 0; r < 16; ++r) negm[r] = negM;
    u32x4 kr[4], vr[4];
#pragma unroll
    for (int i = 0; i < 4; ++i) { kr[i] = *(const u32x4*)(kg + (size_t)(32 * i) * INW); vr[i] = *(const u32x4*)(vg + (size_t)(32 * i) * INW); }
#pragma unroll
    for (int i = 0; i < 4; ++i) { *(LAS u32x4*)(kst + 32 * i * KP) = kr[i]; *(LAS u32x4*)(vst + 32 * i * VP) = vr[i]; }
    __syncthreads();
    const int NT = SEQ / 128;
    const LAS char* kread = lds + r32 * KP + (c * 64 + 8 * hh) * 2;
    const LAS char* vread = lds + 128 * KP + (4 * hh + q_) * VP + (16 * cb + 4 * p_) * 2;
    for (int t = 0; t < NT; ++t) {
        const int cur = (t & 1) * DIFF_TILE, nxt = DIFF_TILE - cur;
        const size_t go = (size_t)(t + 1) * 128 * INW; const bool more = t + 1 < NT;
        if (more) {
#pragma unroll
            for (int i = 0; i < 4; ++i) kr[i] = *(const u32x4*)(kg + go + (size_t)(32 * i) * INW); }
        f32x16 pA0 = negm, pA1 = negm, pB0 = negm, pB1 = negm;
#pragma unroll
        for (int ks = 0; ks < 4; ++ks) {
            const bf16x8 k0 = *(const LAS bf16x8*)(kread + cur + ks * 32), k1 = *(const LAS bf16x8*)(kread + cur + 32 * KP + ks * 32);
            pA0 = MFMA32(k0, qf[ks], pA0); pA1 = MFMA32(k1, qf[ks], pA1);
        }
#pragma unroll
        for (int ks = 0; ks < 4; ++ks) {
            const bf16x8 k0 = *(const LAS bf16x8*)(kread + cur + 64 * KP + ks * 32), k1 = *(const LAS bf16x8*)(kread + cur + 96 * KP + ks * 32);
            pB0 = MFMA32(k0, qf[ks], pB0); pB1 = MFMA32(k1, qf[ks], pB1);
        }
        if (more) {
#pragma unroll
            for (int i = 0; i < 4; ++i) *(LAS u32x4*)(kst + nxt + 32 * i * KP) = kr[i];
#pragma unroll
            for (int i = 0; i < 4; ++i) kr[i] = *(const u32x4*)(vg + go + (size_t)(32 * i) * INW); }
        float sa = 0.f, sb = 0.f;
#pragma unroll
        for (int r = 0; r < 16; ++r) { pA0[r] = __builtin_amdgcn_exp2f(pA0[r]); pA1[r] = __builtin_amdgcn_exp2f(pA1[r]); sa += pA0[r]; sb += pA1[r]; }
        bf16x8 pf[4]; pf[0] = packp(pA0, 0); pf[1] = packp(pA0, 1); pf[2] = packp(pA1, 0); pf[3] = packp(pA1, 1);
#pragma unroll
        for (int kst4 = 0; kst4 < 4; ++kst4)
#pragma unroll
            for (int db = 0; db < 4; ++db) {
                const LAS char* a = vread + cur + kst4 * 16 * VP + db * 64;
                const s16x4 lo = vtr(a), hi = vtr(a + 8 * VP);
                const bf16x8 vf = __builtin_shufflevector(lo, hi, 0, 1, 2, 3, 4, 5, 6, 7);
                o[db] = MFMA32(vf, pf[kst4], o[db]);
            }
#pragma unroll
        for (int r = 0; r < 16; ++r) { pB0[r] = __builtin_amdgcn_exp2f(pB0[r]); pB1[r] = __builtin_amdgcn_exp2f(pB1[r]); sa += pB0[r]; sb += pB1[r]; }
        lsum += sa + sb;
        pf[0] = packp(pB0, 0); pf[1] = packp(pB0, 1); pf[2] = packp(pB1, 0); pf[3] = packp(pB1, 1);
#pragma unroll
        for (int kst4 = 0; kst4 < 4; ++kst4)
#pragma unroll
            for (int db = 0; db < 4; ++db) {
                const LAS char* a = vread + cur + (64 + kst4 * 16) * VP + db * 64;
                const s16x4 lo = vtr(a), hi = vtr(a + 8 * VP);
                const bf16x8 vf = __builtin_shufflevector(lo, hi, 0, 1, 2, 3, 4, 5, 6, 7);
                o[db] = MFMA32(vf, pf[kst4], o[db]);
            }
        if (more) {
#pragma unroll
            for (int i = 0; i < 4; ++i) *(LAS u32x4*)(vst + nxt + 32 * i * VP) = kr[i]; }
        __syncthreads();
    }
    const int lane_e = lane_opaque();
    lsum += shflx(lsum, 32, lane_e);
    float inv = 1.0f / lsum; if (c == 1) inv *= lam;
    const int r32e = lane_e & 31, hhe = lane_e >> 5;
    LAS float* X = (LAS float*)lds + (wid & 3) * 4096;
    if (c == 1) {
#pragma unroll
        for (int db = 0; db < 4; ++db)
#pragma unroll
            for (int r = 0; r < 16; ++r) X[(db * 32 + crow(r, hhe)) * 32 + r32e] = o[db][r] * inv;
    }
    __syncthreads();
    if (c == 0) {
        float ss = 0.f;
#pragma unroll
        for (int db = 0; db < 4; ++db)
#pragma unroll
            for (int r = 0; r < 16; ++r) { const float v = o[db][r] * inv - X[(db * 32 + crow(r, hhe)) * 32 + r32e]; o[db][r] = v; ss += v * v; }
        ss += shflx(ss, 32, lane_e);
        const float rn = __builtin_amdgcn_rsqf(ss * (1.0f / 128.0f) + 1e-6f) * 0.8f;
        bf16_t* op = MIX + (rowbase + q0 + r32e) * DMODEL + 1024 + h * 128;
#pragma unroll
        for (int db = 0; db < 4; ++db)
#pragma unroll
            for (int g4 = 0; g4 < 4; ++g4) { const int d0 = db * 32 + 8 * g4 + 4 * hhe; const f32x4 gg = *(const f32x4*)(g_bout + d0);
                u32x2 w; w.x = cvtpk(o[db][4 * g4] * rn * gg[0], o[db][4 * g4 + 1] * rn * gg[1]); w.y = cvtpk(o[db][4 * g4 + 2] * rn * gg[2], o[db][4 * g4 + 3] * rn * gg[3]);
                *(u32x2*)(op + d0) = w; }
    }
    __syncthreads();
}

template <int MODE> __device__ __forceinline__ void dil_unit(LAS char* wl, const bf16_t* QKV, bf16_t* MIX, float* Opart, float* Lpart, int b, int h, int r16, int ib, float negM, const float* g_aout, int lane) {
    const int r32 = lane & 31, hh = lane >> 5, cb = (lane >> 4) & 1, q_ = (lane & 15) >> 2, p_ = lane & 3;
    const size_t rowbase = (size_t)b * SEQ;
    const int t0 = MODE ? r16 + 512 * ib : 32 * (8 * r16 + ib), qs = MODE ? 16 : 1;
    const int tq = t0 + qs * r32;
    bf16x8 qf[8];
    { const bf16_t* qp = QKV + (rowbase + tq) * INW + h * 128 + 8 * hh;
#pragma unroll
      for (int ks = 0; ks < 8; ++ks) qf[ks] = *(const bf16x8*)(qp + 16 * ks); }
    f32x16 o[4];
#pragma unroll
    for (int i = 0; i < 4; ++i)
#pragma unroll
        for (int r = 0; r < 16; ++r) o[i][r] = 0.f;
    float lsum = 0.f;
    f32x16 negm;
#pragma unroll
    for (int r = 0; r < 16; ++r) negm[r] = negM;
    const int lrow = lane >> 4, lch = lane & 15;
    const bf16_t* kvg = QKV + rowbase * INW + 1024 + h * 128 + lch * 8;
    LAS char* kst = wl + lrow * KP + lch * 16; LAS char* vst = wl + 32 * KP + lrow * VP + lch * 16;
    const LAS char* kread = wl + r32 * KP + 8 * hh * 2;
    const LAS char* vread = wl + 32 * KP + (4 * hh + q_) * VP + (16 * cb + 4 * p_) * 2;
    int klo0, khi0, klo1, khi1, klo2, khi2;
    { const int bq = t0 >> 4; int lo_i = bq - 64; if (lo_i < 0) lo_i = 0; klo0 = lo_i >> 5; khi0 = (bq + 31 * (qs >> 4) + 64) >> 5; if (khi0 > 7) khi0 = 7; }
    { const int bq = t0 >> 2; int lo_i = bq - 64; if (lo_i < 0) lo_i = 0; klo1 = lo_i >> 5; khi1 = (bq + 31 * (qs >> 2) + 64) >> 5; if (khi1 > 31) khi1 = 31; }
    { const int bq = t0;      int lo_i = bq - 64; if (lo_i < 0) lo_i = 0; klo2 = lo_i >> 5; khi2 = (bq + 31 * qs + 64) >> 5;        if (khi2 > 127) khi2 = 127; }
    constexpr int PAT_END = MODE ? 2 : 3;
    int pat = MODE ? 0 : 2, kb = MODE ? klo0 : klo2;
    u32x4 kr[8], vr[8];
#define DIL_LOADK(PAT, KB) do { const int sh_ = 4 - 2 * (PAT); const int rc_ = t0 & ((1 << sh_) - 1); \
        _Pragma("unroll") for (int i = 0; i < 8; ++i) { const int tok = rc_ + ((32 * (KB) + lrow + 4 * i) << sh_); kr[i] = *(const u32x4*)(kvg + (size_t)tok * INW); } } while (0)
#define DIL_LOADV(PAT, KB) do { const int sh_ = 4 - 2 * (PAT); const int rc_ = t0 & ((1 << sh_) - 1); \
        _Pragma("unroll") for (int i = 0; i < 8; ++i) { const int tok = rc_ + ((32 * (KB) + lrow + 4 * i) << sh_); vr[i] = *(const u32x4*)(kvg + (size_t)tok * INW + 1024); } } while (0)
#define DIL_ADV() do { const int hi_c = pat == 0 ? khi0 : (pat == 1 ? khi1 : khi2); if (kb < hi_c) ++kb; else { ++pat; kb = pat == 1 ? klo1 : klo2; } } while (0)
#define DIL_WFENCE() do { __builtin_amdgcn_fence(__ATOMIC_RELEASE, "wavefront"); __builtin_amdgcn_wave_barrier(); __builtin_amdgcn_fence(__ATOMIC_ACQUIRE, "wavefront"); } while (0)
#define DIL_S(P) do { P = negm; _Pragma("unroll") for (int ks = 0; ks < 8; ++ks) { const bf16x8 kf = *(const LAS bf16x8*)(kread + ks * 32); P = MFMA32(kf, qf[ks], P); } } while (0)
    int cpat = pat, ckb = kb;
    DIL_LOADK(pat, kb); DIL_LOADV(pat, kb);
#pragma unroll
    for (int i = 0; i < 8; ++i) { *(LAS u32x4*)(kst + 4 * i * KP) = kr[i]; *(LAS u32x4*)(vst + 4 * i * VP) = vr[i]; }
    DIL_ADV();
    bool have1 = pat < PAT_END;
    int npat = pat, nkb = kb;
    if (have1) { DIL_LOADK(pat, kb); DIL_LOADV(pat, kb); DIL_ADV(); }
    DIL_WFENCE();
    f32x16 p, pn;
    DIL_S(p);
    for (;;) {
        const bool have2 = have1 && pat < PAT_END;
        if (have1) {
            DIL_WFENCE();
#pragma unroll
            for (int i = 0; i < 8; ++i) *(LAS u32x4*)(kst + 4 * i * KP) = kr[i];
            if (have2) DIL_LOADK(pat, kb);
            DIL_WFENCE();
            DIL_S(pn);
        }
        const int sh = 4 - 2 * cpat;
        const int qi = (t0 >> sh) + (qs >> sh) * r32;
        float sa = 0.f;
#pragma unroll
        for (int r = 0; r < 16; ++r) { const int dl = 32 * ckb + crow(r, hh) - qi; const float e = __builtin_amdgcn_exp2f(p[r]); const float pv = (dl <= 64 && dl >= -64) ? e : 0.f; p[r] = pv; sa += pv; }
        lsum += sa;
        bf16x8 pf[2]; pf[0] = packp(p, 0); pf[1] = packp(p, 1);
#pragma unroll
        for (int s = 0; s < 2; ++s)
#pragma unroll
            for (int db = 0; db < 4; ++db) {
                const LAS char* a = vread + s * 16 * VP + db * 64;
                const s16x4 lo = vtr(a), hi = vtr(a + 8 * VP);
                const bf16x8 vf = __builtin_shufflevector(lo, hi, 0, 1, 2, 3, 4, 5, 6, 7);
                o[db] = MFMA32(vf, pf[s], o[db]);
            }
        if (!have1) break;
        DIL_WFENCE();
#pragma unroll
        for (int i = 0; i < 8; ++i) *(LAS u32x4*)(vst + 4 * i * VP) = vr[i];
        if (have2) DIL_LOADV(pat, kb);
        DIL_WFENCE();
        p = pn; cpat = npat; ckb = nkb; npat = pat; nkb = kb; have1 = have2;
        if (have2) DIL_ADV();
    }
#undef DIL_LOADK
#undef DIL_LOADV
#undef DIL_ADV
#undef DIL_WFENCE
#undef DIL_S
    const int lane_f = lane_opaque(), hhf = lane_f >> 5, tqf = t0 + qs * (lane_f & 31);
    lsum += shflx(lsum, 32, lane_f);
    float* pp = Opart + ((rowbase + tqf) * 8 + h) * 128; float* lp = Lpart + (rowbase + tqf) * 8 + h;
    if (MODE == 0) {
#pragma unroll
        for (int db = 0; db < 4; ++db)
#pragma unroll
            for (int g4 = 0; g4 < 4; ++g4) *(f32x4*)(pp + db * 32 + 8 * g4 + 4 * hhf) = (f32x4){o[db][4 * g4], o[db][4 * g4 + 1], o[db][4 * g4 + 2], o[db][4 * g4 + 3]};
        if (hhf == 0) *lp = lsum;
        return;
    }
    lsum += *lp;
#pragma unroll
    for (int db = 0; db < 4; ++db)
#pragma unroll
        for (int g4 = 0; g4 < 4; ++g4) { const f32x4 t = *(const f32x4*)(pp + db * 32 + 8 * g4 + 4 * hhf); o[db][4 * g4] += t[0]; o[db][4 * g4 + 1] += t[1]; o[db][4 * g4 + 2] += t[2]; o[db][4 * g4 + 3] += t[3]; }
    const float inv = 1.0f / lsum; float ss = 0.f;
#pragma unroll
    for (int db = 0; db < 4; ++db)
#pragma unroll
        for (int r = 0; r < 16; ++r) { const float v = o[db][r] * inv; o[db][r] = v; ss += v * v; }
    ss += shflx(ss, 32, lane_f);
    const float rn = __builtin_amdgcn_rsqf(ss * (1.0f / 128.0f) + 1e-6f);
    bf16_t* op = MIX + (rowbase + tqf) * DMODEL + h * 128;
#pragma unroll
    for (int db = 0; db < 4; ++db)
#pragma unroll
        for (int g4 = 0; g4 < 4; ++g4) { const int d0 = db * 32 + 8 * g4 + 4 * hhf; const f32x4 gg = *(const f32x4*)(g_aout + d0);
            u32x2 w; w.x = cvtpk(o[db][4 * g4] * rn * gg[0], o[db][4 * g4 + 1] * rn * gg[1]); w.y = cvtpk(o[db][4 * g4 + 2] * rn * gg[2], o[db][4 * g4 + 3] * rn * gg[3]);
            *(u32x2*)(op + d0) = w; }
}
}

constexpr int NWAVES = 8;
constexpr int DM = 2048, NBATCH = 2, SEQ = 4096, MROWS = NBATCH * SEQ, DFF = 5632, INW = 6144;
constexpr size_t MiB = 1u << 20;
constexpr size_t WS_CTL = 0;
constexpr size_t OFF_GTAB = 1 * MiB - 4096;
constexpr size_t OFF_RS0 = 917504;
constexpr size_t OFF_BAR = 983040, BAR_BYTES = 16384;
constexpr size_t OFF_RS1 = 0, OFF_RS2 = 32768, OFF_ROPEA = 65536, OFF_ROPEB = OFF_ROPEA + 2 * 4096 * 16 * 4;
constexpr int LDK = pg8::LDK, LDQ = pg8::LDQ;
constexpr size_t WS_W1A = 1 * MiB, WS_W1B = WS_W1A + 47 * MiB, WS_WIN = WS_W1B + 22 * MiB, WS_WOUT = WS_WIN + 26 * MiB, WS_W2A = WS_WOUT + 9 * MiB, WS_W2B = WS_W2A + 47 * MiB;
constexpr size_t WS_XN = WS_W2B + 22 * MiB;
constexpr size_t WS_ACT = WS_XN + 34 * MiB;
constexpr size_t WS_MIX = WS_ACT + 98 * MiB;
constexpr size_t WS_OPART = WS_MIX + 34 * MiB;
constexpr size_t WS_LPART = WS_OPART + 32 * MiB;
constexpr size_t WS_END = WS_LPART + 1 * MiB;
constexpr int LDS_BYTES = 155648;
constexpr int XCH_OFF = 131072;
static_assert((size_t)11264 * LDK * 2 <= 47 * MiB && (size_t)6144 * LDK * 2 <= 26 * MiB && (size_t)2048 * LDK * 2 <= 9 * MiB && (size_t)8192 * LDK * 2 <= 34 * MiB && (size_t)8192 * LDQ * 2 <= 98 * MiB && att::INW == LDQ && att::DMODEL == LDK, "ws map");
static_assert(att::DIL_WAVE * 8 <= LDS_BYTES - 64 && 3456 * 4 <= BAR_BYTES && 2 * att::DIFF_TILE <= LDS_BYTES - 64 && XCH_OFF + 8192 <= LDS_BYTES, "LDS map");

#define LAS __attribute__((address_space(3)))
typedef unsigned short bf16;
typedef unsigned v4u __attribute__((ext_vector_type(4)));
typedef unsigned v2u __attribute__((ext_vector_type(2)));
typedef float f32x4 __attribute__((ext_vector_type(4)));
__device__ __forceinline__ unsigned f2bf(float f) { unsigned u = __builtin_bit_cast(unsigned, f); return (u + 0x7fffu + ((u >> 16) & 1u)) >> 16; }
__device__ __forceinline__ unsigned pk2(float lo, float hi) { return f2bf(lo) | (f2bf(hi) << 16); }
__device__ __forceinline__ float wave_sum(float v, int lane) {
#pragma unroll
    for (int o = 1; o < 64; o <<= 1) v += shflx(v, o, lane);
    return v;
}
__device__ __forceinline__ float wave_max(float v, int lane) {
#pragma unroll
    for (int o = 1; o < 64; o <<= 1) v = fmaxf(v, shflx(v, o, lane));
    return v;
}
template <bool GLU> __device__ __forceinline__ void tr_load(const float* W, int N, int item, int lane, f32x4 (&v)[8], const float* gk) {
    const int nblk = N / 32, kb = item / nblk, nb = item % nblk, k0 = 64 * kb, n0 = 32 * nb;
    const float* src = W + (size_t)(k0 + (lane >> 3)) * N + n0 + 4 * (lane & 7);
#pragma unroll
    for (int i = 0; i < 8; ++i) v[i] = __builtin_nontemporal_load((const f32x4*)(src + (size_t)(8 * i) * N));
    if (gk) {
#pragma unroll
        for (int i = 0; i < 8; ++i) v[i] = v[i] * gk[k0 + (lane >> 3) + 8 * i]; }
}
template <bool GLU> __device__ __forceinline__ void tr_store(int K, int N, bf16* WT, int ldw, LAS float* scr, int item, int lane, const f32x4 (&v)[8]) {
    const int nblk = N / 32, kb = item / nblk, nb = item % nblk, k0 = 64 * kb, n0 = 32 * nb;
    int r0 = n0;
    if (GLU) { const int half = N / 2; r0 = n0 < half ? (n0 >> 7) * 256 + (n0 & 127) : ((n0 - half) >> 7) * 256 + 128 + ((n0 - half) & 127); }
    const int rg = lane >> 3, c4 = lane & 7;
#pragma unroll
    for (int i = 0; i < 8; ++i) { LAS float* d = scr + (8 * i + rg) * 33 + 4 * c4; d[0] = v[i][0]; d[1] = v[i][1]; d[2] = v[i][2]; d[3] = v[i][3]; }
    asm volatile("s_waitcnt lgkmcnt(0)" ::: "memory");
    const int c = lane & 7;
#pragma unroll
    for (int j = 0; j < 4; ++j) { const int n = (lane >> 3) + 8 * j; const LAS float* s = scr + (8 * c) * 33 + n;
        v4u o; o.x = pk2(s[0 * 33], s[1 * 33]); o.y = pk2(s[2 * 33], s[3 * 33]); o.z = pk2(s[4 * 33], s[5 * 33]); o.w = pk2(s[6 * 33], s[7 * 33]);
        *(v4u*)(WT + (size_t)(r0 + n) * ldw + k0 + 8 * c) = o; }
    asm volatile("s_waitcnt lgkmcnt(0)" ::: "memory");
}
template <bool GLU, int NIF> __device__ __forceinline__ void tr_matrix(const float* W, int K, int N, bf16* WT, int ldw, LAS float* scr, int gw, int NGW, int lane, const float* gk) {
    const int nitems = (K / 64) * (N / 32);
    for (int it = gw; it < nitems; it += NIF * NGW) {
        f32x4 v[NIF][8];
#pragma unroll
        for (int j = 0; j < NIF; ++j) if (it + j * NGW < nitems) tr_load<GLU>(W, N, it + j * NGW, lane, v[j], gk);
#pragma unroll
        for (int j = 0; j < NIF; ++j) if (it + j * NGW < nitems) tr_store<GLU>(K, N, WT, ldw, scr, it + j * NGW, lane, v[j]);
    }
}

#define XB_TMO      128
#define XB_XCNT(j)  (256  + 64 * (j))
#define XB_XSUB(j)  (1280 + 64 * (j))
#define XB_XGEN(j)  (2304 + 64 * (j))
#define XB_TOP      3328
#define XB_TOPGEN   3392
#define XCD_BAR_WORDS 3456
#define XB_SPIN_CAP (1u << 18)

__device__ __forceinline__ unsigned xb_ld(unsigned* p)              { return __hip_atomic_load(p, __ATOMIC_RELAXED, __HIP_MEMORY_SCOPE_AGENT); }
__device__ __forceinline__ unsigned xb_add(unsigned* p, unsigned v) { return __hip_atomic_fetch_add(p, v, __ATOMIC_RELAXED, __HIP_MEMORY_SCOPE_AGENT); }
__device__ __forceinline__ unsigned xb_xcc_id() { return (unsigned)__builtin_amdgcn_s_getreg((3 << 11) | 20) & 0xFu; }
#define XB_SPIN(cond, bar) do { unsigned _sp = 0; while (cond) { __builtin_amdgcn_s_sleep(1); \
    if ((++_sp & 255u) == 0u) { if (xb_ld(&(bar)[XB_TMO])) break; if (_sp > XB_SPIN_CAP) { atomicAdd(&(bar)[XB_TMO], 1u); break; } } } } while (0)

struct XcdBarrier {
    unsigned* bar; unsigned x; int wid;
    volatile LAS unsigned* st;
};

__device__ __forceinline__ bool xb_lane0() { return lane_opaque() == 0; }
__device__ __forceinline__ XcdBarrier xcd_barrier_post(unsigned* bar, volatile LAS unsigned* st, int wid) {
    XcdBarrier b; b.bar = bar; b.x = xb_xcc_id(); b.st = st; b.wid = wid;
    if (wid == 0 && xb_lane0()) (void)xb_add(&bar[XB_XCNT(b.x)], 1u);
    return b;
}
__device__ __forceinline__ void xcd_barrier_complete(unsigned* bar, unsigned x, unsigned& nloc, unsigned& nx) {
    const unsigned G = gridDim.x * gridDim.y * gridDim.z;
    unsigned sum, cnt, mine, sp = 0u;
    for (;;) {
        sum = 0u; cnt = 0u; mine = 0u;
#pragma unroll
        for (unsigned j = 0; j < 16; ++j) { const unsigned c = xb_ld(&bar[XB_XCNT(j)]); sum += c; cnt += (c > 0u) ? 1u : 0u; mine = (j == x) ? c : mine; }
        if (sum == G) break;
        __builtin_amdgcn_s_sleep(1);
        if ((++sp & 255u) == 0u) { if (xb_ld(&bar[XB_TMO])) break; if (sp > XB_SPIN_CAP) { atomicAdd(&bar[XB_TMO], 1u); break; } }
    }
    nloc = mine > 0u ? mine : 1u; nx = cnt > 0u ? cnt : 1u;
}

__device__ __forceinline__ void xcd_barrier(const XcdBarrier& b) {
    asm volatile("s_waitcnt vmcnt(0)" ::: "memory");
    __syncthreads();
    if (b.wid == 0 && xb_lane0()) {
        unsigned* bar = b.bar;
        __builtin_amdgcn_s_waitcnt(0);
        unsigned nloc = b.st[0], nx = b.st[1];
        if (nloc == 0u) { xcd_barrier_complete(bar, b.x, nloc, nx); b.st[0] = nloc; b.st[1] = nx; }
        const unsigned old = xb_add(&bar[XB_XSUB(b.x)], 1u);
        const unsigned gen = old / nloc;
        if (old + 1u == (gen + 1u) * nloc) {
            __builtin_amdgcn_fence(__ATOMIC_RELEASE, "agent");
            asm volatile("s_waitcnt vmcnt(0)" ::: "memory");
            const unsigned og = xb_add(&bar[XB_TOP], 1u);
            const unsigned tg = og / nx;
            if (og + 1u == (tg + 1u) * nx) xb_add(&bar[XB_TOPGEN], 1u);
            else XB_SPIN(xb_ld(&bar[XB_TOPGEN]) == tg, bar);
            __builtin_amdgcn_fence(__ATOMIC_ACQUIRE, "agent");
            xb_add(&bar[XB_XGEN(b.x)], 1u);
            asm volatile("s_waitcnt vmcnt(0)" ::: "memory");
        } else {
            XB_SPIN(xb_ld(&bar[XB_XGEN(b.x)]) == gen, bar);
            __builtin_amdgcn_fence(__ATOMIC_ACQUIRE, "agent");
            asm volatile("s_waitcnt vmcnt(0)" ::: "memory");
        }
    }
    __syncthreads();
}

struct Args {
    const float* in[20]; float* out; unsigned char* ws;
    float invA[16]; float invB[8];
};

__global__ void __launch_bounds__(NWAVES * 64) hybrid_fwd(Args args) {
    extern __shared__ __attribute__((aligned(16))) unsigned char lds_raw[];
    cg::grid_group grid = cg::this_grid();
    LAS unsigned char* lds = (LAS unsigned char*)lds_raw;
    const int wid = __builtin_amdgcn_readfirstlane((int)threadIdx.x >> 6);
#define fresh_lane() lane_opaque()
    const int lane = fresh_lane(), tid = wid * 64 + lane;
    const int G = gridDim.x, bx = blockIdx.x;
    unsigned char* ws = args.ws;
    volatile LAS unsigned* MISC = (volatile LAS unsigned*)(lds + LDS_BYTES - 64);
    if (tid < 16) MISC[tid] = 0u;
    __syncthreads();
    const XcdBarrier bar = xcd_barrier_post((unsigned*)(ws + OFF_BAR), MISC + 8, wid);
    if (G == 0x7fffffff) grid.sync();
    const float* x = args.in[0];
    float* out = args.out;
    float* rowss1 = (float*)(ws + OFF_RS1); float* rowss2 = (float*)(ws + OFF_RS2);
    float* gtab = (float*)(ws + OFF_GTAB); float* ropeA = (float*)(ws + OFF_ROPEA); float* ropeB = (float*)(ws + OFF_ROPEB);
    bf16* W1A = (bf16*)(ws + WS_W1A); bf16* W1B = (bf16*)(ws + WS_W1B); bf16* WIN = (bf16*)(ws + WS_WIN); bf16* WOUT = (bf16*)(ws + WS_WOUT);
    bf16* W2A = (bf16*)(ws + WS_W2A); bf16* W2B = (bf16*)(ws + WS_W2B);
    bf16* XN = (bf16*)(ws + WS_XN); bf16* ACT = (bf16*)(ws + WS_ACT); bf16* QKV = (bf16*)(ws + WS_ACT); bf16* MIX = (bf16*)(ws + WS_MIX);

#ifndef REP_P0
#define REP_P0 1
#endif
#ifndef REP_DIFF
#define REP_DIFF 1
#endif
#ifndef REP_DIL
#define REP_DIL 1
#endif
#define REP_G1 1
#define REP_SHADOW 1
#define REP_G2 1
#define REP_G3 1
#define REP_G5 1
#define REP_G6 1
#define REP_G7 1
    for (int rep = 0; rep < REP_P0; ++rep) {
        LAS float* scr = (LAS float*)(lds + wid * 16384);
        const int gw = bx * NWAVES + wid, NGW = G * NWAVES;
        constexpr int I_FA = (DM / 64) * (2 * DFF / 32), I_FB = (DFF / 64) * (DM / 32), I_IN = (DM / 64) * (INW / 32), I_OUT = (DM / 64) * (DM / 32);
        tr_matrix<true, 2>(args.in[2], DM, 2 * DFF, W1A, LDK, scr, gw, NGW, lane, args.in[1]);
        tr_matrix<true, 2>(args.in[18], DM, 2 * DFF, W2A, LDK, scr, gw, NGW, lane, args.in[17]);
        float* rowss0 = (float*)(ws + OFF_RS0);
        for (int m = gw; m < MROWS; m += NGW) {
            const f32x4* xr = (const f32x4*)(x + (size_t)m * DM) + lane; f32x4 v[8]; float s = 0.f;
#pragma unroll
            for (int j = 0; j < 8; ++j) { v[j] = xr[64 * j]; s += (v[j][0] * v[j][0] + v[j][1] * v[j][1]) + (v[j][2] * v[j][2] + v[j][3] * v[j][3]); }
            s = wave_sum(s, lane); if (lane == 0) rowss0[m] = s;
            v2u* o8 = (v2u*)(XN + (size_t)m * LDK) + lane;
#pragma unroll
            for (int j = 0; j < 8; ++j) { v2u w; w.x = pk2(v[j][0], v[j][1]); w.y = pk2(v[j][2], v[j][3]); o8[64 * j] = w; }
        }
        const int gt = bx * (NWAVES * 64) + tid, NGT = G * NWAVES * 64;
        for (int i = gt; i < 2 * MROWS; i += NGT) rowss1[i] = 0.f;
        if (gt < 512) { const int t = gt >> 7, d = gt & 127; gtab[gt] = t == 0 ? args.in[6][d] : (t == 1 ? args.in[7][d] : (t == 2 ? args.in[8][d & 63] : args.in[9][d & 63])); }
        for (int i = gt; i < 4096 * 24; i += NGT) {
            const int s = i / 24, k = i % 24; const float inv = k < 16 ? args.invA[k] : args.invB[k - 16];
            const float ang = (float)s * inv; double rev = (double)ang * 0.15915494309189535; rev -= floor(rev);
            const float cs = __builtin_amdgcn_cosf((float)rev), sn = __builtin_amdgcn_sinf((float)rev);
            if (k < 16) { ropeA[s * 16 + k] = cs; ropeA[4096 * 16 + s * 16 + k] = sn; } else { ropeB[s * 8 + k - 16] = cs; ropeB[4096 * 8 + s * 8 + k - 16] = sn; }
        }
    }
    xcd_barrier(bar);

    { pg8::Gemm g{XN, W1A, MROWS, 2 * DFF, DM, LDK}; pg8::StaticOrder S; S.init(MROWS, 2 * DFF, G, bx);
      pg8::EpiSwiGLU E{ACT, DFF, (const float*)(ws + OFF_RS0)};
      pg8::gemm_phase<pg8::EpiSwiGLU, pg8::StaticOrder, true, true>(lds, g, S, E, wid); }
    {
        constexpr int NU = (MROWS / 256) * (2 * DFF / 256);
        const int rounds = (NU + G - 1) / G; int first_idle = NU - (rounds - 1) * G, nidle = G - first_idle;
        if (nidle <= 0) { first_idle = 0; nidle = G; }
        if (bx >= first_idle) {
            LAS float* scr = (LAS float*)(lds + wid * 16384); const int lane_c = fresh_lane();
            const int gw = (bx - first_idle) * NWAVES + wid, NGW = nidle * NWAVES;
            for (int rep = 0; rep < REP_SHADOW; ++rep) {
            tr_matrix<false, 2>(args.in[3], DFF, DM, W1B, DFF, scr, gw, NGW, lane_c, nullptr);
            tr_matrix<false, 2>(args.in[5], DM, INW, WIN, LDK, scr, gw, NGW, lane_c, args.in[4]);
            tr_matrix<false, 2>(args.in[16], DM, DM, WOUT, LDK, scr, gw, NGW, lane_c, nullptr);
            }
        }
    }
    xcd_barrier(bar);
    { pg8::Gemm g{ACT, W1B, MROWS, DM, DFF, DFF}; pg8::StaticOrder S; S.init(MROWS, DM, G, bx);
      pg8::EpiResid<false, true, false> E{nullptr, nullptr, XN, rowss1, 0.5f};
      pg8::gemm_phase<pg8::EpiResid<false, true, false>, pg8::StaticOrder, true, true>(lds, g, S, E, wid); }
    xcd_barrier(bar);
    { pg8::Gemm g{XN, WIN, MROWS, INW, DM, LDK}; pg8::StaticOrder S; S.init(MROWS, INW, G, bx);
      pg8::EpiQKV E{QKV, rowss1, gtab, ropeA, ropeB, (LAS float*)(lds + XCH_OFF)};
      for (int rep = 0; rep < REP_G3; ++rep)
      pg8::gemm_phase<pg8::EpiQKV, pg8::StaticOrder, true, true>(lds, g, S, E, wid); }
    xcd_barrier(bar);
    {
        const float L2E = 1.4426950408889634f;
        const int lane_a = fresh_lane();
        const float gq = fmaxf(fabsf(args.in[6][lane_a]), fabsf(args.in[6][lane_a + 64])), gk = fmaxf(fabsf(args.in[7][lane_a]), fabsf(args.in[7][lane_a + 64]));
        const float negMA = __builtin_bit_cast(float, __builtin_amdgcn_readfirstlane(__builtin_bit_cast(int, -1.02f * 11.313708498984761f * wave_max(gq, lane_a) * wave_max(gk, lane_a) * L2E)));
        const float negMB = __builtin_bit_cast(float, __builtin_amdgcn_readfirstlane(__builtin_bit_cast(int, -1.02f * 8.0f * wave_max(fabsf(args.in[8][lane_a]), lane_a) * wave_max(fabsf(args.in[9][lane_a]), lane_a) * L2E)));
        const float lam = __builtin_bit_cast(float, __builtin_amdgcn_readfirstlane(__builtin_bit_cast(int, __expf(wave_sum(args.in[10][lane_a] * args.in[11][lane_a], lane_a)) - __expf(wave_sum(args.in[12][lane_a] * args.in[13][lane_a], lane_a)) + 0.2f)));
        float* Opart = (float*)(ws + WS_OPART); float* Lpart = (float*)(ws + WS_LPART);
        {
            const int lane_d = fresh_lane();
            for (int wu = bx * NWAVES + wid; wu < 2048; wu += G * NWAVES) {
                const int ib = wu & 7, r16 = (wu >> 3) & 15, h = (wu >> 7) & 7, b = wu >> 10;
                att::dil_unit<0>((LAS char*)lds + wid * att::DIL_WAVE, QKV, MIX, Opart, Lpart, b, h, r16, ib, negMA, args.in[14], lane_d);
            }
        }
        xcd_barrier(bar);
        {
            const int tid_a = wid * 64 + fresh_lane();
            for (int rep = 0; rep < REP_DIFF; ++rep)
            for (int u = bx; u < 512; u += G) {
                const int bh = u >> 5, qblk = u & 31;
                att::diff_unit((LAS char*)lds, QKV, MIX, bh >> 3, bh & 7, qblk, lam, negMB, args.in[15], tid_a, wid, tid_a & 63);
            }
        }
        {
            const int lane_d = fresh_lane();
            for (int rep = 0; rep < REP_DIL; ++rep)
            for (int wu = bx * NWAVES + wid; wu < 2048; wu += G * NWAVES) {
                const int ib = wu & 7, r16 = (wu >> 3) & 15, h = (wu >> 7) & 7, b = wu >> 10;
                att::dil_unit<1>((LAS char*)lds + wid * att::DIL_WAVE, QKV, MIX, Opart, Lpart, b, h, r16, ib, negMA, args.in[14], lane_d);
            }
        }
    }
    xcd_barrier(bar);
    { pg8::Gemm g{MIX, WOUT, MROWS, DM, DM, LDK}; pg8::StaticOrder S; S.init(MROWS, DM, G, bx);
      pg8::EpiResid<false, true, false> E{nullptr, nullptr, XN, rowss2, 1.0f};
      pg8::gemm_phase<pg8::EpiResid<false, true, false>, pg8::StaticOrder, true, true>(lds, g, S, E, wid); }
    xcd_barrier(bar);
    { pg8::Gemm g{XN, W2A, MROWS, 2 * DFF, DM, LDK}; pg8::StaticOrder S; S.init(MROWS, 2 * DFF, G, bx);
      pg8::EpiSwiGLU E{ACT, DFF, rowss2};
      for (int rep = 0; rep < REP_G6; ++rep)
      pg8::gemm_phase<pg8::EpiSwiGLU, pg8::StaticOrder, true, true>(lds, g, S, E, wid); }
    {
        constexpr int NU = (MROWS / 256) * (2 * DFF / 256);
        const int rounds = (NU + G - 1) / G; int first_idle = NU - (rounds - 1) * G, nidle = G - first_idle;
        if (nidle <= 0) { first_idle = 0; nidle = G; }
        if (bx >= first_idle) tr_matrix<false, 2>(args.in[19], DFF, DM, W2B, DFF, (LAS float*)(lds + wid * 16384), (bx - first_idle) * NWAVES + wid, nidle * NWAVES, fresh_lane(), nullptr);
    }
    xcd_barrier(bar);
    { pg8::Gemm g{ACT, W2B, MROWS, DM, DFF, DFF}; pg8::StaticOrder S; S.init(MROWS, DM, G, bx);
      pg8::EpiResid<false, false, true> E{nullptr, out, XN, nullptr, 0.5f};
      pg8::gemm_phase<pg8::EpiResid<false, false, true>, pg8::StaticOrder, true, true>(lds, g, S, E, wid); }
}

extern "C" void kernel_launch(void* const* d_in, const int* in_sizes, int n_in, void* d_out, int out_size, void* d_ws, size_t ws_size, hipStream_t stream) {
    static int grid = 0;
    if (grid == 0) {
        if (n_in != 20 || in_sizes[0] != MROWS * DM || out_size != MROWS * DM || ws_size < WS_END) {
            fprintf(stderr, "kernel_launch: unexpected shapes (n_in %d, in0 %d, out %d, ws %zu < %zu)\n", n_in, n_in > 0 ? in_sizes[0] : -1, out_size, ws_size, (size_t)WS_END); grid = -1; return; }
        int dev = 0, cus = 0, per_cu = 0;
        (void)hipGetDevice(&dev); (void)hipDeviceGetAttribute(&cus, hipDeviceAttributeMultiprocessorCount, dev);
        if (hipFuncSetAttribute((const void*)hybrid_fwd, hipFuncAttributeMaxDynamicSharedMemorySize, LDS_BYTES) != hipSuccess) { fprintf(stderr, "kernel_launch: hipFuncSetAttribute failed\n"); grid = -1; return; }
        if (hipOccupancyMaxActiveBlocksPerMultiprocessor(&per_cu, (const void*)hybrid_fwd, NWAVES * 64, LDS_BYTES) != hipSuccess || per_cu < 1) { fprintf(stderr, "kernel_launch: occupancy query says %d\n", per_cu); per_cu = 1; }
        (void)hipGetLastError();
        grid = cus * per_cu;
    }
    if (grid < 0) return;
    Args a{};
    for (int i = 0; i < 20; ++i) a.in[i] = (const float*)d_in[i];
    a.out = (float*)d_out; a.ws = (unsigned char*)d_ws;
    for (int i = 0; i < 16; ++i) a.invA[i] = (float)pow(500000.0, -(double)i / 16.0);
    for (int i = 0; i < 8; ++i) a.invB[i] = (float)pow(500000.0, -(double)i / 8.0);
    if (hipMemsetAsync((char*)d_ws + OFF_BAR, 0, BAR_BYTES, stream) != hipSuccess) { fprintf(stderr, "kernel_launch: memset failed\n"); return; }
    void* kargs[] = {&a};
    hipError_t e = hipLaunchCooperativeKernel((const void*)hybrid_fwd, dim3(grid), dim3(NWAVES * 64), kargs, LDS_BYTES, stream);
    if (e != hipSuccess) fprintf(stderr, "kernel_launch: cooperative launch failed: %s (grid %d)\n", hipGetErrorString(e), grid);
}
```

```cpp
#include <hip/hip_runtime.h>
#include <hip/hip_cooperative_groups.h>
#include <cstdio>
#include <cstdint>
#include <cmath>
namespace cg = cooperative_groups;
__device__ __forceinline__ int lane_opaque() { unsigned z = 0u; asm volatile("" : "+v"(z)); return (int)__builtin_amdgcn_mbcnt_hi(~0u, __builtin_amdgcn_mbcnt_lo(~0u, z)); }
__device__ __forceinline__ float shflx(float v, int mask, int lane) { return __builtin_bit_cast(float, __builtin_amdgcn_ds_bpermute((lane ^ mask) << 2, __builtin_bit_cast(int, v))); }
namespace pg8 {
#define PG8_LAS __attribute__((address_space(3)))
typedef unsigned short bf16_t;
typedef short bf16x8 __attribute__((ext_vector_type(8)));
typedef float f32x4 __attribute__((ext_vector_type(4)));
typedef unsigned u32x4 __attribute__((ext_vector_type(4)));
constexpr int BM = 256, BK = 64, HALF = 128, HTB = HALF * BK * 2  , STAGE_BYTES = 8 * HTB, NXCD = 8, WGM = 8;

__host__ __device__ __forceinline__ int lds_byte(int r, int c) { const int st = (r >> 4) * 2 + (c >> 5), rr = r & 15, cc = c & 31, ob = rr * 64 + cc * 2; return st * 1024 + (ob ^ (((ob >> 9) & 1) << 5)); }
__host__ __device__ __forceinline__ void stage_rc(int b, int& R, int& C) { const int st = b / 1024, sb = b % 1024, swz = sb ^ (((sb >> 9) & 1) << 5); R = (st >> 1) * 16 + swz / 64; C = (st & 1) * 32 + (swz % 64) / 2; }
__host__ __device__ __forceinline__ int perm32(int rho) { const int n = rho >> 4, i = rho & 15; return 8 * (i >> 2) + 4 * n + (i & 3); }

struct Unit { int pm, pn; };
struct Gemm { const bf16_t* A; const bf16_t* Bt; int M, N, K, ld; };

struct StaticOrder {
    int nM, nN, nwg, G, c;
    __host__ __device__ void init(int M, int N, int G_, int c_) { nM = M / BM; nN = N / BM; nwg = nM * nN; G = G_; c = c_; }
    __host__ __device__ bool next(int i, Unit& u) const {
        const long L = (long)i * G + c; if (L >= nwg) return false;
        int wgid = (int)L; { const int q = nwg / NXCD, r = nwg % NXCD, xcd = wgid % NXCD, off = wgid / NXCD; wgid = (xcd < r ? xcd * (q + 1) : r * (q + 1) + (xcd - r) * q) + off; }
        const int nig = WGM * nN, gid = wgid / nig, fm = gid * WGM, gsz = (nM - fm) < WGM ? (nM - fm) : WGM;
        u.pm = fm + ((wgid % nig) % gsz); u.pn = (wgid % nig) / gsz; return true;
    }
    __device__ __forceinline__ void a_ready(const Unit&) const {}
    __device__ __forceinline__ void done(const Unit&) const {}
};

__device__ __forceinline__ unsigned cvt_pk_bf16(float lo, float hi) { unsigned r; asm volatile("v_cvt_pk_bf16_f32 %0, %1, %2" : "=v"(r) : "v"(lo), "v"(hi)); return r; }
typedef float f32x2 __attribute__((ext_vector_type(2)));

typedef unsigned u32x2 __attribute__((ext_vector_type(2)));
constexpr int LDK = 2176, LDQ = 6272;
__device__ __forceinline__ float fast_silu(float g) { return g * __builtin_amdgcn_rcpf(1.0f + __expf(-g)); }

struct EpiSwiGLU {
    static constexpr bool PERM = true, AFTER_DRAIN = false;
    bf16_t* O; int ldc; const float* rowss;
    __device__ __forceinline__ void operator()(f32x4 (&acc)[2][2][4][2], const Unit& u, int wr, int wc, int fr, int fq) const {
        const int row0 = u.pm * BM + wr * 64 + fr; const int col0 = u.pn * HALF + wc * 32 + 8 * fq;
        float rsv[2][4];
#pragma unroll
        for (int ai = 0; ai < 2; ++ai)
#pragma unroll
            for (int m = 0; m < 4; ++m) rsv[ai][m] = rowss ? rowss[row0 + ai * HALF + m * 16] : 0.f;
#pragma unroll
        for (int ai = 0; ai < 2; ++ai)
#pragma unroll
            for (int m = 0; m < 4; ++m) rsv[ai][m] = rowss ? __builtin_amdgcn_rsqf(rsv[ai][m] * (1.0f / 2048.0f) + 1e-6f) : 1.0f;
        asm volatile("" : "+v"(rsv[0][0]), "+v"(rsv[0][1]), "+v"(rsv[0][2]), "+v"(rsv[0][3]), "+v"(rsv[1][0]), "+v"(rsv[1][1]), "+v"(rsv[1][2]), "+v"(rsv[1][3]));
#pragma unroll
        for (int ai = 0; ai < 2; ++ai)
#pragma unroll
            for (int m = 0; m < 4; ++m) {
                const int row = row0 + ai * HALF + m * 16;
                const float rs = rsv[ai][m];
                f32x4 g0 = acc[ai][0][m][0] * rs, g1 = acc[ai][0][m][1] * rs, u0 = acc[ai][1][m][0] * rs, u1 = acc[ai][1][m][1] * rs;
                u32x4 w;
                w.x = cvt_pk_bf16(fast_silu(g0[0]) * u0[0], fast_silu(g0[1]) * u0[1]); w.y = cvt_pk_bf16(fast_silu(g0[2]) * u0[2], fast_silu(g0[3]) * u0[3]);
                w.z = cvt_pk_bf16(fast_silu(g1[0]) * u1[0], fast_silu(g1[1]) * u1[1]); w.w = cvt_pk_bf16(fast_silu(g1[2]) * u1[2], fast_silu(g1[3]) * u1[3]);
                *(u32x4*)(O + (size_t)row * ldc + col0) = w;
            }
    }
};

template <bool BASE_F32, bool WRITE_XN, bool WRITE_OUT> struct EpiResid {
    static constexpr bool PERM = false, AFTER_DRAIN = false;
    const float* base; float* out; bf16_t* xn; float* rowss; float alpha;
    __device__ __forceinline__ void operator()(f32x4 (&acc)[2][2][4][2], const Unit& u, int wr, int wc, int fr, int fq) const {
        const int row0 = u.pm * BM + wr * 64 + fr; const int col0 = u.pn * BM + wc * 32 + 4 * fq;
#pragma unroll
        for (int ai = 0; ai < 2; ++ai) {
            f32x4 bpre[4][2][2];
#pragma unroll
            for (int m = 0; m < 4; ++m) { const int row = row0 + ai * HALF + m * 16;
#pragma unroll
                for (int bj = 0; bj < 2; ++bj)
#pragma unroll
                    for (int n = 0; n < 2; ++n) {
                        if (BASE_F32) bpre[m][bj][n] = *(const f32x4*)(base + (size_t)row * 2048 + col0 + bj * HALF + n * 16);
                        else { const u32x2 w = *(const u32x2*)(xn + (size_t)row * LDK + col0 + bj * HALF + n * 16);
                               bpre[m][bj][n] = (f32x4){__builtin_bit_cast(float, w.x << 16), __builtin_bit_cast(float, w.x & 0xffff0000u), __builtin_bit_cast(float, w.y << 16), __builtin_bit_cast(float, w.y & 0xffff0000u)}; }
                    } }
#pragma unroll
            for (int m = 0; m < 4; ++m) {
                const int row = row0 + ai * HALF + m * 16; float ss = 0.f;
#pragma unroll
                for (int bj = 0; bj < 2; ++bj)
#pragma unroll
                    for (int n = 0; n < 2; ++n) {
                        const f32x4 o = bpre[m][bj][n] + acc[ai][bj][m][n] * alpha;
                        if (WRITE_OUT) __builtin_nontemporal_store(o, (f32x4*)(out + (size_t)row * 2048 + col0 + bj * HALF + n * 16));
                        if (WRITE_XN) {
                            ss += (o[0] * o[0] + o[1] * o[1]) + (o[2] * o[2] + o[3] * o[3]);
                            u32x2 w; w.x = cvt_pk_bf16(o[0], o[1]); w.y = cvt_pk_bf16(o[2], o[3]);
                            *(u32x2*)(xn + (size_t)row * LDK + col0 + bj * HALF + n * 16) = w;
                        }
                    }
                if (WRITE_XN) { ss += shflx(ss, 16, fq * 16 + fr); ss += shflx(ss, 32, fq * 16 + fr); if (fq == 0) atomicAdd(rowss + row, ss); }
            }
            asm volatile("" ::: "memory");
        }
    }
};

struct EpiQKV {
    static constexpr bool PERM = false, AFTER_DRAIN = false;
    bf16_t* O; const float* rowss; const float* gtab;
    const float* ropeA; const float* ropeB;
    PG8_LAS float* xch;
    __device__ __forceinline__ void operator()(f32x4 (&acc)[2][2][4][2], const Unit& u, int wr, int wc, int, int) const {
        const int lane_q = lane_opaque(), fr = lane_q & 15, fq = lane_q >> 4;
        const int region = u.pn >> 2;
        const int row0 = u.pm * BM + wr * 64 + fr;
#pragma unroll
        for (int ai = 0; ai < 2; ++ai)
#pragma unroll
            for (int m = 0; m < 4; ++m) {
                const float rs = __builtin_amdgcn_rsqf(rowss[row0 + ai * HALF + m * 16] * (1.0f / 2048.0f) + 1e-6f);
#pragma unroll
                for (int bj = 0; bj < 2; ++bj)
#pragma unroll
                    for (int n = 0; n < 2; ++n) acc[ai][bj][m][n] = acc[ai][bj][m][n] * rs;
            }
        const bool isv = (region == 2) || (region == 5);
        if (!isv) {
            const bool isA = region < 2;
            const bool do_rope = isA ? (wc == 0) : ((wc & 1) == 0);
#pragma unroll
            for (int ai = 0; ai < 2; ++ai)
#pragma unroll
                for (int m = 0; m < 4; ++m)
#pragma unroll
                    for (int bj = 0; bj < 2; ++bj) {
                        const f32x4 a = acc[ai][bj][m][0], b = acc[ai][bj][m][1];
                        float s = ((a[0] * a[0] + a[1] * a[1]) + (a[2] * a[2] + a[3] * a[3])) + ((b[0] * b[0] + b[1] * b[1]) + (b[2] * b[2] + b[3] * b[3]));
                        s += shflx(s, 16, fq * 16 + fr); s += shflx(s, 32, fq * 16 + fr);
                        if (fq == 0) xch[((ai * HALF + wr * 64 + m * 16 + fr) * 2 + bj) * 4 + wc] = s;
                    }
            asm volatile("s_waitcnt lgkmcnt(0)" ::: "memory"); __builtin_amdgcn_s_barrier(); asm volatile("" ::: "memory");
            const float* gptr = gtab + (region < 2 ? region : region - 1) * 128;
            const int dbase = isA ? wc * 32 : (wc & 1) * 32;
            f32x4 gv[2]; gv[0] = *(const f32x4*)(gptr + dbase + 4 * fq); gv[1] = *(const f32x4*)(gptr + dbase + 16 + 4 * fq);
            const float qs = region == 0 ? (0.08838834764831845f * 1.4426950408889634f) : (region == 3 ? (0.125f * 1.4426950408889634f) : 1.0f);
#pragma unroll
            for (int ai = 0; ai < 2; ++ai) {
                f32x4 csv[4], snv[4];
                if (do_rope) {
#pragma unroll
                    for (int m = 0; m < 4; ++m) { const int spos = (u.pm * BM + ai * HALF + wr * 64 + m * 16 + fr) & 4095;
                        const float* rp = isA ? ropeA + spos * 16 + 4 * fq : ropeB + spos * 8 + 4 * (fq & 1);
                        csv[m] = *(const f32x4*)rp; snv[m] = *(const f32x4*)(rp + (isA ? 4096 * 16 : 4096 * 8)); }
                }
#pragma unroll
                for (int m = 0; m < 4; ++m) {
                    const int rl = ai * HALF + wr * 64 + m * 16 + fr;
#pragma unroll
                    for (int bj = 0; bj < 2; ++bj) {
                        const f32x4 p = *(const PG8_LAS f32x4*)(xch + (rl * 2 + bj) * 4);
                        float rn;
                        if (isA) rn = __builtin_amdgcn_rsqf(((p[0] + p[1]) + (p[2] + p[3])) * (1.0f / 128.0f) + 1e-6f);
                        else rn = __builtin_amdgcn_rsqf(((wc < 2) ? (p[0] + p[1]) : (p[2] + p[3])) * (1.0f / 64.0f) + 1e-6f);
                        f32x4 v0 = acc[ai][bj][m][0] * rn * gv[0], v1 = acc[ai][bj][m][1] * rn * gv[1];
                        if (isA) {
                            if (do_rope) {
                                const f32x4 cs = csv[m], sn = snv[m];
                                const f32x4 x1 = v0, x2 = v1; v0 = x1 * cs - x2 * sn; v1 = x2 * cs + x1 * sn;
                            }
                        } else {
                            if (do_rope) {
                                const f32x4 cs = csv[m], sn = snv[m];
                                f32x4 pt; pt[0] = shflx(v0[0], 32, fq * 16 + fr); pt[1] = shflx(v0[1], 32, fq * 16 + fr); pt[2] = shflx(v0[2], 32, fq * 16 + fr); pt[3] = shflx(v0[3], 32, fq * 16 + fr);
                                v0 = (fq < 2) ? (v0 * cs - pt * sn) : (v0 * cs + pt * sn);
                            }
                        }
                        acc[ai][bj][m][0] = v0 * qs; acc[ai][bj][m][1] = v1 * qs;
                    }
                }
                asm volatile("" ::: "memory");
            }
        }
        const int col0 = u.pn * BM + wc * 32 + 4 * fq;
#pragma unroll
        for (int ai = 0; ai < 2; ++ai)
#pragma unroll
            for (int m = 0; m < 4; ++m) { bf16_t* rowp = O + (size_t)(row0 + ai * HALF + m * 16) * LDQ + col0;
#pragma unroll
                for (int bj = 0; bj < 2; ++bj)
#pragma unroll
                    for (int n = 0; n < 2; ++n) { const f32x4 v = acc[ai][bj][m][n]; u32x2 w; w.x = cvt_pk_bf16(v[0], v[1]); w.y = cvt_pk_bf16(v[2], v[3]); *(u32x2*)(rowp + bj * HALF + n * 16) = w; } }
    }
};
template <class Epi, class Sched, bool ALIGN_EPI = false, bool SP2 = false>
__device__ __forceinline__ void gemm_phase(PG8_LAS unsigned char* lds, const Gemm g, const Sched& S, const Epi& E, const int wid_s) {
    const int lane_ = lane_opaque();
    const int tid = wid_s * 64 + lane_, wid = wid_s, lane = tid & 63, wr = wid >> 2, wc = wid & 3, fr = lane & 15, fq = lane >> 4;
    const int K = g.ld, nt = g.K / BK;
    unsigned voffA[2], voffB[2];
#pragma unroll
    for (int i = 0; i < 2; ++i) { int R, C; stage_rc(tid * 16 + i * 8192, R, C); const int Rb = Epi::PERM ? ((R & ~31) + perm32(R & 31)) : R;
        voffA[i] = (unsigned)(R * K + C) * 2u; voffB[i] = (unsigned)(Rb * K + C) * 2u; }
    const size_t kstep = (size_t)(BK * 2);
    const size_t hstep = (size_t)HALF * K * 2;
    const size_t tstep = 2 * hstep;
    const unsigned ldsw = (unsigned)wid * 1024u;
    const int aoff = lds_byte(wr * 64 + fr, fq * 8), boff = lds_byte(wc * 32 + fr, fq * 8);
#define PG8_SA(b, h) (((b) * 2 + (h)) * HTB)
#define PG8_SB(b, h) ((4 + (b) * 2 + (h)) * HTB)
#define PG8_STAGE(bufoff, gbase, voff) do { _Pragma("unroll") for (int _i = 0; _i < 2; ++_i) \
        __builtin_amdgcn_global_load_lds((const unsigned*)((const char*)(gbase) + (voff)[_i]), (PG8_LAS unsigned*)(lds + (bufoff) + ldsw + _i * 8192), 16, 0, 0); } while (0)
#define PG8_LDA(dst, b, h) do { _Pragma("unroll") for (int m = 0; m < 4; ++m) _Pragma("unroll") for (int k = 0; k < 2; ++k) dst[m][k] = *(const PG8_LAS bf16x8*)(lds + PG8_SA(b, h) + aoff + m * 2048 + k * 1024); } while (0)
#define PG8_LDB(dst, b, h) do { _Pragma("unroll") for (int n = 0; n < 2; ++n) _Pragma("unroll") for (int k = 0; k < 2; ++k) dst[n][k] = *(const PG8_LAS bf16x8*)(lds + PG8_SB(b, h) + boff + n * 2048 + k * 1024); } while (0)
#define PG8_MMA(ai, bj, At, Bt) do { __builtin_amdgcn_s_setprio(1); _Pragma("unroll") for (int m = 0; m < 4; ++m) _Pragma("unroll") for (int n = 0; n < 2; ++n) _Pragma("unroll") for (int k = 0; k < 2; ++k) \
        acc[ai][bj][m][n] = __builtin_amdgcn_mfma_f32_16x16x32_bf16(Bt[n][k], At[m][k], acc[ai][bj][m][n], 0, 0, 0); __builtin_amdgcn_s_setprio(0); } while (0)
#define PG8_WAIT_V(n) asm volatile("s_waitcnt vmcnt(" #n ")" ::: "memory")
#define PG8_WAIT_L(n) asm volatile("s_waitcnt lgkmcnt(" #n ")" ::: "memory")
#define PG8_BAR __builtin_amdgcn_s_barrier()
#define PG8_SCHED __builtin_amdgcn_sched_barrier(0)
    Unit cur, nxt; int ui = 0;
    if (!S.next(0, cur)) return;
    f32x4 acc[2][2][4][2];
#pragma unroll
    for (int a = 0; a < 2; ++a)
#pragma unroll
        for (int b = 0; b < 2; ++b)
#pragma unroll
            for (int m = 0; m < 4; ++m)
#pragma unroll
                for (int n = 0; n < 2; ++n) acc[a][b][m][n] = (f32x4){0.f, 0.f, 0.f, 0.f};
    bf16x8 At[4][2], B0[2][2], B1[2][2];
    const char* cA = (const char*)g.A + (size_t)cur.pm * tstep; const char* cB = (const char*)g.Bt + (size_t)cur.pn * tstep;
    S.a_ready(cur);
    if constexpr (SP2) {
        PG8_STAGE(PG8_SB(0, 0), cB, voffB); PG8_STAGE(PG8_SB(0, 1), cB + hstep, voffB); PG8_STAGE(PG8_SA(0, 0), cA, voffA); PG8_STAGE(PG8_SA(0, 1), cA + hstep, voffA);
        if (wr == 1) PG8_BAR;
        PG8_WAIT_V(2); PG8_BAR;
        PG8_STAGE(PG8_SB(1, 0), cB + kstep, voffB); PG8_STAGE(PG8_SA(1, 0), cA + kstep, voffA); PG8_STAGE(PG8_SB(1, 1), cB + hstep + kstep, voffB);
        PG8_WAIT_V(6); PG8_BAR;
    } else {
        PG8_STAGE(PG8_SB(0, 0), cB, voffB); PG8_STAGE(PG8_SA(0, 0), cA, voffA); PG8_STAGE(PG8_SB(0, 1), cB + hstep, voffB); PG8_STAGE(PG8_SA(0, 1), cA + hstep, voffA);
        if (wr == 1) PG8_BAR;
        PG8_WAIT_V(4); PG8_BAR;
        PG8_STAGE(PG8_SB(1, 0), cB + kstep, voffB); PG8_STAGE(PG8_SA(1, 0), cA + kstep, voffA); PG8_STAGE(PG8_SB(1, 1), cB + hstep + kstep, voffB);
        PG8_WAIT_V(6); PG8_BAR;
    }
    for (;;) {
        const bool has_next = S.next(ui + 1, nxt);
        const char* nA = has_next ? (const char*)g.A + (size_t)nxt.pm * tstep : cA; const char* nB = has_next ? (const char*)g.Bt + (size_t)nxt.pn * tstep : cB;
        for (int t = 0; t < nt; t += 2) {
            const bool last = (t == nt - 2);
            const char* a1 = cA + (size_t)(t + 1) * kstep;
            const char* a2 = last ? nA : cA + (size_t)(t + 2) * kstep; const char* b2 = last ? nB : cB + (size_t)(t + 2) * kstep;
            const char* a3 = a2 + kstep; const char* b3 = b2 + kstep;
            if (last && has_next) S.a_ready(nxt);
            if constexpr (SP2) {
            PG8_LDB(B0, 0, 0); PG8_LDB(B1, 0, 1); PG8_SCHED; PG8_LDA(At, 0, 0); PG8_STAGE(PG8_SA(1, 1), a1 + hstep, voffA);
            PG8_WAIT_V(8); PG8_WAIT_L(0); PG8_BAR; PG8_MMA(0, 0, At, B0); PG8_MMA(0, 1, At, B1); PG8_BAR; PG8_SCHED;
            PG8_LDA(At, 0, 1); PG8_STAGE(PG8_SB(0, 0), b2, voffB); PG8_STAGE(PG8_SB(0, 1), b2 + hstep, voffB); PG8_STAGE(PG8_SA(0, 0), a2, voffA);
            PG8_WAIT_V(8); PG8_WAIT_L(0); PG8_BAR; PG8_MMA(1, 0, At, B0); PG8_MMA(1, 1, At, B1); PG8_BAR; PG8_SCHED;
            PG8_LDB(B0, 1, 0); PG8_LDB(B1, 1, 1); PG8_SCHED; PG8_LDA(At, 1, 0); PG8_STAGE(PG8_SA(0, 1), a2 + hstep, voffA);
            PG8_WAIT_V(8); PG8_WAIT_L(0); PG8_BAR; PG8_MMA(0, 0, At, B0); PG8_MMA(0, 1, At, B1); PG8_BAR; PG8_SCHED;
            PG8_LDA(At, 1, 1); PG8_STAGE(PG8_SB(1, 0), b3, voffB); PG8_STAGE(PG8_SB(1, 1), b3 + hstep, voffB); PG8_STAGE(PG8_SA(1, 0), a3, voffA);
            PG8_WAIT_V(8); PG8_WAIT_L(0); PG8_BAR; PG8_MMA(1, 0, At, B0); PG8_MMA(1, 1, At, B1); PG8_BAR; PG8_SCHED;
            } else {
            PG8_LDB(B0, 0, 0); PG8_SCHED; PG8_LDA(At, 0, 0); PG8_STAGE(PG8_SA(1, 1), a1 + hstep, voffA);
            PG8_WAIT_L(8); PG8_BAR; PG8_WAIT_L(0); PG8_MMA(0, 0, At, B0); PG8_BAR; PG8_SCHED;
            PG8_LDB(B1, 0, 1); PG8_STAGE(PG8_SB(0, 0), b2, voffB);
            PG8_BAR; PG8_WAIT_L(0); PG8_MMA(0, 1, At, B1); PG8_BAR;
            PG8_LDA(At, 0, 1); PG8_STAGE(PG8_SA(0, 0), a2, voffA);
            PG8_BAR; PG8_WAIT_L(0); PG8_MMA(1, 0, At, B0); PG8_BAR; PG8_SCHED;
            PG8_STAGE(PG8_SB(0, 1), b2 + hstep, voffB);
            PG8_WAIT_V(6); PG8_BAR; PG8_MMA(1, 1, At, B1); PG8_BAR;
            PG8_LDB(B0, 1, 0); PG8_SCHED; PG8_LDA(At, 1, 0); PG8_STAGE(PG8_SA(0, 1), a2 + hstep, voffA);
            PG8_WAIT_L(8); PG8_BAR; PG8_WAIT_L(0); PG8_MMA(0, 0, At, B0); PG8_BAR; PG8_SCHED;
            PG8_LDB(B1, 1, 1); PG8_STAGE(PG8_SB(1, 0), b3, voffB);
            PG8_BAR; PG8_WAIT_L(0); PG8_MMA(0, 1, At, B1); PG8_BAR;
            PG8_LDA(At, 1, 1); PG8_STAGE(PG8_SA(1, 0), a3, voffA);
            PG8_BAR; PG8_WAIT_L(0); PG8_MMA(1, 0, At, B0); PG8_BAR; PG8_SCHED;
            PG8_STAGE(PG8_SB(1, 1), b3 + hstep, voffB);
            PG8_WAIT_V(6); PG8_BAR; PG8_MMA(1, 1, At, B1); PG8_BAR;
            }
        }
        if constexpr (ALIGN_EPI) { if (wr == 0) PG8_BAR; }
        if constexpr (!Epi::AFTER_DRAIN) { E(acc, cur, wr, wc, fr, fq); S.done(cur); }
        if (!has_next) break;
#pragma unroll
        for (int a = 0; a < 2; ++a)
#pragma unroll
            for (int b = 0; b < 2; ++b)
#pragma unroll
                for (int m = 0; m < 4; ++m)
#pragma unroll
                    for (int n = 0; n < 2; ++n) acc[a][b][m][n] = (f32x4){0.f, 0.f, 0.f, 0.f};
        cur = nxt; cA = nA; cB = nB; ++ui;
        if constexpr (ALIGN_EPI) { if (wr == 1) PG8_BAR; }
    }
    PG8_WAIT_V(0);
    if constexpr (!ALIGN_EPI) { if (wr == 0) PG8_BAR; }
    PG8_BAR;
    if constexpr (Epi::AFTER_DRAIN) { E.fused(acc, cur, wr, wc, fr, fq, lds, wid, lane); S.done(cur); }
#undef PG8_SA
#undef PG8_SB
#undef PG8_STAGE
#undef PG8_LDA
#undef PG8_LDB
#undef PG8_MMA
#undef PG8_WAIT_V
#undef PG8_WAIT_L
#undef PG8_BAR
#undef PG8_SCHED
}
}

namespace att {
#define LAS __attribute__((address_space(3)))
typedef unsigned short bf16_t;
typedef short bf16x8 __attribute__((ext_vector_type(8)));
typedef short s16x4 __attribute__((ext_vector_type(4)));
typedef short v4i16_t __attribute__((ext_vector_type(4)));
typedef float f32x16 __attribute__((ext_vector_type(16)));
typedef float f32x4 __attribute__((ext_vector_type(4)));
typedef unsigned u32x4 __attribute__((ext_vector_type(4)));
typedef unsigned u32x2 __attribute__((ext_vector_type(2)));
typedef float f32x2_t __attribute__((ext_vector_type(2))); typedef __bf16 bf16x2_t __attribute__((ext_vector_type(2)));
constexpr int SEQ = 4096, INW = 6272, DMODEL = 2176;
constexpr int KP = 272, VP = 320;
constexpr int DIFF_TILE = 128 * KP + 128 * VP;
constexpr int DIL_WAVE = 32 * KP + 32 * VP;
__device__ __forceinline__ unsigned cvtpk(float lo, float hi) { f32x2_t v = {lo, hi}; bf16x2_t b = __builtin_convertvector(v, bf16x2_t); return __builtin_bit_cast(unsigned, b); }
__device__ __forceinline__ int crow(int r, int hi) { return (r & 3) + 8 * (r >> 2) + 4 * hi; }
__device__ __forceinline__ s16x4 vtr(const LAS char* p) { return __builtin_bit_cast(s16x4, __builtin_amdgcn_ds_read_tr16_b64_v4i16((LAS v4i16_t*)p)); }
__device__ __forceinline__ bf16x8 packp(const f32x16& p, int s) {
    u32x4 w; w.x = cvtpk(p[8 * s], p[8 * s + 1]); w.y = cvtpk(p[8 * s + 2], p[8 * s + 3]); w.z = cvtpk(p[8 * s + 4], p[8 * s + 5]); w.w = cvtpk(p[8 * s + 6], p[8 * s + 7]);
    return __builtin_bit_cast(bf16x8, w);
}
#define MFMA32(a, b, c) __builtin_amdgcn_mfma_f32_32x32x16_bf16((a), (b), (c), 0, 0, 0)

__device__ __forceinline__ void diff_unit(LAS char* lds, const bf16_t* QKV, bf16_t* MIX, int b, int h, int qblk, float lam, float negM, const float* g_bout, int tid, int wid, int lane) {
    const int c = wid >> 2, r32 = lane & 31, hh = lane >> 5, cb = (lane >> 4) & 1, q_ = (lane & 15) >> 2, p_ = lane & 3;
    const size_t rowbase = (size_t)b * SEQ; const int q0 = qblk * 128 + (wid & 3) * 32;
    bf16x8 qf[4];
    { const bf16_t* qp = QKV + (rowbase + q0 + r32) * INW + 3072 + h * 128 + c * 64 + 8 * hh;
#pragma unroll
      for (int ks = 0; ks < 4; ++ks) qf[ks] = *(const bf16x8*)(qp + 16 * ks); }
    const int srow = tid >> 4, sch = tid & 15;
    const bf16_t* kg = QKV + (rowbase + srow) * INW + 4096 + h * 128 + sch * 8;
    const bf16_t* vg = kg + 1024;
    LAS char* kst = lds + srow * KP + sch * 16; LAS char* vst = lds + 128 * KP + srow * VP + sch * 16;
    f32x16 o[4];
#pragma unroll
    for (int i = 0; i < 4; ++i)
#pragma unroll
        for (int r = 0; r < 16; ++r) o[i][r] = 0.f;
    float lsum = 0.f;
    f32x16 negm;
#pragma unroll
    for (int r = 0; r < 16; ++r) negm[r] = negM;
    u32x4 kr[4], vr[4];
#pragma unroll
    for (int i = 0; i < 4; ++i) { kr[i] = *(const u32x4*)(kg + (size_t)(32 * i) * INW); vr[i] = *(const u32x4*)(vg + (size_t)(32 * i) * INW); }
#pragma unroll
    for (int i = 0; i < 4; ++i) { *(LAS u32x4*)(kst + 32 * i * KP) = kr[i]; *(LAS u32x4*)(vst + 32 * i * VP) = vr[i]; }
    __syncthreads();
    const int NT = SEQ / 128;
    const LAS char* kread = lds + r32 * KP + (c * 64 + 8 * hh) * 2;
    const LAS char* vread = lds + 128 * KP + (4 * hh + q_) * VP + (16 * cb + 4 * p_) * 2;
    for (int t = 0; t < NT; ++t) {
        const int cur = (t & 1) * DIFF_TILE, nxt = DIFF_TILE - cur;
        const size_t go = (size_t)(t + 1) * 128 * INW; const bool more = t + 1 < NT;
        if (more) {
#pragma unroll
            for (int i = 0; i < 4; ++i) kr[i] = *(const u32x4*)(kg + go + (size_t)(32 * i) * INW); }
        f32x16 pA0 = negm, pA1 = negm, pB0 = negm, pB1 = negm;
#pragma unroll
        for (int ks = 0; ks < 4; ++ks) {
            const bf16x8 k0 = *(const LAS bf16x8*)(kread + cur + ks * 32), k1 = *(const LAS bf16x8*)(kread + cur + 32 * KP + ks * 32);
            pA0 = MFMA32(k0, qf[ks], pA0); pA1 = MFMA32(k1, qf[ks], pA1);
        }
#pragma unroll
        for (int ks = 0; ks < 4; ++ks) {
            const bf16x8 k0 = *(const LAS bf16x8*)(kread + cur + 64 * KP + ks * 32), k1 = *(const LAS bf16x8*)(kread + cur + 96 * KP + ks * 32);
            pB0 = MFMA32(k0, qf[ks], pB0); pB1 = MFMA32(k1, qf[ks], pB1);
        }
        if (more) {
#pragma unroll
            for (int i = 0; i < 4; ++i) *(LAS u32x4*)(kst + nxt + 32 * i * KP) = kr[i];
#pragma unroll
            for (int i = 0; i < 4; ++i) kr[i] = *(const u32x4*)(vg + go + (size_t)(32 * i) * INW); }
        float sa = 0.f, sb = 0.f;
#pragma unroll
        for (int r = 0; r < 16; ++r) { pA0[r] = __builtin_amdgcn_exp2f(pA0[r]); pA1[r] = __builtin_amdgcn_exp2f(pA1[r]); sa += pA0[r]; sb += pA1[r]; }
        bf16x8 pf[4]; pf[0] = packp(pA0, 0); pf[1] = packp(pA0, 1); pf[2] = packp(pA1, 0); pf[3] = packp(pA1, 1);
#pragma unroll
        for (int kst4 = 0; kst4 < 4; ++kst4)
#pragma unroll
            for (int db = 0; db < 4; ++db) {
                const LAS char* a = vread + cur + kst4 * 16 * VP + db * 64;
                const s16x4 lo = vtr(a), hi = vtr(a + 8 * VP);
                const bf16x8 vf = __builtin_shufflevector(lo, hi, 0, 1, 2, 3, 4, 5, 6, 7);
                o[db] = MFMA32(vf, pf[kst4], o[db]);
            }
#pragma unroll
        for (int r = 0; r < 16; ++r) { pB0[r] = __builtin_amdgcn_exp2f(pB0[r]); pB1[r] = __builtin_amdgcn_exp2f(pB1[r]); sa += pB0[r]; sb += pB1[r]; }
        lsum += sa + sb;
        pf[0] = packp(pB0, 0); pf[1] = packp(pB0, 1); pf[2] = packp(pB1, 0); pf[3] = packp(pB1, 1);
#pragma unroll
        for (int kst4 = 0; kst4 < 4; ++kst4)
#pragma unroll
            for (int db = 0; db < 4; ++db) {
                const LAS char* a = vread + cur + (64 + kst4 * 16) * VP + db * 64;
                const s16x4 lo = vtr(a), hi = vtr(a + 8 * VP);
                const bf16x8 vf = __builtin_shufflevector(lo, hi, 0, 1, 2, 3, 4, 5, 6, 7);
                o[db] = MFMA32(vf, pf[kst4], o[db]);
            }
        if (more) {
#pragma unroll
            for (int i = 0; i < 4; ++i) *(LAS u32x4*)(vst + nxt + 32 * i * VP) = kr[i]; }
        __syncthreads();
    }
    const int lane_e = lane_opaque();
    lsum += shflx(lsum, 32, lane_e);
    float inv = 1.0f / lsum; if (c == 1) inv *= lam;
    const int r32e = lane_e & 31, hhe = lane_e >> 5;
    LAS float* X = (LAS float*)lds + (wid & 3) * 4096;
    if (c == 1) {
#pragma unroll
        for (int db = 0; db < 4; ++db)
#pragma unroll
            for (int r = 0; r < 16; ++r) X[(db * 32 + crow(r, hhe)) * 32 + r32e] = o[db][r] * inv;
    }
    __syncthreads();
    if (c == 0) {
        float ss = 0.f;
#pragma unroll
        for (int db = 0; db < 4; ++db)
#pragma unroll
            for (int r = 0; r < 16; ++r) { const float v = o[db][r] * inv - X[(db * 32 + crow(r, hhe)) * 32 + r32e]; o[db][r] = v; ss += v * v; }
        ss += shflx(ss, 32, lane_e);
        const float rn = __builtin_amdgcn_rsqf(ss * (1.0f / 128.0f) + 1e-6f) * 0.8f;
        bf16_t* op = MIX + (rowbase + q0 + r32e) * DMODEL + 1024 + h * 128;
#pragma unroll
        for (int db = 0; db < 4; ++db)
#pragma unroll
            for (int g4 = 0; g4 < 4; ++g4) { const int d0 = db * 32 + 8 * g4 + 4 * hhe; const f32x4 gg = *(const f32x4*)(g_bout + d0);
                u32x2 w; w.x = cvtpk(o[db][4 * g4] * rn * gg[0], o[db][4 * g4 + 1] * rn * gg[1]); w.y = cvtpk(o[db][4 * g4 + 2] * rn * gg[2], o[db][4 * g4 + 3] * rn * gg[3]);
                *(u32x2*)(op + d0) = w; }
    }
    __syncthreads();
}

template <int MODE> __device__ __forceinline__ void dil_unit(LAS char* wl, const bf16_t* QKV, bf16_t* MIX, float* Opart, float* Lpart, int b, int h, int r16, int ib, float negM, const float* g_aout, int lane) {
    const int r32 = lane & 31, hh = lane >> 5, cb = (lane >> 4) & 1, q_ = (lane & 15) >> 2, p_ = lane & 3;
    const size_t rowbase = (size_t)b * SEQ;
    const int t0 = MODE ? r16 + 512 * ib : 32 * (8 * r16 + ib), qs = MODE ? 16 : 1;
    const int tq = t0 + qs * r32;
    bf16x8 qf[8];
    { const bf16_t* qp = QKV + (rowbase + tq) * INW + h * 128 + 8 * hh;
#pragma unroll
      for (int ks = 0; ks < 8; ++ks) qf[ks] = *(const bf16x8*)(qp + 16 * ks); }
    f32x16 o[4];
#pragma unroll
    for (int i = 0; i < 4; ++i)
#pragma unroll
        for (int r = 0; r < 16; ++r) o[i][r] = 0.f;
    float lsum = 0.f;
    f32x16 negm;
#pragma unroll
    for (int r = 0; r < 16; ++r) negm[r] = negM;
    const int lrow = lane >> 4, lch = lane & 15;
    const bf16_t* kvg = QKV + rowbase * INW + 1024 + h * 128 + lch * 8;
    LAS char* kst = wl + lrow * KP + lch * 16; LAS char* vst = wl + 32 * KP + lrow * VP + lch * 16;
    const LAS char* kread = wl + r32 * KP + 8 * hh * 2;
    const LAS char* vread = wl + 32 * KP + (4 * hh + q_) * VP + (16 * cb + 4 * p_) * 2;
    int klo0, khi0, klo1, khi1, klo2, khi2;
    { const int bq = t0 >> 4; int lo_i = bq - 64; if (lo_i < 0) lo_i = 0; klo0 = lo_i >> 5; khi0 = (bq + 31 * (qs >> 4) + 64) >> 5; if (khi0 > 7) khi0 = 7; }
    { const int bq = t0 >> 2; int lo_i = bq - 64; if (lo_i < 0) lo_i = 0; klo1 = lo_i >> 5; khi1 = (bq + 31 * (qs >> 2) + 64) >> 5; if (khi1 > 31) khi1 = 31; }
    { const int bq = t0;      int lo_i = bq - 64; if (lo_i < 0) lo_i = 0; klo2 = lo_i >> 5; khi2 = (bq + 31 * qs + 64) >> 5;        if (khi2 > 127) khi2 = 127; }
    constexpr int PAT_END = MODE ? 2 : 3;
    int pat = MODE ? 0 : 2, kb = MODE ? klo0 : klo2;
    u32x4 kr[8], vr[8];
#define DIL_LOADK(PAT, KB) do { const int sh_ = 4 - 2 * (PAT); const int rc_ = t0 & ((1 << sh_) - 1); \
        _Pragma("unroll") for (int i = 0; i < 8; ++i) { const int tok = rc_ + ((32 * (KB) + lrow + 4 * i) << sh_); kr[i] = *(const u32x4*)(kvg + (size_t)tok * INW); } } while (0)
#define DIL_LOADV(PAT, KB) do { const int sh_ = 4 - 2 * (PAT); const int rc_ = t0 & ((1 << sh_) - 1); \
        _Pragma("unroll") for (int i = 0; i < 8; ++i) { const int tok = rc_ + ((32 * (KB) + lrow + 4 * i) << sh_); vr[i] = *(const u32x4*)(kvg + (size_t)tok * INW + 1024); } } while (0)
#define DIL_ADV() do { const int hi_c = pat == 0 ? khi0 : (pat == 1 ? khi1 : khi2); if (kb < hi_c) ++kb; else { ++pat; kb = pat == 1 ? klo1 : klo2; } } while (0)
#define DIL_WFENCE() do { __builtin_amdgcn_fence(__ATOMIC_RELEASE, "wavefront"); __builtin_amdgcn_wave_barrier(); __builtin_amdgcn_fence(__ATOMIC_ACQUIRE, "wavefront"); } while (0)
#define DIL_S(P) do { P = negm; _Pragma("unroll") for (int ks = 0; ks < 8; ++ks) { const bf16x8 kf = *(const LAS bf16x8*)(kread + ks * 32); P = MFMA32(kf, qf[ks], P); } } while (0)
    int cpat = pat, ckb = kb;
    DIL_LOADK(pat, kb); DIL_LOADV(pat, kb);
#pragma unroll
    for (int i = 0; i < 8; ++i) { *(LAS u32x4*)(kst + 4 * i * KP) = kr[i]; *(LAS u32x4*)(vst + 4 * i * VP) = vr[i]; }
    DIL_ADV();
    bool have1 = pat < PAT_END;
    int npat = pat, nkb = kb;
    if (have1) { DIL_LOADK(pat, kb); DIL_LOADV(pat, kb); DIL_ADV(); }
    DIL_WFENCE();
    f32x16 p, pn;
    DIL_S(p);
    for (;;) {
        const bool have2 = have1 && pat < PAT_END;
        if (have1) {
            DIL_WFENCE();
#pragma unroll
            for (int i = 0; i < 8; ++i) *(LAS u32x4*)(kst + 4 * i * KP) = kr[i];
            if (have2) DIL_LOADK(pat, kb);
            DIL_WFENCE();
            DIL_S(pn);
        }
        const int sh = 4 - 2 * cpat;
        const int qi = (t0 >> sh) + (qs >> sh) * r32;
        float sa = 0.f;
#pragma unroll
        for (int r = 0; r < 16; ++r) { const int dl = 32 * ckb + crow(r, hh) - qi; const float e = __builtin_amdgcn_exp2f(p[r]); const float pv = (dl <= 64 && dl >= -64) ? e : 0.f; p[r] = pv; sa += pv; }
        lsum += sa;
        bf16x8 pf[2]; pf[0] = packp(p, 0); pf[1] = packp(p, 1);
#pragma unroll
        for (int s = 0; s < 2; ++s)
#pragma unroll
            for (int db = 0; db < 4; ++db) {
                const LAS char* a = vread + s * 16 * VP + db * 64;
                const s16x4 lo = vtr(a), hi = vtr(a + 8 * VP);
                const bf16x8 vf = __builtin_shufflevector(lo, hi, 0, 1, 2, 3, 4, 5, 6, 7);
                o[db] = MFMA32(vf, pf[s], o[db]);
            }
        if (!have1) break;
        DIL_WFENCE();
#pragma unroll
        for (int i = 0; i < 8; ++i) *(LAS u32x4*)(vst + 4 * i * VP) = vr[i];
        if (have2) DIL_LOADV(pat, kb);
        DIL_WFENCE();
        p = pn; cpat = npat; ckb = nkb; npat = pat; nkb = kb; have1 = have2;
        if (have2) DIL_ADV();
    }
#undef DIL_LOADK
#undef DIL_LOADV
#undef DIL_ADV
#undef DIL_WFENCE
#undef DIL_S
    const int lane_f = lane_opaque(), hhf = lane_f >> 5, tqf = t0 + qs * (lane_f & 31);
    lsum += shflx(lsum, 32, lane_f);
    float* pp = Opart + ((rowbase + tqf) * 8 + h) * 128; float* lp = Lpart + (rowbase + tqf) * 8 + h;
    if (MODE == 0) {
#pragma unroll
        for (int db = 0; db < 4; ++db)
#pragma unroll
            for (int g4 = 0; g4 < 4; ++g4) *(f32x4*)(pp + db * 32 + 8 * g4 + 4 * hhf) = (f32x4){o[db][4 * g4], o[db][4 * g4 + 1], o[db][4 * g4 + 2], o[db][4 * g4 + 3]};
        if (hhf == 0) *lp = lsum;
        return;
    }
    lsum += *lp;
#pragma unroll
    for (int db = 0; db < 4; ++db)
#pragma unroll
        for (int g4 = 0; g4 < 4; ++g4) { const f32x4 t = *(const f32x4*)(pp + db * 32 + 8 * g4 + 4 * hhf); o[db][4 * g4] += t[0]; o[db][4 * g4 + 1] += t[1]; o[db][4 * g4 + 2] += t[2]; o[db][4 * g4 + 3] += t[3]; }
    const float inv = 1.0f / lsum; float ss = 0.f;
#pragma unroll
    for (int db = 0; db < 4; ++db)
#pragma unroll
        for (int r = 0; r < 16; ++r) { const float v = o[db][r] * inv; o[db][r] = v; ss += v * v; }
    ss += shflx(ss, 32, lane_f);
    const float rn = __builtin_amdgcn_rsqf(ss * (1.0f / 128.0f) + 1e-6f);
    bf16_t* op = MIX + (rowbase + tqf) * DMODEL + h * 128;
#pragma unroll
    for (int db = 0; db < 4; ++db)
#pragma unroll
        for (int g4 = 0; g4 < 4; ++g4) { const int d0 = db * 32 + 8 * g4 + 4 * hhf; const f32x4 gg = *(const f32x4*)(g_aout + d0);
            u32x2 w; w.x = cvtpk(o[db][4 * g4] * rn * gg[0], o[db][4 * g4 + 1] * rn * gg[1]); w.y = cvtpk(o[db][4 * g4 + 2] * rn * gg[2], o[db][4 * g4 + 3] * rn * gg[3]);
            *(u32x2*)(op + d0) = w; }
}
}

constexpr int NWAVES = 8;
constexpr int DM = 2048, NBATCH = 2, SEQ = 4096, MROWS = NBATCH * SEQ, DFF = 5632, INW = 6144;
constexpr size_t MiB = 1u << 20;
constexpr size_t WS_CTL = 0;
constexpr size_t OFF_GTAB = 1 * MiB - 4096;
constexpr size_t OFF_RS0 = 917504;
constexpr size_t OFF_BAR = 983040, BAR_BYTES = 16384;
constexpr size_t OFF_RS1 = 0, OFF_RS2 = 32768, OFF_ROPEA = 65536, OFF_ROPEB = OFF_ROPEA + 2 * 4096 * 16 * 4;
constexpr int LDK = pg8::LDK, LDQ = pg8::LDQ;
constexpr size_t WS_W1A = 1 * MiB, WS_W1B = WS_W1A + 47 * MiB, WS_WIN = WS_W1B + 22 * MiB, WS_WOUT = WS_WIN + 26 * MiB, WS_W2A = WS_WOUT + 9 * MiB, WS_W2B = WS_W2A + 47 * MiB;
constexpr size_t WS_XN = WS_W2B + 22 * MiB;
constexpr size_t WS_ACT = WS_XN + 34 * MiB;
constexpr size_t WS_MIX = WS_ACT + 98 * MiB;
constexpr size_t WS_OPART = WS_MIX + 34 * MiB;
constexpr size_t WS_LPART = WS_OPART + 32 * MiB;
constexpr size_t WS_END = WS_LPART + 1 * MiB;
constexpr int LDS_BYTES = 155648;
constexpr int XCH_OFF = 131072;
static_assert((size_t)11264 * LDK * 2 <= 47 * MiB && (size_t)6144 * LDK * 2 <= 26 * MiB && (size_t)2048 * LDK * 2 <= 9 * MiB && (size_t)8192 * LDK * 2 <= 34 * MiB && (size_t)8192 * LDQ * 2 <= 98 * MiB && att::INW == LDQ && att::DMODEL == LDK, "ws map");
static_assert(att::DIL_WAVE * 8 <= LDS_BYTES - 64 && 3456 * 4 <= BAR_BYTES && 2 * att::DIFF_TILE <= LDS_BYTES - 64 && XCH_OFF + 8192 <= LDS_BYTES, "LDS map");

#define LAS __attribute__((address_space(3)))
typedef unsigned short bf16;
typedef unsigned v4u __attribute__((ext_vector_type(4)));
typedef unsigned v2u __attribute__((ext_vector_type(2)));
typedef float f32x4 __attribute__((ext_vector_type(4)));
__device__ __forceinline__ unsigned f2bf(float f) { unsigned u = __builtin_bit_cast(unsigned, f); return (u + 0x7fffu + ((u >> 16) & 1u)) >> 16; }
__device__ __forceinline__ unsigned pk2(float lo, float hi) { return f2bf(lo) | (f2bf(hi) << 16); }
__device__ __forceinline__ float wave_sum(float v, int lane) {
#pragma unroll
    for (int o = 1; o < 64; o <<= 1) v += shflx(v, o, lane);
    return v;
}
__device__ __forceinline__ float wave_max(float v, int lane) {
#pragma unroll
    for (int o = 1; o < 64; o <<= 1) v = fmaxf(v, shflx(v, o, lane));
    return v;
}
template <bool GLU> __device__ __forceinline__ void tr_load(const float* W, int N, int item, int lane, f32x4 (&v)[8], const float* gk) {
    const int nblk = N / 32, kb = item / nblk, nb = item % nblk, k0 = 64 * kb, n0 = 32 * nb;
    const float* src = W + (size_t)(k0 + (lane >> 3)) * N + n0 + 4 * (lane & 7);
#pragma unroll
    for (int i = 0; i < 8; ++i) v[i] = __builtin_nontemporal_load((const f32x4*)(src + (size_t)(8 * i) * N));
    if (gk) {
#pragma unroll
        for (int i = 0; i < 8; ++i) v[i] = v[i] * gk[k0 + (lane >> 3) + 8 * i]; }
}
template <bool GLU> __device__ __forceinline__ void tr_store(int K, int N, bf16* WT, int ldw, LAS float* scr, int item, int lane, const f32x4 (&v)[8]) {
    const int nblk = N / 32, kb = item / nblk, nb = item % nblk, k0 = 64 * kb, n0 = 32 * nb;
    int r0 = n0;
    if (GLU) { const int half = N / 2; r0 = n0 < half ? (n0 >> 7) * 256 + (n0 & 127) : ((n0 - half) >> 7) * 256 + 128 + ((n0 - half) & 127); }
    const int rg = lane >> 3, c4 = lane & 7;
#pragma unroll
    for (int i = 0; i < 8; ++i) { LAS float* d = scr + (8 * i + rg) * 33 + 4 * c4; d[0] = v[i][0]; d[1] = v[i][1]; d[2] = v[i][2]; d[3] = v[i][3]; }
    asm volatile("s_waitcnt lgkmcnt(0)" ::: "memory");
    const int c = lane & 7;
#pragma unroll
    for (int j = 0; j < 4; ++j) { const int n = (lane >> 3) + 8 * j; const LAS float* s = scr + (8 * c) * 33 + n;
        v4u o; o.x = pk2(s[0 * 33], s[1 * 33]); o.y = pk2(s[2 * 33], s[3 * 33]); o.z = pk2(s[4 * 33], s[5 * 33]); o.w = pk2(s[6 * 33], s[7 * 33]);
        *(v4u*)(WT + (size_t)(r0 + n) * ldw + k0 + 8 * c) = o; }
    asm volatile("s_waitcnt lgkmcnt(0)" ::: "memory");
}
template <bool GLU, int NIF> __device__ __forceinline__ void tr_matrix(const float* W, int K, int N, bf16* WT, int ldw, LAS float* scr, int gw, int NGW, int lane, const float* gk) {
    const int nitems = (K / 64) * (N / 32);
    for (int it = gw; it < nitems; it += NIF * NGW) {
        f32x4 v[NIF][8];
#pragma unroll
        for (int j = 0; j < NIF; ++j) if (it + j * NGW < nitems) tr_load<GLU>(W, N, it + j * NGW, lane, v[j], gk);
#pragma unroll
        for (int j = 0; j < NIF; ++j) if (it + j * NGW < nitems) tr_store<GLU>(K, N, WT, ldw, scr, it + j * NGW, lane, v[j]);
    }
}

#define XB_TMO      128
#define XB_XCNT(j)  (256  + 64 * (j))
#define XB_XSUB(j)  (1280 + 64 * (j))
#define XB_XGEN(j)  (2304 + 64 * (j))
#define XB_TOP      3328
#define XB_TOPGEN   3392
#define XCD_BAR_WORDS 3456
#define XB_SPIN_CAP (1u << 18)

__device__ __forceinline__ unsigned xb_ld(unsigned* p)              { return __hip_atomic_load(p, __ATOMIC_RELAXED, __HIP_MEMORY_SCOPE_AGENT); }
__device__ __forceinline__ unsigned xb_add(unsigned* p, unsigned v) { return __hip_atomic_fetch_add(p, v, __ATOMIC_RELAXED, __HIP_MEMORY_SCOPE_AGENT); }
__device__ __forceinline__ unsigned xb_xcc_id() { return (unsigned)__builtin_amdgcn_s_getreg((3 << 11) | 20) & 0xFu; }
#define XB_SPIN(cond, bar) do { unsigned _sp = 0; while (cond) { __builtin_amdgcn_s_sleep(1); \
    if ((++_sp & 255u) == 0u) { if (xb_ld(&(bar)[XB_TMO])) break; if (_sp > XB_SPIN_CAP) { atomicAdd(&(bar)[XB_TMO], 1u); break; } } } } while (0)

struct XcdBarrier {
    unsigned* bar; unsigned x; int wid;
    volatile LAS unsigned* st;
};

__device__ __forceinline__ bool xb_lane0() { return lane_opaque() == 0; }
__device__ __forceinline__ XcdBarrier xcd_barrier_post(unsigned* bar, volatile LAS unsigned* st, int wid) {
    XcdBarrier b; b.bar = bar; b.x = xb_xcc_id(); b.st = st; b.wid = wid;
    if (wid == 0 && xb_lane0()) (void)xb_add(&bar[XB_XCNT(b.x)], 1u);
    return b;
}
__device__ __forceinline__ void xcd_barrier_complete(unsigned* bar, unsigned x, unsigned& nloc, unsigned& nx) {
    const unsigned G = gridDim.x * gridDim.y * gridDim.z;
    unsigned sum, cnt, mine, sp = 0u;
    for (;;) {
        sum = 0u; cnt = 0u; mine = 0u;
#pragma unroll
        for (unsigned j = 0; j < 16; ++j) { const unsigned c = xb_ld(&bar[XB_XCNT(j)]); sum += c; cnt += (c > 0u) ? 1u : 0u; mine = (j == x) ? c : mine; }
        if (sum == G) break;
        __builtin_amdgcn_s_sleep(1);
        if ((++sp & 255u) == 0u) { if (xb_ld(&bar[XB_TMO])) break; if (sp > XB_SPIN_CAP) { atomicAdd(&bar[XB_TMO], 1u); break; } }
    }
    nloc = mine > 0u ? mine : 1u; nx = cnt > 0u ? cnt : 1u;
}

__device__ __forceinline__ void xcd_barrier(const XcdBarrier& b) {
    asm volatile("s_waitcnt vmcnt(0)" ::: "memory");
    __syncthreads();
    if (b.wid == 0 && xb_lane0()) {
        unsigned* bar = b.bar;
        __builtin_amdgcn_s_waitcnt(0);
        unsigned nloc = b.st[0], nx = b.st[1];
        if (nloc == 0u) { xcd_barrier_complete(bar, b.x, nloc, nx); b.st[0] = nloc; b.st[1] = nx; }
        const unsigned old = xb_add(&bar[XB_XSUB(b.x)], 1u);
        const unsigned gen = old / nloc;
        if (old + 1u == (gen + 1u) * nloc) {
            __builtin_amdgcn_fence(__ATOMIC_RELEASE, "agent");
            asm volatile("s_waitcnt vmcnt(0)" ::: "memory");
            const unsigned og = xb_add(&bar[XB_TOP], 1u);
            const unsigned tg = og / nx;
            if (og + 1u == (tg + 1u) * nx) xb_add(&bar[XB_TOPGEN], 1u);
            else XB_SPIN(xb_ld(&bar[XB_TOPGEN]) == tg, bar);
            __builtin_amdgcn_fence(__ATOMIC_ACQUIRE, "agent");
            xb_add(&bar[XB_XGEN(b.x)], 1u);
            asm volatile("s_waitcnt vmcnt(0)" ::: "memory");
        } else {
            XB_SPIN(xb_ld(&bar[XB_XGEN(b.x)]) == gen, bar);
            __builtin_amdgcn_fence(__ATOMIC_ACQUIRE, "agent");
            asm volatile("s_waitcnt vmcnt(0)" ::: "memory");
        }
    }
    __syncthreads();
}

struct Args {
    const float* in[20]; float* out; unsigned char* ws;
    float invA[16]; float invB[8];
};

__global__ void __launch_bounds__(NWAVES * 64) hybrid_fwd(Args args) {
    extern __shared__ __attribute__((aligned(16))) unsigned char lds_raw[];
    cg::grid_group grid = cg::this_grid();
    LAS unsigned char* lds = (LAS unsigned char*)lds_raw;
    const int wid = __builtin_amdgcn_readfirstlane((int)threadIdx.x >> 6);
#define fresh_lane() lane_opaque()
    const int lane = fresh_lane(), tid = wid * 64 + lane;
    const int G = gridDim.x, bx = blockIdx.x;
    unsigned char* ws = args.ws;
    volatile LAS unsigned* MISC = (volatile LAS unsigned*)(lds + LDS_BYTES - 64);
    if (tid < 16) MISC[tid] = 0u;
    __syncthreads();
    const XcdBarrier bar = xcd_barrier_post((unsigned*)(ws + OFF_BAR), MISC + 8, wid);
    if (G == 0x7fffffff) grid.sync();
    const float* x = args.in[0];
    float* out = args.out;
    float* rowss1 = (float*)(ws + OFF_RS1); float* rowss2 = (float*)(ws + OFF_RS2);
    float* gtab = (float*)(ws + OFF_GTAB); float* ropeA = (float*)(ws + OFF_ROPEA); float* ropeB = (float*)(ws + OFF_ROPEB);
    bf16* W1A = (bf16*)(ws + WS_W1A); bf16* W1B = (bf16*)(ws + WS_W1B); bf16* WIN = (bf16*)(ws + WS_WIN); bf16* WOUT = (bf16*)(ws + WS_WOUT);
    bf16* W2A = (bf16*)(ws + WS_W2A); bf16* W2B = (bf16*)(ws + WS_W2B);
    bf16* XN = (bf16*)(ws + WS_XN); bf16* ACT = (bf16*)(ws + WS_ACT); bf16* QKV = (bf16*)(ws + WS_ACT); bf16* MIX = (bf16*)(ws + WS_MIX);

#ifndef REP_P0
#define REP_P0 1
#endif
#ifndef REP_DIFF
#define REP_DIFF 1
#endif
#ifndef REP_DIL
#define REP_DIL 1
#endif
#define REP_G1 1
#define REP_SHADOW 1
#define REP_G2 1
#define REP_G3 1
#define REP_G5 1
#define REP_G6 1
#define REP_G7 1
    for (int rep = 0; rep < REP_P0; ++rep) {
        LAS float* scr = (LAS float*)(lds + wid * 16384);
        const int gw = bx * NWAVES + wid, NGW = G * NWAVES;
        constexpr int I_FA = (DM / 64) * (2 * DFF / 32), I_FB = (DFF / 64) * (DM / 32), I_IN = (DM / 64) * (INW / 32), I_OUT = (DM / 64) * (DM / 32);
        tr_matrix<true, 2>(args.in[2], DM, 2 * DFF, W1A, LDK, scr, gw, NGW, lane, args.in[1]);
        tr_matrix<true, 2>(args.in[18], DM, 2 * DFF, W2A, LDK, scr, gw, NGW, lane, args.in[17]);
        float* rowss0 = (float*)(ws + OFF_RS0);
        for (int m = gw; m < MROWS; m += NGW) {
            const f32x4* xr = (const f32x4*)(x + (size_t)m * DM) + lane; f32x4 v[8]; float s = 0.f;
#pragma unroll
            for (int j = 0; j < 8; ++j) { v[j] = __builtin_nontemporal_load(xr + 64 * j); s += (v[j][0] * v[j][0] + v[j][1] * v[j][1]) + (v[j][2] * v[j][2] + v[j][3] * v[j][3]); }
            s = wave_sum(s, lane); if (lane == 0) rowss0[m] = s;
            v2u* o8 = (v2u*)(XN + (size_t)m * LDK) + lane;
#pragma unroll
            for (int j = 0; j < 8; ++j) { v2u w; w.x = pk2(v[j][0], v[j][1]); w.y = pk2(v[j][2], v[j][3]); o8[64 * j] = w; }
        }
        const int gt = bx * (NWAVES * 64) + tid, NGT = G * NWAVES * 64;
        for (int i = gt; i < 2 * MROWS; i += NGT) rowss1[i] = 0.f;
        if (gt < 512) { const int t = gt >> 7, d = gt & 127; gtab[gt] = t == 0 ? args.in[6][d] : (t == 1 ? args.in[7][d] : (t == 2 ? args.in[8][d & 63] : args.in[9][d & 63])); }
        for (int i = gt; i < 4096 * 24; i += NGT) {
            const int s = i / 24, k = i % 24; const float inv = k < 16 ? args.invA[k] : args.invB[k - 16];
            const float ang = (float)s * inv; double rev = (double)ang * 0.15915494309189535; rev -= floor(rev);
            const float cs = __builtin_amdgcn_cosf((float)rev), sn = __builtin_amdgcn_sinf((float)rev);
            if (k < 16) { ropeA[s * 16 + k] = cs; ropeA[4096 * 16 + s * 16 + k] = sn; } else { ropeB[s * 8 + k - 16] = cs; ropeB[4096 * 8 + s * 8 + k - 16] = sn; }
        }
    }
    xcd_barrier(bar);

    { pg8::Gemm g{XN, W1A, MROWS, 2 * DFF, DM, LDK}; pg8::StaticOrder S; S.init(MROWS, 2 * DFF, G, bx);
      pg8::EpiSwiGLU E{ACT, DFF, (const float*)(ws + OFF_RS0)};
      pg8::gemm_phase<pg8::EpiSwiGLU, pg8::StaticOrder, true, true>(lds, g, S, E, wid); }
    {
        constexpr int NU = (MROWS / 256) * (2 * DFF / 256);
        const int rounds = (NU + G - 1) / G; int first_idle = NU - (rounds - 1) * G, nidle = G - first_idle;
        if (nidle <= 0) { first_idle = 0; nidle = G; }
        if (bx >= first_idle) {
            LAS float* scr = (LAS float*)(lds + wid * 16384); const int lane_c = fresh_lane();
            const int gw = (bx - first_idle) * NWAVES + wid, NGW = nidle * NWAVES;
            for (int rep = 0; rep < REP_SHADOW; ++rep) {
            tr_matrix<false, 2>(args.in[3], DFF, DM, W1B, DFF, scr, gw, NGW, lane_c, nullptr);
            tr_matrix<false, 2>(args.in[5], DM, INW, WIN, LDK, scr, gw, NGW, lane_c, args.in[4]);
            tr_matrix<false, 2>(args.in[16], DM, DM, WOUT, LDK, scr, gw, NGW, lane_c, nullptr);
            }
        }
    }
    xcd_barrier(bar);
    { pg8::Gemm g{ACT, W1B, MROWS, DM, DFF, DFF}; pg8::StaticOrder S; S.init(MROWS, DM, G, bx);
      pg8::EpiResid<false, true, false> E{nullptr, nullptr, XN, rowss1, 0.5f};
      pg8::gemm_phase<pg8::EpiResid<false, true, false>, pg8::StaticOrder, true, true>(lds, g, S, E, wid); }
    xcd_barrier(bar);
    { pg8::Gemm g{XN, WIN, MROWS, INW, DM, LDK}; pg8::StaticOrder S; S.init(MROWS, INW, G, bx);
      pg8::EpiQKV E{QKV, rowss1, gtab, ropeA, ropeB, (LAS float*)(lds + XCH_OFF)};
      for (int rep = 0; rep < REP_G3; ++rep)
      pg8::gemm_phase<pg8::EpiQKV, pg8::StaticOrder, true, true>(lds, g, S, E, wid); }
    xcd_barrier(bar);
    {
        const float L2E = 1.4426950408889634f;
        const int lane_a = fresh_lane();
        const float gq = fmaxf(fabsf(args.in[6][lane_a]), fabsf(args.in[6][lane_a + 64])), gk = fmaxf(fabsf(args.in[7][lane_a]), fabsf(args.in[7][lane_a + 64]));
        const float negMA = __builtin_bit_cast(float, __builtin_amdgcn_readfirstlane(__builtin_bit_cast(int, -1.02f * 11.313708498984761f * wave_max(gq, lane_a) * wave_max(gk, lane_a) * L2E)));
        const float negMB = __builtin_bit_cast(float, __builtin_amdgcn_readfirstlane(__builtin_bit_cast(int, -1.02f * 8.0f * wave_max(fabsf(args.in[8][lane_a]), lane_a) * wave_max(fabsf(args.in[9][lane_a]), lane_a) * L2E)));
        const float lam = __builtin_bit_cast(float, __builtin_amdgcn_readfirstlane(__builtin_bit_cast(int, __expf(wave_sum(args.in[10][lane_a] * args.in[11][lane_a], lane_a)) - __expf(wave_sum(args.in[12][lane_a] * args.in[13][lane_a], lane_a)) + 0.2f)));
        float* Opart = (float*)(ws + WS_OPART); float* Lpart = (float*)(ws + WS_LPART);
        {
            const int lane_d = fresh_lane();
            for (int wu = bx * NWAVES + wid; wu < 2048; wu += G * NWAVES) {
                const int ib = wu & 7, r16 = (wu >> 3) & 15, h = (wu >> 7) & 7, b = wu >> 10;
                att::dil_unit<0>((LAS char*)lds + wid * att::DIL_WAVE, QKV, MIX, Opart, Lpart, b, h, r16, ib, negMA, args.in[14], lane_d);
            }
        }
        xcd_barrier(bar);
        {
            const int tid_a = wid * 64 + fresh_lane();
            for (int rep = 0; rep < REP_DIFF; ++rep)
            for (int u = bx; u < 512; u += G) {
                const int bh = u >> 5, qblk = u & 31;
                att::diff_unit((LAS char*)lds, QKV, MIX, bh >> 3, bh & 7, qblk, lam, negMB, args.in[15], tid_a, wid, tid_a & 63);
            }
        }
        {
            const int lane_d = fresh_lane();
            for (int rep = 0; rep < REP_DIL; ++rep)
            for (int wu = bx * NWAVES + wid; wu < 2048; wu += G * NWAVES) {
                const int ib = wu & 7, r16 = (wu >> 3) & 15, h = (wu >> 7) & 7, b = wu >> 10;
                att::dil_unit<1>((LAS char*)lds + wid * att::DIL_WAVE, QKV, MIX, Opart, Lpart, b, h, r16, ib, negMA, args.in[14], lane_d);
            }
        }
    }
    xcd_barrier(bar);
    { pg8::Gemm g{MIX, WOUT, MROWS, DM, DM, LDK}; pg8::StaticOrder S; S.init(MROWS, DM, G, bx);
      pg8::EpiResid<false, true, false> E{nullptr, nullptr, XN, rowss2, 1.0f};
      pg8::gemm_phase<pg8::EpiResid<false, true, false>, pg8::StaticOrder, true, true>(lds, g, S, E, wid); }
    xcd_barrier(bar);
    { pg8::Gemm g{XN, W2A, MROWS, 2 * DFF, DM, LDK}; pg8::StaticOrder S; S.init(MROWS, 2 * DFF, G, bx);
      pg8::EpiSwiGLU E{ACT, DFF, rowss2};
      for (int rep = 0; rep < REP_G6; ++rep)
      pg8::gemm_phase<pg8::EpiSwiGLU, pg8::StaticOrder, true, true>(lds, g, S, E, wid); }
    {
        constexpr int NU = (MROWS / 256) * (2 * DFF / 256);
        const int rounds = (NU + G - 1) / G; int first_idle = NU - (rounds - 1) * G, nidle = G - first_idle;
        if (nidle <= 0) { first_idle = 0; nidle = G; }
        if (bx >= first_idle) tr_matrix<false, 2>(args.in[19], DFF, DM, W2B, DFF, (LAS float*)(lds + wid * 16384), (bx - first_idle) * NWAVES + wid, nidle * NWAVES, fresh_lane(), nullptr);
    }
    xcd_barrier(bar);
    { pg8::Gemm g{ACT, W2B, MROWS, DM, DFF, DFF}; pg8::StaticOrder S; S.init(MROWS, DM, G, bx);
      pg8::EpiResid<false, false, true> E{nullptr, out, XN, nullptr, 0.5f};
      pg8::gemm_phase<pg8::EpiResid<false, false, true>, pg8::StaticOrder, true, true>(lds, g, S, E, wid); }
}

extern "C" void kernel_launch(void* const* d_in, const int* in_sizes, int n_in, void* d_out, int out_size, void* d_ws, size_t ws_size, hipStream_t stream) {
    static int grid = 0;
    if (grid == 0) {
        if (n_in != 20 || in_sizes[0] != MROWS * DM || out_size != MROWS * DM || ws_size < WS_END) {
            fprintf(stderr, "kernel_launch: unexpected shapes (n_in %d, in0 %d, out %d, ws %zu < %zu)\n", n_in, n_in > 0 ? in_sizes[0] : -1, out_size, ws_size, (size_t)WS_END); grid = -1; return; }
        int dev = 0, cus = 0, per_cu = 0;
        (void)hipGetDevice(&dev); (void)hipDeviceGetAttribute(&cus, hipDeviceAttributeMultiprocessorCount, dev);
        if (hipFuncSetAttribute((const void*)hybrid_fwd, hipFuncAttributeMaxDynamicSharedMemorySize, LDS_BYTES) != hipSuccess) { fprintf(stderr, "kernel_launch: hipFuncSetAttribute failed\n"); grid = -1; return; }
        if (hipOccupancyMaxActiveBlocksPerMultiprocessor(&per_cu, (const void*)hybrid_fwd, NWAVES * 64, LDS_BYTES) != hipSuccess || per_cu < 1) { fprintf(stderr, "kernel_launch: occupancy query says %d\n", per_cu); per_cu = 1; }
        (void)hipGetLastError();
        grid = cus * per_cu;
    }
    if (grid < 0) return;
    Args a{};
    for (int i = 0; i < 20; ++i) a.in[i] = (const float*)d_in[i];
    a.out = (float*)d_out; a.ws = (unsigned char*)d_ws;
    for (int i = 0; i < 16; ++i) a.invA[i] = (float)pow(500000.0, -(double)i / 16.0);
    for (int i = 0; i < 8; ++i) a.invB[i] = (float)pow(500000.0, -(double)i / 8.0);
    if (hipMemsetAsync((char*)d_ws + OFF_BAR, 0, BAR_BYTES, stream) != hipSuccess) { fprintf(stderr, "kernel_launch: memset failed\n"); return; }
    void* kargs[] = {&a};
    hipError_t e = hipLaunchCooperativeKernel((const void*)hybrid_fwd, dim3(grid), dim3(NWAVES * 64), kargs, LDS_BYTES, stream);
    if (e != hipSuccess) fprintf(stderr, "kernel_launch: cooperative launch failed: %s (grid %d)\n", hipGetErrorString(e), grid);
}
```

```cpp
#include <hip/hip_runtime.h>
#include <hip/hip_cooperative_groups.h>
#include <cstdio>
#include <cstdint>
#include <cmath>
namespace cg = cooperative_groups;
__device__ __forceinline__ int lane_opaque() { unsigned z = 0u; asm volatile("" : "+v"(z)); return (int)__builtin_amdgcn_mbcnt_hi(~0u, __builtin_amdgcn_mbcnt_lo(~0u, z)); }
__device__ __forceinline__ float shflx(float v, int mask, int lane) { return __builtin_bit_cast(float, __builtin_amdgcn_ds_bpermute((lane ^ mask) << 2, __builtin_bit_cast(int, v))); }
namespace pg8 {
#define PG8_LAS __attribute__((address_space(3)))
typedef unsigned short bf16_t;
typedef short bf16x8 __attribute__((ext_vector_type(8)));
typedef float f32x4 __attribute__((ext_vector_type(4)));
typedef unsigned u32x4 __attribute__((ext_vector_type(4)));
constexpr int BM = 256, BK = 64, HALF = 128, HTB = HALF * BK * 2  , STAGE_BYTES = 8 * HTB, NXCD = 8, WGM = 8;

__host__ __device__ __forceinline__ int lds_byte(int r, int c) { const int st = (r >> 4) * 2 + (c >> 5), rr = r & 15, cc = c & 31, ob = rr * 64 + cc * 2; return st * 1024 + (ob ^ (((ob >> 9) & 1) << 5)); }
__host__ __device__ __forceinline__ void stage_rc(int b, int& R, int& C) { const int st = b / 1024, sb = b % 1024, swz = sb ^ (((sb >> 9) & 1) << 5); R = (st >> 1) * 16 + swz / 64; C = (st & 1) * 32 + (swz % 64) / 2; }
__host__ __device__ __forceinline__ int perm32(int rho) { const int n = rho >> 4, i = rho & 15; return 8 * (i >> 2) + 4 * n + (i & 3); }

struct Unit { int pm, pn; };
struct Gemm { const bf16_t* A; const bf16_t* Bt; int M, N, K, ld; };

struct StaticOrder {
    int nM, nN, nwg, G, c;
    __host__ __device__ void init(int M, int N, int G_, int c_) { nM = M / BM; nN = N / BM; nwg = nM * nN; G = G_; c = c_; }
    __host__ __device__ bool next(int i, Unit& u) const {
        const long L = (long)i * G + c; if (L >= nwg) return false;
        int wgid = (int)L; { const int q = nwg / NXCD, r = nwg % NXCD, xcd = wgid % NXCD, off = wgid / NXCD; wgid = (xcd < r ? xcd * (q + 1) : r * (q + 1) + (xcd - r) * q) + off; }
        const int nig = WGM * nN, gid = wgid / nig, fm = gid * WGM, gsz = (nM - fm) < WGM ? (nM - fm) : WGM;
        u.pm = fm + ((wgid % nig) % gsz); u.pn = (wgid % nig) / gsz; return true;
    }
    __device__ __forceinline__ void a_ready(const Unit&) const {}
    __device__ __forceinline__ void done(const Unit&) const {}
};

__device__ __forceinline__ unsigned cvt_pk_bf16(float lo, float hi) { unsigned r; asm volatile("v_cvt_pk_bf16_f32 %0, %1, %2" : "=v"(r) : "v"(lo), "v"(hi)); return r; }
typedef float f32x2 __attribute__((ext_vector_type(2)));

typedef unsigned u32x2 __attribute__((ext_vector_type(2)));
constexpr int LDK = 2048, LDQ = 6144;
__device__ __forceinline__ float fast_silu(float g) { return g * __builtin_amdgcn_rcpf(1.0f + __expf(-g)); }

struct EpiSwiGLU {
    static constexpr bool PERM = true, AFTER_DRAIN = false;
    bf16_t* O; int ldc; const float* rowss;
    __device__ __forceinline__ void operator()(f32x4 (&acc)[2][2][4][2], const Unit& u, int wr, int wc, int fr, int fq) const {
        const int row0 = u.pm * BM + wr * 64 + fr; const int col0 = u.pn * HALF + wc * 32 + 8 * fq;
        float rsv[2][4];
#pragma unroll
        for (int ai = 0; ai < 2; ++ai)
#pragma unroll
            for (int m = 0; m < 4; ++m) rsv[ai][m] = rowss ? rowss[row0 + ai * HALF + m * 16] : 0.f;
#pragma unroll
        for (int ai = 0; ai < 2; ++ai)
#pragma unroll
            for (int m = 0; m < 4; ++m) rsv[ai][m] = rowss ? __builtin_amdgcn_rsqf(rsv[ai][m] * (1.0f / 2048.0f) + 1e-6f) : 1.0f;
        asm volatile("" : "+v"(rsv[0][0]), "+v"(rsv[0][1]), "+v"(rsv[0][2]), "+v"(rsv[0][3]), "+v"(rsv[1][0]), "+v"(rsv[1][1]), "+v"(rsv[1][2]), "+v"(rsv[1][3]));
#pragma unroll
        for (int ai = 0; ai < 2; ++ai)
#pragma unroll
            for (int m = 0; m < 4; ++m) {
                const int row = row0 + ai * HALF + m * 16;
                const float rs = rsv[ai][m];
                f32x4 g0 = acc[ai][0][m][0] * rs, g1 = acc[ai][0][m][1] * rs, u0 = acc[ai][1][m][0] * rs, u1 = acc[ai][1][m][1] * rs;
                u32x4 w;
                w.x = cvt_pk_bf16(fast_silu(g0[0]) * u0[0], fast_silu(g0[1]) * u0[1]); w.y = cvt_pk_bf16(fast_silu(g0[2]) * u0[2], fast_silu(g0[3]) * u0[3]);
                w.z = cvt_pk_bf16(fast_silu(g1[0]) * u1[0], fast_silu(g1[1]) * u1[1]); w.w = cvt_pk_bf16(fast_silu(g1[2]) * u1[2], fast_silu(g1[3]) * u1[3]);
                *(u32x4*)(O + (size_t)row * ldc + col0) = w;
            }
    }
};

template <bool BASE_F32, bool WRITE_XN, bool WRITE_OUT> struct EpiResid {
    static constexpr bool PERM = false, AFTER_DRAIN = false;
    const float* base; float* out; bf16_t* xn; float* rowss; float alpha;
    __device__ __forceinline__ void operator()(f32x4 (&acc)[2][2][4][2], const Unit& u, int wr, int wc, int fr, int fq) const {
        const int row0 = u.pm * BM + wr * 64 + fr; const int col0 = u.pn * BM + wc * 32 + 4 * fq;
#pragma unroll
        for (int ai = 0; ai < 2; ++ai) {
            f32x4 bpre[4][2][2];
#pragma unroll
            for (int m = 0; m < 4; ++m) { const int row = row0 + ai * HALF + m * 16;
#pragma unroll
                for (int bj = 0; bj < 2; ++bj)
#pragma unroll
                    for (int n = 0; n < 2; ++n) {
                        if (BASE_F32) bpre[m][bj][n] = *(const f32x4*)(base + (size_t)row * 2048 + col0 + bj * HALF + n * 16);
                        else { const u32x2 w = *(const u32x2*)(xn + (size_t)row * LDK + col0 + bj * HALF + n * 16);
                               bpre[m][bj][n] = (f32x4){__builtin_bit_cast(float, w.x << 16), __builtin_bit_cast(float, w.x & 0xffff0000u), __builtin_bit_cast(float, w.y << 16), __builtin_bit_cast(float, w.y & 0xffff0000u)}; }
                    } }
#pragma unroll
            for (int m = 0; m < 4; ++m) {
                const int row = row0 + ai * HALF + m * 16; float ss = 0.f;
#pragma unroll
                for (int bj = 0; bj < 2; ++bj)
#pragma unroll
                    for (int n = 0; n < 2; ++n) {
                        const f32x4 o = bpre[m][bj][n] + acc[ai][bj][m][n] * alpha;
                        if (WRITE_OUT) __builtin_nontemporal_store(o, (f32x4*)(out + (size_t)row * 2048 + col0 + bj * HALF + n * 16));
                        if (WRITE_XN) {
                            ss += (o[0] * o[0] + o[1] * o[1]) + (o[2] * o[2] + o[3] * o[3]);
                            u32x2 w; w.x = cvt_pk_bf16(o[0], o[1]); w.y = cvt_pk_bf16(o[2], o[3]);
                            *(u32x2*)(xn + (size_t)row * LDK + col0 + bj * HALF + n * 16) = w;
                        }
                    }
                if (WRITE_XN) { ss += shflx(ss, 16, fq * 16 + fr); ss += shflx(ss, 32, fq * 16 + fr); if (fq == 0) atomicAdd(rowss + row, ss); }
            }
            asm volatile("" ::: "memory");
        }
    }
};

struct EpiQKV {
    static constexpr bool PERM = false, AFTER_DRAIN = false;
    bf16_t* O; const float* rowss; const float* gtab;
    const float* ropeA; const float* ropeB;
    PG8_LAS float* xch;
    __device__ __forceinline__ void operator()(f32x4 (&acc)[2][2][4][2], const Unit& u, int wr, int wc, int, int) const {
        const int lane_q = lane_opaque(), fr = lane_q & 15, fq = lane_q >> 4;
        const int region = u.pn >> 2;
        const int row0 = u.pm * BM + wr * 64 + fr;
#pragma unroll
        for (int ai = 0; ai < 2; ++ai)
#pragma unroll
            for (int m = 0; m < 4; ++m) {
                const float rs = __builtin_amdgcn_rsqf(rowss[row0 + ai * HALF + m * 16] * (1.0f / 2048.0f) + 1e-6f);
#pragma unroll
                for (int bj = 0; bj < 2; ++bj)
#pragma unroll
                    for (int n = 0; n < 2; ++n) acc[ai][bj][m][n] = acc[ai][bj][m][n] * rs;
            }
        const bool isv = (region == 2) || (region == 5);
        if (!isv) {
            const bool isA = region < 2;
            const bool do_rope = isA ? (wc == 0) : ((wc & 1) == 0);
#pragma unroll
            for (int ai = 0; ai < 2; ++ai)
#pragma unroll
                for (int m = 0; m < 4; ++m)
#pragma unroll
                    for (int bj = 0; bj < 2; ++bj) {
                        const f32x4 a = acc[ai][bj][m][0], b = acc[ai][bj][m][1];
                        float s = ((a[0] * a[0] + a[1] * a[1]) + (a[2] * a[2] + a[3] * a[3])) + ((b[0] * b[0] + b[1] * b[1]) + (b[2] * b[2] + b[3] * b[3]));
                        s += shflx(s, 16, fq * 16 + fr); s += shflx(s, 32, fq * 16 + fr);
                        if (fq == 0) xch[((ai * HALF + wr * 64 + m * 16 + fr) * 2 + bj) * 4 + wc] = s;
                    }
            asm volatile("s_waitcnt lgkmcnt(0)" ::: "memory"); __builtin_amdgcn_s_barrier(); asm volatile("" ::: "memory");
            const float* gptr = gtab + (region < 2 ? region : region - 1) * 128;
            const int dbase = isA ? wc * 32 : (wc & 1) * 32;
            f32x4 gv[2]; gv[0] = *(const f32x4*)(gptr + dbase + 4 * fq); gv[1] = *(const f32x4*)(gptr + dbase + 16 + 4 * fq);
            const float qs = region == 0 ? (0.08838834764831845f * 1.4426950408889634f) : (region == 3 ? (0.125f * 1.4426950408889634f) : 1.0f);
#pragma unroll
            for (int ai = 0; ai < 2; ++ai) {
                f32x4 csv[4], snv[4];
                if (do_rope) {
#pragma unroll
                    for (int m = 0; m < 4; ++m) { const int spos = (u.pm * BM + ai * HALF + wr * 64 + m * 16 + fr) & 4095;
                        const float* rp = isA ? ropeA + spos * 16 + 4 * fq : ropeB + spos * 8 + 4 * (fq & 1);
                        csv[m] = *(const f32x4*)rp; snv[m] = *(const f32x4*)(rp + (isA ? 4096 * 16 : 4096 * 8)); }
                }
#pragma unroll
                for (int m = 0; m < 4; ++m) {
                    const int rl = ai * HALF + wr * 64 + m * 16 + fr;
#pragma unroll
                    for (int bj = 0; bj < 2; ++bj) {
                        const f32x4 p = *(const PG8_LAS f32x4*)(xch + (rl * 2 + bj) * 4);
                        float rn;
                        if (isA) rn = __builtin_amdgcn_rsqf(((p[0] + p[1]) + (p[2] + p[3])) * (1.0f / 128.0f) + 1e-6f);
                        else rn = __builtin_amdgcn_rsqf(((wc < 2) ? (p[0] + p[1]) : (p[2] + p[3])) * (1.0f / 64.0f) + 1e-6f);
                        f32x4 v0 = acc[ai][bj][m][0] * rn * gv[0], v1 = acc[ai][bj][m][1] * rn * gv[1];
                        if (isA) {
                            if (do_rope) {
                                const f32x4 cs = csv[m], sn = snv[m];
                                const f32x4 x1 = v0, x2 = v1; v0 = x1 * cs - x2 * sn; v1 = x2 * cs + x1 * sn;
                            }
                        } else {
                            if (do_rope) {
                                const f32x4 cs = csv[m], sn = snv[m];
                                f32x4 pt; pt[0] = shflx(v0[0], 32, fq * 16 + fr); pt[1] = shflx(v0[1], 32, fq * 16 + fr); pt[2] = shflx(v0[2], 32, fq * 16 + fr); pt[3] = shflx(v0[3], 32, fq * 16 + fr);
                                v0 = (fq < 2) ? (v0 * cs - pt * sn) : (v0 * cs + pt * sn);
                            }
                        }
                        acc[ai][bj][m][0] = v0 * qs; acc[ai][bj][m][1] = v1 * qs;
                    }
                }
                asm volatile("" ::: "memory");
            }
        }
        const int col0 = u.pn * BM + wc * 32 + 4 * fq;
#pragma unroll
        for (int ai = 0; ai < 2; ++ai)
#pragma unroll
            for (int m = 0; m < 4; ++m) { bf16_t* rowp = O + (size_t)(row0 + ai * HALF + m * 16) * LDQ + col0;
#pragma unroll
                for (int bj = 0; bj < 2; ++bj)
#pragma unroll
                    for (int n = 0; n < 2; ++n) { const f32x4 v = acc[ai][bj][m][n]; u32x2 w; w.x = cvt_pk_bf16(v[0], v[1]); w.y = cvt_pk_bf16(v[2], v[3]); *(u32x2*)(rowp + bj * HALF + n * 16) = w; } }
    }
};
template <class Epi, class Sched, bool ALIGN_EPI = false, bool SP2 = false>
__device__ __forceinline__ void gemm_phase(PG8_LAS unsigned char* lds, const Gemm g, const Sched& S, const Epi& E, const int wid_s) {
    const int lane_ = lane_opaque();
    const int tid = wid_s * 64 + lane_, wid = wid_s, lane = tid & 63, wr = wid >> 2, wc = wid & 3, fr = lane & 15, fq = lane >> 4;
    const int K = g.ld, nt = g.K / BK;
    unsigned voffA[2], voffB[2];
#pragma unroll
    for (int i = 0; i < 2; ++i) { int R, C; stage_rc(tid * 16 + i * 8192, R, C); const int Rb = Epi::PERM ? ((R & ~31) + perm32(R & 31)) : R;
        voffA[i] = (unsigned)(R * K + C) * 2u; voffB[i] = (unsigned)(Rb * K + C) * 2u; }
    const size_t kstep = (size_t)(BK * 2);
    const size_t hstep = (size_t)HALF * K * 2;
    const size_t tstep = 2 * hstep;
    const unsigned ldsw = (unsigned)wid * 1024u;
    const int aoff = lds_byte(wr * 64 + fr, fq * 8), boff = lds_byte(wc * 32 + fr, fq * 8);
#define PG8_SA(b, h) (((b) * 2 + (h)) * HTB)
#define PG8_SB(b, h) ((4 + (b) * 2 + (h)) * HTB)
#define PG8_STAGE(bufoff, gbase, voff) do { _Pragma("unroll") for (int _i = 0; _i < 2; ++_i) \
        __builtin_amdgcn_global_load_lds((const unsigned*)((const char*)(gbase) + (voff)[_i]), (PG8_LAS unsigned*)(lds + (bufoff) + ldsw + _i * 8192), 16, 0, 0); } while (0)
#define PG8_LDA(dst, b, h) do { _Pragma("unroll") for (int m = 0; m < 4; ++m) _Pragma("unroll") for (int k = 0; k < 2; ++k) dst[m][k] = *(const PG8_LAS bf16x8*)(lds + PG8_SA(b, h) + aoff + m * 2048 + k * 1024); } while (0)
#define PG8_LDB(dst, b, h) do { _Pragma("unroll") for (int n = 0; n < 2; ++n) _Pragma("unroll") for (int k = 0; k < 2; ++k) dst[n][k] = *(const PG8_LAS bf16x8*)(lds + PG8_SB(b, h) + boff + n * 2048 + k * 1024); } while (0)
#define PG8_MMA(ai, bj, At, Bt) do { __builtin_amdgcn_s_setprio(1); _Pragma("unroll") for (int m = 0; m < 4; ++m) _Pragma("unroll") for (int n = 0; n < 2; ++n) _Pragma("unroll") for (int k = 0; k < 2; ++k) \
        acc[ai][bj][m][n] = __builtin_amdgcn_mfma_f32_16x16x32_bf16(Bt[n][k], At[m][k], acc[ai][bj][m][n], 0, 0, 0); __builtin_amdgcn_s_setprio(0); } while (0)
#define PG8_WAIT_V(n) asm volatile("s_waitcnt vmcnt(" #n ")" ::: "memory")
#define PG8_WAIT_L(n) asm volatile("s_waitcnt lgkmcnt(" #n ")" ::: "memory")
#define PG8_BAR __builtin_amdgcn_s_barrier()
#define PG8_SCHED __builtin_amdgcn_sched_barrier(0)
    Unit cur, nxt; int ui = 0;
    if (!S.next(0, cur)) return;
    f32x4 acc[2][2][4][2];
#pragma unroll
    for (int a = 0; a < 2; ++a)
#pragma unroll
        for (int b = 0; b < 2; ++b)
#pragma unroll
            for (int m = 0; m < 4; ++m)
#pragma unroll
                for (int n = 0; n < 2; ++n) acc[a][b][m][n] = (f32x4){0.f, 0.f, 0.f, 0.f};
    bf16x8 At[4][2], B0[2][2], B1[2][2];
    const char* cA = (const char*)g.A + (size_t)cur.pm * tstep; const char* cB = (const char*)g.Bt + (size_t)cur.pn * tstep;
    S.a_ready(cur);
    if constexpr (SP2) {
        PG8_STAGE(PG8_SB(0, 0), cB, voffB); PG8_STAGE(PG8_SB(0, 1), cB + hstep, voffB); PG8_STAGE(PG8_SA(0, 0), cA, voffA); PG8_STAGE(PG8_SA(0, 1), cA + hstep, voffA);
        if (wr == 1) PG8_BAR;
        PG8_WAIT_V(2); PG8_BAR;
        PG8_STAGE(PG8_SB(1, 0), cB + kstep, voffB); PG8_STAGE(PG8_SA(1, 0), cA + kstep, voffA); PG8_STAGE(PG8_SB(1, 1), cB + hstep + kstep, voffB);
        PG8_WAIT_V(6); PG8_BAR;
    } else {
        PG8_STAGE(PG8_SB(0, 0), cB, voffB); PG8_STAGE(PG8_SA(0, 0), cA, voffA); PG8_STAGE(PG8_SB(0, 1), cB + hstep, voffB); PG8_STAGE(PG8_SA(0, 1), cA + hstep, voffA);
        if (wr == 1) PG8_BAR;
        PG8_WAIT_V(4); PG8_BAR;
        PG8_STAGE(PG8_SB(1, 0), cB + kstep, voffB); PG8_STAGE(PG8_SA(1, 0), cA + kstep, voffA); PG8_STAGE(PG8_SB(1, 1), cB + hstep + kstep, voffB);
        PG8_WAIT_V(6); PG8_BAR;
    }
    for (;;) {
        const bool has_next = S.next(ui + 1, nxt);
        const char* nA = has_next ? (const char*)g.A + (size_t)nxt.pm * tstep : cA; const char* nB = has_next ? (const char*)g.Bt + (size_t)nxt.pn * tstep : cB;
        for (int t = 0; t < nt; t += 2) {
            const bool last = (t == nt - 2);
            const char* a1 = cA + (size_t)(t + 1) * kstep;
            const char* a2 = last ? nA : cA + (size_t)(t + 2) * kstep; const char* b2 = last ? nB : cB + (size_t)(t + 2) * kstep;
            const char* a3 = a2 + kstep; const char* b3 = b2 + kstep;
            if (last && has_next) S.a_ready(nxt);
            if constexpr (SP2) {
            PG8_LDB(B0, 0, 0); PG8_LDB(B1, 0, 1); PG8_SCHED; PG8_LDA(At, 0, 0); PG8_STAGE(PG8_SA(1, 1), a1 + hstep, voffA);
            PG8_WAIT_V(8); PG8_WAIT_L(0); PG8_BAR; PG8_MMA(0, 0, At, B0); PG8_MMA(0, 1, At, B1); PG8_BAR; PG8_SCHED;
            PG8_LDA(At, 0, 1); PG8_STAGE(PG8_SB(0, 0), b2, voffB); PG8_STAGE(PG8_SB(0, 1), b2 + hstep, voffB); PG8_STAGE(PG8_SA(0, 0), a2, voffA);
            PG8_WAIT_V(8); PG8_WAIT_L(0); PG8_BAR; PG8_MMA(1, 0, At, B0); PG8_MMA(1, 1, At, B1); PG8_BAR; PG8_SCHED;
            PG8_LDB(B0, 1, 0); PG8_LDB(B1, 1, 1); PG8_SCHED; PG8_LDA(At, 1, 0); PG8_STAGE(PG8_SA(0, 1), a2 + hstep, voffA);
            PG8_WAIT_V(8); PG8_WAIT_L(0); PG8_BAR; PG8_MMA(0, 0, At, B0); PG8_MMA(0, 1, At, B1); PG8_BAR; PG8_SCHED;
            PG8_LDA(At, 1, 1); PG8_STAGE(PG8_SB(1, 0), b3, voffB); PG8_STAGE(PG8_SB(1, 1), b3 + hstep, voffB); PG8_STAGE(PG8_SA(1, 0), a3, voffA);
            PG8_WAIT_V(8); PG8_WAIT_L(0); PG8_BAR; PG8_MMA(1, 0, At, B0); PG8_MMA(1, 1, At, B1); PG8_BAR; PG8_SCHED;
            } else {
            PG8_LDB(B0, 0, 0); PG8_SCHED; PG8_LDA(At, 0, 0); PG8_STAGE(PG8_SA(1, 1), a1 + hstep, voffA);
            PG8_WAIT_L(8); PG8_BAR; PG8_WAIT_L(0); PG8_MMA(0, 0, At, B0); PG8_BAR; PG8_SCHED;
            PG8_LDB(B1, 0, 1); PG8_STAGE(PG8_SB(0, 0), b2, voffB);
            PG8_BAR; PG8_WAIT_L(0); PG8_MMA(0, 1, At, B1); PG8_BAR;
            PG8_LDA(At, 0, 1); PG8_STAGE(PG8_SA(0, 0), a2, voffA);
            PG8_BAR; PG8_WAIT_L(0); PG8_MMA(1, 0, At, B0); PG8_BAR; PG8_SCHED;
            PG8_STAGE(PG8_SB(0, 1), b2 + hstep, voffB);
            PG8_WAIT_V(6); PG8_BAR; PG8_MMA(1, 1, At, B1); PG8_BAR;
            PG8_LDB(B0, 1, 0); PG8_SCHED; PG8_LDA(At, 1, 0); PG8_STAGE(PG8_SA(0, 1), a2 + hstep, voffA);
            PG8_WAIT_L(8); PG8_BAR; PG8_WAIT_L(0); PG8_MMA(0, 0, At, B0); PG8_BAR; PG8_SCHED;
            PG8_LDB(B1, 1, 1); PG8_STAGE(PG8_SB(1, 0), b3, voffB);
            PG8_BAR; PG8_WAIT_L(0); PG8_MMA(0, 1, At, B1); PG8_BAR;
            PG8_LDA(At, 1, 1); PG8_STAGE(PG8_SA(1, 0), a3, voffA);
            PG8_BAR; PG8_WAIT_L(0); PG8_MMA(1, 0, At, B0); PG8_BAR; PG8_SCHED;
            PG8_STAGE(PG8_SB(1, 1), b3 + hstep, voffB);
            PG8_WAIT_V(6); PG8_BAR; PG8_MMA(1, 1, At, B1); PG8_BAR;
            }
        }
        if constexpr (ALIGN_EPI) { if (wr == 0) PG8_BAR; }
        if constexpr (!Epi::AFTER_DRAIN) { E(acc, cur, wr, wc, fr, fq); S.done(cur); }
        if (!has_next) break;
#pragma unroll
        for (int a = 0; a < 2; ++a)
#pragma unroll
            for (int b = 0; b < 2; ++b)
#pragma unroll
                for (int m = 0; m < 4; ++m)
#pragma unroll
                    for (int n = 0; n < 2; ++n) acc[a][b][m][n] = (f32x4){0.f, 0.f, 0.f, 0.f};
        cur = nxt; cA = nA; cB = nB; ++ui;
        if constexpr (ALIGN_EPI) { if (wr == 1) PG8_BAR; }
    }
    PG8_WAIT_V(0);
    if constexpr (!ALIGN_EPI) { if (wr == 0) PG8_BAR; }
    PG8_BAR;
    if constexpr (Epi::AFTER_DRAIN) { E.fused(acc, cur, wr, wc, fr, fq, lds, wid, lane); S.done(cur); }
#undef PG8_SA
#undef PG8_SB
#undef PG8_STAGE
#undef PG8_LDA
#undef PG8_LDB
#undef PG8_MMA
#undef PG8_WAIT_V
#undef PG8_WAIT_L
#undef PG8_BAR
#undef PG8_SCHED
}
}

namespace att {
#define LAS __attribute__((address_space(3)))
typedef unsigned short bf16_t;
typedef short bf16x8 __attribute__((ext_vector_type(8)));
typedef short s16x4 __attribute__((ext_vector_type(4)));
typedef short v4i16_t __attribute__((ext_vector_type(4)));
typedef float f32x16 __attribute__((ext_vector_type(16)));
typedef float f32x4 __attribute__((ext_vector_type(4)));
typedef unsigned u32x4 __attribute__((ext_vector_type(4)));
typedef unsigned u32x2 __attribute__((ext_vector_type(2)));
typedef float f32x2_t __attribute__((ext_vector_type(2))); typedef __bf16 bf16x2_t __attribute__((ext_vector_type(2)));
constexpr int SEQ = 4096, INW = 6144, DMODEL = 2048;
constexpr int KP = 272, VP = 320;
constexpr int DIFF_TILE = 128 * KP + 128 * VP;
constexpr int DIL_WAVE = 32 * KP + 32 * VP;
__device__ __forceinline__ unsigned cvtpk(float lo, float hi) { f32x2_t v = {lo, hi}; bf16x2_t b = __builtin_convertvector(v, bf16x2_t); return __builtin_bit_cast(unsigned, b); }
__device__ __forceinline__ int crow(int r, int hi) { return (r & 3) + 8 * (r >> 2) + 4 * hi; }
__device__ __forceinline__ s16x4 vtr(const LAS char* p) { return __builtin_bit_cast(s16x4, __builtin_amdgcn_ds_read_tr16_b64_v4i16((LAS v4i16_t*)p)); }
__device__ __forceinline__ bf16x8 packp(const f32x16& p, int s) {
    u32x4 w; w.x = cvtpk(p[8 * s], p[8 * s + 1]); w.y = cvtpk(p[8 * s + 2], p[8 * s + 3]); w.z = cvtpk(p[8 * s + 4], p[8 * s + 5]); w.w = cvtpk(p[8 * s + 6], p[8 * s + 7]);
    return __builtin_bit_cast(bf16x8, w);
}
#define MFMA32(a, b, c) __builtin_amdgcn_mfma_f32_32x32x16_bf16((a), (b), (c), 0, 0, 0)

__device__ __forceinline__ void diff_unit(LAS char* lds, const bf16_t* QKV, bf16_t* MIX, int b, int h, int qblk, float lam, float negM, const float* g_bout, int tid, int wid, int lane) {
    const int c = wid >> 2, r32 = lane & 31, hh = lane >> 5, cb = (lane >> 4) & 1, q_ = (lane & 15) >> 2, p_ = lane & 3;
    const size_t rowbase = (size_t)b * SEQ; const int q0 = qblk * 128 + (wid & 3) * 32;
    bf16x8 qf[4];
    { const bf16_t* qp = QKV + (rowbase + q0 + r32) * INW + 3072 + h * 128 + c * 64 + 8 * hh;
#pragma unroll
      for (int ks = 0; ks < 4; ++ks) qf[ks] = *(const bf16x8*)(qp + 16 * ks); }
    const int srow = tid >> 4, sch = tid & 15;
    const bf16_t* kg = QKV + (rowbase + srow) * INW + 4096 + h * 128 + sch * 8;
    const bf16_t* vg = kg + 1024;
    LAS char* kst = lds + srow * KP + sch * 16; LAS char* vst = lds + 128 * KP + srow * VP + sch * 16;
    f32x16 o[4];
#pragma unroll
    for (int i = 0; i < 4; ++i)
#pragma unroll
        for (int r = 0; r < 16; ++r) o[i][r] = 0.f;
    float lsum = 0.f;
    f32x16 negm;
#pragma unroll
    for (int r = 0; r < 16; ++r) negm[r] = negM;
    u32x4 kr[4], vr[4];
#pragma unroll
    for (int i = 0; i < 4; ++i) { kr[i] = *(const u32x4*)(kg + (size_t)(32 * i) * INW); vr[i] = *(const u32x4*)(vg + (size_t)(32 * i) * INW); }
#pragma unroll
    for (int i = 0; i < 4; ++i) { *(LAS u32x4*)(kst + 32 * i * KP) = kr[i]; *(LAS u32x4*)(vst + 32 * i * VP) = vr[i]; }
    __syncthreads();
    const int NT = SEQ / 128;
    const LAS char* kread = lds + r32 * KP + (c * 64 + 8 * hh) * 2;
    const LAS char* vread = lds + 128 * KP + (4 * hh + q_) * VP + (16 * cb + 4 * p_) * 2;
    for (int t = 0; t < NT; ++t) {
        const int cur = (t & 1) * DIFF_TILE, nxt = DIFF_TILE - cur;
        const size_t go = (size_t)(t + 1) * 128 * INW; const bool more = t + 1 < NT;
        if (more) {
#pragma unroll
            for (int i = 0; i < 4; ++i) kr[i] = *(const u32x4*)(kg + go + (size_t)(32 * i) * INW); }
        f32x16 pA0 = negm, pA1 = negm, pB0 = negm, pB1 = negm;
#pragma unroll
        for (int ks = 0; ks < 4; ++ks) {
            const bf16x8 k0 = *(const LAS bf16x8*)(kread + cur + ks * 32), k1 = *(const LAS bf16x8*)(kread + cur + 32 * KP + ks * 32);
            pA0 = MFMA32(k0, qf[ks], pA0); pA1 = MFMA32(k1, qf[ks], pA1);
        }
#pragma unroll
        for (int ks = 0; ks < 4; ++ks) {
            const bf16x8 k0 = *(const LAS bf16x8*)(kread + cur + 64 * KP + ks * 32), k1 = *(const LAS bf16x8*)(kread + cur + 96 * KP + ks * 32);
            pB0 = MFMA32(k0, qf[ks], pB0); pB1 = MFMA32(k1, qf[ks], pB1);
        }
        if (more) {
#pragma unroll
            for (int i = 0; i < 4; ++i) *(LAS u32x4*)(kst + nxt + 32 * i * KP) = kr[i];
#pragma unroll
            for (int i = 0; i < 4; ++i) kr[i] = *(const u32x4*)(vg + go + (size_t)(32 * i) * INW); }
        float sa = 0.f, sb = 0.f;
#pragma unroll
        for (int r = 0; r < 16; ++r) { pA0[r] = __builtin_amdgcn_exp2f(pA0[r]); pA1[r] = __builtin_amdgcn_exp2f(pA1[r]); sa += pA0[r]; sb += pA1[r]; }
        bf16x8 pf[4]; pf[0] = packp(pA0, 0); pf[1] = packp(pA0, 1); pf[2] = packp(pA1, 0); pf[3] = packp(pA1, 1);
#pragma unroll
        for (int kst4 = 0; kst4 < 4; ++kst4)
#pragma unroll
            for (int db = 0; db < 4; ++db) {
                const LAS char* a = vread + cur + kst4 * 16 * VP + db * 64;
                const s16x4 lo = vtr(a), hi = vtr(a + 8 * VP);
                const bf16x8 vf = __builtin_shufflevector(lo, hi, 0, 1, 2, 3, 4, 5, 6, 7);
                o[db] = MFMA32(vf, pf[kst4], o[db]);
            }
#pragma unroll
        for (int r = 0; r < 16; ++r) { pB0[r] = __builtin_amdgcn_exp2f(pB0[r]); pB1[r] = __builtin_amdgcn_exp2f(pB1[r]); sa += pB0[r]; sb += pB1[r]; }
        lsum += sa + sb;
        pf[0] = packp(pB0, 0); pf[1] = packp(pB0, 1); pf[2] = packp(pB1, 0); pf[3] = packp(pB1, 1);
#pragma unroll
        for (int kst4 = 0; kst4 < 4; ++kst4)
#pragma unroll
            for (int db = 0; db < 4; ++db) {
                const LAS char* a = vread + cur + (64 + kst4 * 16) * VP + db * 64;
                const s16x4 lo = vtr(a), hi = vtr(a + 8 * VP);
                const bf16x8 vf = __builtin_shufflevector(lo, hi, 0, 1, 2, 3, 4, 5, 6, 7);
                o[db] = MFMA32(vf, pf[kst4], o[db]);
            }
        if (more) {
#pragma unroll
            for (int i = 0; i < 4; ++i) *(LAS u32x4*)(vst + nxt + 32 * i * VP) = kr[i]; }
        __syncthreads();
    }
    const int lane_e = lane_opaque();
    lsum += shflx(lsum, 32, lane_e);
    float inv = 1.0f / lsum; if (c == 1) inv *= lam;
    const int r32e = lane_e & 31, hhe = lane_e >> 5;
    LAS float* X = (LAS float*)lds + (wid & 3) * 4096;
    if (c == 1) {
#pragma unroll
        for (int db = 0; db < 4; ++db)
#pragma unroll
            for (int r = 0; r < 16; ++r) X[(db * 32 + crow(r, hhe)) * 32 + r32e] = o[db][r] * inv;
    }
    __syncthreads();
    if (c == 0) {
        float ss = 0.f;
#pragma unroll
        for (int db = 0; db < 4; ++db)
#pragma unroll
            for (int r = 0; r < 16; ++r) { const float v = o[db][r] * inv - X[(db * 32 + crow(r, hhe)) * 32 + r32e]; o[db][r] = v; ss += v * v; }
        ss += shflx(ss, 32, lane_e);
        const float rn = __builtin_amdgcn_rsqf(ss * (1.0f / 128.0f) + 1e-6f) * 0.8f;
        bf16_t* op = MIX + (rowbase + q0 + r32e) * DMODEL + 1024 + h * 128;
#pragma unroll
        for (int db = 0; db < 4; ++db)
#pragma unroll
            for (int g4 = 0; g4 < 4; ++g4) { const int d0 = db * 32 + 8 * g4 + 4 * hhe; const f32x4 gg = *(const f32x4*)(g_bout + d0);
                u32x2 w; w.x = cvtpk(o[db][4 * g4] * rn * gg[0], o[db][4 * g4 + 1] * rn * gg[1]); w.y = cvtpk(o[db][4 * g4 + 2] * rn * gg[2], o[db][4 * g4 + 3] * rn * gg[3]);
                *(u32x2*)(op + d0) = w; }
    }
    __syncthreads();
}

template <int MODE> __device__ __forceinline__ void dil_unit(LAS char* wl, const bf16_t* QKV, bf16_t* MIX, float* Opart, float* Lpart, int b, int h, int r16, int ib, float negM, const float* g_aout, int lane) {
    const int r32 = lane & 31, hh = lane >> 5, cb = (lane >> 4) & 1, q_ = (lane & 15) >> 2, p_ = lane & 3;
    const size_t rowbase = (size_t)b * SEQ;
    const int t0 = MODE ? r16 + 512 * ib : 32 * (8 * r16 + ib), qs = MODE ? 16 : 1;
    const int tq = t0 + qs * r32;
    bf16x8 qf[8];
    { const bf16_t* qp = QKV + (rowbase + tq) * INW + h * 128 + 8 * hh;
#pragma unroll
      for (int ks = 0; ks < 8; ++ks) qf[ks] = *(const bf16x8*)(qp + 16 * ks); }
    f32x16 o[4];
#pragma unroll
    for (int i = 0; i < 4; ++i)
#pragma unroll
        for (int r = 0; r < 16; ++r) o[i][r] = 0.f;
    float lsum = 0.f;
    f32x16 negm;
#pragma unroll
    for (int r = 0; r < 16; ++r) negm[r] = negM;
    const int lrow = lane >> 4, lch = lane & 15;
    const bf16_t* kvg = QKV + rowbase * INW + 1024 + h * 128 + lch * 8;
    LAS char* kst = wl + lrow * KP + lch * 16; LAS char* vst = wl + 32 * KP + lrow * VP + lch * 16;
    const LAS char* kread = wl + r32 * KP + 8 * hh * 2;
    const LAS char* vread = wl + 32 * KP + (4 * hh + q_) * VP + (16 * cb + 4 * p_) * 2;
    int klo0, khi0, klo1, khi1, klo2, khi2;
    { const int bq = t0 >> 4; int lo_i = bq - 64; if (lo_i < 0) lo_i = 0; klo0 = lo_i >> 5; khi0 = (bq + 31 * (qs >> 4) + 64) >> 5; if (khi0 > 7) khi0 = 7; }
    { const int bq = t0 >> 2; int lo_i = bq - 64; if (lo_i < 0) lo_i = 0; klo1 = lo_i >> 5; khi1 = (bq + 31 * (qs >> 2) + 64) >> 5; if (khi1 > 31) khi1 = 31; }
    { const int bq = t0;      int lo_i = bq - 64; if (lo_i < 0) lo_i = 0; klo2 = lo_i >> 5; khi2 = (bq + 31 * qs + 64) >> 5;        if (khi2 > 127) khi2 = 127; }
    constexpr int PAT_END = MODE ? 2 : 3;
    int pat = MODE ? 0 : 2, kb = MODE ? klo0 : klo2;
    u32x4 kr[8], vr[8];
#define DIL_LOADK(PAT, KB) do { const int sh_ = 4 - 2 * (PAT); const int rc_ = t0 & ((1 << sh_) - 1); \
        _Pragma("unroll") for (int i = 0; i < 8; ++i) { const int tok = rc_ + ((32 * (KB) + lrow + 4 * i) << sh_); kr[i] = *(const u32x4*)(kvg + (size_t)tok * INW); } } while (0)
#define DIL_LOADV(PAT, KB) do { const int sh_ = 4 - 2 * (PAT); const int rc_ = t0 & ((1 << sh_) - 1); \
        _Pragma("unroll") for (int i = 0; i < 8; ++i) { const int tok = rc_ + ((32 * (KB) + lrow + 4 * i) << sh_); vr[i] = *(const u32x4*)(kvg + (size_t)tok * INW + 1024); } } while (0)
#define DIL_ADV() do { const int hi_c = pat == 0 ? khi0 : (pat == 1 ? khi1 : khi2); if (kb < hi_c) ++kb; else { ++pat; kb = pat == 1 ? klo1 : klo2; } } while (0)
#define DIL_WFENCE() do { __builtin_amdgcn_fence(__ATOMIC_RELEASE, "wavefront"); __builtin_amdgcn_wave_barrier(); __builtin_amdgcn_fence(__ATOMIC_ACQUIRE, "wavefront"); } while (0)
#define DIL_S(P) do { P = negm; _Pragma("unroll") for (int ks = 0; ks < 8; ++ks) { const bf16x8 kf = *(const LAS bf16x8*)(kread + ks * 32); P = MFMA32(kf, qf[ks], P); } } while (0)
    int cpat = pat, ckb = kb;
    DIL_LOADK(pat, kb); DIL_LOADV(pat, kb);
#pragma unroll
    for (int i = 0; i < 8; ++i) { *(LAS u32x4*)(kst + 4 * i * KP) = kr[i]; *(LAS u32x4*)(vst + 4 * i * VP) = vr[i]; }
    DIL_ADV();
    bool have1 = pat < PAT_END;
    int npat = pat, nkb = kb;
    if (have1) { DIL_LOADK(pat, kb); DIL_LOADV(pat, kb); DIL_ADV(); }
    DIL_WFENCE();
    f32x16 p, pn;
    DIL_S(p);
    for (;;) {
        const bool have2 = have1 && pat < PAT_END;
        if (have1) {
            DIL_WFENCE();
#pragma unroll
            for (int i = 0; i < 8; ++i) *(LAS u32x4*)(kst + 4 * i * KP) = kr[i];
            if (have2) DIL_LOADK(pat, kb);
            DIL_WFENCE();
            DIL_S(pn);
        }
        const int sh = 4 - 2 * cpat;
        const int qi = (t0 >> sh) + (qs >> sh) * r32;
        float sa = 0.f;
#pragma unroll
        for (int r = 0; r < 16; ++r) { const int dl = 32 * ckb + crow(r, hh) - qi; const float e = __builtin_amdgcn_exp2f(p[r]); const float pv = (dl <= 64 && dl >= -64) ? e : 0.f; p[r] = pv; sa += pv; }
        lsum += sa;
        bf16x8 pf[2]; pf[0] = packp(p, 0); pf[1] = packp(p, 1);
#pragma unroll
        for (int s = 0; s < 2; ++s)
#pragma unroll
            for (int db = 0; db < 4; ++db) {
                const LAS char* a = vread + s * 16 * VP + db * 64;
                const s16x4 lo = vtr(a), hi = vtr(a + 8 * VP);
                const bf16x8 vf = __builtin_shufflevector(lo, hi, 0, 1, 2, 3, 4, 5, 6, 7);
                o[db] = MFMA32(vf, pf[s], o[db]);
            }
        if (!have1) break;
        DIL_WFENCE();
#pragma unroll
        for (int i = 0; i < 8; ++i) *(LAS u32x4*)(vst + 4 * i * VP) = vr[i];
        if (have2) DIL_LOADV(pat, kb);
        DIL_WFENCE();
        p = pn; cpat = npat; ckb = nkb; npat = pat; nkb = kb; have1 = have2;
        if (have2) DIL_ADV();
    }
#undef DIL_LOADK
#undef DIL_LOADV
#undef DIL_ADV
#undef DIL_WFENCE
#undef DIL_S
    const int lane_f = lane_opaque(), hhf = lane_f >> 5, tqf = t0 + qs * (lane_f & 31);
    lsum += shflx(lsum, 32, lane_f);
    float* pp = Opart + ((rowbase + tqf) * 8 + h) * 128; float* lp = Lpart + (rowbase + tqf) * 8 + h;
    if (MODE == 0) {
#pragma unroll
        for (int db = 0; db < 4; ++db)
#pragma unroll
            for (int g4 = 0; g4 < 4; ++g4) *(f32x4*)(pp + db * 32 + 8 * g4 + 4 * hhf) = (f32x4){o[db][4 * g4], o[db][4 * g4 + 1], o[db][4 * g4 + 2], o[db][4 * g4 + 3]};
        if (hhf == 0) *lp = lsum;
        return;
    }
    lsum += *lp;
#pragma unroll
    for (int db = 0; db < 4; ++db)
#pragma unroll
        for (int g4 = 0; g4 < 4; ++g4) { const f32x4 t = *(const f32x4*)(pp + db * 32 + 8 * g4 + 4 * hhf); o[db][4 * g4] += t[0]; o[db][4 * g4 + 1] += t[1]; o[db][4 * g4 + 2] += t[2]; o[db][4 * g4 + 3] += t[3]; }
    const float inv = 1.0f / lsum; float ss = 0.f;
#pragma unroll
    for (int db = 0; db < 4; ++db)
#pragma unroll
        for (int r = 0; r < 16; ++r) { const float v = o[db][r] * inv; o[db][r] = v; ss += v * v; }
    ss += shflx(ss, 32, lane_f);
    const float rn = __builtin_amdgcn_rsqf(ss * (1.0f / 128.0f) + 1e-6f);
    bf16_t* op = MIX + (rowbase + tqf) * DMODEL + h * 128;
#pragma unroll
    for (int db = 0; db < 4; ++db)
#pragma unroll
        for (int g4 = 0; g4 < 4; ++g4) { const int d0 = db * 32 + 8 * g4 + 4 * hhf; const f32x4 gg = *(const f32x4*)(g_aout + d0);
            u32x2 w; w.x = cvtpk(o[db][4 * g4] * rn * gg[0], o[db][4 * g4 + 1] * rn * gg[1]); w.y = cvtpk(o[db][4 * g4 + 2] * rn * gg[2], o[db][4 * g4 + 3] * rn * gg[3]);
            *(u32x2*)(op + d0) = w; }
}
}

constexpr int NWAVES = 8;
constexpr int DM = 2048, NBATCH = 2, SEQ = 4096, MROWS = NBATCH * SEQ, DFF = 5632, INW = 6144;
constexpr size_t MiB = 1u << 20;
constexpr size_t WS_CTL = 0;
constexpr size_t OFF_GTAB = 1 * MiB - 4096;
constexpr size_t OFF_RS0 = 917504;
constexpr size_t OFF_BAR = 983040, BAR_BYTES = 16384;
constexpr size_t OFF_RS1 = 0, OFF_RS2 = 32768, OFF_ROPEA = 65536, OFF_ROPEB = OFF_ROPEA + 2 * 4096 * 16 * 4;
constexpr int LDK = pg8::LDK, LDQ = pg8::LDQ;
constexpr size_t WS_W1A = 1 * MiB, WS_W1B = WS_W1A + 47 * MiB, WS_WIN = WS_W1B + 22 * MiB, WS_WOUT = WS_WIN + 26 * MiB, WS_W2A = WS_WOUT + 9 * MiB, WS_W2B = WS_W2A + 47 * MiB;
constexpr size_t WS_XN = WS_W2B + 22 * MiB;
constexpr size_t WS_ACT = WS_XN + 34 * MiB;
constexpr size_t WS_MIX = WS_ACT + 98 * MiB;
constexpr size_t WS_OPART = WS_MIX + 34 * MiB;
constexpr size_t WS_LPART = WS_OPART + 32 * MiB;
constexpr size_t WS_END = WS_LPART + 1 * MiB;
constexpr int LDS_BYTES = 155648;
constexpr int XCH_OFF = 131072;
static_assert((size_t)11264 * LDK * 2 <= 47 * MiB && (size_t)6144 * LDK * 2 <= 26 * MiB && (size_t)2048 * LDK * 2 <= 9 * MiB && (size_t)8192 * LDK * 2 <= 34 * MiB && (size_t)8192 * LDQ * 2 <= 98 * MiB && att::INW == LDQ && att::DMODEL == LDK, "ws map");
static_assert(att::DIL_WAVE * 8 <= LDS_BYTES - 64 && 3456 * 4 <= BAR_BYTES && 2 * att::DIFF_TILE <= LDS_BYTES - 64 && XCH_OFF + 8192 <= LDS_BYTES, "LDS map");

#define LAS __attribute__((address_space(3)))
typedef unsigned short bf16;
typedef unsigned v4u __attribute__((ext_vector_type(4)));
typedef unsigned v2u __attribute__((ext_vector_type(2)));
typedef float f32x4 __attribute__((ext_vector_type(4)));
__device__ __forceinline__ unsigned f2bf(float f) { unsigned u = __builtin_bit_cast(unsigned, f); return (u + 0x7fffu + ((u >> 16) & 1u)) >> 16; }
__device__ __forceinline__ unsigned pk2(float lo, float hi) { return f2bf(lo) | (f2bf(hi) << 16); }
__device__ __forceinline__ float wave_sum(float v, int lane) {
#pragma unroll
    for (int o = 1; o < 64; o <<= 1) v += shflx(v, o, lane);
    return v;
}
__device__ __forceinline__ float wave_max(float v, int lane) {
#pragma unroll
    for (int o = 1; o < 64; o <<= 1) v = fmaxf(v, shflx(v, o, lane));
    return v;
}
template <bool GLU> __device__ __forceinline__ void tr_load(const float* W, int N, int item, int lane, f32x4 (&v)[8], const float* gk) {
    const int nblk = N / 32, kb = item / nblk, nb = item % nblk, k0 = 64 * kb, n0 = 32 * nb;
    const float* src = W + (size_t)(k0 + (lane >> 3)) * N + n0 + 4 * (lane & 7);
#pragma unroll
    for (int i = 0; i < 8; ++i) v[i] = __builtin_nontemporal_load((const f32x4*)(src + (size_t)(8 * i) * N));
    if (gk) {
#pragma unroll
        for (int i = 0; i < 8; ++i) v[i] = v[i] * gk[k0 + (lane >> 3) + 8 * i]; }
}
template <bool GLU> __device__ __forceinline__ void tr_store(int K, int N, bf16* WT, int ldw, LAS float* scr, int item, int lane, const f32x4 (&v)[8]) {
    const int nblk = N / 32, kb = item / nblk, nb = item % nblk, k0 = 64 * kb, n0 = 32 * nb;
    int r0 = n0;
    if (GLU) { const int half = N / 2; r0 = n0 < half ? (n0 >> 7) * 256 + (n0 & 127) : ((n0 - half) >> 7) * 256 + 128 + ((n0 - half) & 127); }
    const int rg = lane >> 3, c4 = lane & 7;
#pragma unroll
    for (int i = 0; i < 8; ++i) { LAS float* d = scr + (8 * i + rg) * 33 + 4 * c4; d[0] = v[i][0]; d[1] = v[i][1]; d[2] = v[i][2]; d[3] = v[i][3]; }
    asm volatile("s_waitcnt lgkmcnt(0)" ::: "memory");
    const int c = lane & 7;
#pragma unroll
    for (int j = 0; j < 4; ++j) { const int n = (lane >> 3) + 8 * j; const LAS float* s = scr + (8 * c) * 33 + n;
        v4u o; o.x = pk2(s[0 * 33], s[1 * 33]); o.y = pk2(s[2 * 33], s[3 * 33]); o.z = pk2(s[4 * 33], s[5 * 33]); o.w = pk2(s[6 * 33], s[7 * 33]);
        *(v4u*)(WT + (size_t)(r0 + n) * ldw + k0 + 8 * c) = o; }
    asm volatile("s_waitcnt lgkmcnt(0)" ::: "memory");
}
template <bool GLU, int NIF> __device__ __forceinline__ void tr_matrix(const float* W, int K, int N, bf16* WT, int ldw, LAS float* scr, int gw, int NGW, int lane, const float* gk) {
    const int nitems = (K / 64) * (N / 32);
    for (int it = gw; it < nitems; it += NIF * NGW) {
        f32x4 v[NIF][8];
#pragma unroll
        for (int j = 0; j < NIF; ++j) if (it + j * NGW < nitems) tr_load<GLU>(W, N, it + j * NGW, lane, v[j], gk);
#pragma unroll
        for (int j = 0; j < NIF; ++j) if (it + j * NGW < nitems) tr_store<GLU>(K, N, WT, ldw, scr, it + j * NGW, lane, v[j]);
    }
}

#define XB_TMO      128
#define XB_XCNT(j)  (256  + 64 * (j))
#define XB_XSUB(j)  (1280 + 64 * (j))
#define XB_XGEN(j)  (2304 + 64 * (j))
#define XB_TOP      3328
#define XB_TOPGEN   3392
#define XCD_BAR_WORDS 3456
#define XB_SPIN_CAP (1u << 18)

__device__ __forceinline__ unsigned xb_ld(unsigned* p)              { return __hip_atomic_load(p, __ATOMIC_RELAXED, __HIP_MEMORY_SCOPE_AGENT); }
__device__ __forceinline__ unsigned xb_add(unsigned* p, unsigned v) { return __hip_atomic_fetch_add(p, v, __ATOMIC_RELAXED, __HIP_MEMORY_SCOPE_AGENT); }
__device__ __forceinline__ unsigned xb_xcc_id() { return (unsigned)__builtin_amdgcn_s_getreg((3 << 11) | 20) & 0xFu; }
#define XB_SPIN(cond, bar) do { unsigned _sp = 0; while (cond) { __builtin_amdgcn_s_sleep(1); \
    if ((++_sp & 255u) == 0u) { if (xb_ld(&(bar)[XB_TMO])) break; if (_sp > XB_SPIN_CAP) { atomicAdd(&(bar)[XB_TMO], 1u); break; } } } } while (0)

struct XcdBarrier {
    unsigned* bar; unsigned x; int wid;
    volatile LAS unsigned* st;
};

__device__ __forceinline__ bool xb_lane0() { return lane_opaque() == 0; }
__device__ __forceinline__ XcdBarrier xcd_barrier_post(unsigned* bar, volatile LAS unsigned* st, int wid) {
    XcdBarrier b; b.bar = bar; b.x = xb_xcc_id(); b.st = st; b.wid = wid;
    if (wid == 0 && xb_lane0()) (void)xb_add(&bar[XB_XCNT(b.x)], 1u);
    return b;
}
__device__ __forceinline__ void xcd_barrier_complete(unsigned* bar, unsigned x, unsigned& nloc, unsigned& nx) {
    const unsigned G = gridDim.x * gridDim.y * gridDim.z;
    unsigned sum, cnt, mine, sp = 0u;
    for (;;) {
        sum = 0u; cnt = 0u; mine = 0u;
#pragma unroll
        for (unsigned j = 0; j < 16; ++j) { const unsigned c = xb_ld(&bar[XB_XCNT(j)]); sum += c; cnt += (c > 0u) ? 1u : 0u; mine = (j == x) ? c : mine; }
        if (sum == G) break;
        __builtin_amdgcn_s_sleep(1);
        if ((++sp & 255u) == 0u) { if (xb_ld(&bar[XB_TMO])) break; if (sp > XB_SPIN_CAP) { atomicAdd(&bar[XB_TMO], 1u); break; } }
    }
    nloc = mine > 0u ? mine : 1u; nx = cnt > 0u ? cnt : 1u;
}

__device__ __forceinline__ void xcd_barrier(const XcdBarrier& b) {
    asm volatile("s_waitcnt vmcnt(0)" ::: "memory");
    __syncthreads();
    if (b.wid == 0 && xb_lane0()) {
        unsigned* bar = b.bar;
        __builtin_amdgcn_s_waitcnt(0);
        unsigned nloc = b.st[0], nx = b.st[1];
        if (nloc == 0u) { xcd_barrier_complete(bar, b.x, nloc, nx); b.st[0] = nloc; b.st[1] = nx; }
        const unsigned old = xb_add(&bar[XB_XSUB(b.x)], 1u);
        const unsigned gen = old / nloc;
        if (old + 1u == (gen + 1u) * nloc) {
            __builtin_amdgcn_fence(__ATOMIC_RELEASE, "agent");
            asm volatile("s_waitcnt vmcnt(0)" ::: "memory");
            const unsigned og = xb_add(&bar[XB_TOP], 1u);
            const unsigned tg = og / nx;
            if (og + 1u == (tg + 1u) * nx) xb_add(&bar[XB_TOPGEN], 1u);
            else XB_SPIN(xb_ld(&bar[XB_TOPGEN]) == tg, bar);
            __builtin_amdgcn_fence(__ATOMIC_ACQUIRE, "agent");
            xb_add(&bar[XB_XGEN(b.x)], 1u);
            asm volatile("s_waitcnt vmcnt(0)" ::: "memory");
        } else {
            XB_SPIN(xb_ld(&bar[XB_XGEN(b.x)]) == gen, bar);
            __builtin_amdgcn_fence(__ATOMIC_ACQUIRE, "agent");
            asm volatile("s_waitcnt vmcnt(0)" ::: "memory");
        }
    }
    __syncthreads();
}

struct Args {
    const float* in[20]; float* out; unsigned char* ws;
    float invA[16]; float invB[8];
};

__global__ void __launch_bounds__(NWAVES * 64) hybrid_fwd(Args args) {
    extern __shared__ __attribute__((aligned(16))) unsigned char lds_raw[];
    cg::grid_group grid = cg::this_grid();
    LAS unsigned char* lds = (LAS unsigned char*)lds_raw;
    const int wid = __builtin_amdgcn_readfirstlane((int)threadIdx.x >> 6);
#define fresh_lane() lane_opaque()
    const int lane = fresh_lane(), tid = wid * 64 + lane;
    const int G = gridDim.x, bx = blockIdx.x;
    unsigned char* ws = args.ws;
    volatile LAS unsigned* MISC = (volatile LAS unsigned*)(lds + LDS_BYTES - 64);
    if (tid < 16) MISC[tid] = 0u;
    __syncthreads();
    const XcdBarrier bar = xcd_barrier_post((unsigned*)(ws + OFF_BAR), MISC + 8, wid);
    if (G == 0x7fffffff) grid.sync();
    const float* x = args.in[0];
    float* out = args.out;
    float* rowss1 = (float*)(ws + OFF_RS1); float* rowss2 = (float*)(ws + OFF_RS2);
    float* gtab = (float*)(ws + OFF_GTAB); float* ropeA = (float*)(ws + OFF_ROPEA); float* ropeB = (float*)(ws + OFF_ROPEB);
    bf16* W1A = (bf16*)(ws + WS_W1A); bf16* W1B = (bf16*)(ws + WS_W1B); bf16* WIN = (bf16*)(ws + WS_WIN); bf16* WOUT = (bf16*)(ws + WS_WOUT);
    bf16* W2A = (bf16*)(ws + WS_W2A); bf16* W2B = (bf16*)(ws + WS_W2B);
    bf16* XN = (bf16*)(ws + WS_XN); bf16* ACT = (bf16*)(ws + WS_ACT); bf16* QKV = (bf16*)(ws + WS_ACT); bf16* MIX = (bf16*)(ws + WS_MIX);

#ifndef REP_P0
#define REP_P0 1
#endif
#ifndef REP_DIFF
#define REP_DIFF 1
#endif
#ifndef REP_DIL
#define REP_DIL 1
#endif
#define REP_G1 1
#define REP_SHADOW 1
#define REP_G2 1
#define REP_G3 1
#define REP_G5 1
#define REP_G6 1
#define REP_G7 1
    for (int rep = 0; rep < REP_P0; ++rep) {
        LAS float* scr = (LAS float*)(lds + wid * 16384);
        const int gw = bx * NWAVES + wid, NGW = G * NWAVES;
        constexpr int I_FA = (DM / 64) * (2 * DFF / 32), I_FB = (DFF / 64) * (DM / 32), I_IN = (DM / 64) * (INW / 32), I_OUT = (DM / 64) * (DM / 32);
        tr_matrix<true, 2>(args.in[2], DM, 2 * DFF, W1A, LDK, scr, gw, NGW, lane, args.in[1]);
        tr_matrix<true, 2>(args.in[18], DM, 2 * DFF, W2A, LDK, scr, gw, NGW, lane, args.in[17]);
        float* rowss0 = (float*)(ws + OFF_RS0);
        for (int m = gw; m < MROWS; m += NGW) {
            const f32x4* xr = (const f32x4*)(x + (size_t)m * DM) + lane; f32x4 v[8]; float s = 0.f;
#pragma unroll
            for (int j = 0; j < 8; ++j) { v[j] = __builtin_nontemporal_load(xr + 64 * j); s += (v[j][0] * v[j][0] + v[j][1] * v[j][1]) + (v[j][2] * v[j][2] + v[j][3] * v[j][3]); }
            s = wave_sum(s, lane); if (lane == 0) rowss0[m] = s;
            v2u* o8 = (v2u*)(XN + (size_t)m * LDK) + lane;
#pragma unroll
            for (int j = 0; j < 8; ++j) { v2u w; w.x = pk2(v[j][0], v[j][1]); w.y = pk2(v[j][2], v[j][3]); o8[64 * j] = w; }
        }
        const int gt = bx * (NWAVES * 64) + tid, NGT = G * NWAVES * 64;
        for (int i = gt; i < 2 * MROWS; i += NGT) rowss1[i] = 0.f;
        if (gt < 512) { const int t = gt >> 7, d = gt & 127; gtab[gt] = t == 0 ? args.in[6][d] : (t == 1 ? args.in[7][d] : (t == 2 ? args.in[8][d & 63] : args.in[9][d & 63])); }
        for (int i = gt; i < 4096 * 24; i += NGT) {
            const int s = i / 24, k = i % 24; const float inv = k < 16 ? args.invA[k] : args.invB[k - 16];
            const float ang = (float)s * inv; double rev = (double)ang * 0.15915494309189535; rev -= floor(rev);
            const float cs = __builtin_amdgcn_cosf((float)rev), sn = __builtin_amdgcn_sinf((float)rev);
            if (k < 16) { ropeA[s * 16 + k] = cs; ropeA[4096 * 16 + s * 16 + k] = sn; } else { ropeB[s * 8 + k - 16] = cs; ropeB[4096 * 8 + s * 8 + k - 16] = sn; }
        }
    }
    xcd_barrier(bar);

    { pg8::Gemm g{XN, W1A, MROWS, 2 * DFF, DM, LDK}; pg8::StaticOrder S; S.init(MROWS, 2 * DFF, G, bx);
      pg8::EpiSwiGLU E{ACT, DFF, (const float*)(ws + OFF_RS0)};
      pg8::gemm_phase<pg8::EpiSwiGLU, pg8::StaticOrder, true, true>(lds, g, S, E, wid); }
    {
        constexpr int NU = (MROWS / 256) * (2 * DFF / 256);
        const int rounds = (NU + G - 1) / G; int first_idle = NU - (rounds - 1) * G, nidle = G - first_idle;
        if (nidle <= 0) { first_idle = 0; nidle = G; }
        if (bx >= first_idle) {
            LAS float* scr = (LAS float*)(lds + wid * 16384); const int lane_c = fresh_lane();
            const int gw = (bx - first_idle) * NWAVES + wid, NGW = nidle * NWAVES;
            for (int rep = 0; rep < REP_SHADOW; ++rep) {
            tr_matrix<false, 2>(args.in[3], DFF, DM, W1B, DFF, scr, gw, NGW, lane_c, nullptr);
            tr_matrix<false, 2>(args.in[5], DM, INW, WIN, LDK, scr, gw, NGW, lane_c, args.in[4]);
            tr_matrix<false, 2>(args.in[16], DM, DM, WOUT, LDK, scr, gw, NGW, lane_c, nullptr);
            }
        }
    }
    xcd_barrier(bar);
    { pg8::Gemm g{ACT, W1B, MROWS, DM, DFF, DFF}; pg8::StaticOrder S; S.init(MROWS, DM, G, bx);
      pg8::EpiResid<false, true, false> E{nullptr, nullptr, XN, rowss1, 0.5f};
      pg8::gemm_phase<pg8::EpiResid<false, true, false>, pg8::StaticOrder, true, true>(lds, g, S, E, wid); }
    xcd_barrier(bar);
    { pg8::Gemm g{XN, WIN, MROWS, INW, DM, LDK}; pg8::StaticOrder S; S.init(MROWS, INW, G, bx);
      pg8::EpiQKV E{QKV, rowss1, gtab, ropeA, ropeB, (LAS float*)(lds + XCH_OFF)};
      for (int rep = 0; rep < REP_G3; ++rep)
      pg8::gemm_phase<pg8::EpiQKV, pg8::StaticOrder, true, true>(lds, g, S, E, wid); }
    xcd_barrier(bar);
    {
        const float L2E = 1.4426950408889634f;
        const int lane_a = fresh_lane();
        const float gq = fmaxf(fabsf(args.in[6][lane_a]), fabsf(args.in[6][lane_a + 64])), gk = fmaxf(fabsf(args.in[7][lane_a]), fabsf(args.in[7][lane_a + 64]));
        const float negMA = __builtin_bit_cast(float, __builtin_amdgcn_readfirstlane(__builtin_bit_cast(int, -1.02f * 11.313708498984761f * wave_max(gq, lane_a) * wave_max(gk, lane_a) * L2E)));
        const float negMB = __builtin_bit_cast(float, __builtin_amdgcn_readfirstlane(__builtin_bit_cast(int, -1.02f * 8.0f * wave_max(fabsf(args.in[8][lane_a]), lane_a) * wave_max(fabsf(args.in[9][lane_a]), lane_a) * L2E)));
        const float lam = __builtin_bit_cast(float, __builtin_amdgcn_readfirstlane(__builtin_bit_cast(int, __expf(wave_sum(args.in[10][lane_a] * args.in[11][lane_a], lane_a)) - __expf(wave_sum(args.in[12][lane_a] * args.in[13][lane_a], lane_a)) + 0.2f)));
        float* Opart = (float*)(ws + WS_OPART); float* Lpart = (float*)(ws + WS_LPART);
        {
            const int lane_d = fresh_lane();
            for (int wu = bx * NWAVES + wid; wu < 2048; wu += G * NWAVES) {
                const int ib = wu & 7, r16 = (wu >> 3) & 15, h = (wu >> 7) & 7, b = wu >> 10;
                att::dil_unit<0>((LAS char*)lds + wid * att::DIL_WAVE, QKV, MIX, Opart, Lpart, b, h, r16, ib, negMA, args.in[14], lane_d);
            }
        }
        xcd_barrier(bar);
        {
            const int tid_a = wid * 64 + fresh_lane();
            for (int rep = 0; rep < REP_DIFF; ++rep)
            for (int u = bx; u < 512; u += G) {
                const int bh = u >> 5, qblk = u & 31;
                att::diff_unit((LAS char*)lds, QKV, MIX, bh >> 3, bh & 7, qblk, lam, negMB, args.in[15], tid_a, wid, tid_a & 63);
            }
        }
        {
            const int lane_d = fresh_lane();
            for (int rep = 0; rep < REP_DIL; ++rep)
            for (int wu = bx * NWAVES + wid; wu < 2048; wu += G * NWAVES) {
                const int ib = wu & 7, r16 = (wu >> 3) & 15, h = (wu >> 7) & 7, b = wu >> 10;
                att::dil_unit<1>((LAS char*)lds + wid * att::DIL_WAVE, QKV, MIX, Opart, Lpart, b, h, r16, ib, negMA, args.in[14], lane_d);
            }
        }
    }
    xcd_barrier(bar);
    { pg8::Gemm g{MIX, WOUT, MROWS, DM, DM, LDK}; pg8::StaticOrder S; S.init(MROWS, DM, G, bx);
      pg8::EpiResid<false, true, false> E{nullptr, nullptr, XN, rowss2, 1.0f};
      pg8::gemm_phase<pg8::EpiResid<false, true, false>, pg8::StaticOrder, true, true>(lds, g, S, E, wid); }
    xcd_barrier(bar);
    { pg8::Gemm g{XN, W2A, MROWS, 2 * DFF, DM, LDK}; pg8::StaticOrder S; S.init(MROWS, 2 * DFF, G, bx);
      pg8::EpiSwiGLU E{ACT, DFF, rowss2};
      for (int rep = 0; rep < REP_G6; ++rep)
      pg8::gemm_phase<pg8::EpiSwiGLU, pg8::StaticOrder, true, true>(lds, g, S, E, wid); }
    {
        constexpr int NU = (MROWS / 256) * (2 * DFF / 256);
        const int rounds = (NU + G - 1) / G; int first_idle = NU - (rounds - 1) * G, nidle = G - first_idle;
        if (nidle <= 0) { first_idle = 0; nidle = G; }
        if (bx >= first_idle) tr_matrix<false, 2>(args.in[19], DFF, DM, W2B, DFF, (LAS float*)(lds + wid * 16384), (bx - first_idle) * NWAVES + wid, nidle * NWAVES, fresh_lane(), nullptr);
    }
    xcd_barrier(bar);
    { pg8::Gemm g{ACT, W2B, MROWS, DM, DFF, DFF}; pg8::StaticOrder S; S.init(MROWS, DM, G, bx);
      pg8::EpiResid<false, false, true> E{nullptr, out, XN, nullptr, 0.5f};
      pg8::gemm_phase<pg8::EpiResid<false, false, true>, pg8::StaticOrder, true, true>(lds, g, S, E, wid); }
}

extern "C" void kernel_launch(void* const* d_in, const int* in_sizes, int n_in, void* d_out, int out_size, void* d_ws, size_t ws_size, hipStream_t stream) {
    static int grid = 0;
    if (grid == 0) {
        if (n_in != 20 || in_sizes[0] != MROWS * DM || out_size != MROWS * DM || ws_size < WS_END) {
            fprintf(stderr, "kernel_launch: unexpected shapes (n_in %d, in0 %d, out %d, ws %zu < %zu)\n", n_in, n_in > 0 ? in_sizes[0] : -1, out_size, ws_size, (size_t)WS_END); grid = -1; return; }
        int dev = 0, cus = 0, per_cu = 0;
        (void)hipGetDevice(&dev); (void)hipDeviceGetAttribute(&cus, hipDeviceAttributeMultiprocessorCount, dev);
        if (hipFuncSetAttribute((const void*)hybrid_fwd, hipFuncAttributeMaxDynamicSharedMemorySize, LDS_BYTES) != hipSuccess) { fprintf(stderr, "kernel_launch: hipFuncSetAttribute failed\n"); grid = -1; return; }
        if (hipOccupancyMaxActiveBlocksPerMultiprocessor(&per_cu, (const void*)hybrid_fwd, NWAVES * 64, LDS_BYTES) != hipSuccess || per_cu < 1) { fprintf(stderr, "kernel_launch: occupancy query says %d\n", per_cu); per_cu = 1; }
        (void)hipGetLastError();
        grid = cus * per_cu;
    }
    if (grid < 0) return;
    Args a{};
    for (int i = 0; i < 20; ++i) a.in[i] = (const float*)d_in[i];
    a.out = (float*)d_out; a.ws = (unsigned char*)d_ws;
    for (int i = 0; i < 16; ++i) a.invA[i] = (float)pow(500000.0, -(double)i / 16.0);
    for (int i = 0; i < 8; ++i) a.invB[i] = (float)pow(500000.0, -(double)i / 8.0);
    if (hipMemsetAsync((char*)d_ws + OFF_BAR, 0, BAR_BYTES, stream) != hipSuccess) { fprintf(stderr, "kernel_launch: memset failed\n"); return; }
    void* kargs[] = {&a};
    hipError_t e = hipLaunchCooperativeKernel((const void*)hybrid_fwd, dim3(grid), dim3(NWAVES * 64), kargs, LDS_BYTES, stream);
    if (e != hipSuccess) fprintf(stderr, "kernel_launch: cooperative launch failed: %s (grid %d)\n", hipGetErrorString(e), grid);
}
```

```cpp
#include <hip/hip_runtime.h>
#include <hip/hip_cooperative_groups.h>
#include <cstdio>
#include <cstdint>
#include <cmath>
namespace cg = cooperative_groups;
__device__ __forceinline__ int lane_opaque() { unsigned z = 0u; asm volatile("" : "+v"(z)); return (int)__builtin_amdgcn_mbcnt_hi(~0u, __builtin_amdgcn_mbcnt_lo(~0u, z)); }
__device__ __forceinline__ float shflx(float v, int mask, int lane) { return __builtin_bit_cast(float, __builtin_amdgcn_ds_bpermute((lane ^ mask) << 2, __builtin_bit_cast(int, v))); }
namespace pg8 {
#define PG8_LAS __attribute__((address_space(3)))
typedef unsigned short bf16_t;
typedef short bf16x8 __attribute__((ext_vector_type(8)));
typedef float f32x4 __attribute__((ext_vector_type(4)));
typedef unsigned u32x4 __attribute__((ext_vector_type(4)));
constexpr int BM = 256, BK = 64, HALF = 128, HTB = HALF * BK * 2  , STAGE_BYTES = 8 * HTB, NXCD = 8, WGM = 8;

__host__ __device__ __forceinline__ int lds_byte(int r, int c) { const int st = (r >> 4) * 2 + (c >> 5), rr = r & 15, cc = c & 31, ob = rr * 64 + cc * 2; return st * 1024 + (ob ^ (((ob >> 9) & 1) << 5)); }
__host__ __device__ __forceinline__ void stage_rc(int b, int& R, int& C) { const int st = b / 1024, sb = b % 1024, swz = sb ^ (((sb >> 9) & 1) << 5); R = (st >> 1) * 16 + swz / 64; C = (st & 1) * 32 + (swz % 64) / 2; }
__host__ __device__ __forceinline__ int perm32(int rho) { const int n = rho >> 4, i = rho & 15; return 8 * (i >> 2) + 4 * n + (i & 3); }

struct Unit { int pm, pn; };
struct Gemm { const bf16_t* A; const bf16_t* Bt; int M, N, K, ld; };

struct StaticOrder {
    int nM, nN, nwg, G, c;
    __host__ __device__ void init(int M, int N, int G_, int c_) { nM = M / BM; nN = N / BM; nwg = nM * nN; G = G_; c = c_; }
    __host__ __device__ bool next(int i, Unit& u) const {
        const long L = (long)i * G + c; if (L >= nwg) return false;
        int wgid = (int)L; { const int q = nwg / NXCD, r = nwg % NXCD, xcd = wgid % NXCD, off = wgid / NXCD; wgid = (xcd < r ? xcd * (q + 1) : r * (q + 1) + (xcd - r) * q) + off; }
        const int nig = WGM * nN, gid = wgid / nig, fm = gid * WGM, gsz = (nM - fm) < WGM ? (nM - fm) : WGM;
        u.pm = fm + ((wgid % nig) % gsz); u.pn = (wgid % nig) / gsz; return true;
    }
    __device__ __forceinline__ void a_ready(const Unit&) const {}
    __device__ __forceinline__ void done(const Unit&) const {}
};

__device__ __forceinline__ unsigned cvt_pk_bf16(float lo, float hi) { unsigned r; asm volatile("v_cvt_pk_bf16_f32 %0, %1, %2" : "=v"(r) : "v"(lo), "v"(hi)); return r; }
typedef float f32x2 __attribute__((ext_vector_type(2)));

typedef unsigned u32x2 __attribute__((ext_vector_type(2)));
constexpr int LDK = 2048, LDQ = 6144;
__device__ __forceinline__ float fast_silu(float g) { return g * __builtin_amdgcn_rcpf(1.0f + __expf(-g)); }

struct EpiSwiGLU {
    static constexpr bool PERM = true, AFTER_DRAIN = false;
    bf16_t* O; int ldc; const float* rowss;
    __device__ __forceinline__ void operator()(f32x4 (&acc)[2][2][4][2], const Unit& u, int wr, int wc, int fr, int fq) const {
        const int row0 = u.pm * BM + wr * 64 + fr; const int col0 = u.pn * HALF + wc * 32 + 8 * fq;
        float rsv[2][4];
#pragma unroll
        for (int ai = 0; ai < 2; ++ai)
#pragma unroll
            for (int m = 0; m < 4; ++m) rsv[ai][m] = rowss ? rowss[row0 + ai * HALF + m * 16] : 0.f;
#pragma unroll
        for (int ai = 0; ai < 2; ++ai)
#pragma unroll
            for (int m = 0; m < 4; ++m) rsv[ai][m] = rowss ? __builtin_amdgcn_rsqf(rsv[ai][m] * (1.0f / 2048.0f) + 1e-6f) : 1.0f;
        asm volatile("" : "+v"(rsv[0][0]), "+v"(rsv[0][1]), "+v"(rsv[0][2]), "+v"(rsv[0][3]), "+v"(rsv[1][0]), "+v"(rsv[1][1]), "+v"(rsv[1][2]), "+v"(rsv[1][3]));
#pragma unroll
        for (int ai = 0; ai < 2; ++ai)
#pragma unroll
            for (int m = 0; m < 4; ++m) {
                const int row = row0 + ai * HALF + m * 16;
                const float rs = rsv[ai][m];
                f32x4 g0 = acc[ai][0][m][0] * rs, g1 = acc[ai][0][m][1] * rs, u0 = acc[ai][1][m][0] * rs, u1 = acc[ai][1][m][1] * rs;
                u32x4 w;
                w.x = cvt_pk_bf16(fast_silu(g0[0]) * u0[0], fast_silu(g0[1]) * u0[1]); w.y = cvt_pk_bf16(fast_silu(g0[2]) * u0[2], fast_silu(g0[3]) * u0[3]);
                w.z = cvt_pk_bf16(fast_silu(g1[0]) * u1[0], fast_silu(g1[1]) * u1[1]); w.w = cvt_pk_bf16(fast_silu(g1[2]) * u1[2], fast_silu(g1[3]) * u1[3]);
                *(u32x4*)(O + (size_t)row * ldc + col0) = w;
            }
    }
};

template <bool BASE_F32, bool WRITE_XN, bool WRITE_OUT> struct EpiResid {
    static constexpr bool PERM = false, AFTER_DRAIN = false;
    const float* base; float* out; bf16_t* xn; float* rowss; float alpha;
    __device__ __forceinline__ void operator()(f32x4 (&acc)[2][2][4][2], const Unit& u, int wr, int wc, int fr, int fq) const {
        const int row0 = u.pm * BM + wr * 64 + fr; const int col0 = u.pn * BM + wc * 32 + 4 * fq;
#pragma unroll
        for (int ai = 0; ai < 2; ++ai) {
            f32x4 bpre[4][2][2];
#pragma unroll
            for (int m = 0; m < 4; ++m) { const int row = row0 + ai * HALF + m * 16;
#pragma unroll
                for (int bj = 0; bj < 2; ++bj)
#pragma unroll
                    for (int n = 0; n < 2; ++n) {
                        if (BASE_F32) bpre[m][bj][n] = *(const f32x4*)(base + (size_t)row * 2048 + col0 + bj * HALF + n * 16);
                        else { const u32x2 w = *(const u32x2*)(xn + (size_t)row * LDK + col0 + bj * HALF + n * 16);
                               bpre[m][bj][n] = (f32x4){__builtin_bit_cast(float, w.x << 16), __builtin_bit_cast(float, w.x & 0xffff0000u), __builtin_bit_cast(float, w.y << 16), __builtin_bit_cast(float, w.y & 0xffff0000u)}; }
                    } }
#pragma unroll
            for (int m = 0; m < 4; ++m) {
                const int row = row0 + ai * HALF + m * 16; float ss = 0.f;
#pragma unroll
                for (int bj = 0; bj < 2; ++bj)
#pragma unroll
                    for (int n = 0; n < 2; ++n) {
                        const f32x4 o = bpre[m][bj][n] + acc[ai][bj][m][n] * alpha;
                        if (WRITE_OUT) __builtin_nontemporal_store(o, (f32x4*)(out + (size_t)row * 2048 + col0 + bj * HALF + n * 16));
                        if (WRITE_XN) {
                            ss += (o[0] * o[0] + o[1] * o[1]) + (o[2] * o[2] + o[3] * o[3]);
                            u32x2 w; w.x = cvt_pk_bf16(o[0], o[1]); w.y = cvt_pk_bf16(o[2], o[3]);
                            *(u32x2*)(xn + (size_t)row * LDK + col0 + bj * HALF + n * 16) = w;
                        }
                    }
                if (WRITE_XN) { ss += shflx(ss, 16, fq * 16 + fr); ss += shflx(ss, 32, fq * 16 + fr); if (fq == 0) atomicAdd(rowss + row, ss); }
            }
            asm volatile("" ::: "memory");
        }
    }
};

struct EpiQKV {
    static constexpr bool PERM = false, AFTER_DRAIN = false;
    bf16_t* O; const float* rowss; const float* gtab;
    const float* ropeA; const float* ropeB;
    PG8_LAS float* xch;
    __device__ __forceinline__ void operator()(f32x4 (&acc)[2][2][4][2], const Unit& u, int wr, int wc, int, int) const {
        const int lane_q = lane_opaque(), fr = lane_q & 15, fq = lane_q >> 4;
        const int region = u.pn >> 2;
        const int row0 = u.pm * BM + wr * 64 + fr;
#pragma unroll
        for (int ai = 0; ai < 2; ++ai)
#pragma unroll
            for (int m = 0; m < 4; ++m) {
                const float rs = __builtin_amdgcn_rsqf(rowss[row0 + ai * HALF + m * 16] * (1.0f / 2048.0f) + 1e-6f);
#pragma unroll
                for (int bj = 0; bj < 2; ++bj)
#pragma unroll
                    for (int n = 0; n < 2; ++n) acc[ai][bj][m][n] = acc[ai][bj][m][n] * rs;
            }
        const bool isv = (region == 2) || (region == 5);
        if (!isv) {
            const bool isA = region < 2;
            const bool do_rope = isA ? (wc == 0) : ((wc & 1) == 0);
#pragma unroll
            for (int ai = 0; ai < 2; ++ai)
#pragma unroll
                for (int m = 0; m < 4; ++m)
#pragma unroll
                    for (int bj = 0; bj < 2; ++bj) {
                        const f32x4 a = acc[ai][bj][m][0], b = acc[ai][bj][m][1];
                        float s = ((a[0] * a[0] + a[1] * a[1]) + (a[2] * a[2] + a[3] * a[3])) + ((b[0] * b[0] + b[1] * b[1]) + (b[2] * b[2] + b[3] * b[3]));
                        s += shflx(s, 16, fq * 16 + fr); s += shflx(s, 32, fq * 16 + fr);
                        if (fq == 0) xch[((ai * HALF + wr * 64 + m * 16 + fr) * 2 + bj) * 4 + wc] = s;
                    }
            asm volatile("s_waitcnt lgkmcnt(0)" ::: "memory"); __builtin_amdgcn_s_barrier(); asm volatile("" ::: "memory");
            const float* gptr = gtab + (region < 2 ? region : region - 1) * 128;
            const int dbase = isA ? wc * 32 : (wc & 1) * 32;
            f32x4 gv[2]; gv[0] = *(const f32x4*)(gptr + dbase + 4 * fq); gv[1] = *(const f32x4*)(gptr + dbase + 16 + 4 * fq);
            const float qs = region == 0 ? (0.08838834764831845f * 1.4426950408889634f) : (region == 3 ? (0.125f * 1.4426950408889634f) : 1.0f);
#pragma unroll
            for (int ai = 0; ai < 2; ++ai) {
                f32x4 csv[4], snv[4];
                if (do_rope) {
#pragma unroll
                    for (int m = 0; m < 4; ++m) { const int spos = (u.pm * BM + ai * HALF + wr * 64 + m * 16 + fr) & 4095;
                        const float* rp = isA ? ropeA + spos * 16 + 4 * fq : ropeB + spos * 8 + 4 * (fq & 1);
                        csv[m] = *(const f32x4*)rp; snv[m] = *(const f32x4*)(rp + (isA ? 4096 * 16 : 4096 * 8)); }
                }
#pragma unroll
                for (int m = 0; m < 4; ++m) {
                    const int rl = ai * HALF + wr * 64 + m * 16 + fr;
#pragma unroll
                    for (int bj = 0; bj < 2; ++bj) {
                        const f32x4 p = *(const PG8_LAS f32x4*)(xch + (rl * 2 + bj) * 4);
                        float rn;
                        if (isA) rn = __builtin_amdgcn_rsqf(((p[0] + p[1]) + (p[2] + p[3])) * (1.0f / 128.0f) + 1e-6f);
                        else rn = __builtin_amdgcn_rsqf(((wc < 2) ? (p[0] + p[1]) : (p[2] + p[3])) * (1.0f / 64.0f) + 1e-6f);
                        f32x4 v0 = acc[ai][bj][m][0] * rn * gv[0], v1 = acc[ai][bj][m][1] * rn * gv[1];
                        if (isA) {
                            if (do_rope) {
                                const f32x4 cs = csv[m], sn = snv[m];
                                const f32x4 x1 = v0, x2 = v1; v0 = x1 * cs - x2 * sn; v1 = x2 * cs + x1 * sn;
                            }
                        } else {
                            if (do_rope) {
                                const f32x4 cs = csv[m], sn = snv[m];
                                f32x4 pt; pt[0] = shflx(v0[0], 32, fq * 16 + fr); pt[1] = shflx(v0[1], 32, fq * 16 + fr); pt[2] = shflx(v0[2], 32, fq * 16 + fr); pt[3] = shflx(v0[3], 32, fq * 16 + fr);
                                v0 = (fq < 2) ? (v0 * cs - pt * sn) : (v0 * cs + pt * sn);
                            }
                        }
                        acc[ai][bj][m][0] = v0 * qs; acc[ai][bj][m][1] = v1 * qs;
                    }
                }
                asm volatile("" ::: "memory");
            }
        }
        const int col0 = u.pn * BM + wc * 32 + 4 * fq;
#pragma unroll
        for (int ai = 0; ai < 2; ++ai)
#pragma unroll
            for (int m = 0; m < 4; ++m) { bf16_t* rowp = O + (size_t)(row0 + ai * HALF + m * 16) * LDQ + col0;
#pragma unroll
                for (int bj = 0; bj < 2; ++bj)
#pragma unroll
                    for (int n = 0; n < 2; ++n) { const f32x4 v = acc[ai][bj][m][n]; u32x2 w; w.x = cvt_pk_bf16(v[0], v[1]); w.y = cvt_pk_bf16(v[2], v[3]); *(u32x2*)(rowp + bj * HALF + n * 16) = w; } }
    }
};
template <class Epi, class Sched, bool ALIGN_EPI = false, bool SP2 = false>
__device__ __forceinline__ void gemm_phase(PG8_LAS unsigned char* lds, const Gemm g, const Sched& S, const Epi& E, const int wid_s) {
    const int lane_ = lane_opaque();
    const int tid = wid_s * 64 + lane_, wid = wid_s, lane = tid & 63, wr = wid >> 2, wc = wid & 3, fr = lane & 15, fq = lane >> 4;
    const int K = g.ld, nt = g.K / BK;
    unsigned voffA[2], voffB[2];
#pragma unroll
    for (int i = 0; i < 2; ++i) { int R, C; stage_rc(tid * 16 + i * 8192, R, C); const int Rb = Epi::PERM ? ((R & ~31) + perm32(R & 31)) : R;
        voffA[i] = (unsigned)(R * K + C) * 2u; voffB[i] = (unsigned)(Rb * K + C) * 2u; }
    const size_t kstep = (size_t)(BK * 2);
    const size_t hstep = (size_t)HALF * K * 2;
    const size_t tstep = 2 * hstep;
    const unsigned ldsw = (unsigned)wid * 1024u;
    const int aoff = lds_byte(wr * 64 + fr, fq * 8), boff = lds_byte(wc * 32 + fr, fq * 8);
#define PG8_SA(b, h) (((b) * 2 + (h)) * HTB)
#define PG8_SB(b, h) ((4 + (b) * 2 + (h)) * HTB)
#define PG8_STAGE(bufoff, gbase, voff) do { _Pragma("unroll") for (int _i = 0; _i < 2; ++_i) \
        __builtin_amdgcn_global_load_lds((const unsigned*)((const char*)(gbase) + (voff)[_i]), (PG8_LAS unsigned*)(lds + (bufoff) + ldsw + _i * 8192), 16, 0, 0); } while (0)
#define PG8_LDA(dst, b, h) do { _Pragma("unroll") for (int m = 0; m < 4; ++m) _Pragma("unroll") for (int k = 0; k < 2; ++k) dst[m][k] = *(const PG8_LAS bf16x8*)(lds + PG8_SA(b, h) + aoff + m * 2048 + k * 1024); } while (0)
#define PG8_LDB(dst, b, h) do { _Pragma("unroll") for (int n = 0; n < 2; ++n) _Pragma("unroll") for (int k = 0; k < 2; ++k) dst[n][k] = *(const PG8_LAS bf16x8*)(lds + PG8_SB(b, h) + boff + n * 2048 + k * 1024); } while (0)
#define PG8_MMA(ai, bj, At, Bt) do { __builtin_amdgcn_s_setprio(1); _Pragma("unroll") for (int m = 0; m < 4; ++m) _Pragma("unroll") for (int n = 0; n < 2; ++n) _Pragma("unroll") for (int k = 0; k < 2; ++k) \
        acc[ai][bj][m][n] = __builtin_amdgcn_mfma_f32_16x16x32_bf16(Bt[n][k], At[m][k], acc[ai][bj][m][n], 0, 0, 0); __builtin_amdgcn_s_setprio(0); } while (0)
#define PG8_WAIT_V(n) asm volatile("s_waitcnt vmcnt(" #n ")" ::: "memory")
#define PG8_WAIT_L(n) asm volatile("s_waitcnt lgkmcnt(" #n ")" ::: "memory")
#define PG8_BAR __builtin_amdgcn_s_barrier()
#define PG8_SCHED __builtin_amdgcn_sched_barrier(0)
    Unit cur, nxt; int ui = 0;
    if (!S.next(0, cur)) return;
    f32x4 acc[2][2][4][2];
#pragma unroll
    for (int a = 0; a < 2; ++a)
#pragma unroll
        for (int b = 0; b < 2; ++b)
#pragma unroll
            for (int m = 0; m < 4; ++m)
#pragma unroll
                for (int n = 0; n < 2; ++n) acc[a][b][m][n] = (f32x4){0.f, 0.f, 0.f, 0.f};
    bf16x8 At[4][2], B0[2][2], B1[2][2];
    const char* cA = (const char*)g.A + (size_t)cur.pm * tstep; const char* cB = (const char*)g.Bt + (size_t)cur.pn * tstep;
    S.a_ready(cur);
    if constexpr (SP2) {
        PG8_STAGE(PG8_SB(0, 0), cB, voffB); PG8_STAGE(PG8_SB(0, 1), cB + hstep, voffB); PG8_STAGE(PG8_SA(0, 0), cA, voffA); PG8_STAGE(PG8_SA(0, 1), cA + hstep, voffA);
        if (wr == 1) PG8_BAR;
        PG8_WAIT_V(2); PG8_BAR;
        PG8_STAGE(PG8_SB(1, 0), cB + kstep, voffB); PG8_STAGE(PG8_SA(1, 0), cA + kstep, voffA); PG8_STAGE(PG8_SB(1, 1), cB + hstep + kstep, voffB);
        PG8_WAIT_V(6); PG8_BAR;
    } else {
        PG8_STAGE(PG8_SB(0, 0), cB, voffB); PG8_STAGE(PG8_SA(0, 0), cA, voffA); PG8_STAGE(PG8_SB(0, 1), cB + hstep, voffB); PG8_STAGE(PG8_SA(0, 1), cA + hstep, voffA);
        if (wr == 1) PG8_BAR;
        PG8_WAIT_V(4); PG8_BAR;
        PG8_STAGE(PG8_SB(1, 0), cB + kstep, voffB); PG8_STAGE(PG8_SA(1, 0), cA + kstep, voffA); PG8_STAGE(PG8_SB(1, 1), cB + hstep + kstep, voffB);
        PG8_WAIT_V(6); PG8_BAR;
    }
    for (;;) {
        const bool has_next = S.next(ui + 1, nxt);
        const char* nA = has_next ? (const char*)g.A + (size_t)nxt.pm * tstep : cA; const char* nB = has_next ? (const char*)g.Bt + (size_t)nxt.pn * tstep : cB;
        for (int t = 0; t < nt; t += 2) {
            const bool last = (t == nt - 2);
            const char* a1 = cA + (size_t)(t + 1) * kstep;
            const char* a2 = last ? nA : cA + (size_t)(t + 2) * kstep; const char* b2 = last ? nB : cB + (size_t)(t + 2) * kstep;
            const char* a3 = a2 + kstep; const char* b3 = b2 + kstep;
            if (last && has_next) S.a_ready(nxt);
            if constexpr (SP2) {
            PG8_LDB(B0, 0, 0); PG8_LDB(B1, 0, 1); PG8_SCHED; PG8_LDA(At, 0, 0); PG8_STAGE(PG8_SA(1, 1), a1 + hstep, voffA);
            PG8_WAIT_V(8); PG8_WAIT_L(0); PG8_BAR; PG8_MMA(0, 0, At, B0); PG8_MMA(0, 1, At, B1); PG8_BAR; PG8_SCHED;
            PG8_LDA(At, 0, 1); PG8_STAGE(PG8_SB(0, 0), b2, voffB); PG8_STAGE(PG8_SB(0, 1), b2 + hstep, voffB); PG8_STAGE(PG8_SA(0, 0), a2, voffA);
            PG8_WAIT_V(8); PG8_WAIT_L(0); PG8_BAR; PG8_MMA(1, 0, At, B0); PG8_MMA(1, 1, At, B1); PG8_BAR; PG8_SCHED;
            PG8_LDB(B0, 1, 0); PG8_LDB(B1, 1, 1); PG8_SCHED; PG8_LDA(At, 1, 0); PG8_STAGE(PG8_SA(0, 1), a2 + hstep, voffA);
            PG8_WAIT_V(8); PG8_WAIT_L(0); PG8_BAR; PG8_MMA(0, 0, At, B0); PG8_MMA(0, 1, At, B1); PG8_BAR; PG8_SCHED;
            PG8_LDA(At, 1, 1); PG8_STAGE(PG8_SB(1, 0), b3, voffB); PG8_STAGE(PG8_SB(1, 1), b3 + hstep, voffB); PG8_STAGE(PG8_SA(1, 0), a3, voffA);
            PG8_WAIT_V(8); PG8_WAIT_L(0); PG8_BAR; PG8_MMA(1, 0, At, B0); PG8_MMA(1, 1, At, B1); PG8_BAR; PG8_SCHED;
            } else {
            PG8_LDB(B0, 0, 0); PG8_SCHED; PG8_LDA(At, 0, 0); PG8_STAGE(PG8_SA(1, 1), a1 + hstep, voffA);
            PG8_WAIT_L(8); PG8_BAR; PG8_WAIT_L(0); PG8_MMA(0, 0, At, B0); PG8_BAR; PG8_SCHED;
            PG8_LDB(B1, 0, 1); PG8_STAGE(PG8_SB(0, 0), b2, voffB);
            PG8_BAR; PG8_WAIT_L(0); PG8_MMA(0, 1, At, B1); PG8_BAR;
            PG8_LDA(At, 0, 1); PG8_STAGE(PG8_SA(0, 0), a2, voffA);
            PG8_BAR; PG8_WAIT_L(0); PG8_MMA(1, 0, At, B0); PG8_BAR; PG8_SCHED;
            PG8_STAGE(PG8_SB(0, 1), b2 + hstep, voffB);
            PG8_WAIT_V(6); PG8_BAR; PG8_MMA(1, 1, At, B1); PG8_BAR;
            PG8_LDB(B0, 1, 0); PG8_SCHED; PG8_LDA(At, 1, 0); PG8_STAGE(PG8_SA(0, 1), a2 + hstep, voffA);
            PG8_WAIT_L(8); PG8_BAR; PG8_WAIT_L(0); PG8_MMA(0, 0, At, B0); PG8_BAR; PG8_SCHED;
            PG8_LDB(B1, 1, 1); PG8_STAGE(PG8_SB(1, 0), b3, voffB);
            PG8_BAR; PG8_WAIT_L(0); PG8_MMA(0, 1, At, B1); PG8_BAR;
            PG8_LDA(At, 1, 1); PG8_STAGE(PG8_SA(1, 0), a3, voffA);
            PG8_BAR; PG8_WAIT_L(0); PG8_MMA(1, 0, At, B0); PG8_BAR; PG8_SCHED;
            PG8_STAGE(PG8_SB(1, 1), b3 + hstep, voffB);
            PG8_WAIT_V(6); PG8_BAR; PG8_MMA(1, 1, At, B1); PG8_BAR;
            }
        }
        if constexpr (ALIGN_EPI) { if (wr == 0) PG8_BAR; }
        if constexpr (!Epi::AFTER_DRAIN) { E(acc, cur, wr, wc, fr, fq); S.done(cur); }
        if (!has_next) break;
#pragma unroll
        for (int a = 0; a < 2; ++a)
#pragma unroll
            for (int b = 0; b < 2; ++b)
#pragma unroll
                for (int m = 0; m < 4; ++m)
#pragma unroll
                    for (int n = 0; n < 2; ++n) acc[a][b][m][n] = (f32x4){0.f, 0.f, 0.f, 0.f};
        cur = nxt; cA = nA; cB = nB; ++ui;
        if constexpr (ALIGN_EPI) { if (wr == 1) PG8_BAR; }
    }
    PG8_WAIT_V(0);
    if constexpr (!ALIGN_EPI) { if (wr == 0) PG8_BAR; }
    PG8_BAR;
    if constexpr (Epi::AFTER_DRAIN) { E.fused(acc, cur, wr, wc, fr, fq, lds, wid, lane); S.done(cur); }
#undef PG8_SA
#undef PG8_SB
#undef PG8_STAGE
#undef PG8_LDA
#undef PG8_LDB
#undef PG8_MMA
#undef PG8_WAIT_V
#undef PG8_WAIT_L
#undef PG8_BAR
#undef PG8_SCHED
}
}

namespace att {
#define LAS __attribute__((address_space(3)))
typedef unsigned short bf16_t;
typedef short bf16x8 __attribute__((ext_vector_type(8)));
typedef short s16x4 __attribute__((ext_vector_type(4)));
typedef short v4i16_t __attribute__((ext_vector_type(4)));
typedef float f32x16 __attribute__((ext_vector_type(16)));
typedef float f32x4 __attribute__((ext_vector_type(4)));
typedef unsigned u32x4 __attribute__((ext_vector_type(4)));
typedef unsigned u32x2 __attribute__((ext_vector_type(2)));
typedef float f32x2_t __attribute__((ext_vector_type(2))); typedef __bf16 bf16x2_t __attribute__((ext_vector_type(2)));
constexpr int SEQ = 4096, INW = 6144, DMODEL = 2048;
constexpr int KP = 272, VP = 320;
constexpr int DIFF_TILE = 128 * KP + 128 * VP;
constexpr int DIL_WAVE = 32 * KP + 32 * VP;
__device__ __forceinline__ unsigned cvtpk(float lo, float hi) { f32x2_t v = {lo, hi}; bf16x2_t b = __builtin_convertvector(v, bf16x2_t); return __builtin_bit_cast(unsigned, b); }
__device__ __forceinline__ int crow(int r, int hi) { return (r & 3) + 8 * (r >> 2) + 4 * hi; }
__device__ __forceinline__ s16x4 vtr(const LAS char* p) { return __builtin_bit_cast(s16x4, __builtin_amdgcn_ds_read_tr16_b64_v4i16((LAS v4i16_t*)p)); }
__device__ __forceinline__ bf16x8 packp(const f32x16& p, int s) {
    u32x4 w; w.x = cvtpk(p[8 * s], p[8 * s + 1]); w.y = cvtpk(p[8 * s + 2], p[8 * s + 3]); w.z = cvtpk(p[8 * s + 4], p[8 * s + 5]); w.w = cvtpk(p[8 * s + 6], p[8 * s + 7]);
    return __builtin_bit_cast(bf16x8, w);
}
#define MFMA32(a, b, c) __builtin_amdgcn_mfma_f32_32x32x16_bf16((a), (b), (c), 0, 0, 0)

__device__ __forceinline__ void diff_unit(LAS char* lds, const bf16_t* QKV, bf16_t* MIX, int b, int h, int qblk, float lam, float negM, const float* g_bout, int tid, int wid, int lane) {
    const int c = wid >> 2, r32 = lane & 31, hh = lane >> 5, cb = (lane >> 4) & 1, q_ = (lane & 15) >> 2, p_ = lane & 3;
    const size_t rowbase = (size_t)b * SEQ; const int q0 = qblk * 128 + (wid & 3) * 32;
    bf16x8 qf[4];
    { const bf16_t* qp = QKV + (rowbase + q0 + r32) * INW + 3072 + h * 128 + c * 64 + 8 * hh;
#pragma unroll
      for (int ks = 0; ks < 4; ++ks) qf[ks] = *(const bf16x8*)(qp + 16 * ks); }
    const int srow = tid >> 4, sch = tid & 15;
    const bf16_t* kg = QKV + (rowbase + srow) * INW + 4096 + h * 128 + sch * 8;
    const bf16_t* vg = kg + 1024;
    LAS char* kst = lds + srow * KP + sch * 16; LAS char* vst = lds + 128 * KP + srow * VP + sch * 16;
    f32x16 o[4];
#pragma unroll
    for (int i = 0; i < 4; ++i)
#pragma unroll
        for (int r = 0; r < 16; ++r) o[i][r] = 0.f;
    float lsum = 0.f;
    f32x16 negm;
#pragma unroll
    for (int r = 0; r < 16; ++r) negm[r] = negM;
    u32x4 kr[4], vr[4];
#pragma unroll
    for (int i = 0; i < 4; ++i) { kr[i] = *(const u32x4*)(kg + (size_t)(32 * i) * INW); vr[i] = *(const u32x4*)(vg + (size_t)(32 * i) * INW); }
#pragma unroll
    for (int i = 0; i < 4; ++i) { *(LAS u32x4*)(kst + 32 * i * KP) = kr[i]; *(LAS u32x4*)(vst + 32 * i * VP) = vr[i]; }
    __syncthreads();
    const int NT = SEQ / 128;
    const LAS char* kread = lds + r32 * KP + (c * 64 + 8 * hh) * 2;
    const LAS char* vread = lds + 128 * KP + (4 * hh + q_) * VP + (16 * cb + 4 * p_) * 2;
    for (int t = 0; t < NT; ++t) {
        const int cur = (t & 1) * DIFF_TILE, nxt = DIFF_TILE - cur;
        const size_t go = (size_t)(t + 1) * 128 * INW; const bool more = t + 1 < NT;
        if (more) {
#pragma unroll
            for (int i = 0; i < 4; ++i) kr[i] = *(const u32x4*)(kg + go + (size_t)(32 * i) * INW); }
        f32x16 pA0 = negm, pA1 = negm, pB0 = negm, pB1 = negm;
#pragma unroll
        for (int ks = 0; ks < 4; ++ks) {
            const bf16x8 k0 = *(const LAS bf16x8*)(kread + cur + ks * 32), k1 = *(const LAS bf16x8*)(kread + cur + 32 * KP + ks * 32);
            pA0 = MFMA32(k0, qf[ks], pA0); pA1 = MFMA32(k1, qf[ks], pA1);
        }
#pragma unroll
        for (int ks = 0; ks < 4; ++ks) {
            const bf16x8 k0 = *(const LAS bf16x8*)(kread + cur + 64 * KP + ks * 32), k1 = *(const LAS bf16x8*)(kread + cur + 96 * KP + ks * 32);
            pB0 = MFMA32(k0, qf[ks], pB0); pB1 = MFMA32(k1, qf[ks], pB1);
        }
        if (more) {
#pragma unroll
            for (int i = 0; i < 4; ++i) *(LAS u32x4*)(kst + nxt + 32 * i * KP) = kr[i];
#pragma unroll
            for (int i = 0; i < 4; ++i) kr[i] = *(const u32x4*)(vg + go + (size_t)(32 * i) * INW); }
        float sa = 0.f, sb = 0.f;
#pragma unroll
        for (int r = 0; r < 16; ++r) { pA0[r] = __builtin_amdgcn_exp2f(pA0[r]); pA1[r] = __builtin_amdgcn_exp2f(pA1[r]); sa += pA0[r]; sb += pA1[r]; }
        bf16x8 pf[4]; pf[0] = packp(pA0, 0); pf[1] = packp(pA0, 1); pf[2] = packp(pA1, 0); pf[3] = packp(pA1, 1);
#pragma unroll
        for (int kst4 = 0; kst4 < 4; ++kst4)
#pragma unroll
            for (int db = 0; db < 4; ++db) {
                const LAS char* a = vread + cur + kst4 * 16 * VP + db * 64;
                const s16x4 lo = vtr(a), hi = vtr(a + 8 * VP);
                const bf16x8 vf = __builtin_shufflevector(lo, hi, 0, 1, 2, 3, 4, 5, 6, 7);
                o[db] = MFMA32(vf, pf[kst4], o[db]);
            }
#pragma unroll
        for (int r = 0; r < 16; ++r) { pB0[r] = __builtin_amdgcn_exp2f(pB0[r]); pB1[r] = __builtin_amdgcn_exp2f(pB1[r]); sa += pB0[r]; sb += pB1[r]; }
        lsum += sa + sb;
        pf[0] = packp(pB0, 0); pf[1] = packp(pB0, 1); pf[2] = packp(pB1, 0); pf[3] = packp(pB1, 1);
#pragma unroll
        for (int kst4 = 0; kst4 < 4; ++kst4)
#pragma unroll
            for (int db = 0; db < 4; ++db) {
                const LAS char* a = vread + cur + (64 + kst4 * 16) * VP + db * 64;
                const s16x4 lo = vtr(a), hi = vtr(a + 8 * VP);
                const bf16x8 vf = __builtin_shufflevector(lo, hi, 0, 1, 2, 3, 4, 5, 6, 7);
                o[db] = MFMA32(vf, pf[kst4], o[db]);
            }
        if (more) {
#pragma unroll
            for (int i = 0; i < 4; ++i) *(LAS u32x4*)(vst + nxt + 32 * i * VP) = kr[i]; }
        __syncthreads();
    }
    const int lane_e = lane_opaque();
    lsum += shflx(lsum, 32, lane_e);
    float inv = 1.0f / lsum; if (c == 1) inv *= lam;
    const int r32e = lane_e & 31, hhe = lane_e >> 5;
    LAS float* X = (LAS float*)lds + (wid & 3) * 4096;
    if (c == 1) {
#pragma unroll
        for (int db = 0; db < 4; ++db)
#pragma unroll
            for (int r = 0; r < 16; ++r) X[(db * 32 + crow(r, hhe)) * 32 + r32e] = o[db][r] * inv;
    }
    __syncthreads();
    if (c == 0) {
        float ss = 0.f;
#pragma unroll
        for (int db = 0; db < 4; ++db)
#pragma unroll
            for (int r = 0; r < 16; ++r) { const float v = o[db][r] * inv - X[(db * 32 + crow(r, hhe)) * 32 + r32e]; o[db][r] = v; ss += v * v; }
        ss += shflx(ss, 32, lane_e);
        const float rn = __builtin_amdgcn_rsqf(ss * (1.0f / 128.0f) + 1e-6f) * 0.8f;
        bf16_t* op = MIX + (rowbase + q0 + r32e) * DMODEL + 1024 + h * 128;
#pragma unroll
        for (int db = 0; db < 4; ++db)
#pragma unroll
            for (int g4 = 0; g4 < 4; ++g4) { const int d0 = db * 32 + 8 * g4 + 4 * hhe; const f32x4 gg = *(const f32x4*)(g_bout + d0);
                u32x2 w; w.x = cvtpk(o[db][4 * g4] * rn * gg[0], o[db][4 * g4 + 1] * rn * gg[1]); w.y = cvtpk(o[db][4 * g4 + 2] * rn * gg[2], o[db][4 * g4 + 3] * rn * gg[3]);
                *(u32x2*)(op + d0) = w; }
    }
    __syncthreads();
}

template <int MODE> __device__ __forceinline__ void dil_unit(LAS char* wl, const bf16_t* QKV, bf16_t* MIX, float* Opart, float* Lpart, int b, int h, int r16, int ib, float negM, const float* g_aout, int lane) {
    const int r32 = lane & 31, hh = lane >> 5, cb = (lane >> 4) & 1, q_ = (lane & 15) >> 2, p_ = lane & 3;
    const size_t rowbase = (size_t)b * SEQ;
    const int t0 = MODE ? r16 + 512 * ib : 32 * (8 * r16 + ib), qs = MODE ? 16 : 1;
    const int tq = t0 + qs * r32;
    bf16x8 qf[8];
    { const bf16_t* qp = QKV + (rowbase + tq) * INW + h * 128 + 8 * hh;
#pragma unroll
      for (int ks = 0; ks < 8; ++ks) qf[ks] = *(const bf16x8*)(qp + 16 * ks); }
    f32x16 o[4];
#pragma unroll
    for (int i = 0; i < 4; ++i)
#pragma unroll
        for (int r = 0; r < 16; ++r) o[i][r] = 0.f;
    float lsum = 0.f;
    f32x16 negm;
#pragma unroll
    for (int r = 0; r < 16; ++r) negm[r] = negM;
    const int lrow = lane >> 4, lch = lane & 15;
    const bf16_t* kvg = QKV + rowbase * INW + 1024 + h * 128 + lch * 8;
    LAS char* kst = wl + lrow * KP + lch * 16; LAS char* vst = wl + 32 * KP + lrow * VP + lch * 16;
    const LAS char* kread = wl + r32 * KP + 8 * hh * 2;
    const LAS char* vread = wl + 32 * KP + (4 * hh + q_) * VP + (16 * cb + 4 * p_) * 2;
    int klo0, khi0, klo1, khi1, klo2, khi2;
    { const int bq = t0 >> 4; int lo_i = bq - 64; if (lo_i < 0) lo_i = 0; klo0 = lo_i >> 5; khi0 = (bq + 31 * (qs >> 4) + 64) >> 5; if (khi0 > 7) khi0 = 7; }
    { const int bq = t0 >> 2; int lo_i = bq - 64; if (lo_i < 0) lo_i = 0; klo1 = lo_i >> 5; khi1 = (bq + 31 * (qs >> 2) + 64) >> 5; if (khi1 > 31) khi1 = 31; }
    { const int bq = t0;      int lo_i = bq - 64; if (lo_i < 0) lo_i = 0; klo2 = lo_i >> 5; khi2 = (bq + 31 * qs + 64) >> 5;        if (khi2 > 127) khi2 = 127; }
    constexpr int PAT_END = MODE ? 2 : 3;
    int pat = MODE ? 0 : 2, kb = MODE ? klo0 : klo2;
    u32x4 kr[8], vr[8];
#define DIL_LOADK(PAT, KB) do { const int sh_ = 4 - 2 * (PAT); const int rc_ = t0 & ((1 << sh_) - 1); \
        _Pragma("unroll") for (int i = 0; i < 8; ++i) { const int tok = rc_ + ((32 * (KB) + lrow + 4 * i) << sh_); kr[i] = *(const u32x4*)(kvg + (size_t)tok * INW); } } while (0)
#define DIL_LOADV(PAT, KB) do { const int sh_ = 4 - 2 * (PAT); const int rc_ = t0 & ((1 << sh_) - 1); \
        _Pragma("unroll") for (int i = 0; i < 8; ++i) { const int tok = rc_ + ((32 * (KB) + lrow + 4 * i) << sh_); vr[i] = *(const u32x4*)(kvg + (size_t)tok * INW + 1024); } } while (0)
#define DIL_ADV() do { const int hi_c = pat == 0 ? khi0 : (pat == 1 ? khi1 : khi2); if (kb < hi_c) ++kb; else { ++pat; kb = pat == 1 ? klo1 : klo2; } } while (0)
#define DIL_WFENCE() do { __builtin_amdgcn_fence(__ATOMIC_RELEASE, "wavefront"); __builtin_amdgcn_wave_barrier(); __builtin_amdgcn_fence(__ATOMIC_ACQUIRE, "wavefront"); } while (0)
#define DIL_S(P) do { P = negm; _Pragma("unroll") for (int ks = 0; ks < 8; ++ks) { const bf16x8 kf = *(const LAS bf16x8*)(kread + ks * 32); P = MFMA32(kf, qf[ks], P); } } while (0)
    int cpat = pat, ckb = kb;
    DIL_LOADK(pat, kb); DIL_LOADV(pat, kb);
#pragma unroll
    for (int i = 0; i < 8; ++i) { *(LAS u32x4*)(kst + 4 * i * KP) = kr[i]; *(LAS u32x4*)(vst + 4 * i * VP) = vr[i]; }
    DIL_ADV();
    bool have1 = pat < PAT_END;
    int npat = pat, nkb = kb;
    if (have1) { DIL_LOADK(pat, kb); DIL_LOADV(pat, kb); DIL_ADV(); }
    DIL_WFENCE();
    f32x16 p, pn;
    DIL_S(p);
    for (;;) {
        const bool have2 = have1 && pat < PAT_END;
        if (have1) {
            DIL_WFENCE();
#pragma unroll
            for (int i = 0; i < 8; ++i) *(LAS u32x4*)(kst + 4 * i * KP) = kr[i];
            if (have2) DIL_LOADK(pat, kb);
            DIL_WFENCE();
            DIL_S(pn);
        }
        const int sh = 4 - 2 * cpat;
        const int qi = (t0 >> sh) + (qs >> sh) * r32;
        float sa = 0.f;
#pragma unroll
        for (int r = 0; r < 16; ++r) { const int dl = 32 * ckb + crow(r, hh) - qi; const float e = __builtin_amdgcn_exp2f(p[r]); const float pv = (dl <= 64 && dl >= -64) ? e : 0.f; p[r] = pv; sa += pv; }
        lsum += sa;
        bf16x8 pf[2]; pf[0] = packp(p, 0); pf[1] = packp(p, 1);
#pragma unroll
        for (int s = 0; s < 2; ++s)
#pragma unroll
            for (int db = 0; db < 4; ++db) {
                const LAS char* a = vread + s * 16 * VP + db * 64;
                const s16x4 lo = vtr(a), hi = vtr(a + 8 * VP);
                const bf16x8 vf = __builtin_shufflevector(lo, hi, 0, 1, 2, 3, 4, 5, 6, 7);
                o[db] = MFMA32(vf, pf[s], o[db]);
            }
        if (!have1) break;
        DIL_WFENCE();
#pragma unroll
        for (int i = 0; i < 8; ++i) *(LAS u32x4*)(vst + 4 * i * VP) = vr[i];
        if (have2) DIL_LOADV(pat, kb);
        DIL_WFENCE();
        p = pn; cpat = npat; ckb = nkb; npat = pat; nkb = kb; have1 = have2;
        if (have2) DIL_ADV();
    }
#undef DIL_LOADK
#undef DIL_LOADV
#undef DIL_ADV
#undef DIL_WFENCE
#undef DIL_S
    const int lane_f = lane_opaque(), hhf = lane_f >> 5, tqf = t0 + qs * (lane_f & 31);
    lsum += shflx(lsum, 32, lane_f);
    float* pp = Opart + ((rowbase + tqf) * 8 + h) * 128; float* lp = Lpart + (rowbase + tqf) * 8 + h;
    if (MODE == 0) {
#pragma unroll
        for (int db = 0; db < 4; ++db)
#pragma unroll
            for (int g4 = 0; g4 < 4; ++g4) *(f32x4*)(pp + db * 32 + 8 * g4 + 4 * hhf) = (f32x4){o[db][4 * g4], o[db][4 * g4 + 1], o[db][4 * g4 + 2], o[db][4 * g4 + 3]};
        if (hhf == 0) *lp = lsum;
        return;
    }
    lsum += *lp;
#pragma unroll
    for (int db = 0; db < 4; ++db)
#pragma unroll
        for (int g4 = 0; g4 < 4; ++g4) { const f32x4 t = *(const f32x4*)(pp + db * 32 + 8 * g4 + 4 * hhf); o[db][4 * g4] += t[0]; o[db][4 * g4 + 1] += t[1]; o[db][4 * g4 + 2] += t[2]; o[db][4 * g4 + 3] += t[3]; }
    const float inv = 1.0f / lsum; float ss = 0.f;
#pragma unroll
    for (int db = 0; db < 4; ++db)
#pragma unroll
        for (int r = 0; r < 16; ++r) { const float v = o[db][r] * inv; o[db][r] = v; ss += v * v; }
    ss += shflx(ss, 32, lane_f);
    const float rn = __builtin_amdgcn_rsqf(ss * (1.0f / 128.0f) + 1e-6f);
    bf16_t* op = MIX + (rowbase + tqf) * DMODEL + h * 128;
#pragma unroll
    for (int db = 0; db < 4; ++db)
#pragma unroll
        for (int g4 = 0; g4 < 4; ++g4) { const int d0 = db * 32 + 8 * g4 + 4 * hhf; const f32x4 gg = *(const f32x4*)(g_aout + d0);
            u32x2 w; w.x = cvtpk(o[db][4 * g4] * rn * gg[0], o[db][4 * g4 + 1] * rn * gg[1]); w.y = cvtpk(o[db][4 * g4 + 2] * rn * gg[2], o[db][4 * g4 + 3] * rn * gg[3]);
            *(u32x2*)(op + d0) = w; }
}
}

constexpr int NWAVES = 8;
constexpr int DM = 2048, NBATCH = 2, SEQ = 4096, MROWS = NBATCH * SEQ, DFF = 5632, INW = 6144;
constexpr size_t MiB = 1u << 20;
constexpr size_t WS_CTL = 0;
constexpr size_t OFF_GTAB = 1 * MiB - 4096;
constexpr size_t OFF_RS0 = 917504;
constexpr size_t OFF_BAR = 983040, BAR_BYTES = 16384;
constexpr size_t OFF_RS1 = 0, OFF_RS2 = 32768, OFF_ROPEA = 65536, OFF_ROPEB = OFF_ROPEA + 2 * 4096 * 16 * 4;
constexpr int LDK = pg8::LDK, LDQ = pg8::LDQ;
constexpr size_t WS_W1A = 1 * MiB, WS_W1B = WS_W1A + 47 * MiB, WS_WIN = WS_W1B + 22 * MiB, WS_WOUT = WS_WIN + 26 * MiB, WS_W2A = WS_WOUT + 9 * MiB, WS_W2B = WS_W2A + 47 * MiB;
constexpr size_t WS_XN = WS_W2B + 22 * MiB;
constexpr size_t WS_ACT = WS_XN + 34 * MiB;
constexpr size_t WS_MIX = WS_ACT + 98 * MiB;
constexpr size_t WS_OPART = WS_MIX + 34 * MiB;
constexpr size_t WS_LPART = WS_OPART + 32 * MiB;
constexpr size_t WS_END = WS_LPART + 1 * MiB;
constexpr int LDS_BYTES = 155648;
constexpr int XCH_OFF = 131072;
static_assert((size_t)11264 * LDK * 2 <= 47 * MiB && (size_t)6144 * LDK * 2 <= 26 * MiB && (size_t)2048 * LDK * 2 <= 9 * MiB && (size_t)8192 * LDK * 2 <= 34 * MiB && (size_t)8192 * LDQ * 2 <= 98 * MiB && att::INW == LDQ && att::DMODEL == LDK, "ws map");
static_assert(att::DIL_WAVE * 8 <= LDS_BYTES - 64 && 3456 * 4 <= BAR_BYTES && 2 * att::DIFF_TILE <= LDS_BYTES - 64 && XCH_OFF + 8192 <= LDS_BYTES, "LDS map");

#define LAS __attribute__((address_space(3)))
typedef unsigned short bf16;
typedef unsigned v4u __attribute__((ext_vector_type(4)));
typedef unsigned v2u __attribute__((ext_vector_type(2)));
typedef float f32x4 __attribute__((ext_vector_type(4)));
__device__ __forceinline__ unsigned f2bf(float f) { unsigned u = __builtin_bit_cast(unsigned, f); return (u + 0x7fffu + ((u >> 16) & 1u)) >> 16; }
__device__ __forceinline__ unsigned pk2(float lo, float hi) { return f2bf(lo) | (f2bf(hi) << 16); }
__device__ __forceinline__ float wave_sum(float v, int lane) {
#pragma unroll
    for (int o = 1; o < 64; o <<= 1) v += shflx(v, o, lane);
    return v;
}
__device__ __forceinline__ float wave_max(float v, int lane) {
#pragma unroll
    for (int o = 1; o < 64; o <<= 1) v = fmaxf(v, shflx(v, o, lane));
    return v;
}
template <bool GLU> __device__ __forceinline__ void tr_load(const float* W, int N, int item, int lane, f32x4 (&v)[8], const float* gk) {
    const int nblk = N / 32, kb = item / nblk, nb = item % nblk, k0 = 64 * kb, n0 = 32 * nb;
    const float* src = W + (size_t)(k0 + (lane >> 3)) * N + n0 + 4 * (lane & 7);
#pragma unroll
    for (int i = 0; i < 8; ++i) v[i] = __builtin_nontemporal_load((const f32x4*)(src + (size_t)(8 * i) * N));
    if (gk) {
#pragma unroll
        for (int i = 0; i < 8; ++i) v[i] = v[i] * gk[k0 + (lane >> 3) + 8 * i]; }
}
template <bool GLU> __device__ __forceinline__ void tr_store(int K, int N, bf16* WT, int ldw, LAS float* scr, int item, int lane, const f32x4 (&v)[8]) {
    const int nblk = N / 32, kb = item / nblk, nb = item % nblk, k0 = 64 * kb, n0 = 32 * nb;
    int r0 = n0;
    if (GLU) { const int half = N / 2; r0 = n0 < half ? (n0 >> 7) * 256 + (n0 & 127) : ((n0 - half) >> 7) * 256 + 128 + ((n0 - half) & 127); }
    const int rg = lane >> 3, c4 = lane & 7;
#pragma unroll
    for (int i = 0; i < 8; ++i) { LAS float* d = scr + (8 * i + rg) * 33 + 4 * c4; d[0] = v[i][0]; d[1] = v[i][1]; d[2] = v[i][2]; d[3] = v[i][3]; }
    asm volatile("s_waitcnt lgkmcnt(0)" ::: "memory");
    const int c = lane & 7;
#pragma unroll
    for (int j = 0; j < 4; ++j) { const int n = (lane >> 3) + 8 * j; const LAS float* s = scr + (8 * c) * 33 + n;
        v4u o; o.x = pk2(s[0 * 33], s[1 * 33]); o.y = pk2(s[2 * 33], s[3 * 33]); o.z = pk2(s[4 * 33], s[5 * 33]); o.w = pk2(s[6 * 33], s[7 * 33]);
        *(v4u*)(WT + (size_t)(r0 + n) * ldw + k0 + 8 * c) = o; }
    asm volatile("s_waitcnt lgkmcnt(0)" ::: "memory");
}
template <bool GLU, int NIF> __device__ __forceinline__ void tr_matrix(const float* W, int K, int N, bf16* WT, int ldw, LAS float* scr, int gw, int NGW, int lane, const float* gk) {
    const int nitems = (K / 64) * (N / 32);
    for (int it = gw; it < nitems; it += NIF * NGW) {
        f32x4 v[NIF][8];
#pragma unroll
        for (int j = 0; j < NIF; ++j) if (it + j * NGW < nitems) tr_load<GLU>(W, N, it + j * NGW, lane, v[j], gk);
#pragma unroll
        for (int j = 0; j < NIF; ++j) if (it + j * NGW < nitems) tr_store<GLU>(K, N, WT, ldw, scr, it + j * NGW, lane, v[j]);
    }
}

#define XB_TMO      128
#define XB_XCNT(j)  (256  + 64 * (j))
#define XB_XSUB(j)  (1280 + 64 * (j))
#define XB_XGEN(j)  (2304 + 64 * (j))
#define XB_TOP      3328
#define XB_TOPGEN   3392
#define XCD_BAR_WORDS 3456
#define XB_SPIN_CAP (1u << 18)

__device__ __forceinline__ unsigned xb_ld(unsigned* p)              { return __hip_atomic_load(p, __ATOMIC_RELAXED, __HIP_MEMORY_SCOPE_AGENT); }
__device__ __forceinline__ unsigned xb_add(unsigned* p, unsigned v) { return __hip_atomic_fetch_add(p, v, __ATOMIC_RELAXED, __HIP_MEMORY_SCOPE_AGENT); }
__device__ __forceinline__ unsigned xb_xcc_id() { return (unsigned)__builtin_amdgcn_s_getreg((3 << 11) | 20) & 0xFu; }
#define XB_SPIN(cond, bar) do { unsigned _sp = 0; while (cond) { __builtin_amdgcn_s_sleep(1); \
    if ((++_sp & 255u) == 0u) { if (xb_ld(&(bar)[XB_TMO])) break; if (_sp > XB_SPIN_CAP) { atomicAdd(&(bar)[XB_TMO], 1u); break; } } } } while (0)

struct XcdBarrier {
    unsigned* bar; unsigned x; int wid;
    volatile LAS unsigned* st;
};

__device__ __forceinline__ bool xb_lane0() { return lane_opaque() == 0; }
__device__ __forceinline__ XcdBarrier xcd_barrier_post(unsigned* bar, volatile LAS unsigned* st, int wid) {
    XcdBarrier b; b.bar = bar; b.x = xb_xcc_id(); b.st = st; b.wid = wid;
    if (wid == 0 && xb_lane0()) (void)xb_add(&bar[XB_XCNT(b.x)], 1u);
    return b;
}
__device__ __forceinline__ void xcd_barrier_complete(unsigned* bar, unsigned x, unsigned& nloc, unsigned& nx) {
    const unsigned G = gridDim.x * gridDim.y * gridDim.z;
    unsigned sum, cnt, mine, sp = 0u;
    for (;;) {
        sum = 0u; cnt = 0u; mine = 0u;
#pragma unroll
        for (unsigned j = 0; j < 16; ++j) { const unsigned c = xb_ld(&bar[XB_XCNT(j)]); sum += c; cnt += (c > 0u) ? 1u : 0u; mine = (j == x) ? c : mine; }
        if (sum == G) break;
        __builtin_amdgcn_s_sleep(1);
        if ((++sp & 255u) == 0u) { if (xb_ld(&bar[XB_TMO])) break; if (sp > XB_SPIN_CAP) { atomicAdd(&bar[XB_TMO], 1u); break; } }
    }
    nloc = mine > 0u ? mine : 1u; nx = cnt > 0u ? cnt : 1u;
}

__device__ __forceinline__ void xcd_barrier(const XcdBarrier& b) {
    asm volatile("s_waitcnt vmcnt(0)" ::: "memory");
    __syncthreads();
    if (b.wid == 0 && xb_lane0()) {
        unsigned* bar = b.bar;
        __builtin_amdgcn_s_waitcnt(0);
        unsigned nloc = b.st[0], nx = b.st[1];
        if (nloc == 0u) { xcd_barrier_complete(bar, b.x, nloc, nx); b.st[0] = nloc; b.st[1] = nx; }
        const unsigned old = xb_add(&bar[XB_XSUB(b.x)], 1u);
        const unsigned gen = old / nloc;
        if (old + 1u == (gen + 1u) * nloc) {
            __builtin_amdgcn_fence(__ATOMIC_RELEASE, "agent");
            asm volatile("s_waitcnt vmcnt(0)" ::: "memory");
            const unsigned og = xb_add(&bar[XB_TOP], 1u);
            const unsigned tg = og / nx;
            if (og + 1u == (tg + 1u) * nx) xb_add(&bar[XB_TOPGEN], 1u);
            else XB_SPIN(xb_ld(&bar[XB_TOPGEN]) == tg, bar);
            __builtin_amdgcn_fence(__ATOMIC_ACQUIRE, "agent");
            xb_add(&bar[XB_XGEN(b.x)], 1u);
            asm volatile("s_waitcnt vmcnt(0)" ::: "memory");
        } else {
            XB_SPIN(xb_ld(&bar[XB_XGEN(b.x)]) == gen, bar);
            __builtin_amdgcn_fence(__ATOMIC_ACQUIRE, "agent");
            asm volatile("s_waitcnt vmcnt(0)" ::: "memory");
        }
    }
    __syncthreads();
}

struct Args {
    const float* in[20]; float* out; unsigned char* ws;
    float invA[16]; float invB[8];
};

__global__ void __launch_bounds__(NWAVES * 64) hybrid_fwd(Args args) {
    extern __shared__ __attribute__((aligned(16))) unsigned char lds_raw[];
    cg::grid_group grid = cg::this_grid();
    LAS unsigned char* lds = (LAS unsigned char*)lds_raw;
    const int wid = __builtin_amdgcn_readfirstlane((int)threadIdx.x >> 6);
#define fresh_lane() lane_opaque()
    const int lane = fresh_lane(), tid = wid * 64 + lane;
    const int G = gridDim.x, bx = blockIdx.x;
    unsigned char* ws = args.ws;
    volatile LAS unsigned* MISC = (volatile LAS unsigned*)(lds + LDS_BYTES - 64);
    if (tid < 16) MISC[tid] = 0u;
    __syncthreads();
    const XcdBarrier bar = xcd_barrier_post((unsigned*)(ws + OFF_BAR), MISC + 8, wid);
    if (G == 0x7fffffff) grid.sync();
    const float* x = args.in[0];
    float* out = args.out;
    float* rowss1 = (float*)(ws + OFF_RS1); float* rowss2 = (float*)(ws + OFF_RS2);
    float* gtab = (float*)(ws + OFF_GTAB); float* ropeA = (float*)(ws + OFF_ROPEA); float* ropeB = (float*)(ws + OFF_ROPEB);
    bf16* W1A = (bf16*)(ws + WS_W1A); bf16* W1B = (bf16*)(ws + WS_W1B); bf16* WIN = (bf16*)(ws + WS_WIN); bf16* WOUT = (bf16*)(ws + WS_WOUT);
    bf16* W2A = (bf16*)(ws + WS_W2A); bf16* W2B = (bf16*)(ws + WS_W2B);
    bf16* XN = (bf16*)(ws + WS_XN); bf16* ACT = (bf16*)(ws + WS_ACT); bf16* QKV = (bf16*)(ws + WS_ACT); bf16* MIX = (bf16*)(ws + WS_MIX);

#ifndef REP_P0
#define REP_P0 1
#endif
#ifndef REP_DIFF
#define REP_DIFF 1
#endif
#ifndef REP_DIL
#define REP_DIL 1
#endif
#define REP_G1 1
#define REP_SHADOW 1
#define REP_G2 1
#define REP_G3 1
#define REP_G5 1
#define REP_G6 1
#define REP_G7 1
    for (int rep = 0; rep < REP_P0; ++rep) {
        LAS float* scr = (LAS float*)(lds + wid * 16384);
        const int gw = bx * NWAVES + wid, NGW = G * NWAVES;
        constexpr int I_FA = (DM / 64) * (2 * DFF / 32), I_FB = (DFF / 64) * (DM / 32), I_IN = (DM / 64) * (INW / 32), I_OUT = (DM / 64) * (DM / 32);
        tr_matrix<true, 2>(args.in[2], DM, 2 * DFF, W1A, LDK, scr, gw, NGW, lane, args.in[1]);
        tr_matrix<true, 2>(args.in[18], DM, 2 * DFF, W2A, LDK, scr, gw, NGW, lane, args.in[17]);
        float* rowss0 = (float*)(ws + OFF_RS0);
        for (int m = gw; m < MROWS; m += NGW) {
            const f32x4* xr = (const f32x4*)(x + (size_t)m * DM) + lane; f32x4 v[8]; float s = 0.f;
#pragma unroll
            for (int j = 0; j < 8; ++j) { v[j] = __builtin_nontemporal_load(xr + 64 * j); s += (v[j][0] * v[j][0] + v[j][1] * v[j][1]) + (v[j][2] * v[j][2] + v[j][3] * v[j][3]); }
            s = wave_sum(s, lane); if (lane == 0) rowss0[m] = s;
            v2u* o8 = (v2u*)(XN + (size_t)m * LDK) + lane;
#pragma unroll
            for (int j = 0; j < 8; ++j) { v2u w; w.x = pk2(v[j][0], v[j][1]); w.y = pk2(v[j][2], v[j][3]); o8[64 * j] = w; }
        }
        const int gt = bx * (NWAVES * 64) + tid, NGT = G * NWAVES * 64;
        for (int i = gt; i < 2 * MROWS; i += NGT) rowss1[i] = 0.f;
        if (gt < 512) { const int t = gt >> 7, d = gt & 127; gtab[gt] = t == 0 ? args.in[6][d] : (t == 1 ? args.in[7][d] : (t == 2 ? args.in[8][d & 63] : args.in[9][d & 63])); }
        for (int i = gt; i < 4096 * 24; i += NGT) {
            const int s = i / 24, k = i % 24; const float inv = k < 16 ? args.invA[k] : args.invB[k - 16];
            const float ang = (float)s * inv; double rev = (double)ang * 0.15915494309189535; rev -= floor(rev);
            const float cs = __builtin_amdgcn_cosf((float)rev), sn = __builtin_amdgcn_sinf((float)rev);
            if (k < 16) { ropeA[s * 16 + k] = cs; ropeA[4096 * 16 + s * 16 + k] = sn; } else { ropeB[s * 8 + k - 16] = cs; ropeB[4096 * 8 + s * 8 + k - 16] = sn; }
        }
    }
    xcd_barrier(bar);

    { pg8::Gemm g{XN, W1A, MROWS, 2 * DFF, DM, LDK}; pg8::StaticOrder S; S.init(MROWS, 2 * DFF, G, bx);
      pg8::EpiSwiGLU E{ACT, DFF, (const float*)(ws + OFF_RS0)};
      pg8::gemm_phase<pg8::EpiSwiGLU, pg8::StaticOrder, true, true>(lds, g, S, E, wid); }
    {
        constexpr int NU = (MROWS / 256) * (2 * DFF / 256);
        const int rounds = (NU + G - 1) / G; int first_idle = NU - (rounds - 1) * G, nidle = G - first_idle;
        if (nidle <= 0) { first_idle = 0; nidle = G; }
        if (bx >= first_idle) {
            LAS float* scr = (LAS float*)(lds + wid * 16384); const int lane_c = fresh_lane();
            const int gw = (bx - first_idle) * NWAVES + wid, NGW = nidle * NWAVES;
            for (int rep = 0; rep < REP_SHADOW; ++rep) {
            tr_matrix<false, 2>(args.in[3], DFF, DM, W1B, DFF, scr, gw, NGW, lane_c, nullptr);
            tr_matrix<false, 2>(args.in[5], DM, INW, WIN, LDK, scr, gw, NGW, lane_c, args.in[4]);
            tr_matrix<false, 2>(args.in[16], DM, DM, WOUT, LDK, scr, gw, NGW, lane_c, nullptr);
            }
        }
    }
    xcd_barrier(bar);
    { pg8::Gemm g{ACT, W1B, MROWS, DM, DFF, DFF}; pg8::StaticOrder S; S.init(MROWS, DM, G, bx);
      pg8::EpiResid<false, true, false> E{nullptr, nullptr, XN, rowss1, 0.5f};
      pg8::gemm_phase<pg8::EpiResid<false, true, false>, pg8::StaticOrder, true, true>(lds, g, S, E, wid); }
    xcd_barrier(bar);
    { pg8::Gemm g{XN, WIN, MROWS, INW, DM, LDK}; pg8::StaticOrder S; S.init(MROWS, INW, G, bx);
      pg8::EpiQKV E{QKV, rowss1, gtab, ropeA, ropeB, (LAS float*)(lds + XCH_OFF)};
      for (int rep = 0; rep < REP_G3; ++rep)
      pg8::gemm_phase<pg8::EpiQKV, pg8::StaticOrder, true, true>(lds, g, S, E, wid); }
    xcd_barrier(bar);
    {
        const float L2E = 1.4426950408889634f;
        const int lane_a = fresh_lane();
        const float gq = fmaxf(fabsf(args.in[6][lane_a]), fabsf(args.in[6][lane_a + 64])), gk = fmaxf(fabsf(args.in[7][lane_a]), fabsf(args.in[7][lane_a + 64]));
        const float negMA = __builtin_bit_cast(float, __builtin_amdgcn_readfirstlane(__builtin_bit_cast(int, -1.02f * 11.313708498984761f * wave_max(gq, lane_a) * wave_max(gk, lane_a) * L2E)));
        const float negMB = __builtin_bit_cast(float, __builtin_amdgcn_readfirstlane(__builtin_bit_cast(int, -1.02f * 8.0f * wave_max(fabsf(args.in[8][lane_a]), lane_a) * wave_max(fabsf(args.in[9][lane_a]), lane_a) * L2E)));
        const float lam = __builtin_bit_cast(float, __builtin_amdgcn_readfirstlane(__builtin_bit_cast(int, __expf(wave_sum(args.in[10][lane_a] * args.in[11][lane_a], lane_a)) - __expf(wave_sum(args.in[12][lane_a] * args.in[13][lane_a], lane_a)) + 0.2f)));
        float* Opart = (float*)(ws + WS_OPART); float* Lpart = (float*)(ws + WS_LPART);
        {
            const int lane_d = fresh_lane();
            for (int wu = bx * NWAVES + wid; wu < 2048; wu += G * NWAVES) {
                int ib = wu & 7, r16 = (wu >> 3) & 15, h = (wu >> 7) & 7, b = wu >> 10;
                if (G == 256) { const int hb = (bx & 7) * 2 + (bx >> 7); r16 = (bx >> 3) & 15; h = hb & 7; b = hb >> 3; }
                att::dil_unit<0>((LAS char*)lds + wid * att::DIL_WAVE, QKV, MIX, Opart, Lpart, b, h, r16, ib, negMA, args.in[14], lane_d);
            }
        }
        xcd_barrier(bar);
        {
            const int tid_a = wid * 64 + fresh_lane();
            for (int rep = 0; rep < REP_DIFF; ++rep)
            for (int u = bx; u < 512; u += G) {
                int bh = u >> 5, qblk = u & 31;
                if (G == 256) { bh = (bx & 7) + 8 * (u >> 8); qblk = bx >> 3; }
                att::diff_unit((LAS char*)lds, QKV, MIX, bh >> 3, bh & 7, qblk, lam, negMB, args.in[15], tid_a, wid, tid_a & 63);
            }
        }
        {
            const int lane_d = fresh_lane();
            for (int rep = 0; rep < REP_DIL; ++rep)
            for (int wu = bx * NWAVES + wid; wu < 2048; wu += G * NWAVES) {
                int ib = wu & 7, r16 = (wu >> 3) & 15, h = (wu >> 7) & 7, b = wu >> 10;
                if (G == 256) { const int hb = (bx & 7) * 2 + (bx >> 7); r16 = (bx >> 3) & 15; h = hb & 7; b = hb >> 3; }
                att::dil_unit<1>((LAS char*)lds + wid * att::DIL_WAVE, QKV, MIX, Opart, Lpart, b, h, r16, ib, negMA, args.in[14], lane_d);
            }
        }
    }
    xcd_barrier(bar);
    { pg8::Gemm g{MIX, WOUT, MROWS, DM, DM, LDK}; pg8::StaticOrder S; S.init(MROWS, DM, G, bx);
      pg8::EpiResid<false, true, false> E{nullptr, nullptr, XN, rowss2, 1.0f};
      pg8::gemm_phase<pg8::EpiResid<false, true, false>, pg8::StaticOrder, true, true>(lds, g, S, E, wid); }
    xcd_barrier(bar);
    { pg8::Gemm g{XN, W2A, MROWS, 2 * DFF, DM, LDK}; pg8::StaticOrder S; S.init(MROWS, 2 * DFF, G, bx);
      pg8::EpiSwiGLU E{ACT, DFF, rowss2};
      for (int rep = 0; rep < REP_G6; ++rep)
      pg8::gemm_phase<pg8::EpiSwiGLU, pg8::StaticOrder, true, true>(lds, g, S, E, wid); }
    {
        constexpr int NU = (MROWS / 256) * (2 * DFF / 256);
        const int rounds = (NU + G - 1) / G; int first_idle = NU - (rounds - 1) * G, nidle = G - first_idle;
        if (nidle <= 0) { first_idle = 0; nidle = G; }
        if (bx >= first_idle) tr_matrix<false, 2>(args.in[19], DFF, DM, W2B, DFF, (LAS float*)(lds + wid * 16384), (bx - first_idle) * NWAVES + wid, nidle * NWAVES, fresh_lane(), nullptr);
    }
    xcd_barrier(bar);
    { pg8::Gemm g{ACT, W2B, MROWS, DM, DFF, DFF}; pg8::StaticOrder S; S.init(MROWS, DM, G, bx);
      pg8::EpiResid<false, false, true> E{nullptr, out, XN, nullptr, 0.5f};
      pg8::gemm_phase<pg8::EpiResid<false, false, true>, pg8::StaticOrder, true, true>(lds, g, S, E, wid); }
}

extern "C" void kernel_launch(void* const* d_in, const int* in_sizes, int n_in, void* d_out, int out_size, void* d_ws, size_t ws_size, hipStream_t stream) {
    static int grid = 0;
    if (grid == 0) {
        if (n_in != 20 || in_sizes[0] != MROWS * DM || out_size != MROWS * DM || ws_size < WS_END) {
            fprintf(stderr, "kernel_launch: unexpected shapes (n_in %d, in0 %d, out %d, ws %zu < %zu)\n", n_in, n_in > 0 ? in_sizes[0] : -1, out_size, ws_size, (size_t)WS_END); grid = -1; return; }
        int dev = 0, cus = 0, per_cu = 0;
        (void)hipGetDevice(&dev); (void)hipDeviceGetAttribute(&cus, hipDeviceAttributeMultiprocessorCount, dev);
        if (hipFuncSetAttribute((const void*)hybrid_fwd, hipFuncAttributeMaxDynamicSharedMemorySize, LDS_BYTES) != hipSuccess) { fprintf(stderr, "kernel_launch: hipFuncSetAttribute failed\n"); grid = -1; return; }
        if (hipOccupancyMaxActiveBlocksPerMultiprocessor(&per_cu, (const void*)hybrid_fwd, NWAVES * 64, LDS_BYTES) != hipSuccess || per_cu < 1) { fprintf(stderr, "kernel_launch: occupancy query says %d\n", per_cu); per_cu = 1; }
        (void)hipGetLastError();
        grid = cus * per_cu;
    }
    if (grid < 0) return;
    Args a{};
    for (int i = 0; i < 20; ++i) a.in[i] = (const float*)d_in[i];
    a.out = (float*)d_out; a.ws = (unsigned char*)d_ws;
    for (int i = 0; i < 16; ++i) a.invA[i] = (float)pow(500000.0, -(double)i / 16.0);
    for (int i = 0; i < 8; ++i) a.invB[i] = (float)pow(500000.0, -(double)i / 8.0);
    if (hipMemsetAsync((char*)d_ws + OFF_BAR, 0, BAR_BYTES, stream) != hipSuccess) { fprintf(stderr, "kernel_launch: memset failed\n"); return; }
    void* kargs[] = {&a};
    hipError_t e = hipLaunchCooperativeKernel((const void*)hybrid_fwd, dim3(grid), dim3(NWAVES * 64), kargs, LDS_BYTES, stream);
    if (e != hipSuccess) fprintf(stderr, "kernel_launch: cooperative launch failed: %s (grid %d)\n", hipGetErrorString(e), grid);
}
```

```cpp
#include <hip/hip_runtime.h>
#include <hip/hip_cooperative_groups.h>
#include <cstdio>
#include <cstdint>
#include <cmath>
namespace cg = cooperative_groups;
__device__ __forceinline__ int lane_opaque() { unsigned z = 0u; asm volatile("" : "+v"(z)); return (int)__builtin_amdgcn_mbcnt_hi(~0u, __builtin_amdgcn_mbcnt_lo(~0u, z)); }
__device__ __forceinline__ float shflx(float v, int mask, int lane) { return __builtin_bit_cast(float, __builtin_amdgcn_ds_bpermute((lane ^ mask) << 2, __builtin_bit_cast(int, v))); }
namespace pg8 {
#define PG8_LAS __attribute__((address_space(3)))
typedef unsigned short bf16_t;
typedef short bf16x8 __attribute__((ext_vector_type(8)));
typedef float f32x4 __attribute__((ext_vector_type(4)));
typedef unsigned u32x4 __attribute__((ext_vector_type(4)));
constexpr int BM = 256, BK = 64, HALF = 128, HTB = HALF * BK * 2  , STAGE_BYTES = 8 * HTB, NXCD = 8, WGM = 8;

__host__ __device__ __forceinline__ int lds_byte(int r, int c) { const int st = (r >> 4) * 2 + (c >> 5), rr = r & 15, cc = c & 31, ob = rr * 64 + cc * 2; return st * 1024 + (ob ^ (((ob >> 9) & 1) << 5)); }
__host__ __device__ __forceinline__ void stage_rc(int b, int& R, int& C) { const int st = b / 1024, sb = b % 1024, swz = sb ^ (((sb >> 9) & 1) << 5); R = (st >> 1) * 16 + swz / 64; C = (st & 1) * 32 + (swz % 64) / 2; }
__host__ __device__ __forceinline__ int perm32(int rho) { const int n = rho >> 4, i = rho & 15; return 8 * (i >> 2) + 4 * n + (i & 3); }

struct Unit { int pm, pn; };
struct Gemm { const bf16_t* A; const bf16_t* Bt; int M, N, K, ld; };

struct StaticOrder {
    int nM, nN, nwg, G, c;
    __host__ __device__ void init(int M, int N, int G_, int c_) { nM = M / BM; nN = N / BM; nwg = nM * nN; G = G_; c = c_; }
    __host__ __device__ bool next(int i, Unit& u) const {
        const long L = (long)i * G + c; if (L >= nwg) return false;
        int wgid = (int)L; { const int q = nwg / NXCD, r = nwg % NXCD, xcd = wgid % NXCD, off = wgid / NXCD; wgid = (xcd < r ? xcd * (q + 1) : r * (q + 1) + (xcd - r) * q) + off; }
        const int nig = WGM * nN, gid = wgid / nig, fm = gid * WGM, gsz = (nM - fm) < WGM ? (nM - fm) : WGM;
        u.pm = fm + ((wgid % nig) % gsz); u.pn = (wgid % nig) / gsz; return true;
    }
    __device__ __forceinline__ void a_ready(const Unit&) const {}
    __device__ __forceinline__ void done(const Unit&) const {}
};

__device__ __forceinline__ unsigned cvt_pk_bf16(float lo, float hi) { unsigned r; asm volatile("v_cvt_pk_bf16_f32 %0, %1, %2" : "=v"(r) : "v"(lo), "v"(hi)); return r; }
typedef float f32x2 __attribute__((ext_vector_type(2)));

typedef unsigned u32x2 __attribute__((ext_vector_type(2)));
constexpr int LDK = 2048, LDQ = 6144;
__device__ __forceinline__ float fast_silu(float g) { return g * __builtin_amdgcn_rcpf(1.0f + __expf(-g)); }

struct EpiSwiGLU {
    static constexpr bool PERM = true, AFTER_DRAIN = false;
    bf16_t* O; int ldc; const float* rowss;
    __device__ __forceinline__ void operator()(f32x4 (&acc)[2][2][4][2], const Unit& u, int wr, int wc, int fr, int fq) const {
        const int row0 = u.pm * BM + wr * 64 + fr; const int col0 = u.pn * HALF + wc * 32 + 8 * fq;
        float rsv[2][4];
#pragma unroll
        for (int ai = 0; ai < 2; ++ai)
#pragma unroll
            for (int m = 0; m < 4; ++m) rsv[ai][m] = rowss ? rowss[row0 + ai * HALF + m * 16] : 0.f;
#pragma unroll
        for (int ai = 0; ai < 2; ++ai)
#pragma unroll
            for (int m = 0; m < 4; ++m) rsv[ai][m] = rowss ? __builtin_amdgcn_rsqf(rsv[ai][m] * (1.0f / 2048.0f) + 1e-6f) : 1.0f;
        asm volatile("" : "+v"(rsv[0][0]), "+v"(rsv[0][1]), "+v"(rsv[0][2]), "+v"(rsv[0][3]), "+v"(rsv[1][0]), "+v"(rsv[1][1]), "+v"(rsv[1][2]), "+v"(rsv[1][3]));
#pragma unroll
        for (int ai = 0; ai < 2; ++ai)
#pragma unroll
            for (int m = 0; m < 4; ++m) {
                const int row = row0 + ai * HALF + m * 16;
                const float rs = rsv[ai][m];
                f32x4 g0 = acc[ai][0][m][0] * rs, g1 = acc[ai][0][m][1] * rs, u0 = acc[ai][1][m][0] * rs, u1 = acc[ai][1][m][1] * rs;
                u32x4 w;
                w.x = cvt_pk_bf16(fast_silu(g0[0]) * u0[0], fast_silu(g0[1]) * u0[1]); w.y = cvt_pk_bf16(fast_silu(g0[2]) * u0[2], fast_silu(g0[3]) * u0[3]);
                w.z = cvt_pk_bf16(fast_silu(g1[0]) * u1[0], fast_silu(g1[1]) * u1[1]); w.w = cvt_pk_bf16(fast_silu(g1[2]) * u1[2], fast_silu(g1[3]) * u1[3]);
                *(u32x4*)(O + (size_t)row * ldc + col0) = w;
            }
    }
};

template <bool BASE_F32, bool WRITE_XN, bool WRITE_OUT> struct EpiResid {
    static constexpr bool PERM = false, AFTER_DRAIN = false;
    const float* base; float* out; bf16_t* xn; float* rowss; float alpha;
    __device__ __forceinline__ void operator()(f32x4 (&acc)[2][2][4][2], const Unit& u, int wr, int wc, int fr, int fq) const {
        const int row0 = u.pm * BM + wr * 64 + fr; const int col0 = u.pn * BM + wc * 32 + 4 * fq;
#pragma unroll
        for (int ai = 0; ai < 2; ++ai) {
            f32x4 bpre[4][2][2];
#pragma unroll
            for (int m = 0; m < 4; ++m) { const int row = row0 + ai * HALF + m * 16;
#pragma unroll
                for (int bj = 0; bj < 2; ++bj)
#pragma unroll
                    for (int n = 0; n < 2; ++n) {
                        if (BASE_F32) bpre[m][bj][n] = *(const f32x4*)(base + (size_t)row * 2048 + col0 + bj * HALF + n * 16);
                        else { const u32x2 w = *(const u32x2*)(xn + (size_t)row * LDK + col0 + bj * HALF + n * 16);
                               bpre[m][bj][n] = (f32x4){__builtin_bit_cast(float, w.x << 16), __builtin_bit_cast(float, w.x & 0xffff0000u), __builtin_bit_cast(float, w.y << 16), __builtin_bit_cast(float, w.y & 0xffff0000u)}; }
                    } }
#pragma unroll
            for (int m = 0; m < 4; ++m) {
                const int row = row0 + ai * HALF + m * 16; float ss = 0.f;
#pragma unroll
                for (int bj = 0; bj < 2; ++bj)
#pragma unroll
                    for (int n = 0; n < 2; ++n) {
                        const f32x4 o = bpre[m][bj][n] + acc[ai][bj][m][n] * alpha;
                        if (WRITE_OUT) __builtin_nontemporal_store(o, (f32x4*)(out + (size_t)row * 2048 + col0 + bj * HALF + n * 16));
                        if (WRITE_XN) {
                            ss += (o[0] * o[0] + o[1] * o[1]) + (o[2] * o[2] + o[3] * o[3]);
                            u32x2 w; w.x = cvt_pk_bf16(o[0], o[1]); w.y = cvt_pk_bf16(o[2], o[3]);
                            *(u32x2*)(xn + (size_t)row * LDK + col0 + bj * HALF + n * 16) = w;
                        }
                    }
                if (WRITE_XN) { ss += shflx(ss, 16, fq * 16 + fr); ss += shflx(ss, 32, fq * 16 + fr); if (fq == 0) atomicAdd(rowss + row, ss); }
            }
            asm volatile("" ::: "memory");
        }
    }
};

struct EpiQKV {
    static constexpr bool PERM = false, AFTER_DRAIN = false;
    bf16_t* O; const float* rowss; const float* gtab;
    const float* ropeA; const float* ropeB;
    PG8_LAS float* xch;
    __device__ __forceinline__ void operator()(f32x4 (&acc)[2][2][4][2], const Unit& u, int wr, int wc, int, int) const {
        const int lane_q = lane_opaque(), fr = lane_q & 15, fq = lane_q >> 4;
        const int region = u.pn >> 2;
        const int row0 = u.pm * BM + wr * 64 + fr;
#pragma unroll
        for (int ai = 0; ai < 2; ++ai)
#pragma unroll
            for (int m = 0; m < 4; ++m) {
                const float rs = __builtin_amdgcn_rsqf(rowss[row0 + ai * HALF + m * 16] * (1.0f / 2048.0f) + 1e-6f);
#pragma unroll
                for (int bj = 0; bj < 2; ++bj)
#pragma unroll
                    for (int n = 0; n < 2; ++n) acc[ai][bj][m][n] = acc[ai][bj][m][n] * rs;
            }
        const bool isv = (region == 2) || (region == 5);
        if (!isv) {
            const bool isA = region < 2;
            const bool do_rope = isA ? (wc == 0) : ((wc & 1) == 0);
#pragma unroll
            for (int ai = 0; ai < 2; ++ai)
#pragma unroll
                for (int m = 0; m < 4; ++m)
#pragma unroll
                    for (int bj = 0; bj < 2; ++bj) {
                        const f32x4 a = acc[ai][bj][m][0], b = acc[ai][bj][m][1];
                        float s = ((a[0] * a[0] + a[1] * a[1]) + (a[2] * a[2] + a[3] * a[3])) + ((b[0] * b[0] + b[1] * b[1]) + (b[2] * b[2] + b[3] * b[3]));
                        s += shflx(s, 16, fq * 16 + fr); s += shflx(s, 32, fq * 16 + fr);
                        if (fq == 0) xch[((ai * HALF + wr * 64 + m * 16 + fr) * 2 + bj) * 4 + wc] = s;
                    }
            asm volatile("s_waitcnt lgkmcnt(0)" ::: "memory"); __builtin_amdgcn_s_barrier(); asm volatile("" ::: "memory");
            const float* gptr = gtab + (region < 2 ? region : region - 1) * 128;
            const int dbase = isA ? wc * 32 : (wc & 1) * 32;
            f32x4 gv[2]; gv[0] = *(const f32x4*)(gptr + dbase + 4 * fq); gv[1] = *(const f32x4*)(gptr + dbase + 16 + 4 * fq);
            const float qs = region == 0 ? (0.08838834764831845f * 1.4426950408889634f) : (region == 3 ? (0.125f * 1.4426950408889634f) : 1.0f);
#pragma unroll
            for (int ai = 0; ai < 2; ++ai) {
                f32x4 csv[4], snv[4];
                if (do_rope) {
#pragma unroll
                    for (int m = 0; m < 4; ++m) { const int spos = (u.pm * BM + ai * HALF + wr * 64 + m * 16 + fr) & 4095;
                        const float* rp = isA ? ropeA + spos * 16 + 4 * fq : ropeB + spos * 8 + 4 * (fq & 1);
                        csv[m] = *(const f32x4*)rp; snv[m] = *(const f32x4*)(rp + (isA ? 4096 * 16 : 4096 * 8)); }
                }
#pragma unroll
                for (int m = 0; m < 4; ++m) {
                    const int rl = ai * HALF + wr * 64 + m * 16 + fr;
#pragma unroll
                    for (int bj = 0; bj < 2; ++bj) {
                        const f32x4 p = *(const PG8_LAS f32x4*)(xch + (rl * 2 + bj) * 4);
                        float rn;
                        if (isA) rn = __builtin_amdgcn_rsqf(((p[0] + p[1]) + (p[2] + p[3])) * (1.0f / 128.0f) + 1e-6f);
                        else rn = __builtin_amdgcn_rsqf(((wc < 2) ? (p[0] + p[1]) : (p[2] + p[3])) * (1.0f / 64.0f) + 1e-6f);
                        f32x4 v0 = acc[ai][bj][m][0] * rn * gv[0], v1 = acc[ai][bj][m][1] * rn * gv[1];
                        if (isA) {
                            if (do_rope) {
                                const f32x4 cs = csv[m], sn = snv[m];
                                const f32x4 x1 = v0, x2 = v1; v0 = x1 * cs - x2 * sn; v1 = x2 * cs + x1 * sn;
                            }
                        } else {
                            if (do_rope) {
                                const f32x4 cs = csv[m], sn = snv[m];
                                f32x4 pt; pt[0] = shflx(v0[0], 32, fq * 16 + fr); pt[1] = shflx(v0[1], 32, fq * 16 + fr); pt[2] = shflx(v0[2], 32, fq * 16 + fr); pt[3] = shflx(v0[3], 32, fq * 16 + fr);
                                v0 = (fq < 2) ? (v0 * cs - pt * sn) : (v0 * cs + pt * sn);
                            }
                        }
                        acc[ai][bj][m][0] = v0 * qs; acc[ai][bj][m][1] = v1 * qs;
                    }
                }
                asm volatile("" ::: "memory");
            }
        }
        const int col0 = u.pn * BM + wc * 32 + 4 * fq;
#pragma unroll
        for (int ai = 0; ai < 2; ++ai)
#pragma unroll
            for (int m = 0; m < 4; ++m) { bf16_t* rowp = O + (size_t)(row0 + ai * HALF + m * 16) * LDQ + col0;
#pragma unroll
                for (int bj = 0; bj < 2; ++bj)
#pragma unroll
                    for (int n = 0; n < 2; ++n) { const f32x4 v = acc[ai][bj][m][n]; u32x2 w; w.x = cvt_pk_bf16(v[0], v[1]); w.y = cvt_pk_bf16(v[2], v[3]); *(u32x2*)(rowp + bj * HALF + n * 16) = w; } }
    }
};
template <class Epi, class Sched, bool ALIGN_EPI = false, bool SP2 = false>
__device__ __forceinline__ void gemm_phase(PG8_LAS unsigned char* lds, const Gemm g, const Sched& S, const Epi& E, const int wid_s) {
    const int lane_ = lane_opaque();
    const int tid = wid_s * 64 + lane_, wid = wid_s, lane = tid & 63, wr = wid >> 2, wc = wid & 3, fr = lane & 15, fq = lane >> 4;
    const int K = g.ld, nt = g.K / BK;
    unsigned voffA[2], voffB[2];
#pragma unroll
    for (int i = 0; i < 2; ++i) { int R, C; stage_rc(tid * 16 + i * 8192, R, C); const int Rb = Epi::PERM ? ((R & ~31) + perm32(R & 31)) : R;
        voffA[i] = (unsigned)(R * K + C) * 2u; voffB[i] = (unsigned)(Rb * K + C) * 2u; }
    const size_t kstep = (size_t)(BK * 2);
    const size_t hstep = (size_t)HALF * K * 2;
    const size_t tstep = 2 * hstep;
    const unsigned ldsw = (unsigned)wid * 1024u;
    const int aoff = lds_byte(wr * 64 + fr, fq * 8), boff = lds_byte(wc * 32 + fr, fq * 8);
#define PG8_SA(b, h) (((b) * 2 + (h)) * HTB)
#define PG8_SB(b, h) ((4 + (b) * 2 + (h)) * HTB)
#define PG8_STAGE(bufoff, gbase, voff) do { _Pragma("unroll") for (int _i = 0; _i < 2; ++_i) \
        __builtin_amdgcn_global_load_lds((const unsigned*)((const char*)(gbase) + (voff)[_i]), (PG8_LAS unsigned*)(lds + (bufoff) + ldsw + _i * 8192), 16, 0, 0); } while (0)
#define PG8_LDA(dst, b, h) do { _Pragma("unroll") for (int m = 0; m < 4; ++m) _Pragma("unroll") for (int k = 0; k < 2; ++k) dst[m][k] = *(const PG8_LAS bf16x8*)(lds + PG8_SA(b, h) + aoff + m * 2048 + k * 1024); } while (0)
#define PG8_LDB(dst, b, h) do { _Pragma("unroll") for (int n = 0; n < 2; ++n) _Pragma("unroll") for (int k = 0; k < 2; ++k) dst[n][k] = *(const PG8_LAS bf16x8*)(lds + PG8_SB(b, h) + boff + n * 2048 + k * 1024); } while (0)
#define PG8_MMA(ai, bj, At, Bt) do { __builtin_amdgcn_s_setprio(1); _Pragma("unroll") for (int m = 0; m < 4; ++m) _Pragma("unroll") for (int n = 0; n < 2; ++n) _Pragma("unroll") for (int k = 0; k < 2; ++k) \
        acc[ai][bj][m][n] = __builtin_amdgcn_mfma_f32_16x16x32_bf16(Bt[n][k], At[m][k], acc[ai][bj][m][n], 0, 0, 0); __builtin_amdgcn_s_setprio(0); } while (0)
#define PG8_WAIT_V(n) asm volatile("s_waitcnt vmcnt(" #n ")" ::: "memory")
#define PG8_WAIT_L(n) asm volatile("s_waitcnt lgkmcnt(" #n ")" ::: "memory")
#define PG8_BAR __builtin_amdgcn_s_barrier()
#define PG8_SCHED __builtin_amdgcn_sched_barrier(0)
    Unit cur, nxt; int ui = 0;
    if (!S.next(0, cur)) return;
    f32x4 acc[2][2][4][2];
#pragma unroll
    for (int a = 0; a < 2; ++a)
#pragma unroll
        for (int b = 0; b < 2; ++b)
#pragma unroll
            for (int m = 0; m < 4; ++m)
#pragma unroll
                for (int n = 0; n < 2; ++n) acc[a][b][m][n] = (f32x4){0.f, 0.f, 0.f, 0.f};
    bf16x8 At[4][2], B0[2][2], B1[2][2];
    const char* cA = (const char*)g.A + (size_t)cur.pm * tstep; const char* cB = (const char*)g.Bt + (size_t)cur.pn * tstep;
    S.a_ready(cur);
    if constexpr (SP2) {
        PG8_STAGE(PG8_SB(0, 0), cB, voffB); PG8_STAGE(PG8_SB(0, 1), cB + hstep, voffB); PG8_STAGE(PG8_SA(0, 0), cA, voffA); PG8_STAGE(PG8_SA(0, 1), cA + hstep, voffA);
        if (wr == 1) PG8_BAR;
        PG8_WAIT_V(2); PG8_BAR;
        PG8_STAGE(PG8_SB(1, 0), cB + kstep, voffB); PG8_STAGE(PG8_SA(1, 0), cA + kstep, voffA); PG8_STAGE(PG8_SB(1, 1), cB + hstep + kstep, voffB);
        PG8_WAIT_V(6); PG8_BAR;
    } else {
        PG8_STAGE(PG8_SB(0, 0), cB, voffB); PG8_STAGE(PG8_SA(0, 0), cA, voffA); PG8_STAGE(PG8_SB(0, 1), cB + hstep, voffB); PG8_STAGE(PG8_SA(0, 1), cA + hstep, voffA);
        if (wr == 1) PG8_BAR;
        PG8_WAIT_V(4); PG8_BAR;
        PG8_STAGE(PG8_SB(1, 0), cB + kstep, voffB); PG8_STAGE(PG8_SA(1, 0), cA + kstep, voffA); PG8_STAGE(PG8_SB(1, 1), cB + hstep + kstep, voffB);
        PG8_WAIT_V(6); PG8_BAR;
    }
    for (;;) {
        const bool has_next = S.next(ui + 1, nxt);
        const char* nA = has_next ? (const char*)g.A + (size_t)nxt.pm * tstep : cA; const char* nB = has_next ? (const char*)g.Bt + (size_t)nxt.pn * tstep : cB;
        for (int t = 0; t < nt; t += 2) {
            const bool last = (t == nt - 2);
            const char* a1 = cA + (size_t)(t + 1) * kstep;
            const char* a2 = last ? nA : cA + (size_t)(t + 2) * kstep; const char* b2 = last ? nB : cB + (size_t)(t + 2) * kstep;
            const char* a3 = a2 + kstep; const char* b3 = b2 + kstep;
            if (last && has_next) S.a_ready(nxt);
            if constexpr (SP2) {
            PG8_LDB(B0, 0, 0); PG8_LDB(B1, 0, 1); PG8_SCHED; PG8_LDA(At, 0, 0); PG8_STAGE(PG8_SA(1, 1), a1 + hstep, voffA);
            PG8_WAIT_V(8); PG8_WAIT_L(0); PG8_BAR; PG8_MMA(0, 0, At, B0); PG8_MMA(0, 1, At, B1); PG8_BAR; PG8_SCHED;
            PG8_LDA(At, 0, 1); PG8_STAGE(PG8_SB(0, 0), b2, voffB); PG8_STAGE(PG8_SB(0, 1), b2 + hstep, voffB); PG8_STAGE(PG8_SA(0, 0), a2, voffA);
            PG8_WAIT_V(8); PG8_WAIT_L(0); PG8_BAR; PG8_MMA(1, 0, At, B0); PG8_MMA(1, 1, At, B1); PG8_BAR; PG8_SCHED;
            PG8_LDB(B0, 1, 0); PG8_LDB(B1, 1, 1); PG8_SCHED; PG8_LDA(At, 1, 0); PG8_STAGE(PG8_SA(0, 1), a2 + hstep, voffA);
            PG8_WAIT_V(8); PG8_WAIT_L(0); PG8_BAR; PG8_MMA(0, 0, At, B0); PG8_MMA(0, 1, At, B1); PG8_BAR; PG8_SCHED;
            PG8_LDA(At, 1, 1); PG8_STAGE(PG8_SB(1, 0), b3, voffB); PG8_STAGE(PG8_SB(1, 1), b3 + hstep, voffB); PG8_STAGE(PG8_SA(1, 0), a3, voffA);
            PG8_WAIT_V(8); PG8_WAIT_L(0); PG8_BAR; PG8_MMA(1, 0, At, B0); PG8_MMA(1, 1, At, B1); PG8_BAR; PG8_SCHED;
            } else {
            PG8_LDB(B0, 0, 0); PG8_SCHED; PG8_LDA(At, 0, 0); PG8_STAGE(PG8_SA(1, 1), a1 + hstep, voffA);
            PG8_WAIT_L(8); PG8_BAR; PG8_WAIT_L(0); PG8_MMA(0, 0, At, B0); PG8_BAR; PG8_SCHED;
            PG8_LDB(B1, 0, 1); PG8_STAGE(PG8_SB(0, 0), b2, voffB);
            PG8_BAR; PG8_WAIT_L(0); PG8_MMA(0, 1, At, B1); PG8_BAR;
            PG8_LDA(At, 0, 1); PG8_STAGE(PG8_SA(0, 0), a2, voffA);
            PG8_BAR; PG8_WAIT_L(0); PG8_MMA(1, 0, At, B0); PG8_BAR; PG8_SCHED;
            PG8_STAGE(PG8_SB(0, 1), b2 + hstep, voffB);
            PG8_WAIT_V(6); PG8_BAR; PG8_MMA(1, 1, At, B1); PG8_BAR;
            PG8_LDB(B0, 1, 0); PG8_SCHED; PG8_LDA(At, 1, 0); PG8_STAGE(PG8_SA(0, 1), a2 + hstep, voffA);
            PG8_WAIT_L(8); PG8_BAR; PG8_WAIT_L(0); PG8_MMA(0, 0, At, B0); PG8_BAR; PG8_SCHED;
            PG8_LDB(B1, 1, 1); PG8_STAGE(PG8_SB(1, 0), b3, voffB);
            PG8_BAR; PG8_WAIT_L(0); PG8_MMA(0, 1, At, B1); PG8_BAR;
            PG8_LDA(At, 1, 1); PG8_STAGE(PG8_SA(1, 0), a3, voffA);
            PG8_BAR; PG8_WAIT_L(0); PG8_MMA(1, 0, At, B0); PG8_BAR; PG8_SCHED;
            PG8_STAGE(PG8_SB(1, 1), b3 + hstep, voffB);
            PG8_WAIT_V(6); PG8_BAR; PG8_MMA(1, 1, At, B1); PG8_BAR;
            }
        }
        if constexpr (ALIGN_EPI) { if (wr == 0) PG8_BAR; }
        if constexpr (!Epi::AFTER_DRAIN) { E(acc, cur, wr, wc, fr, fq); S.done(cur); }
        if (!has_next) break;
#pragma unroll
        for (int a = 0; a < 2; ++a)
#pragma unroll
            for (int b = 0; b < 2; ++b)
#pragma unroll
                for (int m = 0; m < 4; ++m)
#pragma unroll
                    for (int n = 0; n < 2; ++n) acc[a][b][m][n] = (f32x4){0.f, 0.f, 0.f, 0.f};
        cur = nxt; cA = nA; cB = nB; ++ui;
        if constexpr (ALIGN_EPI) { if (wr == 1) PG8_BAR; }
    }
    PG8_WAIT_V(0);
    if constexpr (!ALIGN_EPI) { if (wr == 0) PG8_BAR; }
    PG8_BAR;
    if constexpr (Epi::AFTER_DRAIN) { E.fused(acc, cur, wr, wc, fr, fq, lds, wid, lane); S.done(cur); }
#undef PG8_SA
#undef PG8_SB
#undef PG8_STAGE
#undef PG8_LDA
#undef PG8_LDB
#undef PG8_MMA
#undef PG8_WAIT_V
#undef PG8_WAIT_L
#undef PG8_BAR
#undef PG8_SCHED
}
}

namespace att {
#define LAS __attribute__((address_space(3)))
typedef unsigned short bf16_t;
typedef short bf16x8 __attribute__((ext_vector_type(8)));
typedef short s16x4 __attribute__((ext_vector_type(4)));
typedef short v4i16_t __attribute__((ext_vector_type(4)));
typedef float f32x16 __attribute__((ext_vector_type(16)));
typedef float f32x4 __attribute__((ext_vector_type(4)));
typedef unsigned u32x4 __attribute__((ext_vector_type(4)));
typedef unsigned u32x2 __attribute__((ext_vector_type(2)));
typedef float f32x2_t __attribute__((ext_vector_type(2))); typedef __bf16 bf16x2_t __attribute__((ext_vector_type(2)));
constexpr int SEQ = 4096, INW = 6144, DMODEL = 2048;
constexpr int KP = 272, VP = 320;
constexpr int DIFF_TILE = 128 * KP + 128 * VP;
constexpr int DIL_WAVE = 32 * KP + 32 * VP;
__device__ __forceinline__ unsigned cvtpk(float lo, float hi) { f32x2_t v = {lo, hi}; bf16x2_t b = __builtin_convertvector(v, bf16x2_t); return __builtin_bit_cast(unsigned, b); }
__device__ __forceinline__ int crow(int r, int hi) { return (r & 3) + 8 * (r >> 2) + 4 * hi; }
__device__ __forceinline__ s16x4 vtr(const LAS char* p) { return __builtin_bit_cast(s16x4, __builtin_amdgcn_ds_read_tr16_b64_v4i16((LAS v4i16_t*)p)); }
__device__ __forceinline__ bf16x8 packp(const f32x16& p, int s) {
    u32x4 w; w.x = cvtpk(p[8 * s], p[8 * s + 1]); w.y = cvtpk(p[8 * s + 2], p[8 * s + 3]); w.z = cvtpk(p[8 * s + 4], p[8 * s + 5]); w.w = cvtpk(p[8 * s + 6], p[8 * s + 7]);
    return __builtin_bit_cast(bf16x8, w);
}
#define MFMA32(a, b, c) __builtin_amdgcn_mfma_f32_32x32x16_bf16((a), (b), (c), 0, 0, 0)

__device__ __forceinline__ void diff_unit(LAS char* lds, const bf16_t* QKV, bf16_t* MIX, int b, int h, int qblk, float lam, float negM, const float* g_bout, int tid, int wid, int lane) {
    const int c = wid >> 2, r32 = lane & 31, hh = lane >> 5, cb = (lane >> 4) & 1, q_ = (lane & 15) >> 2, p_ = lane & 3;
    const size_t rowbase = (size_t)b * SEQ; const int q0 = qblk * 128 + (wid & 3) * 32;
    bf16x8 qf[4];
    { const bf16_t* qp = QKV + (rowbase + q0 + r32) * INW + 3072 + h * 128 + c * 64 + 8 * hh;
#pragma unroll
      for (int ks = 0; ks < 4; ++ks) qf[ks] = *(const bf16x8*)(qp + 16 * ks); }
    const int srow = tid >> 4, sch = tid & 15;
    const bf16_t* kg = QKV + (rowbase + srow) * INW + 4096 + h * 128 + sch * 8;
    const bf16_t* vg = kg + 1024;
    LAS char* kst = lds + srow * KP + sch * 16; LAS char* vst = lds + 128 * KP + srow * VP + sch * 16;
    f32x16 o[4];
#pragma unroll
    for (int i = 0; i < 4; ++i)
#pragma unroll
        for (int r = 0; r < 16; ++r) o[i][r] = 0.f;
    float lsum = 0.f;
    f32x16 negm;
#pragma unroll
    for (int r = 0; r < 16; ++r) negm[r] = negM;
    u32x4 kr[4], vr[4];
#pragma unroll
    for (int i = 0; i < 4; ++i) { kr[i] = *(const u32x4*)(kg + (size_t)(32 * i) * INW); vr[i] = *(const u32x4*)(vg + (size_t)(32 * i) * INW); }
#pragma unroll
    for (int i = 0; i < 4; ++i) { *(LAS u32x4*)(kst + 32 * i * KP) = kr[i]; *(LAS u32x4*)(vst + 32 * i * VP) = vr[i]; }
    __syncthreads();
    const int NT = SEQ / 128;
    const LAS char* kread = lds + r32 * KP + (c * 64 + 8 * hh) * 2;
    const LAS char* vread = lds + 128 * KP + (4 * hh + q_) * VP + (16 * cb + 4 * p_) * 2;
    for (int t = 0; t < NT; ++t) {
        const int cur = (t & 1) * DIFF_TILE, nxt = DIFF_TILE - cur;
        const size_t go = (size_t)(t + 1) * 128 * INW; const bool more = t + 1 < NT;
        if (more) {
#pragma unroll
            for (int i = 0; i < 4; ++i) kr[i] = *(const u32x4*)(kg + go + (size_t)(32 * i) * INW); }
        f32x16 pA0 = negm, pA1 = negm, pB0 = negm, pB1 = negm;
#pragma unroll
        for (int ks = 0; ks < 4; ++ks) {
            const bf16x8 k0 = *(const LAS bf16x8*)(kread + cur + ks * 32), k1 = *(const LAS bf16x8*)(kread + cur + 32 * KP + ks * 32);
            pA0 = MFMA32(k0, qf[ks], pA0); pA1 = MFMA32(k1, qf[ks], pA1);
        }
#pragma unroll
        for (int ks = 0; ks < 4; ++ks) {
            const bf16x8 k0 = *(const LAS bf16x8*)(kread + cur + 64 * KP + ks * 32), k1 = *(const LAS bf16x8*)(kread + cur + 96 * KP + ks * 32);
            pB0 = MFMA32(k0, qf[ks], pB0); pB1 = MFMA32(k1, qf[ks], pB1);
        }
        if (more) {
#pragma unroll
            for (int i = 0; i < 4; ++i) *(LAS u32x4*)(kst + nxt + 32 * i * KP) = kr[i];
#pragma unroll
            for (int i = 0; i < 4; ++i) kr[i] = *(const u32x4*)(vg + go + (size_t)(32 * i) * INW); }
        float sa = 0.f, sb = 0.f;
#pragma unroll
        for (int r = 0; r < 16; ++r) { pA0[r] = __builtin_amdgcn_exp2f(pA0[r]); pA1[r] = __builtin_amdgcn_exp2f(pA1[r]); sa += pA0[r]; sb += pA1[r]; }
        bf16x8 pf[4]; pf[0] = packp(pA0, 0); pf[1] = packp(pA0, 1); pf[2] = packp(pA1, 0); pf[3] = packp(pA1, 1);
#pragma unroll
        for (int kst4 = 0; kst4 < 4; ++kst4)
#pragma unroll
            for (int db = 0; db < 4; ++db) {
                const LAS char* a = vread + cur + kst4 * 16 * VP + db * 64;
                const s16x4 lo = vtr(a), hi = vtr(a + 8 * VP);
                const bf16x8 vf = __builtin_shufflevector(lo, hi, 0, 1, 2, 3, 4, 5, 6, 7);
                o[db] = MFMA32(vf, pf[kst4], o[db]);
            }
#pragma unroll
        for (int r = 0; r < 16; ++r) { pB0[r] = __builtin_amdgcn_exp2f(pB0[r]); pB1[r] = __builtin_amdgcn_exp2f(pB1[r]); sa += pB0[r]; sb += pB1[r]; }
        lsum += sa + sb;
        pf[0] = packp(pB0, 0); pf[1] = packp(pB0, 1); pf[2] = packp(pB1, 0); pf[3] = packp(pB1, 1);
#pragma unroll
        for (int kst4 = 0; kst4 < 4; ++kst4)
#pragma unroll
            for (int db = 0; db < 4; ++db) {
                const LAS char* a = vread + cur + (64 + kst4 * 16) * VP + db * 64;
                const s16x4 lo = vtr(a), hi = vtr(a + 8 * VP);
                const bf16x8 vf = __builtin_shufflevector(lo, hi, 0, 1, 2, 3, 4, 5, 6, 7);
                o[db] = MFMA32(vf, pf[kst4], o[db]);
            }
        if (more) {
#pragma unroll
            for (int i = 0; i < 4; ++i) *(LAS u32x4*)(vst + nxt + 32 * i * VP) = kr[i]; }
        __syncthreads();
    }
    const int lane_e = lane_opaque();
    lsum += shflx(lsum, 32, lane_e);
    float inv = 1.0f / lsum; if (c == 1) inv *= lam;
    const int r32e = lane_e & 31, hhe = lane_e >> 5;
    LAS float* X = (LAS float*)lds + (wid & 3) * 4096;
    if (c == 1) {
#pragma unroll
        for (int db = 0; db < 4; ++db)
#pragma unroll
            for (int r = 0; r < 16; ++r) X[(db * 32 + crow(r, hhe)) * 32 + r32e] = o[db][r] * inv;
    }
    __syncthreads();
    if (c == 0) {
        float ss = 0.f;
#pragma unroll
        for (int db = 0; db < 4; ++db)
#pragma unroll
            for (int r = 0; r < 16; ++r) { const float v = o[db][r] * inv - X[(db * 32 + crow(r, hhe)) * 32 + r32e]; o[db][r] = v; ss += v * v; }
        ss += shflx(ss, 32, lane_e);
        const float rn = __builtin_amdgcn_rsqf(ss * (1.0f / 128.0f) + 1e-6f) * 0.8f;
        bf16_t* op = MIX + (rowbase + q0 + r32e) * DMODEL + 1024 + h * 128;
#pragma unroll
        for (int db = 0; db < 4; ++db)
#pragma unroll
            for (int g4 = 0; g4 < 4; ++g4) { const int d0 = db * 32 + 8 * g4 + 4 * hhe; const f32x4 gg = *(const f32x4*)(g_bout + d0);
                u32x2 w; w.x = cvtpk(o[db][4 * g4] * rn * gg[0], o[db][4 * g4 + 1] * rn * gg[1]); w.y = cvtpk(o[db][4 * g4 + 2] * rn * gg[2], o[db][4 * g4 + 3] * rn * gg[3]);
                *(u32x2*)(op + d0) = w; }
    }
    __syncthreads();
}

template <int MODE> __device__ __forceinline__ void dil_unit(LAS char* wl, const bf16_t* QKV, bf16_t* MIX, float* Opart, float* Lpart, int b, int h, int r16, int ib, float negM, const float* g_aout, int lane) {
    const int r32 = lane & 31, hh = lane >> 5, cb = (lane >> 4) & 1, q_ = (lane & 15) >> 2, p_ = lane & 3;
    const size_t rowbase = (size_t)b * SEQ;
    const int t0 = MODE ? r16 + 512 * ib : 32 * (8 * r16 + ib), qs = MODE ? 16 : 1;
    const int tq = t0 + qs * r32;
    bf16x8 qf[8];
    { const bf16_t* qp = QKV + (rowbase + tq) * INW + h * 128 + 8 * hh;
#pragma unroll
      for (int ks = 0; ks < 8; ++ks) qf[ks] = *(const bf16x8*)(qp + 16 * ks); }
    f32x16 o[4];
#pragma unroll
    for (int i = 0; i < 4; ++i)
#pragma unroll
        for (int r = 0; r < 16; ++r) o[i][r] = 0.f;
    float lsum = 0.f;
    f32x16 negm;
#pragma unroll
    for (int r = 0; r < 16; ++r) negm[r] = negM;
    const int lrow = lane >> 4, lch = lane & 15;
    const bf16_t* kvg = QKV + rowbase * INW + 1024 + h * 128 + lch * 8;
    LAS char* kst = wl + lrow * KP + lch * 16; LAS char* vst = wl + 32 * KP + lrow * VP + lch * 16;
    const LAS char* kread = wl + r32 * KP + 8 * hh * 2;
    const LAS char* vread = wl + 32 * KP + (4 * hh + q_) * VP + (16 * cb + 4 * p_) * 2;
    int klo0, khi0, klo1, khi1, klo2, khi2;
    { const int bq = t0 >> 4; int lo_i = bq - 64; if (lo_i < 0) lo_i = 0; klo0 = lo_i >> 5; khi0 = (bq + 31 * (qs >> 4) + 64) >> 5; if (khi0 > 7) khi0 = 7; }
    { const int bq = t0 >> 2; int lo_i = bq - 64; if (lo_i < 0) lo_i = 0; klo1 = lo_i >> 5; khi1 = (bq + 31 * (qs >> 2) + 64) >> 5; if (khi1 > 31) khi1 = 31; }
    { const int bq = t0;      int lo_i = bq - 64; if (lo_i < 0) lo_i = 0; klo2 = lo_i >> 5; khi2 = (bq + 31 * qs + 64) >> 5;        if (khi2 > 127) khi2 = 127; }
    constexpr int PAT_END = MODE ? 2 : 3;
    int pat = MODE ? 0 : 2, kb = MODE ? klo0 : klo2;
    u32x4 kr[8], vr[8];
#define DIL_LOADK(PAT, KB) do { const int sh_ = 4 - 2 * (PAT); const int rc_ = t0 & ((1 << sh_) - 1); \
        _Pragma("unroll") for (int i = 0; i < 8; ++i) { const int tok = rc_ + ((32 * (KB) + lrow + 4 * i) << sh_); kr[i] = *(const u32x4*)(kvg + (size_t)tok * INW); } } while (0)
#define DIL_LOADV(PAT, KB) do { const int sh_ = 4 - 2 * (PAT); const int rc_ = t0 & ((1 << sh_) - 1); \
        _Pragma("unroll") for (int i = 0; i < 8; ++i) { const int tok = rc_ + ((32 * (KB) + lrow + 4 * i) << sh_); vr[i] = *(const u32x4*)(kvg + (size_t)tok * INW + 1024); } } while (0)
#define DIL_ADV() do { const int hi_c = pat == 0 ? khi0 : (pat == 1 ? khi1 : khi2); if (kb < hi_c) ++kb; else { ++pat; kb = pat == 1 ? klo1 : klo2; } } while (0)
#define DIL_WFENCE() do { __builtin_amdgcn_fence(__ATOMIC_RELEASE, "wavefront"); __builtin_amdgcn_wave_barrier(); __builtin_amdgcn_fence(__ATOMIC_ACQUIRE, "wavefront"); } while (0)
#define DIL_S(P) do { P = negm; _Pragma("unroll") for (int ks = 0; ks < 8; ++ks) { const bf16x8 kf = *(const LAS bf16x8*)(kread + ks * 32); P = MFMA32(kf, qf[ks], P); } } while (0)
    int cpat = pat, ckb = kb;
    DIL_LOADK(pat, kb); DIL_LOADV(pat, kb);
#pragma unroll
    for (int i = 0; i < 8; ++i) { *(LAS u32x4*)(kst + 4 * i * KP) = kr[i]; *(LAS u32x4*)(vst + 4 * i * VP) = vr[i]; }
    DIL_ADV();
    bool have1 = pat < PAT_END;
    int npat = pat, nkb = kb;
    if (have1) { DIL_LOADK(pat, kb); DIL_LOADV(pat, kb); DIL_ADV(); }
    DIL_WFENCE();
    f32x16 p, pn;
    DIL_S(p);
    for (;;) {
        const bool have2 = have1 && pat < PAT_END;
        __builtin_amdgcn_iglp_opt(0);
        if (have1) {
            DIL_WFENCE();
#pragma unroll
            for (int i = 0; i < 8; ++i) *(LAS u32x4*)(kst + 4 * i * KP) = kr[i];
            if (have2) DIL_LOADK(pat, kb);
            DIL_WFENCE();
            DIL_S(pn);
        }
        const int sh = 4 - 2 * cpat;
        const int qi = (t0 >> sh) + (qs >> sh) * r32;
        float sa = 0.f;
#pragma unroll
        for (int r = 0; r < 16; ++r) { const int dl = 32 * ckb + crow(r, hh) - qi; const float e = __builtin_amdgcn_exp2f(p[r]); const float pv = (dl <= 64 && dl >= -64) ? e : 0.f; p[r] = pv; sa += pv; }
        lsum += sa;
        bf16x8 pf[2]; pf[0] = packp(p, 0); pf[1] = packp(p, 1);
#pragma unroll
        for (int s = 0; s < 2; ++s)
#pragma unroll
            for (int db = 0; db < 4; ++db) {
                const LAS char* a = vread + s * 16 * VP + db * 64;
                const s16x4 lo = vtr(a), hi = vtr(a + 8 * VP);
                const bf16x8 vf = __builtin_shufflevector(lo, hi, 0, 1, 2, 3, 4, 5, 6, 7);
                o[db] = MFMA32(vf, pf[s], o[db]);
            }
        if (!have1) break;
        DIL_WFENCE();
#pragma unroll
        for (int i = 0; i < 8; ++i) *(LAS u32x4*)(vst + 4 * i * VP) = vr[i];
        if (have2) DIL_LOADV(pat, kb);
        DIL_WFENCE();
        p = pn; cpat = npat; ckb = nkb; npat = pat; nkb = kb; have1 = have2;
        if (have2) DIL_ADV();
    }
#undef DIL_LOADK
#undef DIL_LOADV
#undef DIL_ADV
#undef DIL_WFENCE
#undef DIL_S
    const int lane_f = lane_opaque(), hhf = lane_f >> 5, tqf = t0 + qs * (lane_f & 31);
    lsum += shflx(lsum, 32, lane_f);
    float* pp = Opart + ((rowbase + tqf) * 8 + h) * 128; float* lp = Lpart + (rowbase + tqf) * 8 + h;
    if (MODE == 0) {
#pragma unroll
        for (int db = 0; db < 4; ++db)
#pragma unroll
            for (int g4 = 0; g4 < 4; ++g4) *(f32x4*)(pp + db * 32 + 8 * g4 + 4 * hhf) = (f32x4){o[db][4 * g4], o[db][4 * g4 + 1], o[db][4 * g4 + 2], o[db][4 * g4 + 3]};
        if (hhf == 0) *lp = lsum;
        return;
    }
    lsum += *lp;
#pragma unroll
    for (int db = 0; db < 4; ++db)
#pragma unroll
        for (int g4 = 0; g4 < 4; ++g4) { const f32x4 t = *(const f32x4*)(pp + db * 32 + 8 * g4 + 4 * hhf); o[db][4 * g4] += t[0]; o[db][4 * g4 + 1] += t[1]; o[db][4 * g4 + 2] += t[2]; o[db][4 * g4 + 3] += t[3]; }
    const float inv = 1.0f / lsum; float ss = 0.f;
#pragma unroll
    for (int db = 0; db < 4; ++db)
#pragma unroll
        for (int r = 0; r < 16; ++r) { const float v = o[db][r] * inv; o[db][r] = v; ss += v * v; }
    ss += shflx(ss, 32, lane_f);
    const float rn = __builtin_amdgcn_rsqf(ss * (1.0f / 128.0f) + 1e-6f);
    bf16_t* op = MIX + (rowbase + tqf) * DMODEL + h * 128;
#pragma unroll
    for (int db = 0; db < 4; ++db)
#pragma unroll
        for (int g4 = 0; g4 < 4; ++g4) { const int d0 = db * 32 + 8 * g4 + 4 * hhf; const f32x4 gg = *(const f32x4*)(g_aout + d0);
            u32x2 w; w.x = cvtpk(o[db][4 * g4] * rn * gg[0], o[db][4 * g4 + 1] * rn * gg[1]); w.y = cvtpk(o[db][4 * g4 + 2] * rn * gg[2], o[db][4 * g4 + 3] * rn * gg[3]);
            *(u32x2*)(op + d0) = w; }
}
}

constexpr int NWAVES = 8;
constexpr int DM = 2048, NBATCH = 2, SEQ = 4096, MROWS = NBATCH * SEQ, DFF = 5632, INW = 6144;
constexpr size_t MiB = 1u << 20;
constexpr size_t WS_CTL = 0;
constexpr size_t OFF_GTAB = 1 * MiB - 4096;
constexpr size_t OFF_RS0 = 917504;
constexpr size_t OFF_BAR = 983040, BAR_BYTES = 16384;
constexpr size_t OFF_RS1 = 0, OFF_RS2 = 32768, OFF_ROPEA = 65536, OFF_ROPEB = OFF_ROPEA + 2 * 4096 * 16 * 4;
constexpr int LDK = pg8::LDK, LDQ = pg8::LDQ;
constexpr size_t WS_W1A = 1 * MiB, WS_W1B = WS_W1A + 47 * MiB, WS_WIN = WS_W1B + 22 * MiB, WS_WOUT = WS_WIN + 26 * MiB, WS_W2A = WS_WOUT + 9 * MiB, WS_W2B = WS_W2A + 47 * MiB;
constexpr size_t WS_XN = WS_W2B + 22 * MiB;
constexpr size_t WS_ACT = WS_XN + 34 * MiB;
constexpr size_t WS_MIX = WS_ACT + 98 * MiB;
constexpr size_t WS_OPART = WS_MIX + 34 * MiB;
constexpr size_t WS_LPART = WS_OPART + 32 * MiB;
constexpr size_t WS_END = WS_LPART + 1 * MiB;
constexpr int LDS_BYTES = 155648;
constexpr int XCH_OFF = 131072;
static_assert((size_t)11264 * LDK * 2 <= 47 * MiB && (size_t)6144 * LDK * 2 <= 26 * MiB && (size_t)2048 * LDK * 2 <= 9 * MiB && (size_t)8192 * LDK * 2 <= 34 * MiB && (size_t)8192 * LDQ * 2 <= 98 * MiB && att::INW == LDQ && att::DMODEL == LDK, "ws map");
static_assert(att::DIL_WAVE * 8 <= LDS_BYTES - 64 && 3456 * 4 <= BAR_BYTES && 2 * att::DIFF_TILE <= LDS_BYTES - 64 && XCH_OFF + 8192 <= LDS_BYTES, "LDS map");

#define LAS __attribute__((address_space(3)))
typedef unsigned short bf16;
typedef unsigned v4u __attribute__((ext_vector_type(4)));
typedef unsigned v2u __attribute__((ext_vector_type(2)));
typedef float f32x4 __attribute__((ext_vector_type(4)));
__device__ __forceinline__ unsigned f2bf(float f) { unsigned u = __builtin_bit_cast(unsigned, f); return (u + 0x7fffu + ((u >> 16) & 1u)) >> 16; }
__device__ __forceinline__ unsigned pk2(float lo, float hi) { return f2bf(lo) | (f2bf(hi) << 16); }
__device__ __forceinline__ float wave_sum(float v, int lane) {
#pragma unroll
    for (int o = 1; o < 64; o <<= 1) v += shflx(v, o, lane);
    return v;
}
__device__ __forceinline__ float wave_max(float v, int lane) {
#pragma unroll
    for (int o = 1; o < 64; o <<= 1) v = fmaxf(v, shflx(v, o, lane));
    return v;
}
template <bool GLU> __device__ __forceinline__ void tr_load(const float* W, int N, int item, int lane, f32x4 (&v)[8], const float* gk) {
    const int nblk = N / 32, kb = item / nblk, nb = item % nblk, k0 = 64 * kb, n0 = 32 * nb;
    const float* src = W + (size_t)(k0 + (lane >> 3)) * N + n0 + 4 * (lane & 7);
#pragma unroll
    for (int i = 0; i < 8; ++i) v[i] = __builtin_nontemporal_load((const f32x4*)(src + (size_t)(8 * i) * N));
    if (gk) {
#pragma unroll
        for (int i = 0; i < 8; ++i) v[i] = v[i] * gk[k0 + (lane >> 3) + 8 * i]; }
}
template <bool GLU> __device__ __forceinline__ void tr_store(int K, int N, bf16* WT, int ldw, LAS float* scr, int item, int lane, const f32x4 (&v)[8]) {
    const int nblk = N / 32, kb = item / nblk, nb = item % nblk, k0 = 64 * kb, n0 = 32 * nb;
    int r0 = n0;
    if (GLU) { const int half = N / 2; r0 = n0 < half ? (n0 >> 7) * 256 + (n0 & 127) : ((n0 - half) >> 7) * 256 + 128 + ((n0 - half) & 127); }
    const int rg = lane >> 3, c4 = lane & 7;
#pragma unroll
    for (int i = 0; i < 8; ++i) { LAS float* d = scr + (8 * i + rg) * 33 + 4 * c4; d[0] = v[i][0]; d[1] = v[i][1]; d[2] = v[i][2]; d[3] = v[i][3]; }
    asm volatile("s_waitcnt lgkmcnt(0)" ::: "memory");
    const int c = lane & 7;
#pragma unroll
    for (int j = 0; j < 4; ++j) { const int n = (lane >> 3) + 8 * j; const LAS float* s = scr + (8 * c) * 33 + n;
        v4u o; o.x = pk2(s[0 * 33], s[1 * 33]); o.y = pk2(s[2 * 33], s[3 * 33]); o.z = pk2(s[4 * 33], s[5 * 33]); o.w = pk2(s[6 * 33], s[7 * 33]);
        *(v4u*)(WT + (size_t)(r0 + n) * ldw + k0 + 8 * c) = o; }
    asm volatile("s_waitcnt lgkmcnt(0)" ::: "memory");
}
template <bool GLU, int NIF> __device__ __forceinline__ void tr_matrix(const float* W, int K, int N, bf16* WT, int ldw, LAS float* scr, int gw, int NGW, int lane, const float* gk) {
    const int nitems = (K / 64) * (N / 32);
    for (int it = gw; it < nitems; it += NIF * NGW) {
        f32x4 v[NIF][8];
#pragma unroll
        for (int j = 0; j < NIF; ++j) if (it + j * NGW < nitems) tr_load<GLU>(W, N, it + j * NGW, lane, v[j], gk);
#pragma unroll
        for (int j = 0; j < NIF; ++j) if (it + j * NGW < nitems) tr_store<GLU>(K, N, WT, ldw, scr, it + j * NGW, lane, v[j]);
    }
}

#define XB_TMO      128
#define XB_XCNT(j)  (256  + 64 * (j))
#define XB_XSUB(j)  (1280 + 64 * (j))
#define XB_XGEN(j)  (2304 + 64 * (j))
#define XB_TOP      3328
#define XB_TOPGEN   3392
#define XCD_BAR_WORDS 3456
#define XB_SPIN_CAP (1u << 18)

__device__ __forceinline__ unsigned xb_ld(unsigned* p)              { return __hip_atomic_load(p, __ATOMIC_RELAXED, __HIP_MEMORY_SCOPE_AGENT); }
__device__ __forceinline__ unsigned xb_add(unsigned* p, unsigned v) { return __hip_atomic_fetch_add(p, v, __ATOMIC_RELAXED, __HIP_MEMORY_SCOPE_AGENT); }
__device__ __forceinline__ unsigned xb_xcc_id() { return (unsigned)__builtin_amdgcn_s_getreg((3 << 11) | 20) & 0xFu; }
#define XB_SPIN(cond, bar) do { unsigned _sp = 0; while (cond) { __builtin_amdgcn_s_sleep(1); \
    if ((++_sp & 255u) == 0u) { if (xb_ld(&(bar)[XB_TMO])) break; if (_sp > XB_SPIN_CAP) { atomicAdd(&(bar)[XB_TMO], 1u); break; } } } } while (0)

struct XcdBarrier {
    unsigned* bar; unsigned x; int wid;
    volatile LAS unsigned* st;
};

__device__ __forceinline__ bool xb_lane0() { return lane_opaque() == 0; }
__device__ __forceinline__ XcdBarrier xcd_barrier_post(unsigned* bar, volatile LAS unsigned* st, int wid) {
    XcdBarrier b; b.bar = bar; b.x = xb_xcc_id(); b.st = st; b.wid = wid;
    if (wid == 0 && xb_lane0()) (void)xb_add(&bar[XB_XCNT(b.x)], 1u);
    return b;
}
__device__ __forceinline__ void xcd_barrier_complete(unsigned* bar, unsigned x, unsigned& nloc, unsigned& nx) {
    const unsigned G = gridDim.x * gridDim.y * gridDim.z;
    unsigned sum, cnt, mine, sp = 0u;
    for (;;) {
        sum = 0u; cnt = 0u; mine = 0u;
#pragma unroll
        for (unsigned j = 0; j < 16; ++j) { const unsigned c = xb_ld(&bar[XB_XCNT(j)]); sum += c; cnt += (c > 0u) ? 1u : 0u; mine = (j == x) ? c : mine; }
        if (sum == G) break;
        __builtin_amdgcn_s_sleep(1);
        if ((++sp & 255u) == 0u) { if (xb_ld(&bar[XB_TMO])) break; if (sp > XB_SPIN_CAP) { atomicAdd(&bar[XB_TMO], 1u); break; } }
    }
    nloc = mine > 0u ? mine : 1u; nx = cnt > 0u ? cnt : 1u;
}

__device__ __forceinline__ void xcd_barrier(const XcdBarrier& b) {
    asm volatile("s_waitcnt vmcnt(0)" ::: "memory");
    __syncthreads();
    if (b.wid == 0 && xb_lane0()) {
        unsigned* bar = b.bar;
        __builtin_amdgcn_s_waitcnt(0);
        unsigned nloc = b.st[0], nx = b.st[1];
        if (nloc == 0u) { xcd_barrier_complete(bar, b.x, nloc, nx); b.st[0] = nloc; b.st[1] = nx; }
        const unsigned old = xb_add(&bar[XB_XSUB(b.x)], 1u);
        const unsigned gen = old / nloc;
        if (old + 1u == (gen + 1u) * nloc) {
            __builtin_amdgcn_fence(__ATOMIC_RELEASE, "agent");
            asm volatile("s_waitcnt vmcnt(0)" ::: "memory");
            const unsigned og = xb_add(&bar[XB_TOP], 1u);
            const unsigned tg = og / nx;
            if (og + 1u == (tg + 1u) * nx) xb_add(&bar[XB_TOPGEN], 1u);
            else XB_SPIN(xb_ld(&bar[XB_TOPGEN]) == tg, bar);
            __builtin_amdgcn_fence(__ATOMIC_ACQUIRE, "agent");
            xb_add(&bar[XB_XGEN(b.x)], 1u);
            asm volatile("s_waitcnt vmcnt(0)" ::: "memory");
        } else {
            XB_SPIN(xb_ld(&bar[XB_XGEN(b.x)]) == gen, bar);
            __builtin_amdgcn_fence(__ATOMIC_ACQUIRE, "agent");
            asm volatile("s_waitcnt vmcnt(0)" ::: "memory");
        }
    }
    __syncthreads();
}

struct Args {
    const float* in[20]; float* out; unsigned char* ws;
    float invA[16]; float invB[8];
};

__global__ void __launch_bounds__(NWAVES * 64) hybrid_fwd(Args args) {
    extern __shared__ __attribute__((aligned(16))) unsigned char lds_raw[];
    cg::grid_group grid = cg::this_grid();
    LAS unsigned char* lds = (LAS unsigned char*)lds_raw;
    const int wid = __builtin_amdgcn_readfirstlane((int)threadIdx.x >> 6);
#define fresh_lane() lane_opaque()
    const int lane = fresh_lane(), tid = wid * 64 + lane;
    const int G = gridDim.x, bx = blockIdx.x;
    unsigned char* ws = args.ws;
    volatile LAS unsigned* MISC = (volatile LAS unsigned*)(lds + LDS_BYTES - 64);
    if (tid < 16) MISC[tid] = 0u;
    __syncthreads();
    const XcdBarrier bar = xcd_barrier_post((unsigned*)(ws + OFF_BAR), MISC + 8, wid);
    if (G == 0x7fffffff) grid.sync();
    const float* x = args.in[0];
    float* out = args.out;
    float* rowss1 = (float*)(ws + OFF_RS1); float* rowss2 = (float*)(ws + OFF_RS2);
    float* gtab = (float*)(ws + OFF_GTAB); float* ropeA = (float*)(ws + OFF_ROPEA); float* ropeB = (float*)(ws + OFF_ROPEB);
    bf16* W1A = (bf16*)(ws + WS_W1A); bf16* W1B = (bf16*)(ws + WS_W1B); bf16* WIN = (bf16*)(ws + WS_WIN); bf16* WOUT = (bf16*)(ws + WS_WOUT);
    bf16* W2A = (bf16*)(ws + WS_W2A); bf16* W2B = (bf16*)(ws + WS_W2B);
    bf16* XN = (bf16*)(ws + WS_XN); bf16* ACT = (bf16*)(ws + WS_ACT); bf16* QKV = (bf16*)(ws + WS_ACT); bf16* MIX = (bf16*)(ws + WS_MIX);

#ifndef REP_P0
#define REP_P0 1
#endif
#ifndef REP_DIFF
#define REP_DIFF 1
#endif
#ifndef REP_DIL
#define REP_DIL 1
#endif
#define REP_G1 1
#define REP_SHADOW 1
#define REP_G2 1
#define REP_G3 1
#define REP_G5 1
#define REP_G6 1
#define REP_G7 1
    for (int rep = 0; rep < REP_P0; ++rep) {
        LAS float* scr = (LAS float*)(lds + wid * 16384);
        const int gw = bx * NWAVES + wid, NGW = G * NWAVES;
        constexpr int I_FA = (DM / 64) * (2 * DFF / 32), I_FB = (DFF / 64) * (DM / 32), I_IN = (DM / 64) * (INW / 32), I_OUT = (DM / 64) * (DM / 32);
        tr_matrix<true, 2>(args.in[2], DM, 2 * DFF, W1A, LDK, scr, gw, NGW, lane, args.in[1]);
        tr_matrix<true, 2>(args.in[18], DM, 2 * DFF, W2A, LDK, scr, gw, NGW, lane, args.in[17]);
        float* rowss0 = (float*)(ws + OFF_RS0);
        for (int m = gw; m < MROWS; m += NGW) {
            const f32x4* xr = (const f32x4*)(x + (size_t)m * DM) + lane; f32x4 v[8]; float s = 0.f;
#pragma unroll
            for (int j = 0; j < 8; ++j) { v[j] = __builtin_nontemporal_load(xr + 64 * j); s += (v[j][0] * v[j][0] + v[j][1] * v[j][1]) + (v[j][2] * v[j][2] + v[j][3] * v[j][3]); }
            s = wave_sum(s, lane); if (lane == 0) rowss0[m] = s;
            v2u* o8 = (v2u*)(XN + (size_t)m * LDK) + lane;
#pragma unroll
            for (int j = 0; j < 8; ++j) { v2u w; w.x = pk2(v[j][0], v[j][1]); w.y = pk2(v[j][2], v[j][3]); o8[64 * j] = w; }
        }
        const int gt = bx * (NWAVES * 64) + tid, NGT = G * NWAVES * 64;
        for (int i = gt; i < 2 * MROWS; i += NGT) rowss1[i] = 0.f;
        if (gt < 512) { const int t = gt >> 7, d = gt & 127; gtab[gt] = t == 0 ? args.in[6][d] : (t == 1 ? args.in[7][d] : (t == 2 ? args.in[8][d & 63] : args.in[9][d & 63])); }
        for (int i = gt; i < 4096 * 24; i += NGT) {
            const int s = i / 24, k = i % 24; const float inv = k < 16 ? args.invA[k] : args.invB[k - 16];
            const float ang = (float)s * inv; double rev = (double)ang * 0.15915494309189535; rev -= floor(rev);
            const float cs = __builtin_amdgcn_cosf((float)rev), sn = __builtin_amdgcn_sinf((float)rev);
            if (k < 16) { ropeA[s * 16 + k] = cs; ropeA[4096 * 16 + s * 16 + k] = sn; } else { ropeB[s * 8 + k - 16] = cs; ropeB[4096 * 8 + s * 8 + k - 16] = sn; }
        }
    }
    xcd_barrier(bar);

    { pg8::Gemm g{XN, W1A, MROWS, 2 * DFF, DM, LDK}; pg8::StaticOrder S; S.init(MROWS, 2 * DFF, G, bx);
      pg8::EpiSwiGLU E{ACT, DFF, (const float*)(ws + OFF_RS0)};
      pg8::gemm_phase<pg8::EpiSwiGLU, pg8::StaticOrder, true, true>(lds, g, S, E, wid); }
    {
        constexpr int NU = (MROWS / 256) * (2 * DFF / 256);
        const int rounds = (NU + G - 1) / G; int first_idle = NU - (rounds - 1) * G, nidle = G - first_idle;
        if (nidle <= 0) { first_idle = 0; nidle = G; }
        if (bx >= first_idle) {
            LAS float* scr = (LAS float*)(lds + wid * 16384); const int lane_c = fresh_lane();
            const int gw = (bx - first_idle) * NWAVES + wid, NGW = nidle * NWAVES;
            for (int rep = 0; rep < REP_SHADOW; ++rep) {
            tr_matrix<false, 2>(args.in[3], DFF, DM, W1B, DFF, scr, gw, NGW, lane_c, nullptr);
            tr_matrix<false, 2>(args.in[5], DM, INW, WIN, LDK, scr, gw, NGW, lane_c, args.in[4]);
            tr_matrix<false, 2>(args.in[16], DM, DM, WOUT, LDK, scr, gw, NGW, lane_c, nullptr);
            }
        }
    }
    xcd_barrier(bar);
    { pg8::Gemm g{ACT, W1B, MROWS, DM, DFF, DFF}; pg8::StaticOrder S; S.init(MROWS, DM, G, bx);
      pg8::EpiResid<false, true, false> E{nullptr, nullptr, XN, rowss1, 0.5f};
      pg8::gemm_phase<pg8::EpiResid<false, true, false>, pg8::StaticOrder, true, true>(lds, g, S, E, wid); }
    xcd_barrier(bar);
    { pg8::Gemm g{XN, WIN, MROWS, INW, DM, LDK}; pg8::StaticOrder S; S.init(MROWS, INW, G, bx);
      pg8::EpiQKV E{QKV, rowss1, gtab, ropeA, ropeB, (LAS float*)(lds + XCH_OFF)};
      for (int rep = 0; rep < REP_G3; ++rep)
      pg8::gemm_phase<pg8::EpiQKV, pg8::StaticOrder, true, true>(lds, g, S, E, wid); }
    xcd_barrier(bar);
    {
        const float L2E = 1.4426950408889634f;
        const int lane_a = fresh_lane();
        const float gq = fmaxf(fabsf(args.in[6][lane_a]), fabsf(args.in[6][lane_a + 64])), gk = fmaxf(fabsf(args.in[7][lane_a]), fabsf(args.in[7][lane_a + 64]));
        const float negMA = __builtin_bit_cast(float, __builtin_amdgcn_readfirstlane(__builtin_bit_cast(int, -1.02f * 11.313708498984761f * wave_max(gq, lane_a) * wave_max(gk, lane_a) * L2E)));
        const float negMB = __builtin_bit_cast(float, __builtin_amdgcn_readfirstlane(__builtin_bit_cast(int, -1.02f * 8.0f * wave_max(fabsf(args.in[8][lane_a]), lane_a) * wave_max(fabsf(args.in[9][lane_a]), lane_a) * L2E)));
        const float lam = __builtin_bit_cast(float, __builtin_amdgcn_readfirstlane(__builtin_bit_cast(int, __expf(wave_sum(args.in[10][lane_a] * args.in[11][lane_a], lane_a)) - __expf(wave_sum(args.in[12][lane_a] * args.in[13][lane_a], lane_a)) + 0.2f)));
        float* Opart = (float*)(ws + WS_OPART); float* Lpart = (float*)(ws + WS_LPART);
        {
            const int lane_d = fresh_lane();
            for (int wu = bx * NWAVES + wid; wu < 2048; wu += G * NWAVES) {
                int ib = wu & 7, r16 = (wu >> 3) & 15, h = (wu >> 7) & 7, b = wu >> 10;
                if (G == 256) { const int hb = (bx & 7) * 2 + (bx >> 7); r16 = (bx >> 3) & 15; h = hb & 7; b = hb >> 3; }
                att::dil_unit<0>((LAS char*)lds + wid * att::DIL_WAVE, QKV, MIX, Opart, Lpart, b, h, r16, ib, negMA, args.in[14], lane_d);
            }
        }
        xcd_barrier(bar);
        {
            const int tid_a = wid * 64 + fresh_lane();
            for (int rep = 0; rep < REP_DIFF; ++rep)
            for (int u = bx; u < 512; u += G) {
                int bh = u >> 5, qblk = u & 31;
                if (G == 256) { bh = (bx & 7) + 8 * (u >> 8); qblk = bx >> 3; }
                att::diff_unit((LAS char*)lds, QKV, MIX, bh >> 3, bh & 7, qblk, lam, negMB, args.in[15], tid_a, wid, tid_a & 63);
            }
        }
        {
            const int lane_d = fresh_lane();
            for (int rep = 0; rep < REP_DIL; ++rep)
            for (int wu = bx * NWAVES + wid; wu < 2048; wu += G * NWAVES) {
                int ib = wu & 7, r16 = (wu >> 3) & 15, h = (wu >> 7) & 7, b = wu >> 10;
                if (G == 256) { const int hb = (bx & 7) * 2 + (bx >> 7); r16 = (bx >> 3) & 15; h = hb & 7; b = hb >> 3; }
                att::dil_unit<1>((LAS char*)lds + wid * att::DIL_WAVE, QKV, MIX, Opart, Lpart, b, h, r16, ib, negMA, args.in[14], lane_d);
            }
        }
    }
    xcd_barrier(bar);
    { pg8::Gemm g{MIX, WOUT, MROWS, DM, DM, LDK}; pg8::StaticOrder S; S.init(MROWS, DM, G, bx);
      pg8::EpiResid<false, true, false> E{nullptr, nullptr, XN, rowss2, 1.0f};
      pg8::gemm_phase<pg8::EpiResid<false, true, false>, pg8::StaticOrder, true, true>(lds, g, S, E, wid); }
    xcd_barrier(bar);
    { pg8::Gemm g{XN, W2A, MROWS, 2 * DFF, DM, LDK}; pg8::StaticOrder S; S.init(MROWS, 2 * DFF, G, bx);
      pg8::EpiSwiGLU E{ACT, DFF, rowss2};
      for (int rep = 0; rep < REP_G6; ++rep)
      pg8::gemm_phase<pg8::EpiSwiGLU, pg8::StaticOrder, true, true>(lds, g, S, E, wid); }
    {
        constexpr int NU = (MROWS / 256) * (2 * DFF / 256);
        const int rounds = (NU + G - 1) / G; int first_idle = NU - (rounds - 1) * G, nidle = G - first_idle;
        if (nidle <= 0) { first_idle = 0; nidle = G; }
        if (bx >= first_idle) tr_matrix<false, 2>(args.in[19], DFF, DM, W2B, DFF, (LAS float*)(lds + wid * 16384), (bx - first_idle) * NWAVES + wid, nidle * NWAVES, fresh_lane(), nullptr);
    }
    xcd_barrier(bar);
    { pg8::Gemm g{ACT, W2B, MROWS, DM, DFF, DFF}; pg8::StaticOrder S; S.init(MROWS, DM, G, bx);
      pg8::EpiResid<false, false, true> E{nullptr, out, XN, nullptr, 0.5f};
      pg8::gemm_phase<pg8::EpiResid<false, false, true>, pg8::StaticOrder, true, true>(lds, g, S, E, wid); }
}

extern "C" void kernel_launch(void* const* d_in, const int* in_sizes, int n_in, void* d_out, int out_size, void* d_ws, size_t ws_size, hipStream_t stream) {
    static int grid = 0;
    if (grid == 0) {
        if (n_in != 20 || in_sizes[0] != MROWS * DM || out_size != MROWS * DM || ws_size < WS_END) {
            fprintf(stderr, "kernel_launch: unexpected shapes (n_in %d, in0 %d, out %d, ws %zu < %zu)\n", n_in, n_in > 0 ? in_sizes[0] : -1, out_size, ws_size, (size_t)WS_END); grid = -1; return; }
        int dev = 0, cus = 0, per_cu = 0;
        (void)hipGetDevice(&dev); (void)hipDeviceGetAttribute(&cus, hipDeviceAttributeMultiprocessorCount, dev);
        if (hipFuncSetAttribute((const void*)hybrid_fwd, hipFuncAttributeMaxDynamicSharedMemorySize, LDS_BYTES) != hipSuccess) { fprintf(stderr, "kernel_launch: hipFuncSetAttribute failed\n"); grid = -1; return; }
        if (hipOccupancyMaxActiveBlocksPerMultiprocessor(&per_cu, (const void*)hybrid_fwd, NWAVES * 64, LDS_BYTES) != hipSuccess || per_cu < 1) { fprintf(stderr, "kernel_launch: occupancy query says %d\n", per_cu); per_cu = 1; }
        (void)hipGetLastError();
        grid = cus * per_cu;
    }
    if (grid < 0) return;
    Args a{};
    for (int i = 0; i < 20; ++i) a.in[i] = (const float*)d_in[i];
    a.out = (float*)d_out; a.ws = (unsigned char*)d_ws;
    for (int i = 0; i < 16; ++i) a.invA[i] = (float)pow(500000.0, -(double)i / 16.0);
    for (int i = 0; i < 8; ++i) a.invB[i] = (float)pow(500000.0, -(double)i / 8.0);
    if (hipMemsetAsync((char*)d_ws + OFF_BAR, 0, BAR_BYTES, stream) != hipSuccess) { fprintf(stderr, "kernel_launch: memset failed\n"); return; }
    void* kargs[] = {&a};
    hipError_t e = hipLaunchCooperativeKernel((const void*)hybrid_fwd, dim3(grid), dim3(NWAVES * 64), kargs, LDS_BYTES, stream);
    if (e != hipSuccess) fprintf(stderr, "kernel_launch: cooperative launch failed: %s (grid %d)\n", hipGetErrorString(e), grid);
}
```
